# Optimizing an MI355X kernel written in HIP

```python
import math
import jax, jax.numpy as jnp
from jax import lax
import numpy as np

D_MODEL = 1024
BATCH = 16
SEQ = 2048
DEPTH = 2

GRID_W = 64
CTX_LEN = 256
EPS = 1e-6

NA_HEADS = 4
NA_DIM = 64
WIN_R = 8
WIN_C = 16
DIFF_HEADS = 4
DIFF_QK_DIM = 32
DIFF_V_DIM = 64
MLA_HEADS = 8
MLA_NOPE = 64
MLA_ROPE = 32
MLA_V = 64
MLA_Q_RANK = 256
MLA_KV_RANK = 128
ROPE_DIM = 32
ROPE_THETA = 10000.0
Q_BLOCK = 128

NA_W = NA_HEADS * NA_DIM
DIFF_W = DIFF_HEADS * DIFF_V_DIM
MLA_W = MLA_HEADS * MLA_V
MIX_W = NA_W + DIFF_W + MLA_W
NA_COLS = 3 * NA_W
DIFF_QK_COLS = DIFF_HEADS * 2 * DIFF_QK_DIM
DIFF_COLS = 2 * DIFF_QK_COLS + DIFF_W
MLA_COLS = MLA_Q_RANK + MLA_KV_RANK + MLA_ROPE
IN_COLS = NA_COLS + DIFF_COLS + MLA_COLS

N_EXPERTS = 64
TOP_K = 8
N_GROUPS = 8
TOPK_GROUPS = 4
EXPERT_FF = 256
SHARED_FF = 256
ROUTED_SCALE = 2.5
MOE_BLOCK = 128

kernel_name = 'hybrid_diffusion_block'


def _rmsnorm(x, g):
    xf = x.astype(jnp.float32)
    y = xf * lax.rsqrt(jnp.mean(xf * xf, axis=-1, keepdims=True) + EPS)
    return (y * g.astype(jnp.float32)).astype(x.dtype)


def _softmax(s):
    return jax.nn.softmax(s.astype(jnp.float32), axis=-1)


def _rope_tables(n_tokens, dtype):
    t = jnp.arange(n_tokens)
    row = (t // GRID_W).astype(jnp.float32)
    col = (t % GRID_W).astype(jnp.float32)
    n_freq = ROPE_DIM // 4
    freq = ROPE_THETA ** (-jnp.arange(n_freq, dtype=jnp.float32) / n_freq)
    ang = jnp.concatenate([row[:, None] * freq, col[:, None] * freq], axis=-1)
    return jnp.cos(ang).astype(dtype), jnp.sin(ang).astype(dtype)


def _apply_rope(x, cos, sin):
    shape = (cos.shape[0],) + (1,) * (x.ndim - 3) + (cos.shape[-1],)
    cos = cos.reshape(shape)
    sin = sin.reshape(shape)
    half = x.shape[-1] // 2
    x1, x2 = x[..., :half], x[..., half:]
    return jnp.concatenate([x1 * cos - x2 * sin, x1 * sin + x2 * cos], axis=-1)


def _sweep_query_blocks(fn, q):
    b, s = q.shape[:2]
    nb = s // Q_BLOCK
    qb = jnp.moveaxis(q.reshape((b, nb, Q_BLOCK) + q.shape[2:]), 1, 0)
    out = jnp.moveaxis(lax.map(fn, qb), 0, 1)
    return out.reshape((b, s) + out.shape[3:])


def _attend(q, k, v, scale):
    s = jnp.einsum('bqhd,bkhd->bhqk', q, k).astype(jnp.float32) * scale
    p = _softmax(s).astype(v.dtype)
    return jnp.einsum('bhqk,bkhd->bqhd', p, v)


def _diff_attend(q, k, v, lam):
    s = jnp.einsum('bqhmd,bkhmd->bhmqk', q, k).astype(jnp.float32) * (q.shape[-1] ** -0.5)
    p = _softmax(s)
    a = (p[:, :, 0] - lam * p[:, :, 1]).astype(v.dtype)
    return jnp.einsum('bhqk,bkhd->bqhd', a, v)


def _na_latent(q, k, v, k_ctx, v_ctx, rel_bias):
    b, s, h, d = q.shape
    rows = s // GRID_W
    wr = min(WIN_R, rows)
    scale = d ** -0.5
    qg = jnp.moveaxis(q.reshape(b, rows, GRID_W, h, d), 1, 0)
    kg = k.reshape(b, rows, GRID_W, h, d)
    vg = v.reshape(b, rows, GRID_W, h, d)
    cols = jnp.arange(GRID_W)
    col_start = jnp.clip(cols - WIN_C // 2, 0, GRID_W - WIN_C)
    col_idx = col_start[:, None] + jnp.arange(WIN_C)[None, :]
    dc = col_idx - cols[:, None] + (WIN_C - 1)

    def row_fn(args):
        r, q_row = args
        rs = jnp.clip(r - wr // 2, 0, rows - wr)
        k_nb = jnp.take(lax.dynamic_slice_in_dim(kg, rs, wr, axis=1), col_idx, axis=2)
        v_nb = jnp.take(lax.dynamic_slice_in_dim(vg, rs, wr, axis=1), col_idx, axis=2)
        dr = rs + jnp.arange(wr) - r + (WIN_R - 1)
        bias = rel_bias[:, dr[None, :, None], dc[:, None, :]]
        s_nb = jnp.einsum('bqhd,brqchd->bhqrc', q_row, k_nb).astype(jnp.float32) * scale + bias
        s_nb = s_nb.reshape(b, h, GRID_W, wr * WIN_C)
        s_ctx = jnp.einsum('bqhd,bchd->bhqc', q_row, k_ctx).astype(jnp.float32) * scale
        p = _softmax(jnp.concatenate([s_nb, s_ctx], axis=-1)).astype(v.dtype)
        p_nb = p[..., :wr * WIN_C].reshape(b, h, GRID_W, wr, WIN_C)
        p_ctx = p[..., wr * WIN_C:]
        return (jnp.einsum('bhqrc,brqchd->bqhd', p_nb, v_nb)
                + jnp.einsum('bhqc,bchd->bqhd', p_ctx, v_ctx))

    out = lax.map(row_fn, (jnp.arange(rows), qg))
    return jnp.moveaxis(out, 0, 1).reshape(b, s, h * d)


def _mixer(h_lat, h_ctx, cos, sin, layer_idx, need_ctx, w_in, rel_bias, lam_vec, subln_g,
           q_norm_g, w_uq, kv_norm_g, w_ukv, w_out):
    o_diff = NA_COLS
    o_mla = NA_COLS + DIFF_COLS
    p_lat = h_lat @ w_in
    p_ctx = h_ctx @ w_in

    def na_q(p):
        return p[..., :NA_W].reshape(p.shape[:2] + (NA_HEADS, NA_DIM))

    def na_kv(p):
        sh = p.shape[:2] + (NA_HEADS, NA_DIM)
        return p[..., NA_W:2 * NA_W].reshape(sh), p[..., 2 * NA_W:NA_COLS].reshape(sh)

    def diff_q(p):
        return p[..., o_diff:o_diff + DIFF_QK_COLS].reshape(p.shape[:2] + (DIFF_HEADS, 2, DIFF_QK_DIM))

    def diff_kv(p):
        k = p[..., o_diff + DIFF_QK_COLS:o_diff + 2 * DIFF_QK_COLS].reshape(
            p.shape[:2] + (DIFF_HEADS, 2, DIFF_QK_DIM))
        v = p[..., o_diff + 2 * DIFF_QK_COLS:o_mla].reshape(p.shape[:2] + (DIFF_HEADS, DIFF_V_DIM))
        return k, v

    def mla_q(p):
        cq = _rmsnorm(p[..., o_mla:o_mla + MLA_Q_RANK], q_norm_g)
        return (cq @ w_uq).reshape(p.shape[:2] + (MLA_HEADS, MLA_NOPE + MLA_ROPE))

    def mla_kv(p, rotate):
        ckv = _rmsnorm(p[..., o_mla + MLA_Q_RANK:o_mla + MLA_Q_RANK + MLA_KV_RANK], kv_norm_g)
        kv = (ckv @ w_ukv).reshape(p.shape[:2] + (MLA_HEADS, MLA_NOPE + MLA_V))
        k_rope = p[..., o_mla + MLA_Q_RANK + MLA_KV_RANK:IN_COLS]
        if rotate:
            k_rope = _apply_rope(k_rope, cos, sin)
        k_rope = jnp.broadcast_to(k_rope[:, :, None, :], p.shape[:2] + (MLA_HEADS, MLA_ROPE))
        return jnp.concatenate([kv[..., :MLA_NOPE], k_rope], axis=-1), kv[..., MLA_NOPE:]

    def rope_tail(q):
        return jnp.concatenate([q[..., :MLA_NOPE], _apply_rope(q[..., MLA_NOPE:], cos, sin)], axis=-1)

    lambda_init = 0.8 - 0.6 * math.exp(-0.3 * layer_idx)
    lv = lam_vec.astype(jnp.float32)
    lam = jnp.exp(jnp.sum(lv[0] * lv[1])) - jnp.exp(jnp.sum(lv[2] * lv[3])) + lambda_init

    def diff_post(o):
        o = _rmsnorm(o, subln_g) * (1.0 - lambda_init)
        return o.reshape(o.shape[:2] + (DIFF_W,))

    mla_scale = (MLA_NOPE + MLA_ROPE) ** -0.5

    k_na_c, v_na_c = na_kv(p_ctx)
    k_d_c, v_d_c = diff_kv(p_ctx)
    k_m_c, v_m_c = mla_kv(p_ctx, False)

    k_na, v_na = na_kv(p_lat)
    na_out = _na_latent(na_q(p_lat), k_na, v_na, k_na_c, v_na_c, rel_bias)

    k_d, v_d = diff_kv(p_lat)
    k_d_all = jnp.concatenate([_apply_rope(k_d, cos, sin), k_d_c], axis=1)
    v_d_all = jnp.concatenate([v_d, v_d_c], axis=1)
    d_out = _sweep_query_blocks(lambda qb: _diff_attend(qb, k_d_all, v_d_all, lam),
                                _apply_rope(diff_q(p_lat), cos, sin))

    k_m, v_m = mla_kv(p_lat, True)
    k_m_all = jnp.concatenate([k_m, k_m_c], axis=1)
    v_m_all = jnp.concatenate([v_m, v_m_c], axis=1)
    m_out = _sweep_query_blocks(lambda qb: _attend(qb, k_m_all, v_m_all, mla_scale), rope_tail(mla_q(p_lat)))
    b, s = h_lat.shape[:2]
    out_lat = jnp.concatenate([na_out, diff_post(d_out), m_out.reshape(b, s, MLA_W)], axis=-1) @ w_out

    if not need_ctx:
        return out_lat, None
    bc, c = h_ctx.shape[:2]
    na_c = _attend(na_q(p_ctx), k_na_c, v_na_c, NA_DIM ** -0.5).reshape(bc, c, NA_W)
    d_c = diff_post(_diff_attend(diff_q(p_ctx), k_d_c, v_d_c, lam))
    m_c = _attend(mla_q(p_ctx), k_m_c, v_m_c, mla_scale).reshape(bc, c, MLA_W)
    out_ctx = jnp.concatenate([na_c, d_c, m_c], axis=-1) @ w_out
    return out_lat, out_ctx


def _moe(h, router_w, router_bias, wg, wu, wd, sg, su, sd):
    b, l, d = h.shape
    hb_all = h.reshape(b * l // MOE_BLOCK, MOE_BLOCK, d)

    def block_fn(hb):
        scores = jax.nn.sigmoid((hb @ router_w).astype(jnp.float32))
        sel = scores + router_bias.astype(jnp.float32)
        grp = lax.top_k(sel.reshape(MOE_BLOCK, N_GROUPS, N_EXPERTS // N_GROUPS), 2)[0].sum(-1)
        _, gidx = lax.top_k(grp, TOPK_GROUPS)
        gmask = jnp.sum(jax.nn.one_hot(gidx, N_GROUPS, dtype=jnp.float32), axis=1) > 0
        emask = jnp.repeat(gmask, N_EXPERTS // N_GROUPS, axis=-1)
        _, eidx = lax.top_k(jnp.where(emask, sel, -jnp.inf), TOP_K)
        w = jnp.take_along_axis(scores, eidx, axis=-1)
        w = w / jnp.sum(w, axis=-1, keepdims=True) * ROUTED_SCALE
        gates = jnp.sum(jax.nn.one_hot(eidx, N_EXPERTS, dtype=jnp.float32) * w[..., None], axis=1)
        act = jax.nn.silu(jnp.einsum('qd,edf->qef', hb, wg)) * jnp.einsum('qd,edf->qef', hb, wu)
        routed = jnp.einsum('qef,efd->qd', act * gates[..., None].astype(act.dtype), wd)
        shared = (jax.nn.silu(hb @ sg) * (hb @ su)) @ sd
        return routed + shared

    return lax.map(block_fn, hb_all).reshape(b, l, d)


def setup_inputs(seed: int = 0) -> dict:
    key = jax.random.key(seed)
    ks = jax.random.split(key, 32)
    f32 = jnp.float32

    def nrm(k, shape, scale):
        return jax.random.normal(k, shape, f32) * scale

    L, D, E = DEPTH, D_MODEL, N_EXPERTS
    return {
        'x': nrm(ks[0], (BATCH, SEQ, D), 1.0),
        'c': nrm(ks[1], (BATCH, D), 1.0),
        'ctx': nrm(ks[2], (BATCH, CTX_LEN, D), 1.0),
        'c_ctx': nrm(ks[3], (D,), 1.0),
        'w_ada': nrm(ks[4], (L, D, 6 * D), 0.5 * D ** -0.5),
        'b_ada': nrm(ks[5], (L, 6 * D), 0.02),
        'norm_attn_g': 1.0 + nrm(ks[6], (L, D), 0.02),
        'norm_ffn_g': 1.0 + nrm(ks[7], (L, D), 0.02),
        'w_in': nrm(ks[8], (L, D, IN_COLS), D ** -0.5),
        'na_rel_bias': nrm(ks[9], (L, NA_HEADS, 2 * WIN_R - 1, 2 * WIN_C - 1), 0.1),
        'diff_lambda': nrm(ks[10], (L, 4, DIFF_QK_DIM), 0.1),
        'diff_subln_g': 1.0 + nrm(ks[11], (L, DIFF_V_DIM), 0.02),
        'mla_q_norm_g': 1.0 + nrm(ks[12], (L, MLA_Q_RANK), 0.02),
        'mla_w_uq': nrm(ks[13], (L, MLA_Q_RANK, MLA_HEADS * (MLA_NOPE + MLA_ROPE)), MLA_Q_RANK ** -0.5),
        'mla_kv_norm_g': 1.0 + nrm(ks[14], (L, MLA_KV_RANK), 0.02),
        'mla_w_ukv': nrm(ks[15], (L, MLA_KV_RANK, MLA_HEADS * (MLA_NOPE + MLA_V)), MLA_KV_RANK ** -0.5),
        'w_out': nrm(ks[16], (L, MIX_W, D), MIX_W ** -0.5),
        'router_w': nrm(ks[17], (L, D, E), D ** -0.5),
        'router_bias': nrm(ks[18], (L, E), 0.01),
        'expert_w_gate': nrm(ks[19], (L, E, D, EXPERT_FF), D ** -0.5),
        'expert_w_up': nrm(ks[20], (L, E, D, EXPERT_FF), D ** -0.5),
        'expert_w_down': nrm(ks[21], (L, E, EXPERT_FF, D), EXPERT_FF ** -0.5),
        'shared_w_gate': nrm(ks[22], (L, D, SHARED_FF), D ** -0.5),
        'shared_w_up': nrm(ks[23], (L, D, SHARED_FF), D ** -0.5),
        'shared_w_down': nrm(ks[24], (L, SHARED_FF, D), SHARED_FF ** -0.5),
        'final_norm_g': 1.0 + nrm(ks[25], (D,), 0.02),
    }


def reference(x, c, ctx, c_ctx, w_ada, b_ada, norm_attn_g, norm_ffn_g, w_in, na_rel_bias, diff_lambda,
              diff_subln_g, mla_q_norm_g, mla_w_uq, mla_kv_norm_g, mla_w_ukv, w_out, router_w, router_bias,
              expert_w_gate, expert_w_up, expert_w_down, shared_w_gate, shared_w_up, shared_w_down,
              final_norm_g):
    cos, sin = _rope_tables(x.shape[1], x.dtype)
    xc = ctx
    for l in range(DEPTH):
        need_ctx = l < DEPTH - 1
        mod = (jax.nn.silu(c) @ w_ada[l] + b_ada[l])[:, None, :]
        mod_c = jax.nn.silu(c_ctx) @ w_ada[l] + b_ada[l]
        sh1, sc1, g1, sh2, sc2, g2 = jnp.split(mod, 6, axis=-1)
        sh1c, sc1c, g1c, sh2c, sc2c, g2c = jnp.split(mod_c, 6, axis=-1)
        h = _rmsnorm(x, norm_attn_g[l]) * (1.0 + sc1) + sh1
        hc = _rmsnorm(xc, norm_attn_g[l]) * (1.0 + sc1c) + sh1c
        a_lat, a_ctx = _mixer(h, hc, cos, sin, l, need_ctx, w_in[l], na_rel_bias[l], diff_lambda[l],
                              diff_subln_g[l], mla_q_norm_g[l], mla_w_uq[l], mla_kv_norm_g[l], mla_w_ukv[l],
                              w_out[l])
        x = x + g1 * a_lat
        h2 = _rmsnorm(x, norm_ffn_g[l]) * (1.0 + sc2) + sh2
        x = x + g2 * _moe(h2, router_w[l], router_bias[l], expert_w_gate[l], expert_w_up[l],
                          expert_w_down[l], shared_w_gate[l], shared_w_up[l], shared_w_down[l])
        if need_ctx:
            xc = xc + g1c * a_ctx
            h2c = _rmsnorm(xc, norm_ffn_g[l]) * (1.0 + sc2c) + sh2c
            xc = xc + g2c * _moe(h2c, router_w[l], router_bias[l], expert_w_gate[l], expert_w_up[l],
                                 expert_w_down[l], shared_w_gate[l], shared_w_up[l], shared_w_down[l])
    return _rmsnorm(x, final_norm_g)
```

```cpp
#include <hip/hip_runtime.h>
#include <cstdint>
#include <cstdio>
#include <cmath>

typedef unsigned short bf16_t;

constexpr int NB = 16, SEQ = 2048, DM = 1024, CTX = 256;
constexpr int NLAT = NB * SEQ, NCTX = NB * CTX, NTOK = NLAT + NCTX;
constexpr int INC = 1952;
constexpr int O_NAQ = 0, O_NAK = 256, O_NAV = 512, O_DQ = 768, O_DK = 1024, O_DV = 1280, O_CQ = 1536, O_CKV = 1792, O_KR = 1920;
constexpr int NEXP = 64, EFF = 256;
constexpr int LCAP = NTOK;
constexpr int MODW = 6 * DM;

constexpr size_t MiB = 1u << 20;
constexpr size_t WS_CTL = 0;
constexpr size_t WS_MOD = 1 * MiB;
constexpr size_t WS_LOG = 2 * MiB;
constexpr size_t WS_LIST = 12 * MiB;
constexpr size_t WS_XS = 32 * MiB;
constexpr size_t WS_HB = 176 * MiB;
constexpr size_t WS_PB = 248 * MiB;
constexpr size_t WS_QM = 386 * MiB;
constexpr size_t WS_KVM = 440 * MiB;
constexpr size_t WS_END = 512 * MiB;

__device__ __forceinline__ float bf2f(bf16_t v) { return __uint_as_float(((unsigned)v) << 16); }
__device__ __forceinline__ bf16_t f2bf(float f) { unsigned u = __float_as_uint(f); u += 0x7fffu + ((u >> 16) & 1u); return (bf16_t)(u >> 16); }
__device__ __forceinline__ float wave_sum(float v) {
#pragma unroll
    for (int o = 32; o > 0; o >>= 1) v += __shfl_xor(v, o);
    return v;
}
__device__ __forceinline__ float wave_max(float v) {
#pragma unroll
    for (int o = 32; o > 0; o >>= 1) v = fmaxf(v, __shfl_xor(v, o));
    return v;
}
__device__ __forceinline__ int mod_row(int t) { return t < NLAT ? (t >> 11) : 16; }

__global__ void k_mod(const float* __restrict__ c, const float* __restrict__ c_ctx, const float* __restrict__ w_ada,
                      const float* __restrict__ b_ada, float* __restrict__ mod) {
    const int idx = blockIdx.x * 256 + threadIdx.x;
    if (idx >= 2 * 17 * MODW) return;
    const int n = idx % MODW, r = (idx / MODW) % 17, l = idx / (MODW * 17);
    const float* cv = r < 16 ? c + r * DM : c_ctx;
    const float* w = w_ada + (size_t)l * DM * MODW + n;
    float s = 0.f;
    for (int k = 0; k < DM; ++k) { const float v = cv[k]; s += (v / (1.f + expf(-v))) * w[(size_t)k * MODW]; }
    mod[idx] = s + b_ada[l * MODW + n];
}
__global__ void k_lam(const float* __restrict__ diff_lambda, float* __restrict__ lam) {
    const int lane = threadIdx.x;
    for (int l = 0; l < 2; ++l) {
        const float* lv = diff_lambda + l * 128;
        float a = lane < 32 ? lv[lane] * lv[32 + lane] : 0.f;
        float b = lane < 32 ? lv[64 + lane] * lv[96 + lane] : 0.f;
        a = wave_sum(a); b = wave_sum(b);
        const float li = 0.8f - 0.6f * expf(-0.3f * (float)l);
        if (lane == 0) lam[l] = expf(a) - expf(b) + li;
    }
}

template <bool ROUTER>
__global__ void __launch_bounds__(256) k_norm(const float* __restrict__ XS, const float* __restrict__ g, const float* __restrict__ mod_l,
                                              int sh_chunk, int sc_chunk, bf16_t* __restrict__ HB,
                                              const float* __restrict__ router_w, float* __restrict__ logits) {
    __shared__ float red[4];
    __shared__ float hrow[ROUTER ? 1024 : 4];
    __shared__ float part[ROUTER ? 256 : 4];
    const int t = blockIdx.x, tid = threadIdx.x, r = mod_row(t);
    const float4 v = ((const float4*)(XS + (size_t)t * DM))[tid];
    float ss = v.x * v.x + v.y * v.y + v.z * v.z + v.w * v.w;
    ss = wave_sum(ss);
    if ((tid & 63) == 0) red[tid >> 6] = ss;
    __syncthreads();
    ss = red[0] + red[1] + red[2] + red[3];
    const float rstd = rsqrtf(ss * (1.f / DM) + 1e-6f);
    const float* sh = mod_l + r * MODW + sh_chunk * DM;
    const float* sc = mod_l + r * MODW + sc_chunk * DM;
    const float xv[4] = {v.x, v.y, v.z, v.w};
    float o[4];
#pragma unroll
    for (int i = 0; i < 4; ++i) { const int c = tid * 4 + i; o[i] = xv[i] * rstd * g[c] * (1.f + sc[c]) + sh[c]; }
#pragma unroll
    for (int i = 0; i < 4; ++i) HB[(size_t)t * DM + tid * 4 + i] = f2bf(o[i]);
    if (ROUTER) {
#pragma unroll
        for (int i = 0; i < 4; ++i) hrow[tid * 4 + i] = o[i];
        __syncthreads();
        const int e = tid & 63, p = tid >> 6;
        float s = 0.f;
        for (int k = p * 256; k < p * 256 + 256; ++k) s += hrow[k] * router_w[k * NEXP + e];
        part[tid] = s;
        __syncthreads();
        if (tid < 64) logits[(size_t)t * NEXP + tid] = part[tid] + part[64 + tid] + part[128 + tid] + part[192 + tid];
    }
}

struct EpiStore { bf16_t* O; int ldo; int coloff;
    __device__ __forceinline__ void operator()(int row, int col, float v) const { O[(size_t)row * ldo + coloff + col] = f2bf(v); } };
struct EpiResid { float* XS; const float* mod_l; int chunk; int pad;
    __device__ __forceinline__ void operator()(int row, int col, float v) const {
        const int r = mod_row(row); XS[(size_t)row * DM + col] += mod_l[r * MODW + chunk * DM + col] * v; } };

template <class Epi>
__global__ void __launch_bounds__(256) k_gemm_naive(const bf16_t* __restrict__ A, int lda, const float* __restrict__ Bw, int ldb, int N, int K, Epi epi) {
    __shared__ float As[16][128];
    __shared__ float Bs[16][128];
    const int tid = threadIdx.x, tx = tid & 15, ty = tid >> 4;
    const int m0 = blockIdx.y * 128, n0 = blockIdx.x * 128;
    float acc[8][8];
#pragma unroll
    for (int i = 0; i < 8; ++i)
#pragma unroll
        for (int j = 0; j < 8; ++j) acc[i][j] = 0.f;
    const int ar = tid >> 1, ak = (tid & 1) * 8;
    const int bk = tid >> 4, bn = (tid & 15) * 8;
    for (int k0 = 0; k0 < K; k0 += 16) {
        const uint4 av = *(const uint4*)(A + (size_t)(m0 + ar) * lda + k0 + ak);
        As[ak + 0][ar] = __uint_as_float(av.x << 16); As[ak + 1][ar] = __uint_as_float(av.x & 0xffff0000u);
        As[ak + 2][ar] = __uint_as_float(av.y << 16); As[ak + 3][ar] = __uint_as_float(av.y & 0xffff0000u);
        As[ak + 4][ar] = __uint_as_float(av.z << 16); As[ak + 5][ar] = __uint_as_float(av.z & 0xffff0000u);
        As[ak + 6][ar] = __uint_as_float(av.w << 16); As[ak + 7][ar] = __uint_as_float(av.w & 0xffff0000u);
        float4 b0 = make_float4(0.f, 0.f, 0.f, 0.f), b1 = b0;
        if (n0 + bn < N) { const float* bp = Bw + (size_t)(k0 + bk) * ldb + n0 + bn; b0 = *(const float4*)bp; b1 = *(const float4*)(bp + 4); }
        *(float4*)&Bs[bk][bn] = b0; *(float4*)&Bs[bk][bn + 4] = b1;
        __syncthreads();
#pragma unroll
        for (int kk = 0; kk < 16; ++kk) {
            const float4 a0 = *(const float4*)&As[kk][ty * 8], a1 = *(const float4*)&As[kk][ty * 8 + 4];
            const float4 c0 = *(const float4*)&Bs[kk][tx * 8], c1 = *(const float4*)&Bs[kk][tx * 8 + 4];
            const float a[8] = {a0.x, a0.y, a0.z, a0.w, a1.x, a1.y, a1.z, a1.w};
            const float b[8] = {c0.x, c0.y, c0.z, c0.w, c1.x, c1.y, c1.z, c1.w};
#pragma unroll
            for (int i = 0; i < 8; ++i)
#pragma unroll
                for (int j = 0; j < 8; ++j) acc[i][j] += a[i] * b[j];
        }
        __syncthreads();
    }
#pragma unroll
    for (int i = 0; i < 8; ++i)
#pragma unroll
        for (int j = 0; j < 8; ++j) { const int row = m0 + ty * 8 + i, col = n0 + tx * 8 + j; if (col < N) epi(row, col, acc[i][j]); }
}

__device__ __forceinline__ void rope_cs(int s, int j, float& cs, float& sn) {
    const int rowi = s >> 6, coli = s & 63;
    const float freq = powf(10000.f, -(float)(j & 7) / 8.f);
    const float ang = (float)(j < 8 ? rowi : coli) * freq;
    cs = cosf(ang); sn = sinf(ang);
}
__global__ void k_rope_pb(bf16_t* __restrict__ PB) {
    const int idx = blockIdx.x * 256 + threadIdx.x;
    const int j = idx & 15, gi = (idx >> 4) % 17, t = (idx >> 4) / 17;
    if (t >= NLAT) return;
    const int col0 = gi < 8 ? O_DQ + gi * 32 : (gi < 16 ? O_DK + (gi - 8) * 32 : O_KR);
    float cs, sn; rope_cs(t & 2047, j, cs, sn);
    bf16_t* p = PB + (size_t)t * INC + col0 + j;
    const float x1 = bf2f(p[0]), x2 = bf2f(p[16]);
    p[0] = f2bf(x1 * cs - x2 * sn); p[16] = f2bf(x1 * sn + x2 * cs);
}
__global__ void k_rope_qm(bf16_t* __restrict__ QM) {
    const int idx = blockIdx.x * 256 + threadIdx.x;
    const int j = idx & 15, h = (idx >> 4) & 7, t = idx >> 7;
    if (t >= NLAT) return;
    float cs, sn; rope_cs(t & 2047, j, cs, sn);
    bf16_t* p = QM + (size_t)t * 768 + h * 96 + 64 + j;
    const float x1 = bf2f(p[0]), x2 = bf2f(p[16]);
    p[0] = f2bf(x1 * cs - x2 * sn); p[16] = f2bf(x1 * sn + x2 * cs);
}
__global__ void __launch_bounds__(256) k_mla_norm(bf16_t* __restrict__ PB, const float* __restrict__ qg, const float* __restrict__ kvg) {
    const int t = blockIdx.x * 4 + (threadIdx.x >> 6), lane = threadIdx.x & 63;
    bf16_t* p = PB + (size_t)t * INC;
    float v[4], ss = 0.f;
#pragma unroll
    for (int i = 0; i < 4; ++i) { v[i] = bf2f(p[O_CQ + lane * 4 + i]); ss += v[i] * v[i]; }
    ss = wave_sum(ss);
    float rstd = rsqrtf(ss * (1.f / 256.f) + 1e-6f);
#pragma unroll
    for (int i = 0; i < 4; ++i) p[O_CQ + lane * 4 + i] = f2bf(v[i] * rstd * qg[lane * 4 + i]);
    float w[2]; ss = 0.f;
#pragma unroll
    for (int i = 0; i < 2; ++i) { w[i] = bf2f(p[O_CKV + lane * 2 + i]); ss += w[i] * w[i]; }
    ss = wave_sum(ss);
    rstd = rsqrtf(ss * (1.f / 128.f) + 1e-6f);
#pragma unroll
    for (int i = 0; i < 2; ++i) p[O_CKV + lane * 2 + i] = f2bf(w[i] * rstd * kvg[lane * 2 + i]);
}

__device__ __forceinline__ float dot8(const float* q, uint4 k) {
    return q[0] * __uint_as_float(k.x << 16) + q[1] * __uint_as_float(k.x & 0xffff0000u) + q[2] * __uint_as_float(k.y << 16) + q[3] * __uint_as_float(k.y & 0xffff0000u)
         + q[4] * __uint_as_float(k.z << 16) + q[5] * __uint_as_float(k.z & 0xffff0000u) + q[6] * __uint_as_float(k.w << 16) + q[7] * __uint_as_float(k.w & 0xffff0000u);
}
template <int MODE>
__device__ __forceinline__ int key_row(bool isctx, int b, int s, int j, int h, const float* __restrict__ rel_bias, float& bias) {
    bias = 0.f;
    if (isctx) return NLAT + b * CTX + j;
    if (MODE == 0) {
        if (j < 128) {
            const int i = j >> 4, cc = j & 15, r = s >> 6, cq = s & 63;
            const int rs = min(max(r - 4, 0), 24), cs = min(max(cq - 8, 0), 48);
            const int kr = rs + i, kc = cs + cc;
            bias = rel_bias[(h * 15 + (kr - r + 7)) * 31 + (kc - cq + 15)];
            return b * SEQ + kr * 64 + kc;
        }
        return NLAT + b * CTX + (j - 128);
    }
    return j < SEQ ? b * SEQ + j : NLAT + b * CTX + (j - SEQ);
}
template <int MODE>
__global__ void __launch_bounds__(128) k_attn_naive(const bf16_t* __restrict__ PB, const bf16_t* __restrict__ QM, const bf16_t* __restrict__ KVM,
                                                    bf16_t* __restrict__ HB, const float* __restrict__ rel_bias, const float* __restrict__ subln_g,
                                                    const float* __restrict__ lamp, float one_minus_li, int row0) {
    constexpr int NH = MODE == 2 ? 8 : 4;
    extern __shared__ float smem[];
    const int wave = threadIdx.x >> 6, lane = threadIdx.x & 63;
    const int item = blockIdx.x * 2 + wave;
    const int t = row0 + item / NH, h = item % NH;
    const bool isctx = t >= NLAT;
    const int b = isctx ? ((t - NLAT) >> 8) : (t >> 11), s = t & 2047;
    const int nkeys = isctx ? CTX : (MODE == 0 ? 384 : SEQ + CTX);
    float* qs = smem + wave * (128 + 2 * 2304);
    float* s1 = qs + 128; float* s2 = s1 + 2304;
    if (MODE == 0) qs[lane] = bf2f(PB[(size_t)t * INC + O_NAQ + h * 64 + lane]);
    if (MODE == 1) qs[lane] = bf2f(PB[(size_t)t * INC + O_DQ + h * 64 + lane]);
    if (MODE == 2) { qs[lane] = bf2f(QM[(size_t)t * 768 + h * 96 + lane]); if (lane < 32) qs[64 + lane] = bf2f(QM[(size_t)t * 768 + h * 96 + 64 + lane]); }
    __syncthreads();
    const float scale = MODE == 0 ? 0.125f : (MODE == 1 ? 0.17677669529663687f : 0.10206207261596575f);
    float m1 = -INFINITY, m2 = -INFINITY;
    for (int j = lane; j < nkeys; j += 64) {
        float bias; const int kr = key_row<MODE>(isctx, b, s, j, h, rel_bias, bias);
        if (MODE == 0) {
            const uint4* kp = (const uint4*)(PB + (size_t)kr * INC + O_NAK + h * 64); float d = 0.f;
#pragma unroll
            for (int x = 0; x < 8; ++x) d += dot8(qs + 8 * x, kp[x]);
            d = d * scale + bias; s1[j] = d; m1 = fmaxf(m1, d);
        } else if (MODE == 1) {
            const uint4* kp = (const uint4*)(PB + (size_t)kr * INC + O_DK + h * 64); float d0 = 0.f, d1 = 0.f;
#pragma unroll
            for (int x = 0; x < 4; ++x) { d0 += dot8(qs + 8 * x, kp[x]); d1 += dot8(qs + 32 + 8 * x, kp[4 + x]); }
            d0 *= scale; d1 *= scale; s1[j] = d0; s2[j] = d1; m1 = fmaxf(m1, d0); m2 = fmaxf(m2, d1);
        } else {
            const uint4* kp = (const uint4*)(KVM + (size_t)kr * 1024 + h * 128); const uint4* rp = (const uint4*)(PB + (size_t)kr * INC + O_KR); float d = 0.f;
#pragma unroll
            for (int x = 0; x < 8; ++x) d += dot8(qs + 8 * x, kp[x]);
#pragma unroll
            for (int x = 0; x < 4; ++x) d += dot8(qs + 64 + 8 * x, rp[x]);
            d *= scale; s1[j] = d; m1 = fmaxf(m1, d);
        }
    }
    m1 = wave_max(m1); if (MODE == 1) m2 = wave_max(m2);
    float l1 = 0.f, l2 = 0.f;
    for (int j = lane; j < nkeys; j += 64) {
        const float p = expf(s1[j] - m1); s1[j] = p; l1 += p;
        if (MODE == 1) { const float q = expf(s2[j] - m2); s2[j] = q; l2 += q; }
    }
    l1 = wave_sum(l1); if (MODE == 1) l2 = wave_sum(l2);
    const float lam = MODE == 1 ? lamp[0] : 0.f;
    for (int j = lane; j < nkeys; j += 64) {
        if (MODE == 1) s1[j] = s1[j] / l1 - lam * (s2[j] / l2); else s1[j] = s1[j] / l1;
    }
    __syncthreads();
    float acc = 0.f;
    for (int j = 0; j < nkeys; ++j) {
        float bias; const int kr = key_row<MODE>(isctx, b, s, j, h, rel_bias, bias);
        float vv;
        if (MODE == 0) vv = bf2f(PB[(size_t)kr * INC + O_NAV + h * 64 + lane]);
        else if (MODE == 1) vv = bf2f(PB[(size_t)kr * INC + O_DV + h * 64 + lane]);
        else vv = bf2f(KVM[(size_t)kr * 1024 + h * 128 + 64 + lane]);
        acc += s1[j] * vv;
    }
    if (MODE == 0) HB[(size_t)t * DM + h * 64 + lane] = f2bf(acc);
    else if (MODE == 2) HB[(size_t)t * DM + 512 + h * 64 + lane] = f2bf(acc);
    else {
        const float ss = wave_sum(acc * acc);
        const float o = acc * rsqrtf(ss * (1.f / 64.f) + 1e-6f) * subln_g[lane] * one_minus_li;
        HB[(size_t)t * DM + 256 + h * 64 + lane] = f2bf(o);
    }
}

__global__ void __launch_bounds__(256) k_topk(const float* __restrict__ logits, const float* __restrict__ rbias, int* __restrict__ cnt, uint2* __restrict__ list) {
    const int t = blockIdx.x * 4 + (threadIdx.x >> 6), e = threadIdx.x & 63;
    const float lg = logits[(size_t)t * NEXP + e];
    const float sc = 1.f / (1.f + expf(-lg));
    const float sel = sc + rbias[e];
    float m1 = sel;
#pragma unroll
    for (int o = 1; o < 8; o <<= 1) m1 = fmaxf(m1, __shfl_xor(m1, o));
    int cand = (sel == m1) ? (e & 7) : 8;
#pragma unroll
    for (int o = 1; o < 8; o <<= 1) cand = min(cand, __shfl_xor(cand, o));
    float m2 = ((e & 7) == cand) ? -INFINITY : sel;
#pragma unroll
    for (int o = 1; o < 8; o <<= 1) m2 = fmaxf(m2, __shfl_xor(m2, o));
    const float grp = m1 + m2;
    const int g = e >> 3;
    int grank = 0;
#pragma unroll
    for (int gg = 0; gg < 8; ++gg) { const float og = __shfl(grp, gg * 8); grank += (og > grp || (og == grp && gg < g)) ? 1 : 0; }
    const bool gsel = grank < 4;
    const float ms = gsel ? sel : -INFINITY;
    int rk = 0;
    for (int ee = 0; ee < 64; ++ee) { const float o = __shfl(ms, ee); rk += (o > ms || (o == ms && ee < e)) ? 1 : 0; }
    const bool chosen = gsel && rk < 8;
    const float wsum = wave_sum(chosen ? sc : 0.f);
    const float w = sc / wsum * 2.5f;
    if (chosen) { const int slot = atomicAdd(&cnt[e], 1); list[(size_t)e * LCAP + slot] = make_uint2((unsigned)t, __float_as_uint(w)); }
}

__global__ void __launch_bounds__(256) k_moe_naive(const bf16_t* __restrict__ HB, const int* __restrict__ cnt, const uint2* __restrict__ list, int ntok,
                                                   const float* __restrict__ wg_l, const float* __restrict__ wu_l, const float* __restrict__ wd_l,
                                                   const float* __restrict__ sg_l, const float* __restrict__ su_l, const float* __restrict__ sd_l,
                                                   const float* __restrict__ mod_l, float* __restrict__ XS) {
    const int e = blockIdx.y, n = e < NEXP ? cnt[e] : ntok, slot0 = blockIdx.x * 8, tid = threadIdx.x;
    if (slot0 >= n) return;
    __shared__ float hs[8][1024];
    __shared__ float as[8][256];
    __shared__ int toks[8];
    __shared__ float wts[8];
    if (tid < 8) {
        const int slot = slot0 + tid; const bool valid = slot < n;
        int tk = 0; float w = 0.f;
        if (valid) { if (e < NEXP) { const uint2 en = list[(size_t)e * LCAP + slot]; tk = (int)en.x; w = __uint_as_float(en.y); } else { tk = slot; w = 1.f; } }
        toks[tid] = tk; wts[tid] = w;
    }
    __syncthreads();
#pragma unroll
    for (int i = 0; i < 8; ++i) {
        const bf16_t* hp = HB + (size_t)toks[i] * DM + tid * 4;
#pragma unroll
        for (int c = 0; c < 4; ++c) hs[i][tid * 4 + c] = bf2f(hp[c]);
    }
    __syncthreads();
    const float* WG = e < NEXP ? wg_l + (size_t)e * DM * EFF : sg_l;
    const float* WU = e < NEXP ? wu_l + (size_t)e * DM * EFF : su_l;
    const float* WD = e < NEXP ? wd_l + (size_t)e * EFF * DM : sd_l;
    float g[8], u[8];
#pragma unroll
    for (int i = 0; i < 8; ++i) { g[i] = 0.f; u[i] = 0.f; }
    for (int k = 0; k < DM; ++k) {
        const float wgv = WG[(size_t)k * EFF + tid], wuv = WU[(size_t)k * EFF + tid];
#pragma unroll
        for (int i = 0; i < 8; ++i) { const float hv = hs[i][k]; g[i] += hv * wgv; u[i] += hv * wuv; }
    }
#pragma unroll
    for (int i = 0; i < 8; ++i) as[i][tid] = (g[i] / (1.f + expf(-g[i]))) * u[i] * wts[i];
    __syncthreads();
    float o[8][4];
#pragma unroll
    for (int i = 0; i < 8; ++i)
#pragma unroll
        for (int j = 0; j < 4; ++j) o[i][j] = 0.f;
    for (int f = 0; f < EFF; ++f) {
        float wdv[4];
#pragma unroll
        for (int j = 0; j < 4; ++j) wdv[j] = WD[(size_t)f * DM + tid + 256 * j];
#pragma unroll
        for (int i = 0; i < 8; ++i) { const float a = as[i][f];
#pragma unroll
            for (int j = 0; j < 4; ++j) o[i][j] += a * wdv[j]; }
    }
#pragma unroll
    for (int i = 0; i < 8; ++i) {
        if (slot0 + i < n) {
            const int tk = toks[i], r = mod_row(tk);
#pragma unroll
            for (int j = 0; j < 4; ++j) { const int c = tid + 256 * j; atomicAdd(&XS[(size_t)tk * DM + c], mod_l[r * MODW + 5 * DM + c] * o[i][j]); }
        }
    }
}

__global__ void __launch_bounds__(256) k_final(const float* __restrict__ XS, const float* __restrict__ g, float* __restrict__ out) {
    __shared__ float red[4];
    const int t = blockIdx.x, tid = threadIdx.x;
    const float4 v = ((const float4*)(XS + (size_t)t * DM))[tid];
    float ss = v.x * v.x + v.y * v.y + v.z * v.z + v.w * v.w;
    ss = wave_sum(ss);
    if ((tid & 63) == 0) red[tid >> 6] = ss;
    __syncthreads();
    ss = red[0] + red[1] + red[2] + red[3];
    const float rstd = rsqrtf(ss * (1.f / DM) + 1e-6f);
    const float4 gv = ((const float4*)g)[tid];
    ((float4*)(out + (size_t)t * DM))[tid] = make_float4(v.x * rstd * gv.x, v.y * rstd * gv.y, v.z * rstd * gv.z, v.w * rstd * gv.w);
}

extern "C" void kernel_launch(void* const* d_in, const int* in_sizes, int n_in, void* d_out, int out_size, void* d_ws, size_t ws_size, hipStream_t stream) {
    if (ws_size < WS_END) { fprintf(stderr, "workspace too small: %zu\n", ws_size); return; }
    const float* x = (const float*)d_in[0];       const float* c = (const float*)d_in[1];
    const float* ctx = (const float*)d_in[2];     const float* c_ctx = (const float*)d_in[3];
    const float* w_ada = (const float*)d_in[4];   const float* b_ada = (const float*)d_in[5];
    const float* norm_attn_g = (const float*)d_in[6]; const float* norm_ffn_g = (const float*)d_in[7];
    const float* w_in = (const float*)d_in[8];    const float* na_rel_bias = (const float*)d_in[9];
    const float* diff_lambda = (const float*)d_in[10]; const float* diff_subln_g = (const float*)d_in[11];
    const float* mla_q_norm_g = (const float*)d_in[12]; const float* mla_w_uq = (const float*)d_in[13];
    const float* mla_kv_norm_g = (const float*)d_in[14]; const float* mla_w_ukv = (const float*)d_in[15];
    const float* w_out = (const float*)d_in[16];  const float* router_w = (const float*)d_in[17];
    const float* router_bias = (const float*)d_in[18];
    const float* ewg = (const float*)d_in[19];    const float* ewu = (const float*)d_in[20];   const float* ewd = (const float*)d_in[21];
    const float* swg = (const float*)d_in[22];    const float* swu = (const float*)d_in[23];   const float* swd = (const float*)d_in[24];
    const float* final_norm_g = (const float*)d_in[25];
    char* ws = (char*)d_ws;
    int* cnt = (int*)(ws + WS_CTL);
    float* mod = (float*)(ws + WS_MOD); float* lam = mod + 2 * 17 * MODW;
    float* logits = (float*)(ws + WS_LOG);
    uint2* list = (uint2*)(ws + WS_LIST);
    float* XS = (float*)(ws + WS_XS);
    bf16_t* HB = (bf16_t*)(ws + WS_HB); bf16_t* PB = (bf16_t*)(ws + WS_PB); bf16_t* QM = (bf16_t*)(ws + WS_QM); bf16_t* KVM = (bf16_t*)(ws + WS_KVM);

    hipMemcpyAsync(XS, x, (size_t)NLAT * DM * 4, hipMemcpyDeviceToDevice, stream);
    hipMemcpyAsync(XS + (size_t)NLAT * DM, ctx, (size_t)NCTX * DM * 4, hipMemcpyDeviceToDevice, stream);
    k_mod<<<(2 * 17 * MODW + 255) / 256, 256, 0, stream>>>(c, c_ctx, w_ada, b_ada, mod);
    k_lam<<<1, 64, 0, stream>>>(diff_lambda, lam);
    const size_t attn_lds = 2 * (128 + 2 * 2304) * sizeof(float);
    for (int l = 0; l < 2; ++l) {
        const int nq = l == 0 ? NTOK : NLAT;
        const float* mod_l = mod + (size_t)l * 17 * MODW;
        const float li = 0.8f - 0.6f * expf(-0.3f * (float)l);
        k_norm<false><<<NTOK, 256, 0, stream>>>(XS, norm_attn_g + l * DM, mod_l, 0, 1, HB, nullptr, nullptr);
        { EpiStore ep{}; ep.O = PB; ep.ldo = INC; ep.coloff = 0;
          k_gemm_naive<EpiStore><<<dim3((INC + 127) / 128, NTOK / 128), 256, 0, stream>>>(HB, DM, w_in + (size_t)l * DM * INC, INC, INC, DM, ep); }
        k_rope_pb<<<(NLAT * 17 * 16) / 256, 256, 0, stream>>>(PB);
        k_mla_norm<<<NTOK / 4, 256, 0, stream>>>(PB, mla_q_norm_g + l * 256, mla_kv_norm_g + l * 128);
        { EpiStore ep{}; ep.O = QM; ep.ldo = 768; ep.coloff = 0;
          k_gemm_naive<EpiStore><<<dim3(768 / 128, NTOK / 128), 256, 0, stream>>>(PB + O_CQ, INC, mla_w_uq + (size_t)l * 256 * 768, 768, 768, 256, ep); }
        { EpiStore ep{}; ep.O = KVM; ep.ldo = 1024; ep.coloff = 0;
          k_gemm_naive<EpiStore><<<dim3(1024 / 128, NTOK / 128), 256, 0, stream>>>(PB + O_CKV, INC, mla_w_ukv + (size_t)l * 128 * 1024, 1024, 1024, 128, ep); }
        k_rope_qm<<<(NLAT * 8 * 16) / 256, 256, 0, stream>>>(QM);
        k_attn_naive<0><<<nq * 4 / 2, 128, attn_lds, stream>>>(PB, QM, KVM, HB, na_rel_bias + l * 4 * 15 * 31, diff_subln_g + l * 64, lam + l, 1.f - li, 0);
        k_attn_naive<1><<<nq * 4 / 2, 128, attn_lds, stream>>>(PB, QM, KVM, HB, na_rel_bias + l * 4 * 15 * 31, diff_subln_g + l * 64, lam + l, 1.f - li, 0);
        k_attn_naive<2><<<nq * 8 / 2, 128, attn_lds, stream>>>(PB, QM, KVM, HB, na_rel_bias + l * 4 * 15 * 31, diff_subln_g + l * 64, lam + l, 1.f - li, 0);
        { EpiResid ep{}; ep.XS = XS; ep.mod_l = mod_l; ep.chunk = 2; ep.pad = 0;
          k_gemm_naive<EpiResid><<<dim3(DM / 128, nq / 128), 256, 0, stream>>>(HB, DM, w_out + (size_t)l * DM * DM, DM, DM, DM, ep); }
        hipMemsetAsync(cnt, 0, 4096, stream);
        k_norm<true><<<nq, 256, 0, stream>>>(XS, norm_ffn_g + l * DM, mod_l, 3, 4, HB, router_w + (size_t)l * DM * NEXP, logits);
        k_topk<<<nq / 4, 256, 0, stream>>>(logits, router_bias + l * NEXP, cnt, list);
        k_moe_naive<<<dim3((nq + 7) / 8, NEXP + 1), 256, 0, stream>>>(HB, cnt, list, nq,
            ewg + (size_t)l * NEXP * DM * EFF, ewu + (size_t)l * NEXP * DM * EFF, ewd + (size_t)l * NEXP * EFF * DM,
            swg + (size_t)l * DM * EFF, swu + (size_t)l * DM * EFF, swd + (size_t)l * EFF * DM, mod_l, XS);
    }
    k_final<<<NLAT, 256, 0, stream>>>(XS, final_norm_g, (float*)d_out);
}
```

```cpp
#include <hip/hip_runtime.h>
#include <cstdint>
#include <cstdio>
#include <cmath>

typedef unsigned short bf16_t;

constexpr int NB = 16, SEQ = 2048, DM = 1024, CTX = 256;
constexpr int NLAT = NB * SEQ, NCTX = NB * CTX, NTOK = NLAT + NCTX;
constexpr int INC = 1952;
constexpr int PBS = 2048;
constexpr int O_NAQ = 0, O_NAK = 256, O_NAV = 512, O_DQ = 768, O_DK = 1024, O_DV = 1280, O_CQ = 1536, O_CKV = 1792, O_KR = 1920;
constexpr int NEXP = 64, EFF = 256;
constexpr int LCAP = NTOK;
constexpr int MODW = 6 * DM;

constexpr size_t MiB = 1u << 20;
constexpr size_t WS_CTL = 0;
constexpr size_t WS_MOD = 1 * MiB;
constexpr size_t WS_ROPE = 2 * MiB;
constexpr size_t WS_SSQ = 3 * MiB;
constexpr size_t WS_XS = 8 * MiB;
constexpr size_t WS_HB = 152 * MiB;
constexpr size_t WS_PB = 224 * MiB;
constexpr size_t WS_QM = 368 * MiB;
constexpr size_t WS_KVM = 422 * MiB;
constexpr size_t WS_WB = 494 * MiB;
constexpr size_t WS_END = 600 * MiB;
constexpr size_t WS_LOG = WS_PB;
constexpr size_t WS_LIST = WS_PB + 16 * MiB;
constexpr size_t WB_WIN = 0;
constexpr size_t WB_WUQ = WB_WIN + (size_t)2048 * 1024;
constexpr size_t WB_WUKV = WB_WUQ + (size_t)768 * 256;
constexpr size_t WB_WOUT = WB_WUKV + (size_t)1024 * 256;
constexpr size_t WB_WGU = WB_WOUT + (size_t)1024 * 1024;
constexpr size_t WB_WD = WB_WGU + (size_t)65 * 512 * 1024;
constexpr size_t WB_END = WB_WD + (size_t)65 * 1024 * 256;
static_assert(WS_WB + WB_END * 2 <= WS_END, "weights fit");

__device__ __forceinline__ float bf2f(bf16_t v) { return __uint_as_float(((unsigned)v) << 16); }
__device__ __forceinline__ bf16_t f2bf(float f) { unsigned u = __float_as_uint(f); u += 0x7fffu + ((u >> 16) & 1u); return (bf16_t)(u >> 16); }
__device__ __forceinline__ float wave_sum(float v) {
#pragma unroll
    for (int o = 32; o > 0; o >>= 1) v += __shfl_xor(v, o);
    return v;
}
__device__ __forceinline__ float wave_max(float v) {
#pragma unroll
    for (int o = 32; o > 0; o >>= 1) v = fmaxf(v, __shfl_xor(v, o));
    return v;
}
__device__ __forceinline__ int mod_row(int t) { return t < NLAT ? (t >> 11) : 16; }

__global__ void k_mod(const float* __restrict__ c, const float* __restrict__ c_ctx, const float* __restrict__ w_ada,
                      const float* __restrict__ b_ada, float* __restrict__ mod) {
    const int idx = blockIdx.x * 256 + threadIdx.x;
    if (idx >= 2 * 17 * MODW) return;
    const int n = idx % MODW, r = (idx / MODW) % 17, l = idx / (MODW * 17);
    const float* cv = r < 16 ? c + r * DM : c_ctx;
    const float* w = w_ada + (size_t)l * DM * MODW + n;
    float s = 0.f;
    for (int k = 0; k < DM; ++k) { const float v = cv[k]; s += (v / (1.f + expf(-v))) * w[(size_t)k * MODW]; }
    mod[idx] = s + b_ada[l * MODW + n];
}
__global__ void k_lam(const float* __restrict__ diff_lambda, float* __restrict__ lam) {
    const int lane = threadIdx.x;
    for (int l = 0; l < 2; ++l) {
        const float* lv = diff_lambda + l * 128;
        float a = lane < 32 ? lv[lane] * lv[32 + lane] : 0.f;
        float b = lane < 32 ? lv[64 + lane] * lv[96 + lane] : 0.f;
        a = wave_sum(a); b = wave_sum(b);
        const float li = 0.8f - 0.6f * expf(-0.3f * (float)l);
        if (lane == 0) lam[l] = expf(a) - expf(b) + li;
    }
}

template <bool ROUTER>
__global__ void __launch_bounds__(256) k_norm(const float* __restrict__ XS, const float* __restrict__ g, const float* __restrict__ mod_l,
                                              int sh_chunk, int sc_chunk, bf16_t* __restrict__ HB,
                                              const float* __restrict__ router_w, float* __restrict__ logits) {
    __shared__ float red[4];
    __shared__ float hrow[ROUTER ? 1024 : 4];
    __shared__ float part[ROUTER ? 256 : 4];
    const int t = blockIdx.x, tid = threadIdx.x, r = mod_row(t);
    const float4 v = ((const float4*)(XS + (size_t)t * DM))[tid];
    float ss = v.x * v.x + v.y * v.y + v.z * v.z + v.w * v.w;
    ss = wave_sum(ss);
    if ((tid & 63) == 0) red[tid >> 6] = ss;
    __syncthreads();
    ss = red[0] + red[1] + red[2] + red[3];
    const float rstd = rsqrtf(ss * (1.f / DM) + 1e-6f);
    const float* sh = mod_l + r * MODW + sh_chunk * DM;
    const float* sc = mod_l + r * MODW + sc_chunk * DM;
    const float xv[4] = {v.x, v.y, v.z, v.w};
    float o[4];
#pragma unroll
    for (int i = 0; i < 4; ++i) { const int c = tid * 4 + i; o[i] = xv[i] * rstd * g[c] * (1.f + sc[c]) + sh[c]; }
#pragma unroll
    for (int i = 0; i < 4; ++i) HB[(size_t)t * DM + tid * 4 + i] = f2bf(o[i]);
    if (ROUTER) {
#pragma unroll
        for (int i = 0; i < 4; ++i) hrow[tid * 4 + i] = o[i];
        __syncthreads();
        const int e = tid & 63, p = tid >> 6;
        float s = 0.f;
        for (int k = p * 256; k < p * 256 + 256; ++k) s += hrow[k] * router_w[k * NEXP + e];
        part[tid] = s;
        __syncthreads();
        if (tid < 64) logits[(size_t)t * NEXP + tid] = part[tid] + part[64 + tid] + part[128 + tid] + part[192 + tid];
    }
}

struct EpiStore { bf16_t* O; int ldo; int coloff;
    __device__ __forceinline__ void operator()(int row, int col, float v) const { O[(size_t)row * ldo + coloff + col] = f2bf(v); } };
struct EpiResid { float* XS; const float* mod_l; int chunk; int pad;
    __device__ __forceinline__ void operator()(int row, int col, float v) const {
        const int r = mod_row(row); XS[(size_t)row * DM + col] += mod_l[r * MODW + chunk * DM + col] * v; } };

template <class Epi>
__global__ void __launch_bounds__(256) k_gemm_naive(const bf16_t* __restrict__ A, int lda, const float* __restrict__ Bw, int ldb, int N, int K, Epi epi) {
    __shared__ float As[16][128];
    __shared__ float Bs[16][128];
    const int tid = threadIdx.x, tx = tid & 15, ty = tid >> 4;
    const int m0 = blockIdx.y * 128, n0 = blockIdx.x * 128;
    float acc[8][8];
#pragma unroll
    for (int i = 0; i < 8; ++i)
#pragma unroll
        for (int j = 0; j < 8; ++j) acc[i][j] = 0.f;
    const int ar = tid >> 1, ak = (tid & 1) * 8;
    const int bk = tid >> 4, bn = (tid & 15) * 8;
    for (int k0 = 0; k0 < K; k0 += 16) {
        const uint4 av = *(const uint4*)(A + (size_t)(m0 + ar) * lda + k0 + ak);
        As[ak + 0][ar] = __uint_as_float(av.x << 16); As[ak + 1][ar] = __uint_as_float(av.x & 0xffff0000u);
        As[ak + 2][ar] = __uint_as_float(av.y << 16); As[ak + 3][ar] = __uint_as_float(av.y & 0xffff0000u);
        As[ak + 4][ar] = __uint_as_float(av.z << 16); As[ak + 5][ar] = __uint_as_float(av.z & 0xffff0000u);
        As[ak + 6][ar] = __uint_as_float(av.w << 16); As[ak + 7][ar] = __uint_as_float(av.w & 0xffff0000u);
        float4 b0 = make_float4(0.f, 0.f, 0.f, 0.f), b1 = b0;
        if (n0 + bn < N) { const float* bp = Bw + (size_t)(k0 + bk) * ldb + n0 + bn; b0 = *(const float4*)bp; b1 = *(const float4*)(bp + 4); }
        *(float4*)&Bs[bk][bn] = b0; *(float4*)&Bs[bk][bn + 4] = b1;
        __syncthreads();
#pragma unroll
        for (int kk = 0; kk < 16; ++kk) {
            const float4 a0 = *(const float4*)&As[kk][ty * 8], a1 = *(const float4*)&As[kk][ty * 8 + 4];
            const float4 c0 = *(const float4*)&Bs[kk][tx * 8], c1 = *(const float4*)&Bs[kk][tx * 8 + 4];
            const float a[8] = {a0.x, a0.y, a0.z, a0.w, a1.x, a1.y, a1.z, a1.w};
            const float b[8] = {c0.x, c0.y, c0.z, c0.w, c1.x, c1.y, c1.z, c1.w};
#pragma unroll
            for (int i = 0; i < 8; ++i)
#pragma unroll
                for (int j = 0; j < 8; ++j) acc[i][j] += a[i] * b[j];
        }
        __syncthreads();
    }
#pragma unroll
    for (int i = 0; i < 8; ++i)
#pragma unroll
        for (int j = 0; j < 8; ++j) { const int row = m0 + ty * 8 + i, col = n0 + tx * 8 + j; if (col < N) epi(row, col, acc[i][j]); }
}

__device__ __forceinline__ void rope_cs(int s, int j, float& cs, float& sn) {
    const int rowi = s >> 6, coli = s & 63;
    const float freq = powf(10000.f, -(float)(j & 7) / 8.f);
    const float ang = (float)(j < 8 ? rowi : coli) * freq;
    cs = cosf(ang); sn = sinf(ang);
}
__global__ void k_rope_pb(bf16_t* __restrict__ PB) {
    const int idx = blockIdx.x * 256 + threadIdx.x;
    const int j = idx & 15, gi = (idx >> 4) % 17, t = (idx >> 4) / 17;
    if (t >= NLAT) return;
    const int col0 = gi < 8 ? O_DQ + gi * 32 : (gi < 16 ? O_DK + (gi - 8) * 32 : O_KR);
    float cs, sn; rope_cs(t & 2047, j, cs, sn);
    bf16_t* p = PB + (size_t)t * PBS + col0 + j;
    const float x1 = bf2f(p[0]), x2 = bf2f(p[16]);
    p[0] = f2bf(x1 * cs - x2 * sn); p[16] = f2bf(x1 * sn + x2 * cs);
}
__global__ void k_rope_qm(bf16_t* __restrict__ QM) {
    const int idx = blockIdx.x * 256 + threadIdx.x;
    const int j = idx & 15, h = (idx >> 4) & 7, t = idx >> 7;
    if (t >= NLAT) return;
    float cs, sn; rope_cs(t & 2047, j, cs, sn);
    bf16_t* p = QM + (size_t)t * 768 + h * 96 + 64 + j;
    const float x1 = bf2f(p[0]), x2 = bf2f(p[16]);
    p[0] = f2bf(x1 * cs - x2 * sn); p[16] = f2bf(x1 * sn + x2 * cs);
}
__global__ void __launch_bounds__(256) k_mla_norm(bf16_t* __restrict__ PB, const float* __restrict__ qg, const float* __restrict__ kvg) {
    const int t = blockIdx.x * 4 + (threadIdx.x >> 6), lane = threadIdx.x & 63;
    bf16_t* p = PB + (size_t)t * PBS;
    float v[4], ss = 0.f;
#pragma unroll
    for (int i = 0; i < 4; ++i) { v[i] = bf2f(p[O_CQ + lane * 4 + i]); ss += v[i] * v[i]; }
    ss = wave_sum(ss);
    float rstd = rsqrtf(ss * (1.f / 256.f) + 1e-6f);
#pragma unroll
    for (int i = 0; i < 4; ++i) p[O_CQ + lane * 4 + i] = f2bf(v[i] * rstd * qg[lane * 4 + i]);
    float w[2]; ss = 0.f;
#pragma unroll
    for (int i = 0; i < 2; ++i) { w[i] = bf2f(p[O_CKV + lane * 2 + i]); ss += w[i] * w[i]; }
    ss = wave_sum(ss);
    rstd = rsqrtf(ss * (1.f / 128.f) + 1e-6f);
#pragma unroll
    for (int i = 0; i < 2; ++i) p[O_CKV + lane * 2 + i] = f2bf(w[i] * rstd * kvg[lane * 2 + i]);
}

__device__ __forceinline__ float dot8(const float* q, uint4 k) {
    return q[0] * __uint_as_float(k.x << 16) + q[1] * __uint_as_float(k.x & 0xffff0000u) + q[2] * __uint_as_float(k.y << 16) + q[3] * __uint_as_float(k.y & 0xffff0000u)
         + q[4] * __uint_as_float(k.z << 16) + q[5] * __uint_as_float(k.z & 0xffff0000u) + q[6] * __uint_as_float(k.w << 16) + q[7] * __uint_as_float(k.w & 0xffff0000u);
}
template <int MODE>
__device__ __forceinline__ int key_row(bool isctx, int b, int s, int j, int h, const float* __restrict__ rel_bias, float& bias) {
    bias = 0.f;
    if (isctx) return NLAT + b * CTX + j;
    if (MODE == 0) {
        if (j < 128) {
            const int i = j >> 4, cc = j & 15, r = s >> 6, cq = s & 63;
            const int rs = min(max(r - 4, 0), 24), cs = min(max(cq - 8, 0), 48);
            const int kr = rs + i, kc = cs + cc;
            bias = rel_bias[(h * 15 + (kr - r + 7)) * 31 + (kc - cq + 15)];
            return b * SEQ + kr * 64 + kc;
        }
        return NLAT + b * CTX + (j - 128);
    }
    return j < SEQ ? b * SEQ + j : NLAT + b * CTX + (j - SEQ);
}
template <int MODE>
__global__ void __launch_bounds__(128) k_attn_naive(const bf16_t* __restrict__ PB, const bf16_t* __restrict__ QM, const bf16_t* __restrict__ KVM,
                                                    bf16_t* __restrict__ HB, const float* __restrict__ rel_bias, const float* __restrict__ subln_g,
                                                    const float* __restrict__ lamp, float one_minus_li, int row0) {
    constexpr int NH = MODE == 2 ? 8 : 4;
    extern __shared__ float smem[];
    const int wave = threadIdx.x >> 6, lane = threadIdx.x & 63;
    const int item = blockIdx.x * 2 + wave;
    const int t = row0 + item / NH, h = item % NH;
    const bool isctx = t >= NLAT;
    const int b = isctx ? ((t - NLAT) >> 8) : (t >> 11), s = t & 2047;
    const int nkeys = isctx ? CTX : (MODE == 0 ? 384 : SEQ + CTX);
    float* qs = smem + wave * (128 + 2 * 2304);
    float* s1 = qs + 128; float* s2 = s1 + 2304;
    if (MODE == 0) qs[lane] = bf2f(PB[(size_t)t * PBS + O_NAQ + h * 64 + lane]);
    if (MODE == 1) qs[lane] = bf2f(PB[(size_t)t * PBS + O_DQ + h * 64 + lane]);
    if (MODE == 2) { qs[lane] = bf2f(QM[(size_t)t * 768 + h * 96 + lane]); if (lane < 32) qs[64 + lane] = bf2f(QM[(size_t)t * 768 + h * 96 + 64 + lane]); }
    __syncthreads();
    const float scale = MODE == 0 ? 0.125f : (MODE == 1 ? 0.17677669529663687f : 0.10206207261596575f);
    float m1 = -INFINITY, m2 = -INFINITY;
    for (int j = lane; j < nkeys; j += 64) {
        float bias; const int kr = key_row<MODE>(isctx, b, s, j, h, rel_bias, bias);
        if (MODE == 0) {
            const uint4* kp = (const uint4*)(PB + (size_t)kr * PBS + O_NAK + h * 64); float d = 0.f;
#pragma unroll
            for (int x = 0; x < 8; ++x) d += dot8(qs + 8 * x, kp[x]);
            d = d * scale + bias; s1[j] = d; m1 = fmaxf(m1, d);
        } else if (MODE == 1) {
            const uint4* kp = (const uint4*)(PB + (size_t)kr * PBS + O_DK + h * 64); float d0 = 0.f, d1 = 0.f;
#pragma unroll
            for (int x = 0; x < 4; ++x) { d0 += dot8(qs + 8 * x, kp[x]); d1 += dot8(qs + 32 + 8 * x, kp[4 + x]); }
            d0 *= scale; d1 *= scale; s1[j] = d0; s2[j] = d1; m1 = fmaxf(m1, d0); m2 = fmaxf(m2, d1);
        } else {
            const uint4* kp = (const uint4*)(KVM + (size_t)kr * 1024 + h * 128); const uint4* rp = (const uint4*)(PB + (size_t)kr * PBS + O_KR); float d = 0.f;
#pragma unroll
            for (int x = 0; x < 8; ++x) d += dot8(qs + 8 * x, kp[x]);
#pragma unroll
            for (int x = 0; x < 4; ++x) d += dot8(qs + 64 + 8 * x, rp[x]);
            d *= scale; s1[j] = d; m1 = fmaxf(m1, d);
        }
    }
    m1 = wave_max(m1); if (MODE == 1) m2 = wave_max(m2);
    float l1 = 0.f, l2 = 0.f;
    for (int j = lane; j < nkeys; j += 64) {
        const float p = expf(s1[j] - m1); s1[j] = p; l1 += p;
        if (MODE == 1) { const float q = expf(s2[j] - m2); s2[j] = q; l2 += q; }
    }
    l1 = wave_sum(l1); if (MODE == 1) l2 = wave_sum(l2);
    const float lam = MODE == 1 ? lamp[0] : 0.f;
    for (int j = lane; j < nkeys; j += 64) {
        if (MODE == 1) s1[j] = s1[j] / l1 - lam * (s2[j] / l2); else s1[j] = s1[j] / l1;
    }
    __syncthreads();
    float acc = 0.f;
    for (int j = 0; j < nkeys; ++j) {
        float bias; const int kr = key_row<MODE>(isctx, b, s, j, h, rel_bias, bias);
        float vv;
        if (MODE == 0) vv = bf2f(PB[(size_t)kr * PBS + O_NAV + h * 64 + lane]);
        else if (MODE == 1) vv = bf2f(PB[(size_t)kr * PBS + O_DV + h * 64 + lane]);
        else vv = bf2f(KVM[(size_t)kr * 1024 + h * 128 + 64 + lane]);
        acc += s1[j] * vv;
    }
    if (MODE == 0) HB[(size_t)t * DM + h * 64 + lane] = f2bf(acc);
    else if (MODE == 2) HB[(size_t)t * DM + 512 + h * 64 + lane] = f2bf(acc);
    else {
        const float ss = wave_sum(acc * acc);
        const float o = acc * rsqrtf(ss * (1.f / 64.f) + 1e-6f) * subln_g[lane] * one_minus_li;
        HB[(size_t)t * DM + 256 + h * 64 + lane] = f2bf(o);
    }
}

__global__ void __launch_bounds__(256) k_topk(const float* __restrict__ logits, const float* __restrict__ rbias, int* __restrict__ cnt, uint2* __restrict__ list) {
    const int t = blockIdx.x * 4 + (threadIdx.x >> 6), e = threadIdx.x & 63;
    const float lg = logits[(size_t)t * NEXP + e];
    const float sc = 1.f / (1.f + expf(-lg));
    const float sel = sc + rbias[e];
    float m1 = sel;
#pragma unroll
    for (int o = 1; o < 8; o <<= 1) m1 = fmaxf(m1, __shfl_xor(m1, o));
    int cand = (sel == m1) ? (e & 7) : 8;
#pragma unroll
    for (int o = 1; o < 8; o <<= 1) cand = min(cand, __shfl_xor(cand, o));
    float m2 = ((e & 7) == cand) ? -INFINITY : sel;
#pragma unroll
    for (int o = 1; o < 8; o <<= 1) m2 = fmaxf(m2, __shfl_xor(m2, o));
    const float grp = m1 + m2;
    const int g = e >> 3;
    int grank = 0;
#pragma unroll
    for (int gg = 0; gg < 8; ++gg) { const float og = __shfl(grp, gg * 8); grank += (og > grp || (og == grp && gg < g)) ? 1 : 0; }
    const bool gsel = grank < 4;
    const float ms = gsel ? sel : -INFINITY;
    int rk = 0;
    for (int ee = 0; ee < 64; ++ee) { const float o = __shfl(ms, ee); rk += (o > ms || (o == ms && ee < e)) ? 1 : 0; }
    const bool chosen = gsel && rk < 8;
    const float wsum = wave_sum(chosen ? sc : 0.f);
    const float w = sc / wsum * 2.5f;
    if (chosen) { const int slot = atomicAdd(&cnt[e], 1); list[(size_t)e * LCAP + slot] = make_uint2((unsigned)t, __float_as_uint(w)); }
}

__global__ void __launch_bounds__(256) k_moe_naive(const bf16_t* __restrict__ HB, const int* __restrict__ cnt, const uint2* __restrict__ list, int ntok,
                                                   const float* __restrict__ wg_l, const float* __restrict__ wu_l, const float* __restrict__ wd_l,
                                                   const float* __restrict__ sg_l, const float* __restrict__ su_l, const float* __restrict__ sd_l,
                                                   const float* __restrict__ mod_l, float* __restrict__ XS) {
    const int e = blockIdx.y, n = e < NEXP ? cnt[e] : ntok, slot0 = blockIdx.x * 8, tid = threadIdx.x;
    if (slot0 >= n) return;
    __shared__ float hs[8][1024];
    __shared__ float as[8][256];
    __shared__ int toks[8];
    __shared__ float wts[8];
    if (tid < 8) {
        const int slot = slot0 + tid; const bool valid = slot < n;
        int tk = 0; float w = 0.f;
        if (valid) { if (e < NEXP) { const uint2 en = list[(size_t)e * LCAP + slot]; tk = (int)en.x; w = __uint_as_float(en.y); } else { tk = slot; w = 1.f; } }
        toks[tid] = tk; wts[tid] = w;
    }
    __syncthreads();
#pragma unroll
    for (int i = 0; i < 8; ++i) {
        const bf16_t* hp = HB + (size_t)toks[i] * DM + tid * 4;
#pragma unroll
        for (int c = 0; c < 4; ++c) hs[i][tid * 4 + c] = bf2f(hp[c]);
    }
    __syncthreads();
    const float* WG = e < NEXP ? wg_l + (size_t)e * DM * EFF : sg_l;
    const float* WU = e < NEXP ? wu_l + (size_t)e * DM * EFF : su_l;
    const float* WD = e < NEXP ? wd_l + (size_t)e * EFF * DM : sd_l;
    float g[8], u[8];
#pragma unroll
    for (int i = 0; i < 8; ++i) { g[i] = 0.f; u[i] = 0.f; }
    for (int k = 0; k < DM; ++k) {
        const float wgv = WG[(size_t)k * EFF + tid], wuv = WU[(size_t)k * EFF + tid];
#pragma unroll
        for (int i = 0; i < 8; ++i) { const float hv = hs[i][k]; g[i] += hv * wgv; u[i] += hv * wuv; }
    }
#pragma unroll
    for (int i = 0; i < 8; ++i) as[i][tid] = (g[i] / (1.f + expf(-g[i]))) * u[i] * wts[i];
    __syncthreads();
    float o[8][4];
#pragma unroll
    for (int i = 0; i < 8; ++i)
#pragma unroll
        for (int j = 0; j < 4; ++j) o[i][j] = 0.f;
    for (int f = 0; f < EFF; ++f) {
        float wdv[4];
#pragma unroll
        for (int j = 0; j < 4; ++j) wdv[j] = WD[(size_t)f * DM + tid + 256 * j];
#pragma unroll
        for (int i = 0; i < 8; ++i) { const float a = as[i][f];
#pragma unroll
            for (int j = 0; j < 4; ++j) o[i][j] += a * wdv[j]; }
    }
#pragma unroll
    for (int i = 0; i < 8; ++i) {
        if (slot0 + i < n) {
            const int tk = toks[i], r = mod_row(tk);
#pragma unroll
            for (int j = 0; j < 4; ++j) { const int c = tid + 256 * j; atomicAdd(&XS[(size_t)tk * DM + c], mod_l[r * MODW + 5 * DM + c] * o[i][j]); }
        }
    }
}

__global__ void __launch_bounds__(256) k_final(const float* __restrict__ XS, const float* __restrict__ g, float* __restrict__ out) {
    __shared__ float red[4];
    const int t = blockIdx.x, tid = threadIdx.x;
    const float4 v = ((const float4*)(XS + (size_t)t * DM))[tid];
    float ss = v.x * v.x + v.y * v.y + v.z * v.z + v.w * v.w;
    ss = wave_sum(ss);
    if ((tid & 63) == 0) red[tid >> 6] = ss;
    __syncthreads();
    ss = red[0] + red[1] + red[2] + red[3];
    const float rstd = rsqrtf(ss * (1.f / DM) + 1e-6f);
    const float4 gv = ((const float4*)g)[tid];
    ((float4*)(out + (size_t)t * DM))[tid] = make_float4(v.x * rstd * gv.x, v.y * rstd * gv.y, v.z * rstd * gv.z, v.w * rstd * gv.w);
}

#define LAS __attribute__((address_space(3)))
typedef short bf16x8 __attribute__((ext_vector_type(8)));
typedef float f32x4 __attribute__((ext_vector_type(4)));
typedef float f32x2 __attribute__((ext_vector_type(2)));
typedef unsigned u32x2 __attribute__((ext_vector_type(2)));
typedef unsigned u32x4 __attribute__((ext_vector_type(4)));
typedef __bf16 bf16x2_t __attribute__((ext_vector_type(2)));

struct Params { const float* in[26]; float* out; unsigned char* ws; int layer, i1, i2, i3; };

constexpr int NTHREADS = 512;
constexpr int LDS_BYTES = 147456;

__device__ __forceinline__ unsigned pk_bf16(float lo, float hi) { f32x2 v = {lo, hi}; bf16x2_t b = __builtin_convertvector(v, bf16x2_t); return __builtin_bit_cast(unsigned, b); }

namespace g8 {
constexpr int BM = 256, BK = 64, HALF = 128, HTB = HALF * BK * 2, STAGE_BYTES = 8 * HTB, NXCD = 8, WGM = 8;
__host__ __device__ __forceinline__ int lds_byte(int r, int c) { const int st = (r >> 4) * 2 + (c >> 5), rr = r & 15, cc = c & 31, ob = rr * 64 + cc * 2; return st * 1024 + (ob ^ (((ob >> 9) & 1) << 5)); }
__host__ __device__ __forceinline__ void stage_rc(int b, int& R, int& C) { const int st = b / 1024, sb = b % 1024, swz = sb ^ (((sb >> 9) & 1) << 5); R = (st >> 1) * 16 + swz / 64; C = (st & 1) * 32 + (swz % 64) / 2; }

struct Unit2 { int pm, pn; };
struct DenseOrder {
    int nM, nN, nwg, G, c;
    __device__ __forceinline__ void init(int nM_, int nN_, int G_, int c_) { nM = nM_; nN = nN_; nwg = nM * nN; G = G_; c = c_; }
    __device__ __forceinline__ bool next(int i, Unit2& u) const {
        const long L = (long)i * G + c; if (L >= nwg) return false;
        int wgid = (int)L; { const int q = nwg / NXCD, r = nwg % NXCD, xcd = wgid % NXCD, off = wgid / NXCD; wgid = (xcd < r ? xcd * (q + 1) : r * (q + 1) + (xcd - r) * q) + off; }
        const int nig = WGM * nN, gid = wgid / nig, fm = gid * WGM, gsz = (nM - fm) < WGM ? (nM - fm) : WGM;
        u.pm = fm + ((wgid % nig) % gsz); u.pn = (wgid % nig) / gsz; return true;
    }
};

#define G8_SA(b, h) (((b) * 2 + (h)) * g8::HTB)
#define G8_SB(b, h) ((4 + (b) * 2 + (h)) * g8::HTB)
#define G8_GLDS(gp, ldsoff) __builtin_amdgcn_global_load_lds((const unsigned*)(gp), (LAS unsigned*)(lds + (ldsoff)), 16, 0, 0)
#define G8_STAGE_A(bufoff, o0, o1, kb) do { G8_GLDS(Ab + (o0) + (kb), (bufoff) + ldsw); G8_GLDS(Ab + (o1) + (kb), (bufoff) + ldsw + 8192); } while (0)
#define G8_STAGE_B(bufoff, bp, kb) do { G8_GLDS((bp) + voffB[0] + (kb), (bufoff) + ldsw); G8_GLDS((bp) + voffB[1] + (kb), (bufoff) + ldsw + 8192); } while (0)
#define G8_LDA(dst, b, h) do { _Pragma("unroll") for (int m = 0; m < 4; ++m) _Pragma("unroll") for (int k = 0; k < 2; ++k) dst[m][k] = *(const LAS bf16x8*)(lds + G8_SA(b, h) + aoff + m * 2048 + k * 1024); } while (0)
#define G8_LDB(dst, b, h) do { _Pragma("unroll") for (int n = 0; n < 2; ++n) _Pragma("unroll") for (int k = 0; k < 2; ++k) dst[n][k] = *(const LAS bf16x8*)(lds + G8_SB(b, h) + boff + n * 2048 + k * 1024); } while (0)
#define G8_MMA(ai, bj, At, Bt) do { __builtin_amdgcn_s_setprio(1); _Pragma("unroll") for (int m = 0; m < 4; ++m) _Pragma("unroll") for (int n = 0; n < 2; ++n) _Pragma("unroll") for (int k = 0; k < 2; ++k) \
        acc[ai][bj][m][n] = __builtin_amdgcn_mfma_f32_16x16x32_bf16(Bt[n][k], At[m][k], acc[ai][bj][m][n], 0, 0, 0); __builtin_amdgcn_s_setprio(0); } while (0)
#define G8_WAIT_V(n) asm volatile("s_waitcnt vmcnt(" #n ")" ::: "memory")
#define G8_WAIT_L(n) asm volatile("s_waitcnt lgkmcnt(" #n ")" ::: "memory")
#define G8_BAR __builtin_amdgcn_s_barrier()
#define G8_SCHED __builtin_amdgcn_sched_barrier(0)

template <class P>
__device__ __forceinline__ void gemm_phase(LAS unsigned char* lds, const P& pr) {
    typedef typename P::Unit Unit;
    constexpr int K = P::K, nt = K / BK;
    static_assert(K % 128 == 0 && nt >= 2, "K must be a multiple of 128");
    const int tid = threadIdx.x, wid = __builtin_amdgcn_readfirstlane(tid >> 6), lane = tid & 63, wr = wid >> 2, wc = wid & 3, fr = lane & 15, fq = lane >> 4;
    int Rr[2], Cc[2]; unsigned voffB[2];
#pragma unroll
    for (int i = 0; i < 2; ++i) { stage_rc(tid * 16 + i * 8192, Rr[i], Cc[i]); voffB[i] = (unsigned)(Rr[i] * K + Cc[i]) * 2u; }
    constexpr unsigned kstep = BK * 2;
    constexpr size_t hstepB = (size_t)HALF * K * 2;
    const unsigned ldsw = (unsigned)wid * 1024u;
    const int aoff = lds_byte(wr * 64 + fr, fq * 8), boff = lds_byte(wc * 32 + fr, fq * 8);
    Unit cur, nxt; int ui = 0;
    if (!pr.next(0, cur)) return;
    f32x4 acc[2][2][4][2];
#pragma unroll
    for (int a = 0; a < 2; ++a)
#pragma unroll
        for (int b = 0; b < 2; ++b)
#pragma unroll
            for (int m = 0; m < 4; ++m)
#pragma unroll
                for (int n = 0; n < 2; ++n) acc[a][b][m][n] = (f32x4){0.f, 0.f, 0.f, 0.f};
    bf16x8 At[4][2], B0[2][2], B1[2][2];
    const char* Ab = pr.a_base();
    unsigned ca[2][2], na[2][2];
    pr.a_offsets(cur, Rr, Cc, ca);
    const char* cB = pr.b_ptr(cur);
    G8_STAGE_B(G8_SB(0, 0), cB, 0); G8_STAGE_B(G8_SB(0, 1), cB + hstepB, 0); G8_STAGE_A(G8_SA(0, 0), ca[0][0], ca[0][1], 0); G8_STAGE_A(G8_SA(0, 1), ca[1][0], ca[1][1], 0);
    if (wr == 1) G8_BAR;
    G8_WAIT_V(2); G8_BAR;
    G8_STAGE_B(G8_SB(1, 0), cB, kstep); G8_STAGE_A(G8_SA(1, 0), ca[0][0], ca[0][1], kstep); G8_STAGE_B(G8_SB(1, 1), cB + hstepB, kstep);
    G8_WAIT_V(6); G8_BAR;
    for (;;) {
        const bool has_next = pr.next(ui + 1, nxt);
        const char* nB = cB;
#pragma unroll
        for (int h = 0; h < 2; ++h)
#pragma unroll
            for (int i = 0; i < 2; ++i) na[h][i] = ca[h][i];
        if (has_next) { pr.a_offsets(nxt, Rr, Cc, na); nB = pr.b_ptr(nxt); }
#pragma unroll 1
        for (int t = 0; t < nt; t += 2) {
            const bool last = (t == nt - 2);
            const unsigned k1 = (unsigned)(t + 1) * kstep, k2 = (unsigned)(t + 2) * kstep;
            unsigned a2[2][2];
#pragma unroll
            for (int h = 0; h < 2; ++h)
#pragma unroll
                for (int i = 0; i < 2; ++i) a2[h][i] = last ? na[h][i] : ca[h][i] + k2;
            const char* b2 = last ? nB : cB + k2;
            G8_LDB(B0, 0, 0); G8_LDB(B1, 0, 1); G8_SCHED; G8_LDA(At, 0, 0); G8_STAGE_A(G8_SA(1, 1), ca[1][0], ca[1][1], k1);
            G8_WAIT_V(8); G8_WAIT_L(0); G8_BAR; G8_MMA(0, 0, At, B0); G8_MMA(0, 1, At, B1); G8_BAR; G8_SCHED;
            G8_LDA(At, 0, 1); G8_STAGE_B(G8_SB(0, 0), b2, 0); G8_STAGE_B(G8_SB(0, 1), b2 + hstepB, 0); G8_STAGE_A(G8_SA(0, 0), a2[0][0], a2[0][1], 0);
            G8_WAIT_V(8); G8_WAIT_L(0); G8_BAR; G8_MMA(1, 0, At, B0); G8_MMA(1, 1, At, B1); G8_BAR; G8_SCHED;
            G8_LDB(B0, 1, 0); G8_LDB(B1, 1, 1); G8_SCHED; G8_LDA(At, 1, 0); G8_STAGE_A(G8_SA(0, 1), a2[1][0], a2[1][1], 0);
            G8_WAIT_V(8); G8_WAIT_L(0); G8_BAR; G8_MMA(0, 0, At, B0); G8_MMA(0, 1, At, B1); G8_BAR; G8_SCHED;
            G8_LDA(At, 1, 1); G8_STAGE_B(G8_SB(1, 0), b2, kstep); G8_STAGE_B(G8_SB(1, 1), b2 + hstepB, kstep); G8_STAGE_A(G8_SA(1, 0), a2[0][0], a2[0][1], kstep);
            G8_WAIT_V(8); G8_WAIT_L(0); G8_BAR; G8_MMA(1, 0, At, B0); G8_MMA(1, 1, At, B1); G8_BAR; G8_SCHED;
        }
        if (wr == 0) G8_BAR;
        pr.epilogue(acc, cur, wr, wc, fr, fq);
        if (!has_next) break;
#pragma unroll
        for (int a = 0; a < 2; ++a)
#pragma unroll
            for (int b = 0; b < 2; ++b)
#pragma unroll
                for (int m = 0; m < 4; ++m)
#pragma unroll
                    for (int n = 0; n < 2; ++n) acc[a][b][m][n] = (f32x4){0.f, 0.f, 0.f, 0.f};
        cur = nxt; cB = nB; ++ui;
#pragma unroll
        for (int h = 0; h < 2; ++h)
#pragma unroll
            for (int i = 0; i < 2; ++i) ca[h][i] = na[h][i];
        if (wr == 1) G8_BAR;
    }
    G8_WAIT_V(0);
    G8_BAR;
}
}

struct Ws {
    unsigned* ctl; float* mod; float* lam; float* rope; float* ssq; float* sskv;
    float* XS; bf16_t* HB; bf16_t* PB; bf16_t* QM; bf16_t* KVM; bf16_t* WB;
    __device__ __host__ __forceinline__ explicit Ws(unsigned char* ws) {
        ctl = (unsigned*)(ws + WS_CTL); mod = (float*)(ws + WS_MOD); lam = mod + 2 * 17 * MODW; rope = (float*)(ws + WS_ROPE);
        ssq = (float*)(ws + WS_SSQ); sskv = ssq + (size_t)NTOK * 4;
        XS = (float*)(ws + WS_XS); HB = (bf16_t*)(ws + WS_HB); PB = (bf16_t*)(ws + WS_PB); QM = (bf16_t*)(ws + WS_QM); KVM = (bf16_t*)(ws + WS_KVM); WB = (bf16_t*)(ws + WS_WB);
    }
};

__device__ __forceinline__ void conv_tile(const float* __restrict__ W, int N, int k0, int n0, bf16_t* __restrict__ Bt, int ldo, int mode, const float* __restrict__ kscale, LAS float* tile) {
    const int tid = threadIdx.x;
#pragma unroll
    for (int i = 0; i < 8; ++i) {
        const int kk = (tid >> 6) + 8 * i, n = tid & 63;
        float v = (n0 + n < N) ? W[(size_t)(k0 + kk) * N + n0 + n] : 0.f;
        if (kscale) v *= kscale[k0 + kk];
        tile[kk * 65 + n] = v;
    }
    __syncthreads();
#pragma unroll
    for (int i = 0; i < 2; ++i) {
        const int item = tid + 512 * i, n = item >> 4, kq = item & 15, ng = n0 + n;
        if (ng < N) {
            const int drow = mode == 0 ? ng : (32 * (ng >> 4) + (ng & 15) + (mode == 2 ? 16 : 0));
            const LAS float* s = tile + (4 * kq) * 65 + n;
            u32x2 o; o.x = pk_bf16(s[0], s[65]); o.y = pk_bf16(s[130], s[195]);
            *(u32x2*)(Bt + (size_t)drow * ldo + k0 + 4 * kq) = o;
        }
    }
    __syncthreads();
}
__device__ __forceinline__ void phase_convert(const Params& P, LAS unsigned char* lds) {
    const Ws W(P.ws);
    const int l = P.layer, tid = threadIdx.x, c = blockIdx.x, G = gridDim.x;
    LAS float* tile = (LAS float*)lds;
    constexpr int I_E = 65 * 192, I_IN = 16 * 31, I_OUT = 256, I_UQ = 48, I_UKV = 32, NITEMS = I_E + I_IN + I_OUT + I_UQ + I_UKV;
    for (int it = c; it < NITEMS; it += G) {
        int r = it;
        if (r < I_E) {
            const int e = r / 192, w = (r % 192) / 64, t = r % 64;
            if (w < 2) {
                const float* src = e < 64 ? P.in[19 + w] + ((size_t)l * 64 + e) * 262144 : P.in[22 + w] + (size_t)l * 262144;
                conv_tile(src, 256, (t >> 2) * 64, (t & 3) * 64, W.WB + WB_WGU + (size_t)e * 524288, 1024, 1 + w, nullptr, tile);
            } else {
                const float* src = e < 64 ? P.in[21] + ((size_t)l * 64 + e) * 262144 : P.in[24] + (size_t)l * 262144;
                conv_tile(src, 1024, (t >> 4) * 64, (t & 15) * 64, W.WB + WB_WD + (size_t)e * 262144, 256, 0, nullptr, tile);
            }
            continue;
        }
        r -= I_E;
        if (r < I_IN) { conv_tile(P.in[8] + (size_t)l * 1024 * INC, INC, (r / 31) * 64, (r % 31) * 64, W.WB + WB_WIN, 1024, 0, nullptr, tile); continue; }
        r -= I_IN;
        if (r < I_OUT) { conv_tile(P.in[16] + (size_t)l * 1024 * 1024, 1024, (r >> 4) * 64, (r & 15) * 64, W.WB + WB_WOUT, 1024, 0, nullptr, tile); continue; }
        r -= I_OUT;
        if (r < I_UQ) { conv_tile(P.in[13] + (size_t)l * 256 * 768, 768, (r / 12) * 64, (r % 12) * 64, W.WB + WB_WUQ, 256, 0, P.in[12] + l * 256, tile); continue; }
        r -= I_UQ;
        conv_tile(P.in[15] + (size_t)l * 128 * 1024, 1024, (r >> 4) * 64, (r & 15) * 64, W.WB + WB_WUKV, 256, 0, P.in[14] + l * 128, tile);
    }
    {
        const int gid = c * NTHREADS + tid, gsz = G * NTHREADS;
        const u32x4 z = {0u, 0u, 0u, 0u};
        for (int i = gid; i < 96 * 128; i += gsz) *(u32x4*)(W.WB + WB_WIN + (size_t)1952 * 1024 + (size_t)i * 8) = z;
        for (int i = gid; i < 1024 * 16; i += gsz) *(u32x4*)(W.WB + WB_WUKV + (size_t)(i >> 4) * 256 + 128 + (i & 15) * 8) = z;
    }
    if (l == 0) {
        LAS float* st = (LAS float*)lds;
        LAS float* red = st + 17 * 1024;
        const int wave = tid >> 6, lane = tid & 63;
        for (int u = c; u < 192; u += G) {
            const int l2 = u / 96, cg = u % 96;
            for (int i = tid; i < 17 * 1024; i += NTHREADS) { const int r = i >> 10, k = i & 1023; const float v = r < 16 ? P.in[1][r * 1024 + k] : P.in[3][k]; st[i] = v / (1.f + expf(-v)); }
            __syncthreads();
            const float* w = P.in[4] + (size_t)l2 * 1024 * MODW + cg * 64 + lane;
            float a[17];
#pragma unroll
            for (int r = 0; r < 17; ++r) a[r] = 0.f;
            for (int k = wave * 128; k < wave * 128 + 128; ++k) {
                const float wv = w[(size_t)k * MODW];
#pragma unroll
                for (int r = 0; r < 17; ++r) a[r] += st[r * 1024 + k] * wv;
            }
#pragma unroll
            for (int r = 0; r < 17; ++r) red[(wave * 17 + r) * 64 + lane] = a[r];
            __syncthreads();
            for (int i = tid; i < 17 * 64; i += NTHREADS) {
                const int r = i >> 6, col = i & 63; float s = 0.f;
#pragma unroll
                for (int w8 = 0; w8 < 8; ++w8) s += red[(w8 * 17 + r) * 64 + col];
                W.mod[((size_t)l2 * 17 + r) * MODW + cg * 64 + col] = s + P.in[5][l2 * MODW + cg * 64 + col];
            }
            __syncthreads();
        }
        for (int i = c * NTHREADS + tid; i < 2048 * 16; i += G * NTHREADS) { float cs, sn; rope_cs(i >> 4, i & 15, cs, sn); W.rope[2 * i] = cs; W.rope[2 * i + 1] = sn; }
        if (c == G - 1 && wave == 0) {
            for (int l2 = 0; l2 < 2; ++l2) {
                const float* lv = P.in[10] + l2 * 128;
                float a = lane < 32 ? lv[lane] * lv[32 + lane] : 0.f, b = lane < 32 ? lv[64 + lane] * lv[96 + lane] : 0.f;
                a = wave_sum(a); b = wave_sum(b);
                const float li = 0.8f - 0.6f * expf(-0.3f * (float)l2);
                if (lane == 0) W.lam[l2] = expf(a) - expf(b) + li;
            }
        }
    }
}

struct ProbInProj {
    typedef g8::Unit2 Unit; static constexpr int K = 1024;
    g8::DenseOrder ord; const bf16_t* A; const bf16_t* Bt; bf16_t* PB; const float* rope; float* ssq; float* sskv;
    __device__ __forceinline__ bool next(int i, Unit& u) const { return ord.next(i, u); }
    __device__ __forceinline__ const char* a_base() const { return (const char*)A; }
    __device__ __forceinline__ void a_offsets(const Unit& u, const int (&R)[2], const int (&C)[2], unsigned (&o)[2][2]) const {
#pragma unroll
        for (int h = 0; h < 2; ++h)
#pragma unroll
            for (int i = 0; i < 2; ++i) o[h][i] = (unsigned)((u.pm * 256 + h * 128 + R[i]) * K + C[i]) * 2u;
    }
    __device__ __forceinline__ const char* b_ptr(const Unit& u) const { return (const char*)(Bt + (size_t)u.pn * 256 * K); }
    __device__ __forceinline__ void epilogue(const f32x4 (&acc)[2][2][4][2], const Unit& u, int wr, int wc, int fr, int fq) const {
        const int pn = u.pn; const bool lat = u.pm < NLAT / 256;
        const int rowb = u.pm * 256 + wr * 64 + fr, colb = pn * 256 + wc * 32 + 4 * fq;
        const bool want_ss = pn >= 6;
#pragma unroll
        for (int ai = 0; ai < 2; ++ai)
#pragma unroll
            for (int m = 0; m < 4; ++m) {
                const int row = rowb + ai * 128 + m * 16;
                bf16_t* prow = PB + (size_t)row * PBS + colb;
                float ss = 0.f;
#pragma unroll
                for (int bj = 0; bj < 2; ++bj) {
                    f32x4 v0 = acc[ai][bj][m][0], v1 = acc[ai][bj][m][1];
                    const bool rp = lat && (pn == 3 || pn == 4 || (pn == 7 && bj == 1 && wc == 0));
                    if (rp) {
                        const f32x4* tb = (const f32x4*)(rope + ((size_t)(row & 2047) * 16 + 4 * fq) * 2);
                        const f32x4 t0 = tb[0], t1 = tb[1];
                        const f32x4 cs = {t0[0], t0[2], t1[0], t1[2]}, sn = {t0[1], t0[3], t1[1], t1[3]};
                        const f32x4 o1 = v0 * cs - v1 * sn, o2 = v0 * sn + v1 * cs;
                        v0 = o1; v1 = o2;
                    }
                    u32x2 w0, w1; w0.x = pk_bf16(v0[0], v0[1]); w0.y = pk_bf16(v0[2], v0[3]); w1.x = pk_bf16(v1[0], v1[1]); w1.y = pk_bf16(v1[2], v1[3]);
                    *(u32x2*)(prow + bj * 128) = w0; *(u32x2*)(prow + bj * 128 + 16) = w1;
                    if (want_ss && (pn == 6 || bj == 0)) {
                        const float a0 = __uint_as_float(w0.x << 16), a1 = __uint_as_float(w0.x & 0xffff0000u), a2 = __uint_as_float(w0.y << 16), a3 = __uint_as_float(w0.y & 0xffff0000u);
                        const float b0 = __uint_as_float(w1.x << 16), b1 = __uint_as_float(w1.x & 0xffff0000u), b2 = __uint_as_float(w1.y << 16), b3 = __uint_as_float(w1.y & 0xffff0000u);
                        ss += a0 * a0 + a1 * a1 + a2 * a2 + a3 * a3 + b0 * b0 + b1 * b1 + b2 * b2 + b3 * b3;
                    }
                }
                if (want_ss) {
                    ss += __shfl_xor(ss, 16); ss += __shfl_xor(ss, 32);
                    if (fq == 0) (pn == 6 ? ssq : sskv)[(size_t)row * 4 + wc] = ss;
                }
            }
    }
};
__device__ __forceinline__ void phase_inproj(const Params& P, LAS unsigned char* lds) {
    const Ws W(P.ws);
    ProbInProj pr; pr.ord.init(NTOK / 256, 8, gridDim.x, blockIdx.x);
    pr.A = W.HB; pr.Bt = W.WB + WB_WIN; pr.PB = W.PB; pr.rope = W.rope; pr.ssq = W.ssq; pr.sskv = W.sskv;
    g8::gemm_phase(lds, pr);
}

struct UnitM { int pm, pn, kv; };
struct ProbMla {
    typedef UnitM Unit; static constexpr int K = 256;
    int nq_units, n_units, G, c;
    const bf16_t* PBp; const bf16_t* Wuq; const bf16_t* Wukv; bf16_t* QM; bf16_t* KVM; const float* rope; const float* ssq; const float* sskv;
    __device__ __forceinline__ bool next(int i, Unit& u) const {
        const int L = i * G + c; if (L >= n_units) return false;
        if (L < nq_units) { u.kv = 0; u.pm = L / 3; u.pn = L % 3; } else { const int r = L - nq_units; u.kv = 1; u.pm = r >> 2; u.pn = r & 3; }
        return true;
    }
    __device__ __forceinline__ const char* a_base() const { return (const char*)PBp; }
    __device__ __forceinline__ void a_offsets(const Unit& u, const int (&R)[2], const int (&C)[2], unsigned (&o)[2][2]) const {
        const int cb = u.kv ? O_CKV : O_CQ;
#pragma unroll
        for (int h = 0; h < 2; ++h)
#pragma unroll
            for (int i = 0; i < 2; ++i) o[h][i] = (unsigned)((u.pm * 256 + h * 128 + R[i]) * PBS + cb + C[i]) * 2u;
    }
    __device__ __forceinline__ const char* b_ptr(const Unit& u) const { return (const char*)((u.kv ? Wukv : Wuq) + (size_t)u.pn * 256 * K); }
    __device__ __forceinline__ void epilogue(const f32x4 (&acc)[2][2][4][2], const Unit& u, int wr, int wc, int fr, int fq) const {
        const bool lat = u.pm < NLAT / 256;
        const int rowb = u.pm * 256 + wr * 64 + fr, colb = u.pn * 256 + wc * 32 + 4 * fq;
        const float* ssp = u.kv ? sskv : ssq; const float inv = u.kv ? (1.f / 128.f) : (1.f / 256.f);
        bf16_t* O = u.kv ? KVM : QM; const int ldo = u.kv ? 1024 : 768;
#pragma unroll
        for (int ai = 0; ai < 2; ++ai)
#pragma unroll
            for (int m = 0; m < 4; ++m) {
                const int row = rowb + ai * 128 + m * 16;
                const f32x4 s4 = *(const f32x4*)(ssp + (size_t)row * 4);
                const float rstd = rsqrtf((s4[0] + s4[1] + s4[2] + s4[3]) * inv + 1e-6f);
                bf16_t* prow = O + (size_t)row * ldo + colb;
#pragma unroll
                for (int bj = 0; bj < 2; ++bj) {
                    f32x4 v0 = acc[ai][bj][m][0] * rstd, v1 = acc[ai][bj][m][1] * rstd;
                    const int g32 = u.pn * 8 + bj * 4 + wc;
                    if (!u.kv && lat && (g32 % 3) == 2) {
                        const f32x4* tb = (const f32x4*)(rope + ((size_t)(row & 2047) * 16 + 4 * fq) * 2);
                        const f32x4 t0 = tb[0], t1 = tb[1];
                        const f32x4 cs = {t0[0], t0[2], t1[0], t1[2]}, sn = {t0[1], t0[3], t1[1], t1[3]};
                        const f32x4 o1 = v0 * cs - v1 * sn, o2 = v0 * sn + v1 * cs;
                        v0 = o1; v1 = o2;
                    }
                    u32x2 w0, w1; w0.x = pk_bf16(v0[0], v0[1]); w0.y = pk_bf16(v0[2], v0[3]); w1.x = pk_bf16(v1[0], v1[1]); w1.y = pk_bf16(v1[2], v1[3]);
                    *(u32x2*)(prow + bj * 128) = w0; *(u32x2*)(prow + bj * 128 + 16) = w1;
                }
            }
    }
};
__device__ __forceinline__ void phase_mla(const Params& P, LAS unsigned char* lds) {
    const Ws W(P.ws);
    const int nq = P.layer == 0 ? NTOK : NLAT;
    ProbMla pr; pr.nq_units = (nq / 256) * 3; pr.n_units = pr.nq_units + (NTOK / 256) * 4; pr.G = gridDim.x; pr.c = blockIdx.x;
    pr.PBp = W.PB; pr.Wuq = W.WB + WB_WUQ; pr.Wukv = W.WB + WB_WUKV; pr.QM = W.QM; pr.KVM = W.KVM; pr.rope = W.rope; pr.ssq = W.ssq; pr.sskv = W.sskv;
    g8::gemm_phase(lds, pr);
}

struct ProbOut {
    typedef g8::Unit2 Unit; static constexpr int K = 1024;
    g8::DenseOrder ord; const bf16_t* A; const bf16_t* Bt; float* XS; const float* x_in; const float* ctx_in; const float* mod_l; int layer;
    __device__ __forceinline__ bool next(int i, Unit& u) const { return ord.next(i, u); }
    __device__ __forceinline__ const char* a_base() const { return (const char*)A; }
    __device__ __forceinline__ void a_offsets(const Unit& u, const int (&R)[2], const int (&C)[2], unsigned (&o)[2][2]) const {
#pragma unroll
        for (int h = 0; h < 2; ++h)
#pragma unroll
            for (int i = 0; i < 2; ++i) o[h][i] = (unsigned)((u.pm * 256 + h * 128 + R[i]) * K + C[i]) * 2u;
    }
    __device__ __forceinline__ const char* b_ptr(const Unit& u) const { return (const char*)(Bt + (size_t)u.pn * 256 * K); }
    __device__ __forceinline__ void epilogue(const f32x4 (&acc)[2][2][4][2], const Unit& u, int wr, int wc, int fr, int fq) const {
        const int r = u.pm < NLAT / 256 ? (u.pm >> 3) : 16;
        const int rowb = u.pm * 256 + wr * 64 + fr, colb = u.pn * 256 + wc * 32 + 4 * fq;
        const float* gate = mod_l + r * MODW + 2 * DM + colb;
        f32x4 gv[2][2];
#pragma unroll
        for (int bj = 0; bj < 2; ++bj)
#pragma unroll
            for (int n = 0; n < 2; ++n) gv[bj][n] = *(const f32x4*)(gate + bj * 128 + n * 16);
#pragma unroll
        for (int ai = 0; ai < 2; ++ai)
#pragma unroll
            for (int m = 0; m < 4; ++m) {
                const int row = rowb + ai * 128 + m * 16;
                float* xo = XS + (size_t)row * DM + colb;
                const float* xi = layer == 0 ? (row < NLAT ? x_in + (size_t)row * DM : ctx_in + (size_t)(row - NLAT) * DM) + colb : xo;
#pragma unroll
                for (int bj = 0; bj < 2; ++bj)
#pragma unroll
                    for (int n = 0; n < 2; ++n) {
                        const f32x4 b = *(const f32x4*)(xi + bj * 128 + n * 16);
                        *(f32x4*)(xo + bj * 128 + n * 16) = b + gv[bj][n] * acc[ai][bj][m][n];
                    }
            }
    }
};
__device__ __forceinline__ void phase_outproj(const Params& P, LAS unsigned char* lds) {
    const Ws W(P.ws);
    const int nq = P.layer == 0 ? NTOK : NLAT;
    ProbOut pr; pr.ord.init(nq / 256, 4, gridDim.x, blockIdx.x);
    pr.A = W.HB; pr.Bt = W.WB + WB_WOUT; pr.XS = W.XS; pr.x_in = P.in[0]; pr.ctx_in = P.in[2]; pr.mod_l = W.mod + (size_t)P.layer * 17 * MODW; pr.layer = P.layer;
    g8::gemm_phase(lds, pr);
}

enum { PH_CONV = 0, PH_INPROJ = 1, PH_MLA = 2, PH_OUTPROJ = 3 };
template <int PH>
__global__ void __launch_bounds__(NTHREADS, 2) k_phase(Params P) {
    extern __shared__ __attribute__((aligned(16))) unsigned char dyn_lds[];
    LAS unsigned char* lds = (LAS unsigned char*)dyn_lds;
    if (PH == PH_CONV) phase_convert(P, lds);
    if (PH == PH_INPROJ) phase_inproj(P, lds);
    if (PH == PH_MLA) phase_mla(P, lds);
    if (PH == PH_OUTPROJ) phase_outproj(P, lds);
}

#ifndef FAST_GEMMS
#define FAST_GEMMS 1
#endif
template <int PH> static void launch_phase(const Params& P, int grid, hipStream_t stream) {
    static bool attr_set = false;
    if (!attr_set) { (void)hipFuncSetAttribute((const void*)k_phase<PH>, hipFuncAttributeMaxDynamicSharedMemorySize, LDS_BYTES); attr_set = true; }
    hipLaunchKernelGGL(k_phase<PH>, dim3(grid), dim3(NTHREADS), LDS_BYTES, stream, P);
}
extern "C" void kernel_launch(void* const* d_in, const int* in_sizes, int n_in, void* d_out, int out_size, void* d_ws, size_t ws_size, hipStream_t stream) {
    if (ws_size < WS_END || n_in != 26) { fprintf(stderr, "kernel_launch: workspace %zu < %zu or n_in %d != 26\n", ws_size, (size_t)WS_END, n_in); return; }
    static int grid = 0;
    if (!grid) { int dev = 0, cus = 0; (void)hipGetDevice(&dev); (void)hipDeviceGetAttribute(&cus, hipDeviceAttributeMultiprocessorCount, dev); grid = cus > 0 ? cus : 256; }
    const float* x = (const float*)d_in[0];       const float* c = (const float*)d_in[1];
    const float* ctx = (const float*)d_in[2];     const float* c_ctx = (const float*)d_in[3];
    const float* w_ada = (const float*)d_in[4];   const float* b_ada = (const float*)d_in[5];
    const float* norm_attn_g = (const float*)d_in[6]; const float* norm_ffn_g = (const float*)d_in[7];
    const float* w_in = (const float*)d_in[8];    const float* na_rel_bias = (const float*)d_in[9];
    const float* diff_lambda = (const float*)d_in[10]; const float* diff_subln_g = (const float*)d_in[11];
    const float* mla_q_norm_g = (const float*)d_in[12]; const float* mla_w_uq = (const float*)d_in[13];
    const float* mla_kv_norm_g = (const float*)d_in[14]; const float* mla_w_ukv = (const float*)d_in[15];
    const float* w_out = (const float*)d_in[16];  const float* router_w = (const float*)d_in[17];
    const float* router_bias = (const float*)d_in[18];
    const float* ewg = (const float*)d_in[19];    const float* ewu = (const float*)d_in[20];   const float* ewd = (const float*)d_in[21];
    const float* swg = (const float*)d_in[22];    const float* swu = (const float*)d_in[23];   const float* swd = (const float*)d_in[24];
    const float* final_norm_g = (const float*)d_in[25];
    unsigned char* ws = (unsigned char*)d_ws;
    Ws W(ws);
    int* cnt = (int*)(ws + WS_CTL) + 8192;
    float* mod = W.mod; float* lam = W.lam;
    float* logits = (float*)(ws + WS_LOG);
    uint2* list = (uint2*)(ws + WS_LIST);
    float* XS = W.XS; bf16_t* HB = W.HB; bf16_t* PB = W.PB; bf16_t* QM = W.QM; bf16_t* KVM = W.KVM;
    Params P{}; for (int i = 0; i < 26; ++i) P.in[i] = (const float*)d_in[i]; P.out = (float*)d_out; P.ws = ws;

    (void)hipMemsetAsync(ws + WS_CTL, 0, 1 * MiB, stream);
    (void)hipMemcpyAsync(XS, x, (size_t)NLAT * DM * 4, hipMemcpyDeviceToDevice, stream);
    (void)hipMemcpyAsync(XS + (size_t)NLAT * DM, ctx, (size_t)NCTX * DM * 4, hipMemcpyDeviceToDevice, stream);
#if !FAST_GEMMS
    k_mod<<<(2 * 17 * MODW + 255) / 256, 256, 0, stream>>>(c, c_ctx, w_ada, b_ada, mod);
    k_lam<<<1, 64, 0, stream>>>(diff_lambda, lam);
#endif
    const size_t attn_lds = 2 * (128 + 2 * 2304) * sizeof(float);
    for (int l = 0; l < 2; ++l) {
        const int nq = l == 0 ? NTOK : NLAT;
        const float* mod_l = mod + (size_t)l * 17 * MODW;
        const float li = 0.8f - 0.6f * expf(-0.3f * (float)l);
        P.layer = l;
#if FAST_GEMMS
        launch_phase<PH_CONV>(P, grid, stream);
#endif
        k_norm<false><<<NTOK, 256, 0, stream>>>(XS, norm_attn_g + l * DM, mod_l, 0, 1, HB, nullptr, nullptr);
#if FAST_GEMMS
        launch_phase<PH_INPROJ>(P, grid, stream);
        launch_phase<PH_MLA>(P, grid, stream);
#else
        (void)hipMemsetAsync(PB, 0, (size_t)NTOK * PBS * 2, stream);
        { EpiStore ep{}; ep.O = PB; ep.ldo = PBS; ep.coloff = 0;
          k_gemm_naive<EpiStore><<<dim3((INC + 127) / 128, NTOK / 128), 256, 0, stream>>>(HB, DM, w_in + (size_t)l * DM * INC, INC, INC, DM, ep); }
        k_rope_pb<<<(NLAT * 17 * 16) / 256, 256, 0, stream>>>(PB);
        k_mla_norm<<<NTOK / 4, 256, 0, stream>>>(PB, mla_q_norm_g + l * 256, mla_kv_norm_g + l * 128);
        { EpiStore ep{}; ep.O = QM; ep.ldo = 768; ep.coloff = 0;
          k_gemm_naive<EpiStore><<<dim3(768 / 128, NTOK / 128), 256, 0, stream>>>(PB + O_CQ, PBS, mla_w_uq + (size_t)l * 256 * 768, 768, 768, 256, ep); }
        { EpiStore ep{}; ep.O = KVM; ep.ldo = 1024; ep.coloff = 0;
          k_gemm_naive<EpiStore><<<dim3(1024 / 128, NTOK / 128), 256, 0, stream>>>(PB + O_CKV, PBS, mla_w_ukv + (size_t)l * 128 * 1024, 1024, 1024, 128, ep); }
        k_rope_qm<<<(NLAT * 8 * 16) / 256, 256, 0, stream>>>(QM);
#endif
        k_attn_naive<0><<<nq * 4 / 2, 128, attn_lds, stream>>>(PB, QM, KVM, HB, na_rel_bias + l * 4 * 15 * 31, diff_subln_g + l * 64, lam + l, 1.f - li, 0);
        k_attn_naive<1><<<nq * 4 / 2, 128, attn_lds, stream>>>(PB, QM, KVM, HB, na_rel_bias + l * 4 * 15 * 31, diff_subln_g + l * 64, lam + l, 1.f - li, 0);
        k_attn_naive<2><<<nq * 8 / 2, 128, attn_lds, stream>>>(PB, QM, KVM, HB, na_rel_bias + l * 4 * 15 * 31, diff_subln_g + l * 64, lam + l, 1.f - li, 0);
#if FAST_GEMMS
        launch_phase<PH_OUTPROJ>(P, grid, stream);
#else
        { EpiResid ep{}; ep.XS = XS; ep.mod_l = mod_l; ep.chunk = 2; ep.pad = 0;
          k_gemm_naive<EpiResid><<<dim3(DM / 128, nq / 128), 256, 0, stream>>>(HB, DM, w_out + (size_t)l * DM * DM, DM, DM, DM, ep); }
#endif
        (void)hipMemsetAsync(cnt, 0, 4096, stream);
        k_norm<true><<<nq, 256, 0, stream>>>(XS, norm_ffn_g + l * DM, mod_l, 3, 4, HB, router_w + (size_t)l * DM * NEXP, logits);
        k_topk<<<nq / 4, 256, 0, stream>>>(logits, router_bias + l * NEXP, cnt, list);
        k_moe_naive<<<dim3((nq + 7) / 8, NEXP + 1), 256, 0, stream>>>(HB, cnt, list, nq,
            ewg + (size_t)l * NEXP * DM * EFF, ewu + (size_t)l * NEXP * DM * EFF, ewd + (size_t)l * NEXP * EFF * DM,
            swg + (size_t)l * DM * EFF, swu + (size_t)l * DM * EFF, swd + (size_t)l * EFF * DM, mod_l, XS);
    }
    k_final<<<NLAT, 256, 0, stream>>>(XS, final_norm_g, (float*)d_out);
}
```

```cpp
#include <hip/hip_runtime.h>
#include <cstdint>
#include <cstdio>
#include <cmath>

typedef unsigned short bf16_t;

constexpr int NB = 16, SEQ = 2048, DM = 1024, CTX = 256;
constexpr int NLAT = NB * SEQ, NCTX = NB * CTX, NTOK = NLAT + NCTX;
constexpr int INC = 1952;
constexpr int PBS = 2048;
constexpr int O_NAQ = 0, O_NAK = 256, O_NAV = 512, O_DQ = 768, O_DK = 1024, O_DV = 1280, O_CQ = 1536, O_CKV = 1792, O_KR = 1920;
constexpr int NEXP = 64, EFF = 256;
constexpr int LCAP = NTOK;
constexpr int MODW = 6 * DM;

constexpr size_t MiB = 1u << 20;
constexpr size_t WS_CTL = 0;
constexpr size_t WS_MOD = 1 * MiB;
constexpr size_t WS_ROPE = 2 * MiB;
constexpr size_t WS_SSQ = 3 * MiB;
constexpr size_t WS_XS = 8 * MiB;
constexpr size_t WS_HB = 152 * MiB;
constexpr size_t WS_PB = 224 * MiB;
constexpr size_t WS_QM = 368 * MiB;
constexpr size_t WS_KVM = 422 * MiB;
constexpr size_t WS_WB = 494 * MiB;
constexpr size_t WS_END = 600 * MiB;
constexpr size_t WS_LOG = WS_PB;
constexpr size_t WS_LIST = WS_PB + 16 * MiB;
constexpr size_t WB_WIN = 0;
constexpr size_t WB_WUQ = WB_WIN + (size_t)2048 * 1024;
constexpr size_t WB_WUKV = WB_WUQ + (size_t)768 * 256;
constexpr size_t WB_WOUT = WB_WUKV + (size_t)1024 * 256;
constexpr size_t WB_WGU = WB_WOUT + (size_t)1024 * 1024;
constexpr size_t WB_WD = WB_WGU + (size_t)65 * 512 * 1024;
constexpr size_t WB_END = WB_WD + (size_t)65 * 1024 * 256;
static_assert(WS_WB + WB_END * 2 <= WS_END, "weights fit");

__device__ __forceinline__ float bf2f(bf16_t v) { return __uint_as_float(((unsigned)v) << 16); }
__device__ __forceinline__ bf16_t f2bf(float f) { unsigned u = __float_as_uint(f); u += 0x7fffu + ((u >> 16) & 1u); return (bf16_t)(u >> 16); }
__device__ __forceinline__ float wave_sum(float v) {
#pragma unroll
    for (int o = 32; o > 0; o >>= 1) v += __shfl_xor(v, o);
    return v;
}
__device__ __forceinline__ float wave_max(float v) {
#pragma unroll
    for (int o = 32; o > 0; o >>= 1) v = fmaxf(v, __shfl_xor(v, o));
    return v;
}
__device__ __forceinline__ int mod_row(int t) { return t < NLAT ? (t >> 11) : 16; }

__global__ void k_mod(const float* __restrict__ c, const float* __restrict__ c_ctx, const float* __restrict__ w_ada,
                      const float* __restrict__ b_ada, float* __restrict__ mod) {
    const int idx = blockIdx.x * 256 + threadIdx.x;
    if (idx >= 2 * 17 * MODW) return;
    const int n = idx % MODW, r = (idx / MODW) % 17, l = idx / (MODW * 17);
    const float* cv = r < 16 ? c + r * DM : c_ctx;
    const float* w = w_ada + (size_t)l * DM * MODW + n;
    float s = 0.f;
    for (int k = 0; k < DM; ++k) { const float v = cv[k]; s += (v / (1.f + expf(-v))) * w[(size_t)k * MODW]; }
    mod[idx] = s + b_ada[l * MODW + n];
}
__global__ void k_lam(const float* __restrict__ diff_lambda, float* __restrict__ lam) {
    const int lane = threadIdx.x;
    for (int l = 0; l < 2; ++l) {
        const float* lv = diff_lambda + l * 128;
        float a = lane < 32 ? lv[lane] * lv[32 + lane] : 0.f;
        float b = lane < 32 ? lv[64 + lane] * lv[96 + lane] : 0.f;
        a = wave_sum(a); b = wave_sum(b);
        const float li = 0.8f - 0.6f * expf(-0.3f * (float)l);
        if (lane == 0) lam[l] = expf(a) - expf(b) + li;
    }
}

template <bool ROUTER>
__global__ void __launch_bounds__(256) k_norm(const float* __restrict__ XS, const float* __restrict__ g, const float* __restrict__ mod_l,
                                              int sh_chunk, int sc_chunk, bf16_t* __restrict__ HB,
                                              const float* __restrict__ router_w, float* __restrict__ logits) {
    __shared__ float red[4];
    __shared__ float hrow[ROUTER ? 1024 : 4];
    __shared__ float part[ROUTER ? 256 : 4];
    const int t = blockIdx.x, tid = threadIdx.x, r = mod_row(t);
    const float4 v = ((const float4*)(XS + (size_t)t * DM))[tid];
    float ss = v.x * v.x + v.y * v.y + v.z * v.z + v.w * v.w;
    ss = wave_sum(ss);
    if ((tid & 63) == 0) red[tid >> 6] = ss;
    __syncthreads();
    ss = red[0] + red[1] + red[2] + red[3];
    const float rstd = rsqrtf(ss * (1.f / DM) + 1e-6f);
    const float* sh = mod_l + r * MODW + sh_chunk * DM;
    const float* sc = mod_l + r * MODW + sc_chunk * DM;
    const float xv[4] = {v.x, v.y, v.z, v.w};
    float o[4];
#pragma unroll
    for (int i = 0; i < 4; ++i) { const int c = tid * 4 + i; o[i] = xv[i] * rstd * g[c] * (1.f + sc[c]) + sh[c]; }
#pragma unroll
    for (int i = 0; i < 4; ++i) HB[(size_t)t * DM + tid * 4 + i] = f2bf(o[i]);
    if (ROUTER) {
#pragma unroll
        for (int i = 0; i < 4; ++i) hrow[tid * 4 + i] = o[i];
        __syncthreads();
        const int e = tid & 63, p = tid >> 6;
        float s = 0.f;
        for (int k = p * 256; k < p * 256 + 256; ++k) s += hrow[k] * router_w[k * NEXP + e];
        part[tid] = s;
        __syncthreads();
        if (tid < 64) logits[(size_t)t * NEXP + tid] = part[tid] + part[64 + tid] + part[128 + tid] + part[192 + tid];
    }
}

struct EpiStore { bf16_t* O; int ldo; int coloff;
    __device__ __forceinline__ void operator()(int row, int col, float v) const { O[(size_t)row * ldo + coloff + col] = f2bf(v); } };
struct EpiResid { float* XS; const float* mod_l; int chunk; int pad;
    __device__ __forceinline__ void operator()(int row, int col, float v) const {
        const int r = mod_row(row); XS[(size_t)row * DM + col] += mod_l[r * MODW + chunk * DM + col] * v; } };

template <class Epi>
__global__ void __launch_bounds__(256) k_gemm_naive(const bf16_t* __restrict__ A, int lda, const float* __restrict__ Bw, int ldb, int N, int K, Epi epi) {
    __shared__ float As[16][128];
    __shared__ float Bs[16][128];
    const int tid = threadIdx.x, tx = tid & 15, ty = tid >> 4;
    const int m0 = blockIdx.y * 128, n0 = blockIdx.x * 128;
    float acc[8][8];
#pragma unroll
    for (int i = 0; i < 8; ++i)
#pragma unroll
        for (int j = 0; j < 8; ++j) acc[i][j] = 0.f;
    const int ar = tid >> 1, ak = (tid & 1) * 8;
    const int bk = tid >> 4, bn = (tid & 15) * 8;
    for (int k0 = 0; k0 < K; k0 += 16) {
        const uint4 av = *(const uint4*)(A + (size_t)(m0 + ar) * lda + k0 + ak);
        As[ak + 0][ar] = __uint_as_float(av.x << 16); As[ak + 1][ar] = __uint_as_float(av.x & 0xffff0000u);
        As[ak + 2][ar] = __uint_as_float(av.y << 16); As[ak + 3][ar] = __uint_as_float(av.y & 0xffff0000u);
        As[ak + 4][ar] = __uint_as_float(av.z << 16); As[ak + 5][ar] = __uint_as_float(av.z & 0xffff0000u);
        As[ak + 6][ar] = __uint_as_float(av.w << 16); As[ak + 7][ar] = __uint_as_float(av.w & 0xffff0000u);
        float4 b0 = make_float4(0.f, 0.f, 0.f, 0.f), b1 = b0;
        if (n0 + bn < N) { const float* bp = Bw + (size_t)(k0 + bk) * ldb + n0 + bn; b0 = *(const float4*)bp; b1 = *(const float4*)(bp + 4); }
        *(float4*)&Bs[bk][bn] = b0; *(float4*)&Bs[bk][bn + 4] = b1;
        __syncthreads();
#pragma unroll
        for (int kk = 0; kk < 16; ++kk) {
            const float4 a0 = *(const float4*)&As[kk][ty * 8], a1 = *(const float4*)&As[kk][ty * 8 + 4];
            const float4 c0 = *(const float4*)&Bs[kk][tx * 8], c1 = *(const float4*)&Bs[kk][tx * 8 + 4];
            const float a[8] = {a0.x, a0.y, a0.z, a0.w, a1.x, a1.y, a1.z, a1.w};
            const float b[8] = {c0.x, c0.y, c0.z, c0.w, c1.x, c1.y, c1.z, c1.w};
#pragma unroll
            for (int i = 0; i < 8; ++i)
#pragma unroll
                for (int j = 0; j < 8; ++j) acc[i][j] += a[i] * b[j];
        }
        __syncthreads();
    }
#pragma unroll
    for (int i = 0; i < 8; ++i)
#pragma unroll
        for (int j = 0; j < 8; ++j) { const int row = m0 + ty * 8 + i, col = n0 + tx * 8 + j; if (col < N) epi(row, col, acc[i][j]); }
}

__device__ __forceinline__ void rope_cs(int s, int j, float& cs, float& sn) {
    const int rowi = s >> 6, coli = s & 63;
    const float freq = powf(10000.f, -(float)(j & 7) / 8.f);
    const float ang = (float)(j < 8 ? rowi : coli) * freq;
    cs = cosf(ang); sn = sinf(ang);
}
__global__ void k_rope_pb(bf16_t* __restrict__ PB) {
    const int idx = blockIdx.x * 256 + threadIdx.x;
    const int j = idx & 15, gi = (idx >> 4) % 17, t = (idx >> 4) / 17;
    if (t >= NLAT) return;
    const int col0 = gi < 8 ? O_DQ + gi * 32 : (gi < 16 ? O_DK + (gi - 8) * 32 : O_KR);
    float cs, sn; rope_cs(t & 2047, j, cs, sn);
    bf16_t* p = PB + (size_t)t * PBS + col0 + j;
    const float x1 = bf2f(p[0]), x2 = bf2f(p[16]);
    p[0] = f2bf(x1 * cs - x2 * sn); p[16] = f2bf(x1 * sn + x2 * cs);
}
__global__ void k_rope_qm(bf16_t* __restrict__ QM) {
    const int idx = blockIdx.x * 256 + threadIdx.x;
    const int j = idx & 15, h = (idx >> 4) & 7, t = idx >> 7;
    if (t >= NLAT) return;
    float cs, sn; rope_cs(t & 2047, j, cs, sn);
    bf16_t* p = QM + (size_t)t * 768 + h * 96 + 64 + j;
    const float x1 = bf2f(p[0]), x2 = bf2f(p[16]);
    p[0] = f2bf(x1 * cs - x2 * sn); p[16] = f2bf(x1 * sn + x2 * cs);
}
__global__ void __launch_bounds__(256) k_mla_norm(bf16_t* __restrict__ PB, const float* __restrict__ qg, const float* __restrict__ kvg) {
    const int t = blockIdx.x * 4 + (threadIdx.x >> 6), lane = threadIdx.x & 63;
    bf16_t* p = PB + (size_t)t * PBS;
    float v[4], ss = 0.f;
#pragma unroll
    for (int i = 0; i < 4; ++i) { v[i] = bf2f(p[O_CQ + lane * 4 + i]); ss += v[i] * v[i]; }
    ss = wave_sum(ss);
    float rstd = rsqrtf(ss * (1.f / 256.f) + 1e-6f);
#pragma unroll
    for (int i = 0; i < 4; ++i) p[O_CQ + lane * 4 + i] = f2bf(v[i] * rstd * qg[lane * 4 + i]);
    float w[2]; ss = 0.f;
#pragma unroll
    for (int i = 0; i < 2; ++i) { w[i] = bf2f(p[O_CKV + lane * 2 + i]); ss += w[i] * w[i]; }
    ss = wave_sum(ss);
    rstd = rsqrtf(ss * (1.f / 128.f) + 1e-6f);
#pragma unroll
    for (int i = 0; i < 2; ++i) p[O_CKV + lane * 2 + i] = f2bf(w[i] * rstd * kvg[lane * 2 + i]);
}

__device__ __forceinline__ float dot8(const float* q, uint4 k) {
    return q[0] * __uint_as_float(k.x << 16) + q[1] * __uint_as_float(k.x & 0xffff0000u) + q[2] * __uint_as_float(k.y << 16) + q[3] * __uint_as_float(k.y & 0xffff0000u)
         + q[4] * __uint_as_float(k.z << 16) + q[5] * __uint_as_float(k.z & 0xffff0000u) + q[6] * __uint_as_float(k.w << 16) + q[7] * __uint_as_float(k.w & 0xffff0000u);
}
template <int MODE>
__device__ __forceinline__ int key_row(bool isctx, int b, int s, int j, int h, const float* __restrict__ rel_bias, float& bias) {
    bias = 0.f;
    if (isctx) return NLAT + b * CTX + j;
    if (MODE == 0) {
        if (j < 128) {
            const int i = j >> 4, cc = j & 15, r = s >> 6, cq = s & 63;
            const int rs = min(max(r - 4, 0), 24), cs = min(max(cq - 8, 0), 48);
            const int kr = rs + i, kc = cs + cc;
            bias = rel_bias[(h * 15 + (kr - r + 7)) * 31 + (kc - cq + 15)];
            return b * SEQ + kr * 64 + kc;
        }
        return NLAT + b * CTX + (j - 128);
    }
    return j < SEQ ? b * SEQ + j : NLAT + b * CTX + (j - SEQ);
}
template <int MODE>
__global__ void __launch_bounds__(128) k_attn_naive(const bf16_t* __restrict__ PB, const bf16_t* __restrict__ QM, const bf16_t* __restrict__ KVM,
                                                    bf16_t* __restrict__ HB, const float* __restrict__ rel_bias, const float* __restrict__ subln_g,
                                                    const float* __restrict__ lamp, float one_minus_li, int row0) {
    constexpr int NH = MODE == 2 ? 8 : 4;
    extern __shared__ float smem[];
    const int wave = threadIdx.x >> 6, lane = threadIdx.x & 63;
    const int item = blockIdx.x * 2 + wave;
    const int t = row0 + item / NH, h = item % NH;
    const bool isctx = t >= NLAT;
    const int b = isctx ? ((t - NLAT) >> 8) : (t >> 11), s = t & 2047;
    const int nkeys = isctx ? CTX : (MODE == 0 ? 384 : SEQ + CTX);
    float* qs = smem + wave * (128 + 2 * 2304);
    float* s1 = qs + 128; float* s2 = s1 + 2304;
    if (MODE == 0) qs[lane] = bf2f(PB[(size_t)t * PBS + O_NAQ + h * 64 + lane]);
    if (MODE == 1) qs[lane] = bf2f(PB[(size_t)t * PBS + O_DQ + h * 64 + lane]);
    if (MODE == 2) { qs[lane] = bf2f(QM[(size_t)t * 768 + h * 96 + lane]); if (lane < 32) qs[64 + lane] = bf2f(QM[(size_t)t * 768 + h * 96 + 64 + lane]); }
    __syncthreads();
    const float scale = MODE == 0 ? 0.125f : (MODE == 1 ? 0.17677669529663687f : 0.10206207261596575f);
    float m1 = -INFINITY, m2 = -INFINITY;
    for (int j = lane; j < nkeys; j += 64) {
        float bias; const int kr = key_row<MODE>(isctx, b, s, j, h, rel_bias, bias);
        if (MODE == 0) {
            const uint4* kp = (const uint4*)(PB + (size_t)kr * PBS + O_NAK + h * 64); float d = 0.f;
#pragma unroll
            for (int x = 0; x < 8; ++x) d += dot8(qs + 8 * x, kp[x]);
            d = d * scale + bias; s1[j] = d; m1 = fmaxf(m1, d);
        } else if (MODE == 1) {
            const uint4* kp = (const uint4*)(PB + (size_t)kr * PBS + O_DK + h * 64); float d0 = 0.f, d1 = 0.f;
#pragma unroll
            for (int x = 0; x < 4; ++x) { d0 += dot8(qs + 8 * x, kp[x]); d1 += dot8(qs + 32 + 8 * x, kp[4 + x]); }
            d0 *= scale; d1 *= scale; s1[j] = d0; s2[j] = d1; m1 = fmaxf(m1, d0); m2 = fmaxf(m2, d1);
        } else {
            const uint4* kp = (const uint4*)(KVM + (size_t)kr * 1024 + h * 128); const uint4* rp = (const uint4*)(PB + (size_t)kr * PBS + O_KR); float d = 0.f;
#pragma unroll
            for (int x = 0; x < 8; ++x) d += dot8(qs + 8 * x, kp[x]);
#pragma unroll
            for (int x = 0; x < 4; ++x) d += dot8(qs + 64 + 8 * x, rp[x]);
            d *= scale; s1[j] = d; m1 = fmaxf(m1, d);
        }
    }
    m1 = wave_max(m1); if (MODE == 1) m2 = wave_max(m2);
    float l1 = 0.f, l2 = 0.f;
    for (int j = lane; j < nkeys; j += 64) {
        const float p = expf(s1[j] - m1); s1[j] = p; l1 += p;
        if (MODE == 1) { const float q = expf(s2[j] - m2); s2[j] = q; l2 += q; }
    }
    l1 = wave_sum(l1); if (MODE == 1) l2 = wave_sum(l2);
    const float lam = MODE == 1 ? lamp[0] : 0.f;
    for (int j = lane; j < nkeys; j += 64) {
        if (MODE == 1) s1[j] = s1[j] / l1 - lam * (s2[j] / l2); else s1[j] = s1[j] / l1;
    }
    __syncthreads();
    float acc = 0.f;
    for (int j = 0; j < nkeys; ++j) {
        float bias; const int kr = key_row<MODE>(isctx, b, s, j, h, rel_bias, bias);
        float vv;
        if (MODE == 0) vv = bf2f(PB[(size_t)kr * PBS + O_NAV + h * 64 + lane]);
        else if (MODE == 1) vv = bf2f(PB[(size_t)kr * PBS + O_DV + h * 64 + lane]);
        else vv = bf2f(KVM[(size_t)kr * 1024 + h * 128 + 64 + lane]);
        acc += s1[j] * vv;
    }
    if (MODE == 0) HB[(size_t)t * DM + h * 64 + lane] = f2bf(acc);
    else if (MODE == 2) HB[(size_t)t * DM + 512 + h * 64 + lane] = f2bf(acc);
    else {
        const float ss = wave_sum(acc * acc);
        const float o = acc * rsqrtf(ss * (1.f / 64.f) + 1e-6f) * subln_g[lane] * one_minus_li;
        HB[(size_t)t * DM + 256 + h * 64 + lane] = f2bf(o);
    }
}

__global__ void __launch_bounds__(256) k_topk(const float* __restrict__ logits, const float* __restrict__ rbias, int* __restrict__ cnt, uint2* __restrict__ list) {
    const int t = blockIdx.x * 4 + (threadIdx.x >> 6), e = threadIdx.x & 63;
    const float lg = logits[(size_t)t * NEXP + e];
    const float sc = 1.f / (1.f + expf(-lg));
    const float sel = sc + rbias[e];
    float m1 = sel;
#pragma unroll
    for (int o = 1; o < 8; o <<= 1) m1 = fmaxf(m1, __shfl_xor(m1, o));
    int cand = (sel == m1) ? (e & 7) : 8;
#pragma unroll
    for (int o = 1; o < 8; o <<= 1) cand = min(cand, __shfl_xor(cand, o));
    float m2 = ((e & 7) == cand) ? -INFINITY : sel;
#pragma unroll
    for (int o = 1; o < 8; o <<= 1) m2 = fmaxf(m2, __shfl_xor(m2, o));
    const float grp = m1 + m2;
    const int g = e >> 3;
    int grank = 0;
#pragma unroll
    for (int gg = 0; gg < 8; ++gg) { const float og = __shfl(grp, gg * 8); grank += (og > grp || (og == grp && gg < g)) ? 1 : 0; }
    const bool gsel = grank < 4;
    const float ms = gsel ? sel : -INFINITY;
    int rk = 0;
    for (int ee = 0; ee < 64; ++ee) { const float o = __shfl(ms, ee); rk += (o > ms || (o == ms && ee < e)) ? 1 : 0; }
    const bool chosen = gsel && rk < 8;
    const float wsum = wave_sum(chosen ? sc : 0.f);
    const float w = sc / wsum * 2.5f;
    if (chosen) { const int slot = atomicAdd(&cnt[e], 1); list[(size_t)e * LCAP + slot] = make_uint2((unsigned)t, __float_as_uint(w)); }
}

__global__ void __launch_bounds__(256) k_moe_naive(const bf16_t* __restrict__ HB, const int* __restrict__ cnt, const uint2* __restrict__ list, int ntok,
                                                   const float* __restrict__ wg_l, const float* __restrict__ wu_l, const float* __restrict__ wd_l,
                                                   const float* __restrict__ sg_l, const float* __restrict__ su_l, const float* __restrict__ sd_l,
                                                   const float* __restrict__ mod_l, float* __restrict__ XS) {
    const int e = blockIdx.y, n = e < NEXP ? cnt[e] : ntok, slot0 = blockIdx.x * 8, tid = threadIdx.x;
    if (slot0 >= n) return;
    __shared__ float hs[8][1024];
    __shared__ float as[8][256];
    __shared__ int toks[8];
    __shared__ float wts[8];
    if (tid < 8) {
        const int slot = slot0 + tid; const bool valid = slot < n;
        int tk = 0; float w = 0.f;
        if (valid) { if (e < NEXP) { const uint2 en = list[(size_t)e * LCAP + slot]; tk = (int)en.x; w = __uint_as_float(en.y); } else { tk = slot; w = 1.f; } }
        toks[tid] = tk; wts[tid] = w;
    }
    __syncthreads();
#pragma unroll
    for (int i = 0; i < 8; ++i) {
        const bf16_t* hp = HB + (size_t)toks[i] * DM + tid * 4;
#pragma unroll
        for (int c = 0; c < 4; ++c) hs[i][tid * 4 + c] = bf2f(hp[c]);
    }
    __syncthreads();
    const float* WG = e < NEXP ? wg_l + (size_t)e * DM * EFF : sg_l;
    const float* WU = e < NEXP ? wu_l + (size_t)e * DM * EFF : su_l;
    const float* WD = e < NEXP ? wd_l + (size_t)e * EFF * DM : sd_l;
    float g[8], u[8];
#pragma unroll
    for (int i = 0; i < 8; ++i) { g[i] = 0.f; u[i] = 0.f; }
    for (int k = 0; k < DM; ++k) {
        const float wgv = WG[(size_t)k * EFF + tid], wuv = WU[(size_t)k * EFF + tid];
#pragma unroll
        for (int i = 0; i < 8; ++i) { const float hv = hs[i][k]; g[i] += hv * wgv; u[i] += hv * wuv; }
    }
#pragma unroll
    for (int i = 0; i < 8; ++i) as[i][tid] = (g[i] / (1.f + expf(-g[i]))) * u[i] * wts[i];
    __syncthreads();
    float o[8][4];
#pragma unroll
    for (int i = 0; i < 8; ++i)
#pragma unroll
        for (int j = 0; j < 4; ++j) o[i][j] = 0.f;
    for (int f = 0; f < EFF; ++f) {
        float wdv[4];
#pragma unroll
        for (int j = 0; j < 4; ++j) wdv[j] = WD[(size_t)f * DM + tid + 256 * j];
#pragma unroll
        for (int i = 0; i < 8; ++i) { const float a = as[i][f];
#pragma unroll
            for (int j = 0; j < 4; ++j) o[i][j] += a * wdv[j]; }
    }
#pragma unroll
    for (int i = 0; i < 8; ++i) {
        if (slot0 + i < n) {
            const int tk = toks[i], r = mod_row(tk);
#pragma unroll
            for (int j = 0; j < 4; ++j) { const int c = tid + 256 * j; atomicAdd(&XS[(size_t)tk * DM + c], mod_l[r * MODW + 5 * DM + c] * o[i][j]); }
        }
    }
}

__global__ void __launch_bounds__(256) k_final(const float* __restrict__ XS, const float* __restrict__ g, float* __restrict__ out) {
    __shared__ float red[4];
    const int t = blockIdx.x, tid = threadIdx.x;
    const float4 v = ((const float4*)(XS + (size_t)t * DM))[tid];
    float ss = v.x * v.x + v.y * v.y + v.z * v.z + v.w * v.w;
    ss = wave_sum(ss);
    if ((tid & 63) == 0) red[tid >> 6] = ss;
    __syncthreads();
    ss = red[0] + red[1] + red[2] + red[3];
    const float rstd = rsqrtf(ss * (1.f / DM) + 1e-6f);
    const float4 gv = ((const float4*)g)[tid];
    ((float4*)(out + (size_t)t * DM))[tid] = make_float4(v.x * rstd * gv.x, v.y * rstd * gv.y, v.z * rstd * gv.z, v.w * rstd * gv.w);
}

#define LAS __attribute__((address_space(3)))
typedef short bf16x8 __attribute__((ext_vector_type(8)));
typedef float f32x4 __attribute__((ext_vector_type(4)));
typedef float f32x2 __attribute__((ext_vector_type(2)));
typedef unsigned u32x2 __attribute__((ext_vector_type(2)));
typedef unsigned u32x4 __attribute__((ext_vector_type(4)));
typedef __bf16 bf16x2_t __attribute__((ext_vector_type(2)));

struct Params { const float* in[26]; float* out; unsigned char* ws; int layer, i1, i2, i3; };

constexpr int NTHREADS = 512;
constexpr int LDS_BYTES = 147456;

__device__ __forceinline__ unsigned pk_bf16(float lo, float hi) { f32x2 v = {lo, hi}; bf16x2_t b = __builtin_convertvector(v, bf16x2_t); return __builtin_bit_cast(unsigned, b); }

namespace g8 {
constexpr int BM = 256, BK = 64, HALF = 128, HTB = HALF * BK * 2, STAGE_BYTES = 8 * HTB, NXCD = 8, WGM = 8;
__host__ __device__ __forceinline__ int lds_byte(int r, int c) { const int st = (r >> 4) * 2 + (c >> 5), rr = r & 15, cc = c & 31, ob = rr * 64 + cc * 2; return st * 1024 + (ob ^ (((ob >> 9) & 1) << 5)); }
__host__ __device__ __forceinline__ void stage_rc(int b, int& R, int& C) { const int st = b / 1024, sb = b % 1024, swz = sb ^ (((sb >> 9) & 1) << 5); R = (st >> 1) * 16 + swz / 64; C = (st & 1) * 32 + (swz % 64) / 2; }

struct Unit2 { int pm, pn; };
struct DenseOrder {
    int nM, nN, nwg, G, c;
    __device__ __forceinline__ void init(int nM_, int nN_, int G_, int c_) { nM = nM_; nN = nN_; nwg = nM * nN; G = G_; c = c_; }
    __device__ __forceinline__ bool next(int i, Unit2& u) const {
        const long L = (long)i * G + c; if (L >= nwg) return false;
        int wgid = (int)L; { const int q = nwg / NXCD, r = nwg % NXCD, xcd = wgid % NXCD, off = wgid / NXCD; wgid = (xcd < r ? xcd * (q + 1) : r * (q + 1) + (xcd - r) * q) + off; }
        const int nig = WGM * nN, gid = wgid / nig, fm = gid * WGM, gsz = (nM - fm) < WGM ? (nM - fm) : WGM;
        u.pm = fm + ((wgid % nig) % gsz); u.pn = (wgid % nig) / gsz; return true;
    }
};

#define G8_SA(b, h) (((b) * 2 + (h)) * g8::HTB)
#define G8_SB(b, h) ((4 + (b) * 2 + (h)) * g8::HTB)
#define G8_GLDS(gp, ldsoff) __builtin_amdgcn_global_load_lds((const unsigned*)(gp), (LAS unsigned*)(lds + (ldsoff)), 16, 0, 0)
#define G8_STAGE_A(bufoff, o0, o1, kb) do { G8_GLDS(Ab + (o0) + (kb), (bufoff) + ldsw); G8_GLDS(Ab + (o1) + (kb), (bufoff) + ldsw + 8192); } while (0)
#define G8_STAGE_B(bufoff, bp, kb) do { G8_GLDS((bp) + voffB[0] + (kb), (bufoff) + ldsw); G8_GLDS((bp) + voffB[1] + (kb), (bufoff) + ldsw + 8192); } while (0)
#define G8_LDA(dst, b, h) do { _Pragma("unroll") for (int m = 0; m < 4; ++m) _Pragma("unroll") for (int k = 0; k < 2; ++k) dst[m][k] = *(const LAS bf16x8*)(lds + G8_SA(b, h) + aoff + m * 2048 + k * 1024); } while (0)
#define G8_LDB(dst, b, h) do { _Pragma("unroll") for (int n = 0; n < 2; ++n) _Pragma("unroll") for (int k = 0; k < 2; ++k) dst[n][k] = *(const LAS bf16x8*)(lds + G8_SB(b, h) + boff + n * 2048 + k * 1024); } while (0)
#define G8_MMA(ai, bj, At, Bt) do { __builtin_amdgcn_s_setprio(1); _Pragma("unroll") for (int m = 0; m < 4; ++m) _Pragma("unroll") for (int n = 0; n < 2; ++n) _Pragma("unroll") for (int k = 0; k < 2; ++k) \
        acc[ai][bj][m][n] = __builtin_amdgcn_mfma_f32_16x16x32_bf16(Bt[n][k], At[m][k], acc[ai][bj][m][n], 0, 0, 0); __builtin_amdgcn_s_setprio(0); } while (0)
#define G8_WAIT_V(n) asm volatile("s_waitcnt vmcnt(" #n ")" ::: "memory")
#define G8_WAIT_L(n) asm volatile("s_waitcnt lgkmcnt(" #n ")" ::: "memory")
#define G8_BAR __builtin_amdgcn_s_barrier()
#define G8_SCHED __builtin_amdgcn_sched_barrier(0)

template <class P>
__device__ __forceinline__ void gemm_phase(LAS unsigned char* lds, const P& pr) {
    typedef typename P::Unit Unit;
    constexpr int K = P::K, nt = K / BK;
    static_assert(K % 128 == 0 && nt >= 2, "K must be a multiple of 128");
    const int tid = threadIdx.x, wid = __builtin_amdgcn_readfirstlane(tid >> 6), lane = tid & 63, wr = wid >> 2, wc = wid & 3, fr = lane & 15, fq = lane >> 4;
    int Rr[2], Cc[2]; unsigned voffB[2];
#pragma unroll
    for (int i = 0; i < 2; ++i) { stage_rc(tid * 16 + i * 8192, Rr[i], Cc[i]); voffB[i] = (unsigned)(Rr[i] * K + Cc[i]) * 2u; }
    constexpr unsigned kstep = BK * 2;
    constexpr size_t hstepB = (size_t)HALF * K * 2;
    const unsigned ldsw = (unsigned)wid * 1024u;
    const int aoff = lds_byte(wr * 64 + fr, fq * 8), boff = lds_byte(wc * 32 + fr, fq * 8);
    Unit cur, nxt; int ui = 0;
    if (!pr.next(0, cur)) return;
    f32x4 acc[2][2][4][2];
#pragma unroll
    for (int a = 0; a < 2; ++a)
#pragma unroll
        for (int b = 0; b < 2; ++b)
#pragma unroll
            for (int m = 0; m < 4; ++m)
#pragma unroll
                for (int n = 0; n < 2; ++n) acc[a][b][m][n] = (f32x4){0.f, 0.f, 0.f, 0.f};
    bf16x8 At[4][2], B0[2][2], B1[2][2];
    const char* Ab = pr.a_base();
    unsigned ca[2][2], na[2][2];
    pr.a_offsets(cur, Rr, Cc, ca);
    const char* cB = pr.b_ptr(cur);
    G8_STAGE_B(G8_SB(0, 0), cB, 0); G8_STAGE_B(G8_SB(0, 1), cB + hstepB, 0); G8_STAGE_A(G8_SA(0, 0), ca[0][0], ca[0][1], 0); G8_STAGE_A(G8_SA(0, 1), ca[1][0], ca[1][1], 0);
    if (wr == 1) G8_BAR;
    G8_WAIT_V(2); G8_BAR;
    G8_STAGE_B(G8_SB(1, 0), cB, kstep); G8_STAGE_A(G8_SA(1, 0), ca[0][0], ca[0][1], kstep); G8_STAGE_B(G8_SB(1, 1), cB + hstepB, kstep);
    G8_WAIT_V(6); G8_BAR;
    for (;;) {
        const bool has_next = pr.next(ui + 1, nxt);
        const char* nB = cB;
#pragma unroll
        for (int h = 0; h < 2; ++h)
#pragma unroll
            for (int i = 0; i < 2; ++i) na[h][i] = ca[h][i];
        if (has_next) { pr.a_offsets(nxt, Rr, Cc, na); nB = pr.b_ptr(nxt); }
#pragma unroll 1
        for (int t = 0; t < nt; t += 2) {
            const bool last = (t == nt - 2);
            const unsigned k1 = (unsigned)(t + 1) * kstep, k2 = (unsigned)(t + 2) * kstep;
            unsigned a2[2][2];
#pragma unroll
            for (int h = 0; h < 2; ++h)
#pragma unroll
                for (int i = 0; i < 2; ++i) a2[h][i] = last ? na[h][i] : ca[h][i] + k2;
            const char* b2 = last ? nB : cB + k2;
            G8_LDB(B0, 0, 0); G8_LDB(B1, 0, 1); G8_SCHED; G8_LDA(At, 0, 0); G8_STAGE_A(G8_SA(1, 1), ca[1][0], ca[1][1], k1);
            G8_WAIT_V(8); G8_WAIT_L(0); G8_BAR; G8_MMA(0, 0, At, B0); G8_MMA(0, 1, At, B1); G8_BAR; G8_SCHED;
            G8_LDA(At, 0, 1); G8_STAGE_B(G8_SB(0, 0), b2, 0); G8_STAGE_B(G8_SB(0, 1), b2 + hstepB, 0); G8_STAGE_A(G8_SA(0, 0), a2[0][0], a2[0][1], 0);
            G8_WAIT_V(8); G8_WAIT_L(0); G8_BAR; G8_MMA(1, 0, At, B0); G8_MMA(1, 1, At, B1); G8_BAR; G8_SCHED;
            G8_LDB(B0, 1, 0); G8_LDB(B1, 1, 1); G8_SCHED; G8_LDA(At, 1, 0); G8_STAGE_A(G8_SA(0, 1), a2[1][0], a2[1][1], 0);
            G8_WAIT_V(8); G8_WAIT_L(0); G8_BAR; G8_MMA(0, 0, At, B0); G8_MMA(0, 1, At, B1); G8_BAR; G8_SCHED;
            G8_LDA(At, 1, 1); G8_STAGE_B(G8_SB(1, 0), b2, kstep); G8_STAGE_B(G8_SB(1, 1), b2 + hstepB, kstep); G8_STAGE_A(G8_SA(1, 0), a2[0][0], a2[0][1], kstep);
            G8_WAIT_V(8); G8_WAIT_L(0); G8_BAR; G8_MMA(1, 0, At, B0); G8_MMA(1, 1, At, B1); G8_BAR; G8_SCHED;
        }
        if (wr == 0) G8_BAR;
        pr.epilogue(acc, cur, wr, wc, fr, fq);
        if (!has_next) break;
#pragma unroll
        for (int a = 0; a < 2; ++a)
#pragma unroll
            for (int b = 0; b < 2; ++b)
#pragma unroll
                for (int m = 0; m < 4; ++m)
#pragma unroll
                    for (int n = 0; n < 2; ++n) acc[a][b][m][n] = (f32x4){0.f, 0.f, 0.f, 0.f};
        cur = nxt; cB = nB; ++ui;
#pragma unroll
        for (int h = 0; h < 2; ++h)
#pragma unroll
            for (int i = 0; i < 2; ++i) ca[h][i] = na[h][i];
        if (wr == 1) G8_BAR;
    }
    G8_WAIT_V(0);
    G8_BAR;
}
}

struct Ws {
    unsigned* ctl; float* mod; float* lam; float* rope; float* ssq; float* sskv;
    float* XS; bf16_t* HB; bf16_t* PB; bf16_t* QM; bf16_t* KVM; bf16_t* WB;
    __device__ __host__ __forceinline__ explicit Ws(unsigned char* ws) {
        ctl = (unsigned*)(ws + WS_CTL); mod = (float*)(ws + WS_MOD); lam = mod + 2 * 17 * MODW; rope = (float*)(ws + WS_ROPE);
        ssq = (float*)(ws + WS_SSQ); sskv = ssq + (size_t)NTOK * 4;
        XS = (float*)(ws + WS_XS); HB = (bf16_t*)(ws + WS_HB); PB = (bf16_t*)(ws + WS_PB); QM = (bf16_t*)(ws + WS_QM); KVM = (bf16_t*)(ws + WS_KVM); WB = (bf16_t*)(ws + WS_WB);
    }
};

__device__ __forceinline__ void conv_tile(const float* __restrict__ W, int N, int k0, int n0, bf16_t* __restrict__ Bt, int ldo, int mode, const float* __restrict__ kscale, LAS float* tile) {
    const int tid = threadIdx.x;
#pragma unroll
    for (int i = 0; i < 8; ++i) {
        const int kk = (tid >> 6) + 8 * i, n = tid & 63;
        float v = (n0 + n < N) ? W[(size_t)(k0 + kk) * N + n0 + n] : 0.f;
        if (kscale) v *= kscale[k0 + kk];
        tile[kk * 65 + n] = v;
    }
    __syncthreads();
#pragma unroll
    for (int i = 0; i < 2; ++i) {
        const int item = tid + 512 * i, n = item >> 4, kq = item & 15, ng = n0 + n;
        if (ng < N) {
            const int drow = mode == 0 ? ng : (32 * (ng >> 4) + (ng & 15) + (mode == 2 ? 16 : 0));
            const LAS float* s = tile + (4 * kq) * 65 + n;
            u32x2 o; o.x = pk_bf16(s[0], s[65]); o.y = pk_bf16(s[130], s[195]);
            *(u32x2*)(Bt + (size_t)drow * ldo + k0 + 4 * kq) = o;
        }
    }
    __syncthreads();
}
__device__ __forceinline__ void phase_convert(const Params& P, LAS unsigned char* lds) {
    const Ws W(P.ws);
    const int l = P.layer, tid = threadIdx.x, c = blockIdx.x, G = gridDim.x;
    LAS float* tile = (LAS float*)lds;
    constexpr int I_E = 65 * 192, I_IN = 16 * 31, I_OUT = 256, I_UQ = 48, I_UKV = 32, NITEMS = I_E + I_IN + I_OUT + I_UQ + I_UKV;
    for (int it = c; it < NITEMS; it += G) {
        int r = it;
        if (r < I_E) {
            const int e = r / 192, w = (r % 192) / 64, t = r % 64;
            if (w < 2) {
                const float* src = e < 64 ? P.in[19 + w] + ((size_t)l * 64 + e) * 262144 : P.in[22 + w] + (size_t)l * 262144;
                conv_tile(src, 256, (t >> 2) * 64, (t & 3) * 64, W.WB + WB_WGU + (size_t)e * 524288, 1024, 1 + w, nullptr, tile);
            } else {
                const float* src = e < 64 ? P.in[21] + ((size_t)l * 64 + e) * 262144 : P.in[24] + (size_t)l * 262144;
                conv_tile(src, 1024, (t >> 4) * 64, (t & 15) * 64, W.WB + WB_WD + (size_t)e * 262144, 256, 0, nullptr, tile);
            }
            continue;
        }
        r -= I_E;
        if (r < I_IN) { conv_tile(P.in[8] + (size_t)l * 1024 * INC, INC, (r / 31) * 64, (r % 31) * 64, W.WB + WB_WIN, 1024, 0, nullptr, tile); continue; }
        r -= I_IN;
        if (r < I_OUT) { conv_tile(P.in[16] + (size_t)l * 1024 * 1024, 1024, (r >> 4) * 64, (r & 15) * 64, W.WB + WB_WOUT, 1024, 0, nullptr, tile); continue; }
        r -= I_OUT;
        if (r < I_UQ) { conv_tile(P.in[13] + (size_t)l * 256 * 768, 768, (r / 12) * 64, (r % 12) * 64, W.WB + WB_WUQ, 256, 0, P.in[12] + l * 256, tile); continue; }
        r -= I_UQ;
        conv_tile(P.in[15] + (size_t)l * 128 * 1024, 1024, (r >> 4) * 64, (r & 15) * 64, W.WB + WB_WUKV, 256, 0, P.in[14] + l * 128, tile);
    }
    {
        const int gid = c * NTHREADS + tid, gsz = G * NTHREADS;
        const u32x4 z = {0u, 0u, 0u, 0u};
        for (int i = gid; i < 96 * 128; i += gsz) *(u32x4*)(W.WB + WB_WIN + (size_t)1952 * 1024 + (size_t)i * 8) = z;
        for (int i = gid; i < 1024 * 16; i += gsz) *(u32x4*)(W.WB + WB_WUKV + (size_t)(i >> 4) * 256 + 128 + (i & 15) * 8) = z;
    }
    if (l == 0) {
        LAS float* st = (LAS float*)lds;
        LAS float* red = st + 17 * 1024;
        const int wave = tid >> 6, lane = tid & 63;
        for (int u = c; u < 192; u += G) {
            const int l2 = u / 96, cg = u % 96;
            for (int i = tid; i < 17 * 1024; i += NTHREADS) { const int r = i >> 10, k = i & 1023; const float v = r < 16 ? P.in[1][r * 1024 + k] : P.in[3][k]; st[i] = v / (1.f + expf(-v)); }
            __syncthreads();
            const float* w = P.in[4] + (size_t)l2 * 1024 * MODW + cg * 64 + lane;
            float a[17];
#pragma unroll
            for (int r = 0; r < 17; ++r) a[r] = 0.f;
            for (int k = wave * 128; k < wave * 128 + 128; ++k) {
                const float wv = w[(size_t)k * MODW];
#pragma unroll
                for (int r = 0; r < 17; ++r) a[r] += st[r * 1024 + k] * wv;
            }
#pragma unroll
            for (int r = 0; r < 17; ++r) red[(wave * 17 + r) * 64 + lane] = a[r];
            __syncthreads();
            for (int i = tid; i < 17 * 64; i += NTHREADS) {
                const int r = i >> 6, col = i & 63; float s = 0.f;
#pragma unroll
                for (int w8 = 0; w8 < 8; ++w8) s += red[(w8 * 17 + r) * 64 + col];
                W.mod[((size_t)l2 * 17 + r) * MODW + cg * 64 + col] = s + P.in[5][l2 * MODW + cg * 64 + col];
            }
            __syncthreads();
        }
        for (int i = c * NTHREADS + tid; i < 2048 * 16; i += G * NTHREADS) { float cs, sn; rope_cs(i >> 4, i & 15, cs, sn); W.rope[2 * i] = cs; W.rope[2 * i + 1] = sn; }
        if (c == G - 1 && wave == 0) {
            for (int l2 = 0; l2 < 2; ++l2) {
                const float* lv = P.in[10] + l2 * 128;
                float a = lane < 32 ? lv[lane] * lv[32 + lane] : 0.f, b = lane < 32 ? lv[64 + lane] * lv[96 + lane] : 0.f;
                a = wave_sum(a); b = wave_sum(b);
                const float li = 0.8f - 0.6f * expf(-0.3f * (float)l2);
                if (lane == 0) W.lam[l2] = expf(a) - expf(b) + li;
            }
        }
    }
}

struct ProbInProj {
    typedef g8::Unit2 Unit; static constexpr int K = 1024;
    g8::DenseOrder ord; const bf16_t* A; const bf16_t* Bt; bf16_t* PB; const float* rope; float* ssq; float* sskv;
    __device__ __forceinline__ bool next(int i, Unit& u) const { return ord.next(i, u); }
    __device__ __forceinline__ const char* a_base() const { return (const char*)A; }
    __device__ __forceinline__ void a_offsets(const Unit& u, const int (&R)[2], const int (&C)[2], unsigned (&o)[2][2]) const {
#pragma unroll
        for (int h = 0; h < 2; ++h)
#pragma unroll
            for (int i = 0; i < 2; ++i) o[h][i] = (unsigned)((u.pm * 256 + h * 128 + R[i]) * K + C[i]) * 2u;
    }
    __device__ __forceinline__ const char* b_ptr(const Unit& u) const { return (const char*)(Bt + (size_t)u.pn * 256 * K); }
    __device__ __forceinline__ void epilogue(const f32x4 (&acc)[2][2][4][2], const Unit& u, int wr, int wc, int fr, int fq) const {
        const int pn = u.pn; const bool lat = u.pm < NLAT / 256;
        const int rowb = u.pm * 256 + wr * 64 + fr, colb = pn * 256 + wc * 32 + 4 * fq;
        const bool want_ss = pn >= 6;
#pragma unroll
        for (int ai = 0; ai < 2; ++ai)
#pragma unroll
            for (int m = 0; m < 4; ++m) {
                const int row = rowb + ai * 128 + m * 16;
                bf16_t* prow = PB + (size_t)row * PBS + colb;
                float ss = 0.f;
#pragma unroll
                for (int bj = 0; bj < 2; ++bj) {
                    f32x4 v0 = acc[ai][bj][m][0], v1 = acc[ai][bj][m][1];
                    const bool rp = lat && (pn == 3 || pn == 4 || (pn == 7 && bj == 1 && wc == 0));
                    if (rp) {
                        const f32x4* tb = (const f32x4*)(rope + ((size_t)(row & 2047) * 16 + 4 * fq) * 2);
                        const f32x4 t0 = tb[0], t1 = tb[1];
                        const f32x4 cs = {t0[0], t0[2], t1[0], t1[2]}, sn = {t0[1], t0[3], t1[1], t1[3]};
                        const f32x4 o1 = v0 * cs - v1 * sn, o2 = v0 * sn + v1 * cs;
                        v0 = o1; v1 = o2;
                    }
                    u32x2 w0, w1; w0.x = pk_bf16(v0[0], v0[1]); w0.y = pk_bf16(v0[2], v0[3]); w1.x = pk_bf16(v1[0], v1[1]); w1.y = pk_bf16(v1[2], v1[3]);
                    *(u32x2*)(prow + bj * 128) = w0; *(u32x2*)(prow + bj * 128 + 16) = w1;
                    if (want_ss && (pn == 6 || bj == 0)) {
                        const float a0 = __uint_as_float(w0.x << 16), a1 = __uint_as_float(w0.x & 0xffff0000u), a2 = __uint_as_float(w0.y << 16), a3 = __uint_as_float(w0.y & 0xffff0000u);
                        const float b0 = __uint_as_float(w1.x << 16), b1 = __uint_as_float(w1.x & 0xffff0000u), b2 = __uint_as_float(w1.y << 16), b3 = __uint_as_float(w1.y & 0xffff0000u);
                        ss += a0 * a0 + a1 * a1 + a2 * a2 + a3 * a3 + b0 * b0 + b1 * b1 + b2 * b2 + b3 * b3;
                    }
                }
                if (want_ss) {
                    ss += __shfl_xor(ss, 16); ss += __shfl_xor(ss, 32);
                    if (fq == 0) (pn == 6 ? ssq : sskv)[(size_t)row * 4 + wc] = ss;
                }
            }
    }
};
__device__ __forceinline__ void phase_inproj(const Params& P, LAS unsigned char* lds) {
    const Ws W(P.ws);
    ProbInProj pr; pr.ord.init(NTOK / 256, 8, gridDim.x, blockIdx.x);
    pr.A = W.HB; pr.Bt = W.WB + WB_WIN; pr.PB = W.PB; pr.rope = W.rope; pr.ssq = W.ssq; pr.sskv = W.sskv;
    g8::gemm_phase(lds, pr);
}

struct UnitM { int pm, pn, kv; };
struct ProbMla {
    typedef UnitM Unit; static constexpr int K = 256;
    int nq_units, n_units, G, c;
    const bf16_t* PBp; const bf16_t* Wuq; const bf16_t* Wukv; bf16_t* QM; bf16_t* KVM; const float* rope; const float* ssq; const float* sskv;
    __device__ __forceinline__ bool next(int i, Unit& u) const {
        const int L = i * G + c; if (L >= n_units) return false;
        if (L < nq_units) { u.kv = 0; u.pm = L / 3; u.pn = L % 3; } else { const int r = L - nq_units; u.kv = 1; u.pm = r >> 2; u.pn = r & 3; }
        return true;
    }
    __device__ __forceinline__ const char* a_base() const { return (const char*)PBp; }
    __device__ __forceinline__ void a_offsets(const Unit& u, const int (&R)[2], const int (&C)[2], unsigned (&o)[2][2]) const {
        const int cb = u.kv ? O_CKV : O_CQ;
#pragma unroll
        for (int h = 0; h < 2; ++h)
#pragma unroll
            for (int i = 0; i < 2; ++i) o[h][i] = (unsigned)((u.pm * 256 + h * 128 + R[i]) * PBS + cb + C[i]) * 2u;
    }
    __device__ __forceinline__ const char* b_ptr(const Unit& u) const { return (const char*)((u.kv ? Wukv : Wuq) + (size_t)u.pn * 256 * K); }
    __device__ __forceinline__ void epilogue(const f32x4 (&acc)[2][2][4][2], const Unit& u, int wr, int wc, int fr, int fq) const {
        const bool lat = u.pm < NLAT / 256;
        const int rowb = u.pm * 256 + wr * 64 + fr, colb = u.pn * 256 + wc * 32 + 4 * fq;
        const float* ssp = u.kv ? sskv : ssq; const float inv = u.kv ? (1.f / 128.f) : (1.f / 256.f);
        bf16_t* O = u.kv ? KVM : QM; const int ldo = u.kv ? 1024 : 768;
#pragma unroll
        for (int ai = 0; ai < 2; ++ai)
#pragma unroll
            for (int m = 0; m < 4; ++m) {
                const int row = rowb + ai * 128 + m * 16;
                const f32x4 s4 = *(const f32x4*)(ssp + (size_t)row * 4);
                const float rstd = rsqrtf((s4[0] + s4[1] + s4[2] + s4[3]) * inv + 1e-6f);
                bf16_t* prow = O + (size_t)row * ldo + colb;
#pragma unroll
                for (int bj = 0; bj < 2; ++bj) {
                    f32x4 v0 = acc[ai][bj][m][0] * rstd, v1 = acc[ai][bj][m][1] * rstd;
                    const int g32 = u.pn * 8 + bj * 4 + wc;
                    if (!u.kv && lat && (g32 % 3) == 2) {
                        const f32x4* tb = (const f32x4*)(rope + ((size_t)(row & 2047) * 16 + 4 * fq) * 2);
                        const f32x4 t0 = tb[0], t1 = tb[1];
                        const f32x4 cs = {t0[0], t0[2], t1[0], t1[2]}, sn = {t0[1], t0[3], t1[1], t1[3]};
                        const f32x4 o1 = v0 * cs - v1 * sn, o2 = v0 * sn + v1 * cs;
                        v0 = o1; v1 = o2;
                    }
                    u32x2 w0, w1; w0.x = pk_bf16(v0[0], v0[1]); w0.y = pk_bf16(v0[2], v0[3]); w1.x = pk_bf16(v1[0], v1[1]); w1.y = pk_bf16(v1[2], v1[3]);
                    *(u32x2*)(prow + bj * 128) = w0; *(u32x2*)(prow + bj * 128 + 16) = w1;
                }
            }
    }
};
__device__ __forceinline__ void phase_mla(const Params& P, LAS unsigned char* lds) {
    const Ws W(P.ws);
    const int nq = P.layer == 0 ? NTOK : NLAT;
    ProbMla pr; pr.nq_units = (nq / 256) * 3; pr.n_units = pr.nq_units + (NTOK / 256) * 4; pr.G = gridDim.x; pr.c = blockIdx.x;
    pr.PBp = W.PB; pr.Wuq = W.WB + WB_WUQ; pr.Wukv = W.WB + WB_WUKV; pr.QM = W.QM; pr.KVM = W.KVM; pr.rope = W.rope; pr.ssq = W.ssq; pr.sskv = W.sskv;
    g8::gemm_phase(lds, pr);
}

struct ProbOut {
    typedef g8::Unit2 Unit; static constexpr int K = 1024;
    g8::DenseOrder ord; const bf16_t* A; const bf16_t* Bt; float* XS; const float* x_in; const float* ctx_in; const float* mod_l; int layer;
    __device__ __forceinline__ bool next(int i, Unit& u) const { return ord.next(i, u); }
    __device__ __forceinline__ const char* a_base() const { return (const char*)A; }
    __device__ __forceinline__ void a_offsets(const Unit& u, const int (&R)[2], const int (&C)[2], unsigned (&o)[2][2]) const {
#pragma unroll
        for (int h = 0; h < 2; ++h)
#pragma unroll
            for (int i = 0; i < 2; ++i) o[h][i] = (unsigned)((u.pm * 256 + h * 128 + R[i]) * K + C[i]) * 2u;
    }
    __device__ __forceinline__ const char* b_ptr(const Unit& u) const { return (const char*)(Bt + (size_t)u.pn * 256 * K); }
    __device__ __forceinline__ void epilogue(const f32x4 (&acc)[2][2][4][2], const Unit& u, int wr, int wc, int fr, int fq) const {
        const int r = u.pm < NLAT / 256 ? (u.pm >> 3) : 16;
        const int rowb = u.pm * 256 + wr * 64 + fr, colb = u.pn * 256 + wc * 32 + 4 * fq;
        const float* gate = mod_l + r * MODW + 2 * DM + colb;
        f32x4 gv[2][2];
#pragma unroll
        for (int bj = 0; bj < 2; ++bj)
#pragma unroll
            for (int n = 0; n < 2; ++n) gv[bj][n] = *(const f32x4*)(gate + bj * 128 + n * 16);
#pragma unroll
        for (int ai = 0; ai < 2; ++ai)
#pragma unroll
            for (int m = 0; m < 4; ++m) {
                const int row = rowb + ai * 128 + m * 16;
                float* xo = XS + (size_t)row * DM + colb;
                const float* xi = layer == 0 ? (row < NLAT ? x_in + (size_t)row * DM : ctx_in + (size_t)(row - NLAT) * DM) + colb : xo;
#pragma unroll
                for (int bj = 0; bj < 2; ++bj)
#pragma unroll
                    for (int n = 0; n < 2; ++n) {
                        const f32x4 b = *(const f32x4*)(xi + bj * 128 + n * 16);
                        *(f32x4*)(xo + bj * 128 + n * 16) = b + gv[bj][n] * acc[ai][bj][m][n];
                    }
            }
    }
};
__device__ __forceinline__ void phase_outproj(const Params& P, LAS unsigned char* lds) {
    const Ws W(P.ws);
    const int nq = P.layer == 0 ? NTOK : NLAT;
    ProbOut pr; pr.ord.init(nq / 256, 4, gridDim.x, blockIdx.x);
    pr.A = W.HB; pr.Bt = W.WB + WB_WOUT; pr.XS = W.XS; pr.x_in = P.in[0]; pr.ctx_in = P.in[2]; pr.mod_l = W.mod + (size_t)P.layer * 17 * MODW; pr.layer = P.layer;
    g8::gemm_phase(lds, pr);
}

constexpr int NCHUNK = 4;
constexpr int CAPC = NTOK / NCHUNK;
constexpr size_t WS_LIST2 = WS_PB;
constexpr size_t WS_ACT = WS_PB + 20 * MiB;
constexpr size_t WS_Y = WS_PB + 70 * MiB;
static_assert(WS_Y + (size_t)CAPC * 9 * 1024 * 2 <= WS_WB, "MoE overlay fits");
constexpr int CW_CNT = 8192;
constexpr int LDS_TAB = 131072;

typedef float f32x16 __attribute__((ext_vector_type(16)));
__device__ __forceinline__ void phase_norm2(const Params& P, LAS unsigned char* lds) {
    const Ws W(P.ws);
    const int l = P.layer, tid = threadIdx.x, wave = __builtin_amdgcn_readfirstlane(tid >> 6), lane = tid & 63, G = gridDim.x, c = blockIdx.x;
    const int nq = l == 0 ? NTOK : NLAT, csz = nq / NCHUNK, nunits = nq / 32;
    const float* mod_l = W.mod + (size_t)l * 17 * MODW;
    const float* gn = P.in[7] + l * DM;
    const float* rw = P.in[17] + (size_t)l * DM * NEXP;
    const float* rb = P.in[18] + l * NEXP;
    int* cnt = (int*)(W.ctl + CW_CNT);
    uint2* list = (uint2*)(P.ws + WS_LIST2);
    LAS float* At = (LAS float*)lds;
    float Br[64][2];
#pragma unroll
    for (int p = 0; p < 64; ++p)
#pragma unroll
        for (int n = 0; n < 2; ++n) Br[p][n] = rw[(size_t)(128 * wave + 2 * p + (lane >> 5)) * NEXP + n * 32 + (lane & 31)];
    for (int u = c; u < nunits; u += G) {
        const int t0 = u * 32;
#pragma unroll 1
        for (int j = 0; j < 4; ++j) {
            const int tl = wave * 4 + j, t = t0 + tl, r = mod_row(t);
            const float* xr = W.XS + (size_t)t * DM;
            const float* sh = mod_l + r * MODW + 3 * DM; const float* sc = mod_l + r * MODW + 4 * DM;
            f32x4 v[4]; float ss = 0.f;
#pragma unroll
            for (int q = 0; q < 4; ++q) { v[q] = *(const f32x4*)(xr + 256 * q + lane * 4); ss += v[q][0] * v[q][0] + v[q][1] * v[q][1] + v[q][2] * v[q][2] + v[q][3] * v[q][3]; }
            ss = wave_sum(ss);
            const float rstd = rsqrtf(ss * (1.f / DM) + 1e-6f);
#pragma unroll
            for (int q = 0; q < 4; ++q) {
                const int col = 256 * q + lane * 4;
                const f32x4 g4 = *(const f32x4*)(gn + col), s4 = *(const f32x4*)(sc + col), h4 = *(const f32x4*)(sh + col);
                const f32x4 o = v[q] * rstd * g4 * (s4 + 1.f) + h4;
                u32x2 w; w.x = pk_bf16(o[0], o[1]); w.y = pk_bf16(o[2], o[3]);
                *(u32x2*)(W.HB + (size_t)t * DM + col) = w;
                LAS float* ap = At + tl * 1025 + col;
                ap[0] = o[0]; ap[1] = o[1]; ap[2] = o[2]; ap[3] = o[3];
            }
        }
        __syncthreads();
        f32x16 acc0, acc1;
#pragma unroll
        for (int i = 0; i < 16; ++i) { acc0[i] = 0.f; acc1[i] = 0.f; }
        const LAS float* arow = At + (lane & 31) * 1025 + 128 * wave + (lane >> 5);
#pragma unroll
        for (int p = 0; p < 64; ++p) {
            const float a = arow[2 * p];
            acc0 = __builtin_amdgcn_mfma_f32_32x32x2f32(a, Br[p][0], acc0, 0, 0, 0);
            acc1 = __builtin_amdgcn_mfma_f32_32x32x2f32(a, Br[p][1], acc1, 0, 0, 0);
        }
        __syncthreads();
        LAS float* part = At;
#pragma unroll
        for (int i = 0; i < 16; ++i) {
            const int tok = (i & 3) + 8 * (i >> 2) + 4 * (lane >> 5);
            part[(wave * 32 + tok) * 64 + (lane & 31)] = acc0[i];
            part[(wave * 32 + tok) * 64 + 32 + (lane & 31)] = acc1[i];
        }
        __syncthreads();
#pragma unroll 1
        for (int j = 0; j < 4; ++j) {
            const int tl = wave * 4 + j, t = t0 + tl, e = lane;
            float lg = 0.f;
#pragma unroll
            for (int w8 = 0; w8 < 8; ++w8) lg += part[(w8 * 32 + tl) * 64 + e];
            const float sc = 1.f / (1.f + expf(-lg));
            const float sel = sc + rb[e];
            float m1 = sel;
#pragma unroll
            for (int o = 1; o < 8; o <<= 1) m1 = fmaxf(m1, __shfl_xor(m1, o));
            int cand = (sel == m1) ? (e & 7) : 8;
#pragma unroll
            for (int o = 1; o < 8; o <<= 1) cand = min(cand, __shfl_xor(cand, o));
            float m2 = ((e & 7) == cand) ? -INFINITY : sel;
#pragma unroll
            for (int o = 1; o < 8; o <<= 1) m2 = fmaxf(m2, __shfl_xor(m2, o));
            const float grp = m1 + m2;
            const int g = e >> 3;
            int grank = 0;
#pragma unroll
            for (int gg = 0; gg < 8; ++gg) { const float og = __shfl(grp, gg * 8); grank += (og > grp || (og == grp && gg < g)) ? 1 : 0; }
            const bool gsel = grank < 4;
            const float ms = gsel ? sel : -INFINITY;
            int rk = 0;
            for (int ee = 0; ee < 64; ++ee) { const float o = __shfl(ms, ee); rk += (o > ms || (o == ms && ee < e)) ? 1 : 0; }
            const bool chosen = gsel && rk < 8;
            const float wsum = wave_sum(chosen ? sc : 0.f);
            const float w = sc / wsum * 2.5f;
            if (chosen) {
                const int ch = t / csz;
                const int slot = atomicAdd(&cnt[ch * 64 + e], 1);
                list[((size_t)ch * 64 + e) * CAPC + slot] = make_uint2((unsigned)(t * 8 + rk), __float_as_uint(w));
            }
        }
        __syncthreads();
    }
}

struct UnitG { int e, t, pn, cnt, pb; };
struct MoeTab {
    const LAS int* cnts; const LAS int* pre; int ntiles;
};
__device__ __forceinline__ MoeTab moe_table(const Params& P, LAS unsigned char* lds, int ch, int csz) {
    const Ws W(P.ws);
    LAS int* cnts = (LAS int*)(lds + LDS_TAB); LAS int* pre = cnts + 80;
    const int tid = threadIdx.x;
    if (tid < 64) cnts[tid] = (int)__hip_atomic_load(W.ctl + CW_CNT + ch * 64 + tid, __ATOMIC_RELAXED, __HIP_MEMORY_SCOPE_AGENT);
    if (tid == 64) cnts[64] = csz;
    __syncthreads();
    if (tid == 0) { int s = 0; for (int e = 0; e < 65; ++e) { pre[e] = s; s += (cnts[e] + 255) >> 8; } pre[65] = s; }
    __syncthreads();
    MoeTab T; T.cnts = cnts; T.pre = pre; T.ntiles = pre[65];
    return T;
}
struct ProbMoe1 {
    typedef UnitG Unit; static constexpr int K = 1024;
    int G, c, chunk_base; MoeTab T;
    const uint2* list; const bf16_t* HB; const bf16_t* Wgu; bf16_t* act;
    __device__ __forceinline__ bool next(int i, Unit& u) const {
        const int L = i * G + c; if (L >= 2 * T.ntiles) return false;
        const int rt = L >> 1; u.pn = L & 1;
        int e = 0; while (T.pre[e + 1] <= rt) ++e;
        u.e = e; u.t = rt - T.pre[e]; u.cnt = T.cnts[e]; u.pb = rt * 256; return true;
    }
    __device__ __forceinline__ const char* a_base() const { return (const char*)HB; }
    __device__ __forceinline__ void a_offsets(const Unit& u, const int (&R)[2], const int (&C)[2], unsigned (&o)[2][2]) const {
#pragma unroll
        for (int h = 0; h < 2; ++h)
#pragma unroll
            for (int i = 0; i < 2; ++i) {
                const int slot = u.t * 256 + h * 128 + R[i]; int tok = 0;
                if (slot < u.cnt) tok = u.e < 64 ? (int)(list[(size_t)u.e * CAPC + slot].x >> 3) : chunk_base + slot;
                o[h][i] = (unsigned)tok * 2048u + (unsigned)C[i] * 2u;
            }
    }
    __device__ __forceinline__ const char* b_ptr(const Unit& u) const { return (const char*)(Wgu + (size_t)u.e * 524288 + (size_t)u.pn * 256 * K); }
    __device__ __forceinline__ void epilogue(const f32x4 (&acc)[2][2][4][2], const Unit& u, int wr, int wc, int fr, int fq) const {
#pragma unroll
        for (int ai = 0; ai < 2; ++ai)
#pragma unroll
            for (int m = 0; m < 4; ++m) {
                const int rl = ai * 128 + wr * 64 + m * 16 + fr, slot = u.t * 256 + rl;
                float w = 0.f;
                if (slot < u.cnt) w = u.e < 64 ? __uint_as_float(list[(size_t)u.e * CAPC + slot].y) : 1.f;
                bf16_t* arow = act + (size_t)(u.pb + rl) * 256 + 128 * u.pn + 16 * wc + 4 * fq;
#pragma unroll
                for (int bj = 0; bj < 2; ++bj) {
                    const f32x4 g = acc[ai][bj][m][0], up = acc[ai][bj][m][1];
                    f32x4 a;
#pragma unroll
                    for (int j = 0; j < 4; ++j) a[j] = g[j] / (1.f + __expf(-g[j])) * up[j] * w;
                    u32x2 o; o.x = pk_bf16(a[0], a[1]); o.y = pk_bf16(a[2], a[3]);
                    *(u32x2*)(arow + bj * 64) = o;
                }
            }
    }
};
__device__ __forceinline__ void phase_moe1(const Params& P, LAS unsigned char* lds) {
    const Ws W(P.ws);
    const int nq = P.layer == 0 ? NTOK : NLAT, csz = nq / NCHUNK, ch = P.i1;
    ProbMoe1 pr; pr.G = gridDim.x; pr.c = blockIdx.x; pr.chunk_base = ch * csz; pr.T = moe_table(P, lds, ch, csz);
    pr.list = (const uint2*)(P.ws + WS_LIST2) + (size_t)ch * 64 * CAPC; pr.HB = W.HB; pr.Wgu = W.WB + WB_WGU; pr.act = (bf16_t*)(P.ws + WS_ACT);
    g8::gemm_phase(lds, pr);
}
struct ProbMoe2 {
    typedef UnitG Unit; static constexpr int K = 256;
    int G, c, chunk_base; MoeTab T;
    const uint2* list; const bf16_t* act; const bf16_t* Wd; bf16_t* Y;
    __device__ __forceinline__ bool next(int i, Unit& u) const {
        const int L = i * G + c; if (L >= 4 * T.ntiles) return false;
        const int rt = L >> 2; u.pn = L & 3;
        int e = 0; while (T.pre[e + 1] <= rt) ++e;
        u.e = e; u.t = rt - T.pre[e]; u.cnt = T.cnts[e]; u.pb = rt * 256; return true;
    }
    __device__ __forceinline__ const char* a_base() const { return (const char*)act; }
    __device__ __forceinline__ void a_offsets(const Unit& u, const int (&R)[2], const int (&C)[2], unsigned (&o)[2][2]) const {
#pragma unroll
        for (int h = 0; h < 2; ++h)
#pragma unroll
            for (int i = 0; i < 2; ++i) o[h][i] = (unsigned)((u.pb + h * 128 + R[i]) * 256 + C[i]) * 2u;
    }
    __device__ __forceinline__ const char* b_ptr(const Unit& u) const { return (const char*)(Wd + (size_t)u.e * 262144 + (size_t)u.pn * 256 * K); }
    __device__ __forceinline__ void epilogue(const f32x4 (&acc)[2][2][4][2], const Unit& u, int wr, int wc, int fr, int fq) const {
#pragma unroll
        for (int ai = 0; ai < 2; ++ai)
#pragma unroll
            for (int m = 0; m < 4; ++m) {
                const int rl = ai * 128 + wr * 64 + m * 16 + fr, slot = u.t * 256 + rl;
                if (slot < u.cnt) {
                    int yrow;
                    if (u.e < 64) { const unsigned x = list[(size_t)u.e * CAPC + slot].x; yrow = ((int)(x >> 3) - chunk_base) * 9 + (int)(x & 7u); }
                    else yrow = slot * 9 + 8;
                    bf16_t* yp = Y + (size_t)yrow * 1024 + 256 * u.pn + 32 * wc + 4 * fq;
#pragma unroll
                    for (int bj = 0; bj < 2; ++bj)
#pragma unroll
                        for (int n = 0; n < 2; ++n) {
                            const f32x4 v = acc[ai][bj][m][n];
                            u32x2 o; o.x = pk_bf16(v[0], v[1]); o.y = pk_bf16(v[2], v[3]);
                            *(u32x2*)(yp + bj * 128 + n * 16) = o;
                        }
                }
            }
    }
};
__device__ __forceinline__ void phase_moe2(const Params& P, LAS unsigned char* lds) {
    const Ws W(P.ws);
    const int nq = P.layer == 0 ? NTOK : NLAT, csz = nq / NCHUNK, ch = P.i1;
    ProbMoe2 pr; pr.G = gridDim.x; pr.c = blockIdx.x; pr.chunk_base = ch * csz; pr.T = moe_table(P, lds, ch, csz);
    pr.list = (const uint2*)(P.ws + WS_LIST2) + (size_t)ch * 64 * CAPC; pr.act = (const bf16_t*)(P.ws + WS_ACT); pr.Wd = W.WB + WB_WD; pr.Y = (bf16_t*)(P.ws + WS_Y);
    g8::gemm_phase(lds, pr);
}
__device__ __forceinline__ void phase_comb(const Params& P, LAS unsigned char* lds) {
    const Ws W(P.ws);
    const int nq = P.layer == 0 ? NTOK : NLAT, csz = nq / NCHUNK, ch = P.i1, base = ch * csz;
    const int tid = threadIdx.x, wave = tid >> 6, lane = tid & 63;
    const float* mod_l = W.mod + (size_t)P.layer * 17 * MODW;
    const bf16_t* Y = (const bf16_t*)(P.ws + WS_Y);
    for (int tl = blockIdx.x * 8 + wave; tl < csz; tl += gridDim.x * 8) {
        const int t = base + tl, r = mod_row(t);
        const float* g2 = mod_l + r * MODW + 5 * DM;
        float* xr = W.XS + (size_t)t * DM;
#pragma unroll
        for (int q = 0; q < 4; ++q) {
            const int col = 256 * q + lane * 4;
            f32x4 s = {0.f, 0.f, 0.f, 0.f};
#pragma unroll
            for (int k = 0; k < 9; ++k) {
                const u32x2 v = *(const u32x2*)(Y + ((size_t)tl * 9 + k) * 1024 + col);
                s[0] += __uint_as_float(v.x << 16); s[1] += __uint_as_float(v.x & 0xffff0000u); s[2] += __uint_as_float(v.y << 16); s[3] += __uint_as_float(v.y & 0xffff0000u);
            }
            const f32x4 x = *(const f32x4*)(xr + col), g = *(const f32x4*)(g2 + col);
            *(f32x4*)(xr + col) = x + g * s;
        }
    }
}

__device__ __forceinline__ void phase_norm1(const Params& P, LAS unsigned char* lds) {
    const Ws W(P.ws);
    const int l = P.layer, tid = threadIdx.x, wave = tid >> 6, lane = tid & 63;
    const float* mod_l = W.mod + (size_t)l * 17 * MODW;
    const float* gn = P.in[6] + l * DM;
    for (int t = blockIdx.x * 8 + wave; t < NTOK; t += gridDim.x * 8) {
        const int r = mod_row(t);
        const float* xr = l == 0 ? (t < NLAT ? P.in[0] + (size_t)t * DM : P.in[2] + (size_t)(t - NLAT) * DM) : W.XS + (size_t)t * DM;
        const float* sh = mod_l + r * MODW; const float* sc = mod_l + r * MODW + DM;
        f32x4 v[4]; float ss = 0.f;
#pragma unroll
        for (int q = 0; q < 4; ++q) { v[q] = *(const f32x4*)(xr + 256 * q + lane * 4); ss += v[q][0] * v[q][0] + v[q][1] * v[q][1] + v[q][2] * v[q][2] + v[q][3] * v[q][3]; }
        ss = wave_sum(ss);
        const float rstd = rsqrtf(ss * (1.f / DM) + 1e-6f);
#pragma unroll
        for (int q = 0; q < 4; ++q) {
            const int col = 256 * q + lane * 4;
            const f32x4 g4 = *(const f32x4*)(gn + col), s4 = *(const f32x4*)(sc + col), h4 = *(const f32x4*)(sh + col);
            const f32x4 o = v[q] * rstd * g4 * (s4 + 1.f) + h4;
            u32x2 w; w.x = pk_bf16(o[0], o[1]); w.y = pk_bf16(o[2], o[3]);
            *(u32x2*)(W.HB + (size_t)t * DM + col) = w;
        }
    }
}

typedef short v4i16_t __attribute__((ext_vector_type(4)));
__device__ __forceinline__ bf16x8 pack8(float a0, float a1, float a2, float a3, float a4, float a5, float a6, float a7) {
    u32x4 w; w.x = pk_bf16(a0, a1); w.y = pk_bf16(a2, a3); w.z = pk_bf16(a4, a5); w.w = pk_bf16(a6, a7); return __builtin_bit_cast(bf16x8, w);
}
__device__ __forceinline__ float max16(const f32x16& s) {
    return fmaxf(fmaxf(fmaxf(fmaxf(s[0], s[1]), fmaxf(s[2], s[3])), fmaxf(fmaxf(s[4], s[5]), fmaxf(s[6], s[7]))),
                 fmaxf(fmaxf(fmaxf(s[8], s[9]), fmaxf(s[10], s[11])), fmaxf(fmaxf(s[12], s[13]), fmaxf(s[14], s[15]))));
}
constexpr int AT_KBUF = 64 * 208, AT_STAGE = AT_KBUF + 8192, AT_BT = 2 * AT_STAGE;
template <int MODE>
__device__ __forceinline__ void attn_unit(const Params& P, const Ws& W, LAS unsigned char* lds, const int b, const int h, const int qb, const bool ctxq) {
    constexpr int NST = MODE == 2 ? 6 : (MODE == 1 ? 2 : 4);
    constexpr int NMAP = MODE == 1 ? 2 : 1;
    constexpr int KSTR = MODE == 2 ? 208 : 144;
    constexpr float CS = MODE == 2 ? 0.14724444602590306f : (MODE == 1 ? 0.25503486164919736f : 0.18033688011112042f);
    constexpr float NEG = -1e30f;
    const int tid = threadIdx.x, wave = __builtin_amdgcn_readfirstlane(tid >> 6), lane = tid & 63, r32 = lane & 31, hh = lane >> 5;
    const int l = P.layer;
    const int t0 = ctxq ? NLAT + b * CTX : b * SEQ + qb * 256;
    const int tq = t0 + wave * 32 + r32;
    bf16x8 qf[NMAP][NST];
    {
        const bf16_t* src = MODE == 2 ? W.QM + (size_t)tq * 768 + h * 96 : W.PB + (size_t)tq * PBS + (MODE == 1 ? O_DQ : O_NAQ) + h * 64;
#pragma unroll
        for (int mp = 0; mp < NMAP; ++mp)
#pragma unroll
            for (int st = 0; st < NST; ++st) qf[mp][st] = *(const bf16x8*)(src + 32 * mp + 16 * st + 8 * hh);
    }
    int ntiles = 36, nwin = 0, krs = 0;
    if (ctxq) ntiles = 4;
    else if (MODE == 0) { krs = min(max(4 * qb - 4, 0), 24); nwin = min(max(4 * qb - 1, 0), 24) + 8 - krs; ntiles = nwin + 4; }
    LAS float* btab = (LAS float*)(lds + AT_BT);
    if (MODE == 0 && !ctxq) { const float* rbp = P.in[9] + ((size_t)l * 4 + h) * 465; for (int i = tid; i < 465; i += NTHREADS) btab[i] = 8.f * rbp[i]; }
    const int kkey = tid >> 3, kch = tid & 7;
    const unsigned kw_off = (unsigned)(kkey * KSTR + kch * 16);
    const unsigned rw_off = (unsigned)((tid >> 2) * KSTR + 128 + (tid & 3) * 16);
    const unsigned vw_off = (unsigned)(AT_KBUF + ((kkey >> 2) * 2 + (kch >> 2)) * 256 + (kkey & 3) * 64 + (kch & 3) * 16);
    u32x4 kreg, vreg, rreg = {0u, 0u, 0u, 0u};
#define AT_ROW0(i) (ctxq ? NLAT + b * CTX + 64 * (i) : (MODE == 0 ? ((i) < nwin ? b * SEQ + 64 * (krs + (i)) : NLAT + b * CTX + 64 * ((i) - nwin)) : ((i) < 32 ? b * SEQ + 64 * (i) : NLAT + b * CTX + 64 * ((i) - 32))))
#define AT_LOAD(i) do { const int row0_ = AT_ROW0(i); \
        if (MODE == 2) { const bf16_t* kp_ = W.KVM + (size_t)(row0_ + kkey) * 1024 + h * 128 + 8 * kch; kreg = *(const u32x4*)kp_; vreg = *(const u32x4*)(kp_ + 64); \
                         if (tid < 256) rreg = *(const u32x4*)(W.PB + (size_t)(row0_ + (tid >> 2)) * PBS + O_KR + 8 * (tid & 3)); } \
        else { const bf16_t* kp_ = W.PB + (size_t)(row0_ + kkey) * PBS + h * 64 + 8 * kch; kreg = *(const u32x4*)(kp_ + (MODE == 1 ? O_DK : O_NAK)); vreg = *(const u32x4*)(kp_ + (MODE == 1 ? O_DV : O_NAV)); } } while (0)
#define AT_WRITE(buf) do { LAS unsigned char* sb_ = lds + (buf) * AT_STAGE; *(LAS u32x4*)(sb_ + kw_off) = kreg; *(LAS u32x4*)(sb_ + vw_off) = vreg; \
        if (MODE == 2 && tid < 256) *(LAS u32x4*)(sb_ + rw_off) = rreg; } while (0)
    f32x16 O[NMAP][2]; float mrun[NMAP], lrun[NMAP];
#pragma unroll
    for (int mp = 0; mp < NMAP; ++mp) { mrun[mp] = NEG; lrun[mp] = 0.f;
#pragma unroll
        for (int d = 0; d < 2; ++d)
#pragma unroll
            for (int i = 0; i < 16; ++i) O[mp][d][i] = 0.f; }
    const unsigned kr_off = (unsigned)(r32 * KSTR + hh * 16);
    const unsigned vr_off = (unsigned)(AT_KBUF + hh * 512 + ((lane & 15) >> 2) * 64 + (((lane >> 4) & 1) * 16 + (lane & 3) * 4) * 2);
    AT_LOAD(0); AT_WRITE(0); if (ntiles > 1) AT_LOAD(1);
    __syncthreads();
#pragma unroll 1
    for (int i = 0; i < ntiles; ++i) {
        const int cur = i & 1;
        if (i + 1 < ntiles) AT_WRITE(cur ^ 1);
        if (i + 2 < ntiles) AT_LOAD(i + 2);
        const bool wtile = (MODE == 0) && !ctxq && i < nwin;
        bool active = true;
        int kr = 0, rq = 0;
        if (wtile) { kr = krs + i; rq = 4 * qb + (wave >> 1); const int rsq = min(max(rq - 4, 0), 24); active = kr >= rsq && kr < rsq + 8; }
        if (active) {
            const LAS unsigned char* sb = lds + cur * AT_STAGE;
            bf16x8 pf[NMAP][4];
#pragma unroll
            for (int mp = 0; mp < NMAP; ++mp) {
                f32x16 S0, S1;
#pragma unroll
                for (int q = 0; q < 16; ++q) { S0[q] = 0.f; S1[q] = 0.f; }
#pragma unroll
                for (int st = 0; st < NST; ++st) {
                    const bf16x8 k0 = *(const LAS bf16x8*)(sb + kr_off + ((MODE == 1 ? 4 * mp : 0) + 2 * st) * 16);
                    const bf16x8 k1 = *(const LAS bf16x8*)(sb + kr_off + 32 * KSTR + ((MODE == 1 ? 4 * mp : 0) + 2 * st) * 16);
                    S0 = __builtin_amdgcn_mfma_f32_32x32x16_bf16(k0, qf[mp][st], S0, 0, 0, 0);
                    S1 = __builtin_amdgcn_mfma_f32_32x32x16_bf16(k1, qf[mp][st], S1, 0, 0, 0);
                }
                if (wtile) {
                    const int cq = 32 * (wave & 1) + r32, cs = min(max(cq - 8, 0), 48);
                    const LAS float* bt = btab + (kr - rq + 7) * 31 + 15 - cq;
#pragma unroll
                    for (int q = 0; q < 16; ++q) {
                        const int kc0 = (q & 3) + 8 * (q >> 2) + 4 * hh, kc1 = kc0 + 32;
                        S0[q] = ((unsigned)(kc0 - cs) < 16u) ? S0[q] + bt[kc0] : NEG;
                        S1[q] = ((unsigned)(kc1 - cs) < 16u) ? S1[q] + bt[kc1] : NEG;
                    }
                }
                float mx = fmaxf(max16(S0), max16(S1));
                mx = fmaxf(mx, __shfl_xor(mx, 32));
                const float mnew = fmaxf(mrun[mp], mx);
                const float alpha = __builtin_amdgcn_exp2f((mrun[mp] - mnew) * CS);
                const float mc = mnew * CS;
                float ls = 0.f;
#pragma unroll
                for (int q = 0; q < 16; ++q) { S0[q] = __builtin_amdgcn_exp2f(fmaf(S0[q], CS, -mc)); S1[q] = __builtin_amdgcn_exp2f(fmaf(S1[q], CS, -mc)); ls += S0[q] + S1[q]; }
                lrun[mp] = lrun[mp] * alpha + ls; mrun[mp] = mnew;
#pragma unroll
                for (int d = 0; d < 2; ++d)
#pragma unroll
                    for (int q = 0; q < 16; ++q) O[mp][d][q] *= alpha;
                pf[mp][0] = pack8(S0[0], S0[1], S0[2], S0[3], S0[4], S0[5], S0[6], S0[7]);
                pf[mp][1] = pack8(S0[8], S0[9], S0[10], S0[11], S0[12], S0[13], S0[14], S0[15]);
                pf[mp][2] = pack8(S1[0], S1[1], S1[2], S1[3], S1[4], S1[5], S1[6], S1[7]);
                pf[mp][3] = pack8(S1[8], S1[9], S1[10], S1[11], S1[12], S1[13], S1[14], S1[15]);
            }
#pragma unroll
            for (int d = 0; d < 2; ++d)
#pragma unroll
                for (int s4 = 0; s4 < 4; ++s4) {
                    const LAS unsigned char* vp = sb + vr_off + (8 * s4 + d) * 256;
                    const v4i16_t va = __builtin_amdgcn_ds_read_tr16_b64_v4i16((LAS v4i16_t*)vp);
                    const v4i16_t vb = __builtin_amdgcn_ds_read_tr16_b64_v4i16((LAS v4i16_t*)(vp + 1024));
                    bf16x8 vf; vf[0] = va[0]; vf[1] = va[1]; vf[2] = va[2]; vf[3] = va[3]; vf[4] = vb[0]; vf[5] = vb[1]; vf[6] = vb[2]; vf[7] = vb[3];
#pragma unroll
                    for (int mp = 0; mp < NMAP; ++mp) O[mp][d] = __builtin_amdgcn_mfma_f32_32x32x16_bf16(vf, pf[mp][s4], O[mp][d], 0, 0, 0);
                }
        }
        __syncthreads();
    }
    float inv[NMAP];
#pragma unroll
    for (int mp = 0; mp < NMAP; ++mp) { const float lt = lrun[mp] + __shfl_xor(lrun[mp], 32); inv[mp] = 1.f / lt; }
    bf16_t* orow = W.HB + (size_t)tq * DM + (MODE == 0 ? 0 : (MODE == 1 ? 256 : 512)) + h * 64 + 4 * hh;
    if (MODE == 1) {
        const float lam = W.lam[l], li = 0.8f - 0.6f * expf(-0.3f * (float)l);
        const float* sg = P.in[11] + l * 64;
        const float c2 = lam * inv[1];
        float ss = 0.f;
#pragma unroll
        for (int d = 0; d < 2; ++d)
#pragma unroll
            for (int q = 0; q < 16; ++q) { const float o = O[0][d][q] * inv[0] - c2 * O[NMAP - 1][d][q]; O[0][d][q] = o; ss += o * o; }
        ss += __shfl_xor(ss, 32);
        const float rs = rsqrtf(ss * (1.f / 64.f) + 1e-6f) * (1.f - li);
#pragma unroll
        for (int d = 0; d < 2; ++d)
#pragma unroll
            for (int g4 = 0; g4 < 4; ++g4) {
                const int dv = 32 * d + 8 * g4 + 4 * hh;
                const f32x4 gg = *(const f32x4*)(sg + dv);
                u32x2 w; w.x = pk_bf16(O[0][d][4 * g4] * rs * gg[0], O[0][d][4 * g4 + 1] * rs * gg[1]); w.y = pk_bf16(O[0][d][4 * g4 + 2] * rs * gg[2], O[0][d][4 * g4 + 3] * rs * gg[3]);
                *(u32x2*)(orow + 32 * d + 8 * g4) = w;
            }
    } else {
#pragma unroll
        for (int d = 0; d < 2; ++d)
#pragma unroll
            for (int g4 = 0; g4 < 4; ++g4) {
                u32x2 w; w.x = pk_bf16(O[0][d][4 * g4] * inv[0], O[0][d][4 * g4 + 1] * inv[0]); w.y = pk_bf16(O[0][d][4 * g4 + 2] * inv[0], O[0][d][4 * g4 + 3] * inv[0]);
                *(u32x2*)(orow + 32 * d + 8 * g4) = w;
            }
    }
#undef AT_ROW0
#undef AT_LOAD
#undef AT_WRITE
}
__device__ __forceinline__ void phase_attn(const Params& P, LAS unsigned char* lds) {
    const Ws W(P.ws);
    const int G = gridDim.x, c = blockIdx.x;
    for (int u = c; u < 1024; u += G) { const int x = u & 7, j = u >> 3, qb = j & 7, bh = (j >> 3) * 8 + x; attn_unit<2>(P, W, lds, bh >> 3, bh & 7, qb, false); }
    for (int u = c; u < 512; u += G) { const int x = u & 7, j = u >> 3, qb = j & 7, bh = (j >> 3) * 8 + x; attn_unit<1>(P, W, lds, bh >> 2, bh & 3, qb, false); }
    for (int u = c; u < 512; u += G) { const int x = u & 7, j = u >> 3, qb = j & 7, bh = (j >> 3) * 8 + x; attn_unit<0>(P, W, lds, bh >> 2, bh & 3, qb, false); }
    if (P.layer == 0) {
        for (int u = c; u < 256; u += G) {
            if (u < 128) attn_unit<2>(P, W, lds, u >> 3, u & 7, 0, true);
            else if (u < 192) attn_unit<1>(P, W, lds, (u - 128) >> 2, (u - 128) & 3, 0, true);
            else attn_unit<0>(P, W, lds, (u - 192) >> 2, (u - 192) & 3, 0, true);
        }
    }
}

enum { PH_CONV = 0, PH_INPROJ = 1, PH_MLA = 2, PH_OUTPROJ = 3, PH_NORM2 = 4, PH_MOE1 = 5, PH_MOE2 = 6, PH_COMB = 7, PH_NORM1 = 8, PH_ATTN = 9 };
template <int PH>
__global__ void __launch_bounds__(NTHREADS, 2) k_phase(Params P) {
    extern __shared__ __attribute__((aligned(16))) unsigned char dyn_lds[];
    LAS unsigned char* lds = (LAS unsigned char*)dyn_lds;
    if (PH == PH_CONV) phase_convert(P, lds);
    if (PH == PH_INPROJ) phase_inproj(P, lds);
    if (PH == PH_MLA) phase_mla(P, lds);
    if (PH == PH_OUTPROJ) phase_outproj(P, lds);
    if (PH == PH_NORM2) phase_norm2(P, lds);
    if (PH == PH_MOE1) phase_moe1(P, lds);
    if (PH == PH_MOE2) phase_moe2(P, lds);
    if (PH == PH_COMB) phase_comb(P, lds);
    if (PH == PH_NORM1) phase_norm1(P, lds);
    if (PH == PH_ATTN) phase_attn(P, lds);
}

#ifndef FAST_GEMMS
#define FAST_GEMMS 1
#endif
#ifndef FAST_MOE
#define FAST_MOE 1
#endif
#ifndef FAST_ATTN
#define FAST_ATTN 1
#endif
template <int PH> static void launch_phase(const Params& P, int grid, hipStream_t stream) {
    static bool attr_set = false;
    if (!attr_set) { (void)hipFuncSetAttribute((const void*)k_phase<PH>, hipFuncAttributeMaxDynamicSharedMemorySize, LDS_BYTES); attr_set = true; }
    hipLaunchKernelGGL(k_phase<PH>, dim3(grid), dim3(NTHREADS), LDS_BYTES, stream, P);
}
extern "C" void kernel_launch(void* const* d_in, const int* in_sizes, int n_in, void* d_out, int out_size, void* d_ws, size_t ws_size, hipStream_t stream) {
    if (ws_size < WS_END || n_in != 26) { fprintf(stderr, "kernel_launch: workspace %zu < %zu or n_in %d != 26\n", ws_size, (size_t)WS_END, n_in); return; }
    static int grid = 0;
    if (!grid) { int dev = 0, cus = 0; (void)hipGetDevice(&dev); (void)hipDeviceGetAttribute(&cus, hipDeviceAttributeMultiprocessorCount, dev); grid = cus > 0 ? cus : 256; }
    const float* x = (const float*)d_in[0];       const float* c = (const float*)d_in[1];
    const float* ctx = (const float*)d_in[2];     const float* c_ctx = (const float*)d_in[3];
    const float* w_ada = (const float*)d_in[4];   const float* b_ada = (const float*)d_in[5];
    const float* norm_attn_g = (const float*)d_in[6]; const float* norm_ffn_g = (const float*)d_in[7];
    const float* w_in = (const float*)d_in[8];    const float* na_rel_bias = (const float*)d_in[9];
    const float* diff_lambda = (const float*)d_in[10]; const float* diff_subln_g = (const float*)d_in[11];
    const float* mla_q_norm_g = (const float*)d_in[12]; const float* mla_w_uq = (const float*)d_in[13];
    const float* mla_kv_norm_g = (const float*)d_in[14]; const float* mla_w_ukv = (const float*)d_in[15];
    const float* w_out = (const float*)d_in[16];  const float* router_w = (const float*)d_in[17];
    const float* router_bias = (const float*)d_in[18];
    const float* ewg = (const float*)d_in[19];    const float* ewu = (const float*)d_in[20];   const float* ewd = (const float*)d_in[21];
    const float* swg = (const float*)d_in[22];    const float* swu = (const float*)d_in[23];   const float* swd = (const float*)d_in[24];
    const float* final_norm_g = (const float*)d_in[25];
    unsigned char* ws = (unsigned char*)d_ws;
    Ws W(ws);
    int* cnt = (int*)(ws + WS_CTL) + 8192;
    float* mod = W.mod; float* lam = W.lam;
    float* logits = (float*)(ws + WS_LOG);
    uint2* list = (uint2*)(ws + WS_LIST);
    float* XS = W.XS; bf16_t* HB = W.HB; bf16_t* PB = W.PB; bf16_t* QM = W.QM; bf16_t* KVM = W.KVM;
    Params P{}; for (int i = 0; i < 26; ++i) P.in[i] = (const float*)d_in[i]; P.out = (float*)d_out; P.ws = ws;

    (void)hipMemsetAsync(ws + WS_CTL, 0, 1 * MiB, stream);
    (void)hipMemcpyAsync(XS, x, (size_t)NLAT * DM * 4, hipMemcpyDeviceToDevice, stream);
    (void)hipMemcpyAsync(XS + (size_t)NLAT * DM, ctx, (size_t)NCTX * DM * 4, hipMemcpyDeviceToDevice, stream);
#if !FAST_GEMMS
    k_mod<<<(2 * 17 * MODW + 255) / 256, 256, 0, stream>>>(c, c_ctx, w_ada, b_ada, mod);
    k_lam<<<1, 64, 0, stream>>>(diff_lambda, lam);
#endif
    const size_t attn_lds = 2 * (128 + 2 * 2304) * sizeof(float);
    for (int l = 0; l < 2; ++l) {
        const int nq = l == 0 ? NTOK : NLAT;
        const float* mod_l = mod + (size_t)l * 17 * MODW;
        const float li = 0.8f - 0.6f * expf(-0.3f * (float)l);
        P.layer = l;
#if FAST_GEMMS
        launch_phase<PH_CONV>(P, grid, stream);
#endif
#if FAST_ATTN
        launch_phase<PH_NORM1>(P, grid, stream);
#else
        k_norm<false><<<NTOK, 256, 0, stream>>>(XS, norm_attn_g + l * DM, mod_l, 0, 1, HB, nullptr, nullptr);
#endif
#if FAST_GEMMS
        launch_phase<PH_INPROJ>(P, grid, stream);
        launch_phase<PH_MLA>(P, grid, stream);
#else
        (void)hipMemsetAsync(PB, 0, (size_t)NTOK * PBS * 2, stream);
        { EpiStore ep{}; ep.O = PB; ep.ldo = PBS; ep.coloff = 0;
          k_gemm_naive<EpiStore><<<dim3((INC + 127) / 128, NTOK / 128), 256, 0, stream>>>(HB, DM, w_in + (size_t)l * DM * INC, INC, INC, DM, ep); }
        k_rope_pb<<<(NLAT * 17 * 16) / 256, 256, 0, stream>>>(PB);
        k_mla_norm<<<NTOK / 4, 256, 0, stream>>>(PB, mla_q_norm_g + l * 256, mla_kv_norm_g + l * 128);
        { EpiStore ep{}; ep.O = QM; ep.ldo = 768; ep.coloff = 0;
          k_gemm_naive<EpiStore><<<dim3(768 / 128, NTOK / 128), 256, 0, stream>>>(PB + O_CQ, PBS, mla_w_uq + (size_t)l * 256 * 768, 768, 768, 256, ep); }
        { EpiStore ep{}; ep.O = KVM; ep.ldo = 1024; ep.coloff = 0;
          k_gemm_naive<EpiStore><<<dim3(1024 / 128, NTOK / 128), 256, 0, stream>>>(PB + O_CKV, PBS, mla_w_ukv + (size_t)l * 128 * 1024, 1024, 1024, 128, ep); }
        k_rope_qm<<<(NLAT * 8 * 16) / 256, 256, 0, stream>>>(QM);
#endif
#if FAST_ATTN
        launch_phase<PH_ATTN>(P, grid, stream);
#else
        k_attn_naive<0><<<nq * 4 / 2, 128, attn_lds, stream>>>(PB, QM, KVM, HB, na_rel_bias + l * 4 * 15 * 31, diff_subln_g + l * 64, lam + l, 1.f - li, 0);
        k_attn_naive<1><<<nq * 4 / 2, 128, attn_lds, stream>>>(PB, QM, KVM, HB, na_rel_bias + l * 4 * 15 * 31, diff_subln_g + l * 64, lam + l, 1.f - li, 0);
        k_attn_naive<2><<<nq * 8 / 2, 128, attn_lds, stream>>>(PB, QM, KVM, HB, na_rel_bias + l * 4 * 15 * 31, diff_subln_g + l * 64, lam + l, 1.f - li, 0);
#endif
#if FAST_GEMMS
        launch_phase<PH_OUTPROJ>(P, grid, stream);
#else
        { EpiResid ep{}; ep.XS = XS; ep.mod_l = mod_l; ep.chunk = 2; ep.pad = 0;
          k_gemm_naive<EpiResid><<<dim3(DM / 128, nq / 128), 256, 0, stream>>>(HB, DM, w_out + (size_t)l * DM * DM, DM, DM, DM, ep); }
#endif
#if FAST_MOE
        (void)hipMemsetAsync((unsigned*)(ws + WS_CTL) + CW_CNT, 0, NCHUNK * 64 * 4, stream);
        launch_phase<PH_NORM2>(P, grid, stream);
        for (int ch = 0; ch < NCHUNK; ++ch) { P.i1 = ch; launch_phase<PH_MOE1>(P, grid, stream); launch_phase<PH_MOE2>(P, grid, stream); launch_phase<PH_COMB>(P, grid, stream); }
        P.i1 = 0;
#else
        (void)hipMemsetAsync(cnt, 0, 4096, stream);
        k_norm<true><<<nq, 256, 0, stream>>>(XS, norm_ffn_g + l * DM, mod_l, 3, 4, HB, router_w + (size_t)l * DM * NEXP, logits);
        k_topk<<<nq / 4, 256, 0, stream>>>(logits, router_bias + l * NEXP, cnt, list);
        k_moe_naive<<<dim3((nq + 7) / 8, NEXP + 1), 256, 0, stream>>>(HB, cnt, list, nq,
            ewg + (size_t)l * NEXP * DM * EFF, ewu + (size_t)l * NEXP * DM * EFF, ewd + (size_t)l * NEXP * EFF * DM,
            swg + (size_t)l * DM * EFF, swu + (size_t)l * DM * EFF, swd + (size_t)l * EFF * DM, mod_l, XS);
#endif
    }
    k_final<<<NLAT, 256, 0, stream>>>(XS, final_norm_g, (float*)d_out);
}
```

```cpp
#include <hip/hip_runtime.h>
#include <cstdint>
#include <cstdio>
#include <cmath>

typedef unsigned short bf16_t;

constexpr int NB = 16, SEQ = 2048, DM = 1024, CTX = 256;
constexpr int NLAT = NB * SEQ, NCTX = NB * CTX, NTOK = NLAT + NCTX;
constexpr int INC = 1952;
constexpr int PBS = 2048;
constexpr int O_NAQ = 0, O_NAK = 256, O_NAV = 512, O_DQ = 768, O_DK = 1024, O_DV = 1280, O_CQ = 1536, O_CKV = 1792, O_KR = 1920;
constexpr int NEXP = 64, EFF = 256;
constexpr int LCAP = NTOK;
constexpr int MODW = 6 * DM;

constexpr size_t MiB = 1u << 20;
constexpr size_t WS_CTL = 0;
constexpr size_t WS_MOD = 1 * MiB;
constexpr size_t WS_ROPE = 2 * MiB;
constexpr size_t WS_SSQ = 3 * MiB;
constexpr size_t WS_JUNK = 6 * MiB;
constexpr size_t WS_XS = 8 * MiB;
constexpr size_t WS_HB = 152 * MiB;
constexpr size_t WS_PB = 224 * MiB;
constexpr size_t WS_QM = 368 * MiB;
constexpr size_t WS_KVM = 422 * MiB;
constexpr size_t WS_WB = 494 * MiB;
constexpr size_t WS_END = 600 * MiB;
constexpr size_t WS_LOG = WS_PB;
constexpr size_t WS_LIST = WS_PB + 16 * MiB;
constexpr size_t WB_WIN = 0;
constexpr size_t WB_WUQ = WB_WIN + (size_t)2048 * 1024;
constexpr size_t WB_WUKV = WB_WUQ + (size_t)768 * 256;
constexpr size_t WB_WOUT = WB_WUKV + (size_t)1024 * 256;
constexpr size_t WB_WGU = WB_WOUT + (size_t)1024 * 1024;
constexpr size_t WB_WD = WB_WGU + (size_t)65 * 512 * 1024;
constexpr size_t WB_END = WB_WD + (size_t)65 * 1024 * 256;
static_assert(WS_WB + WB_END * 2 <= WS_END, "weights fit");

__device__ __forceinline__ float bf2f(bf16_t v) { return __uint_as_float(((unsigned)v) << 16); }
__device__ __forceinline__ bf16_t f2bf(float f) { unsigned u = __float_as_uint(f); u += 0x7fffu + ((u >> 16) & 1u); return (bf16_t)(u >> 16); }
__device__ __forceinline__ float wave_sum(float v) {
#pragma unroll
    for (int o = 32; o > 0; o >>= 1) v += __shfl_xor(v, o);
    return v;
}
__device__ __forceinline__ float wave_max(float v) {
#pragma unroll
    for (int o = 32; o > 0; o >>= 1) v = fmaxf(v, __shfl_xor(v, o));
    return v;
}
__device__ __forceinline__ int mod_row(int t) { return t < NLAT ? (t >> 11) : 16; }

__device__ __forceinline__ void rope_cs(int s, int j, float& cs, float& sn) {
    const int rowi = s >> 6, coli = s & 63;
    const float freq = powf(10000.f, -(float)(j & 7) / 8.f);
    const float ang = (float)(j < 8 ? rowi : coli) * freq;
    cs = cosf(ang); sn = sinf(ang);
}
#define LAS __attribute__((address_space(3)))
typedef short bf16x8 __attribute__((ext_vector_type(8)));
typedef float f32x4 __attribute__((ext_vector_type(4)));
typedef float f32x2 __attribute__((ext_vector_type(2)));
typedef unsigned u32x2 __attribute__((ext_vector_type(2)));
typedef unsigned u32x4 __attribute__((ext_vector_type(4)));
typedef __bf16 bf16x2_t __attribute__((ext_vector_type(2)));

struct Params { const float* in[26]; float* out; unsigned char* ws; int ph_lo, ph_hi, i2, i3; };
typedef const Params __attribute__((address_space(4)))* KP;
__device__ __forceinline__ KP kparams() { KP p = (KP)__builtin_amdgcn_kernarg_segment_ptr(); asm volatile("" : "+s"(p)); return p; }
#ifndef PROBE_HALF
#define PROBE_HALF -1
#endif
enum { ID_CONV = 0, ID_NORM1, ID_INPROJ, ID_MLA, ID_ATTN, ID_OUTPROJ, ID_NORM2, ID_MOE, ID_COMB };
template <int ID> __device__ __forceinline__ int pgrid() { int g = (int)gridDim.x; asm volatile("" : "+s"(g)); return ID == PROBE_HALF ? g / 2 : g; }
template <int ID> __device__ __forceinline__ int pblk() { int b = (int)blockIdx.x; asm volatile("" : "+s"(b)); return ID == PROBE_HALF ? ((b & 1) ? -1 : b >> 1) : b; }
__device__ __forceinline__ int tid_opaque() { int t = (int)threadIdx.x; asm volatile("" : "+v"(t)); return t; }

constexpr int NTHREADS = 512;
constexpr int LDS_BYTES = 147456;

__device__ __forceinline__ unsigned pk_bf16(float lo, float hi) { f32x2 v = {lo, hi}; bf16x2_t b = __builtin_convertvector(v, bf16x2_t); return __builtin_bit_cast(unsigned, b); }

namespace g8 {
constexpr int BM = 256, BK = 64, HALF = 128, HTB = HALF * BK * 2, STAGE_BYTES = 8 * HTB, NXCD = 8, WGM = 8;
__host__ __device__ __forceinline__ int lds_byte(int r, int c) { const int st = (r >> 4) * 2 + (c >> 5), rr = r & 15, cc = c & 31, ob = rr * 64 + cc * 2; return st * 1024 + (ob ^ (((ob >> 9) & 1) << 5)); }
__host__ __device__ __forceinline__ void stage_rc(int b, int& R, int& C) { const int st = b / 1024, sb = b % 1024, swz = sb ^ (((sb >> 9) & 1) << 5); R = (st >> 1) * 16 + swz / 64; C = (st & 1) * 32 + (swz % 64) / 2; }

struct Unit2 { int pm, pn; };
struct DenseOrder {
    int nM, nN, nwg, G, c;
    __device__ __forceinline__ void init(int nM_, int nN_, int G_, int c_) { nM = nM_; nN = nN_; nwg = nM * nN; G = G_; c = c_; }
    __device__ __forceinline__ bool next(int i, Unit2& u) const {
        const long L = (long)i * G + c; if (L >= nwg) return false;
        int wgid = (int)L; { const int q = nwg / NXCD, r = nwg % NXCD, xcd = wgid % NXCD, off = wgid / NXCD; wgid = (xcd < r ? xcd * (q + 1) : r * (q + 1) + (xcd - r) * q) + off; }
        const int nig = WGM * nN, gid = wgid / nig, fm = gid * WGM, gsz = (nM - fm) < WGM ? (nM - fm) : WGM;
        u.pm = fm + ((wgid % nig) % gsz); u.pn = (wgid % nig) / gsz; return true;
    }
};

#define G8_SA(b, h) (((b) * 2 + (h)) * g8::HTB)
#define G8_SB(b, h) ((4 + (b) * 2 + (h)) * g8::HTB)
#define G8_GLDS(gp, ldsoff) __builtin_amdgcn_global_load_lds((const unsigned*)(gp), (LAS unsigned*)(lds + (ldsoff)), 16, 0, 0)
#define G8_STAGE_A(bufoff, o0, o1, kb) do { G8_GLDS(Ab + (o0) + (kb), (bufoff) + ldsw); G8_GLDS(Ab + (o1) + (kb), (bufoff) + ldsw + 8192); } while (0)
#define G8_STAGE_B(bufoff, bp, kb) do { G8_GLDS((bp) + voffB[0] + (kb), (bufoff) + ldsw); G8_GLDS((bp) + voffB[1] + (kb), (bufoff) + ldsw + 8192); } while (0)
#define G8_LDA(dst, b, h) do { _Pragma("unroll") for (int m = 0; m < 4; ++m) _Pragma("unroll") for (int k = 0; k < 2; ++k) dst[m][k] = *(const LAS bf16x8*)(lds + G8_SA(b, h) + aoff + m * 2048 + k * 1024); } while (0)
#define G8_LDB(dst, b, h) do { _Pragma("unroll") for (int n = 0; n < 2; ++n) _Pragma("unroll") for (int k = 0; k < 2; ++k) dst[n][k] = *(const LAS bf16x8*)(lds + G8_SB(b, h) + boff + n * 2048 + k * 1024); } while (0)
#define G8_MMA(ai, bj, At, Bt) do { __builtin_amdgcn_s_setprio(1); _Pragma("unroll") for (int m = 0; m < 4; ++m) _Pragma("unroll") for (int n = 0; n < 2; ++n) _Pragma("unroll") for (int k = 0; k < 2; ++k) \
        acc[ai][bj][m][n] = __builtin_amdgcn_mfma_f32_16x16x32_bf16(Bt[n][k], At[m][k], acc[ai][bj][m][n], 0, 0, 0); __builtin_amdgcn_s_setprio(0); } while (0)
#define G8_WAIT_V(n) asm volatile("s_waitcnt vmcnt(" #n ")" ::: "memory")
#define G8_WAIT_L(n) asm volatile("s_waitcnt lgkmcnt(" #n ")" ::: "memory")
#define G8_BAR __builtin_amdgcn_s_barrier()
#define G8_SCHED __builtin_amdgcn_sched_barrier(0)

template <class P>
__device__ __forceinline__ void gemm_phase(LAS unsigned char* lds, const P& pr) {
    typedef typename P::Unit Unit;
    constexpr int K = P::K, nt = K / BK;
    static_assert(K % 128 == 0 && nt >= 2, "K must be a multiple of 128");
    const int tid = tid_opaque(), wid = __builtin_amdgcn_readfirstlane(tid >> 6), lane = tid & 63, wr = wid >> 2, wc = wid & 3, fr = lane & 15, fq = lane >> 4;
    int Rr[2], Cc[2]; unsigned voffB[2];
#pragma unroll
    for (int i = 0; i < 2; ++i) { stage_rc(tid * 16 + i * 8192, Rr[i], Cc[i]); voffB[i] = (unsigned)(Rr[i] * K + Cc[i]) * 2u; }
    constexpr unsigned kstep = BK * 2;
    constexpr size_t hstepB = (size_t)HALF * K * 2;
    const unsigned ldsw = (unsigned)wid * 1024u;
    const int aoff = lds_byte(wr * 64 + fr, fq * 8), boff = lds_byte(wc * 32 + fr, fq * 8);
    Unit cur, nxt; int ui = 0;
    int pend = -1;
    if (!pr.next(0, cur)) return;
    f32x4 acc[2][2][4][2];
#pragma unroll
    for (int a = 0; a < 2; ++a)
#pragma unroll
        for (int b = 0; b < 2; ++b)
#pragma unroll
            for (int m = 0; m < 4; ++m)
#pragma unroll
                for (int n = 0; n < 2; ++n) acc[a][b][m][n] = (f32x4){0.f, 0.f, 0.f, 0.f};
    bf16x8 At[4][2], B0[2][2], B1[2][2];
    const char* Ab = pr.a_base();
    unsigned ca[2][2], na[2][2];
    pr.a_ready(cur);
    pr.a_offsets(cur, Rr, Cc, ca);
    const char* cB = pr.b_ptr(cur);
    G8_STAGE_B(G8_SB(0, 0), cB, 0); G8_STAGE_B(G8_SB(0, 1), cB + hstepB, 0); G8_STAGE_A(G8_SA(0, 0), ca[0][0], ca[0][1], 0); G8_STAGE_A(G8_SA(0, 1), ca[1][0], ca[1][1], 0);
    if (wr == 1) G8_BAR;
    G8_WAIT_V(2); G8_BAR;
    G8_STAGE_B(G8_SB(1, 0), cB, kstep); G8_STAGE_A(G8_SA(1, 0), ca[0][0], ca[0][1], kstep); G8_STAGE_B(G8_SB(1, 1), cB + hstepB, kstep);
    G8_WAIT_V(6); G8_BAR;
    for (;;) {
        const bool has_next = pr.next(ui + 1, nxt);
        const char* nB = cB;
#pragma unroll
        for (int h = 0; h < 2; ++h)
#pragma unroll
            for (int i = 0; i < 2; ++i) na[h][i] = ca[h][i];
        if (has_next) { pr.a_offsets(nxt, Rr, Cc, na); nB = pr.b_ptr(nxt); }
#pragma unroll 1
        for (int t = 0; t < nt; t += 2) {
            const bool last = (t == nt - 2);
            if (last && has_next) pr.a_ready(nxt);
            const unsigned k1 = (unsigned)(t + 1) * kstep, k2 = (unsigned)(t + 2) * kstep;
            unsigned a2[2][2];
#pragma unroll
            for (int h = 0; h < 2; ++h)
#pragma unroll
                for (int i = 0; i < 2; ++i) a2[h][i] = last ? na[h][i] : ca[h][i] + k2;
            const char* b2 = last ? nB : cB + k2;
            G8_LDB(B0, 0, 0); G8_LDB(B1, 0, 1); G8_SCHED; G8_LDA(At, 0, 0); G8_STAGE_A(G8_SA(1, 1), ca[1][0], ca[1][1], k1);
            G8_WAIT_V(8); G8_WAIT_L(0); G8_BAR; G8_MMA(0, 0, At, B0); G8_MMA(0, 1, At, B1); G8_BAR; G8_SCHED;
            G8_LDA(At, 0, 1); G8_STAGE_B(G8_SB(0, 0), b2, 0); G8_STAGE_B(G8_SB(0, 1), b2 + hstepB, 0); G8_STAGE_A(G8_SA(0, 0), a2[0][0], a2[0][1], 0);
            G8_WAIT_V(8); G8_WAIT_L(0); G8_BAR; G8_MMA(1, 0, At, B0); G8_MMA(1, 1, At, B1); G8_BAR; G8_SCHED;
            if (P::HAS_DONE && t == 0 && pend >= 0) { pr.done(pend); pend = -1; }
            G8_LDB(B0, 1, 0); G8_LDB(B1, 1, 1); G8_SCHED; G8_LDA(At, 1, 0); G8_STAGE_A(G8_SA(0, 1), a2[1][0], a2[1][1], 0);
            G8_WAIT_V(8); G8_WAIT_L(0); G8_BAR; G8_MMA(0, 0, At, B0); G8_MMA(0, 1, At, B1); G8_BAR; G8_SCHED;
            G8_LDA(At, 1, 1); G8_STAGE_B(G8_SB(1, 0), b2, kstep); G8_STAGE_B(G8_SB(1, 1), b2 + hstepB, kstep); G8_STAGE_A(G8_SA(1, 0), a2[0][0], a2[0][1], kstep);
            G8_WAIT_V(8); G8_WAIT_L(0); G8_BAR; G8_MMA(1, 0, At, B0); G8_MMA(1, 1, At, B1); G8_BAR; G8_SCHED;
        }
        if (wr == 0) G8_BAR;
        pr.epilogue(acc, cur, wr, wc, fr, fq);
        if (P::HAS_DONE) pend = pr.done_token(cur);
        if (!has_next) break;
#pragma unroll
        for (int a = 0; a < 2; ++a)
#pragma unroll
            for (int b = 0; b < 2; ++b)
#pragma unroll
                for (int m = 0; m < 4; ++m)
#pragma unroll
                    for (int n = 0; n < 2; ++n) acc[a][b][m][n] = (f32x4){0.f, 0.f, 0.f, 0.f};
        cur = nxt; cB = nB; ++ui;
#pragma unroll
        for (int h = 0; h < 2; ++h)
#pragma unroll
            for (int i = 0; i < 2; ++i) ca[h][i] = na[h][i];
        if (wr == 1) G8_BAR;
    }
    G8_WAIT_V(0);
    if (P::HAS_DONE && pend >= 0) pr.done(pend);
    G8_BAR;
}
}

struct Ws {
    unsigned* ctl; float* mod; float* lam; float* rope; float* ssq; float* sskv;
    bf16_t* XS; bf16_t* HB; bf16_t* PB; bf16_t* QM; bf16_t* KVM; bf16_t* WB;
    __device__ __host__ __forceinline__ explicit Ws(unsigned char* ws) {
        ctl = (unsigned*)(ws + WS_CTL); mod = (float*)(ws + WS_MOD); lam = mod + 2 * 17 * MODW; rope = (float*)(ws + WS_ROPE);
        ssq = (float*)(ws + WS_SSQ); sskv = ssq + (size_t)NTOK * 4;
        XS = (bf16_t*)(ws + WS_XS); HB = (bf16_t*)(ws + WS_HB); PB = (bf16_t*)(ws + WS_PB); QM = (bf16_t*)(ws + WS_QM); KVM = (bf16_t*)(ws + WS_KVM); WB = (bf16_t*)(ws + WS_WB);
    }
};

__device__ __forceinline__ int conv_drow(int ng, int mode) {
    if (mode == 1 || mode == 2) { const int a = ng & 127; return (ng & ~127) * 2 + 128 * ((a >> 2) & 1) + 32 * (a >> 5) + 16 * (mode - 1) + 4 * ((a >> 3) & 3) + (a & 3); }
    if (mode == 3) { const int c = ng & 63; return (ng & ~63) + 16 * ((c >> 2) & 3) + 4 * (c >> 4) + (c & 3); }
    if (mode == 4) { const int c = ng & 255, g = c >> 5; return (ng & ~255) + 128 * ((c >> 2) & 1) + 32 * (g >> 1) + 16 * ((c >> 4) & 1) + 4 * (2 * (g & 1) + ((c >> 3) & 1)) + (c & 3); }
    return ng;
}
struct ConvDesc { const float* W; const float* ks; bf16_t* Bt; int N, k0, n0, ldo, mode; };
__device__ __forceinline__ void conv_load(const ConvDesc& d, float (&v)[32], int lane) {
#pragma unroll
    for (int i = 0; i < 32; ++i) v[i] = d.W[(size_t)(d.k0 + 2 * i + (lane >> 5)) * d.N + d.n0 + (lane & 31)];
}
__device__ __forceinline__ void conv_store(const ConvDesc& d, float (&v)[32], LAS float* scr, int lane) {
    if (d.ks) {
#pragma unroll
        for (int i = 0; i < 32; ++i) v[i] *= d.ks[d.k0 + 2 * i + (lane >> 5)];
    }
#pragma unroll
    for (int i = 0; i < 32; ++i) scr[(2 * i + (lane >> 5)) * 33 + (lane & 31)] = v[i];
    asm volatile("s_waitcnt lgkmcnt(0)" ::: "memory");
    const int c = lane & 7;
#pragma unroll
    for (int j = 0; j < 4; ++j) {
        const int n = (lane >> 3) + 8 * j;
        const LAS float* sp = scr + (8 * c) * 33 + n;
        u32x4 o; o.x = pk_bf16(sp[0], sp[33]); o.y = pk_bf16(sp[66], sp[99]); o.z = pk_bf16(sp[132], sp[165]); o.w = pk_bf16(sp[198], sp[231]);
        *(u32x4*)(d.Bt + (size_t)conv_drow(d.n0 + n, d.mode) * d.ldo + d.k0 + 8 * c) = o;
    }
    asm volatile("s_waitcnt lgkmcnt(0)" ::: "memory");
}
constexpr int CV_E = 65 * 384, CV_IN = 16 * 61, CV_OUT = 512, CV_UQ = 96, CV_UKV = 64, CV_ITEMS = CV_E + CV_IN + CV_OUT + CV_UQ + CV_UKV;
__device__ __forceinline__ void conv_decode(const KP P, const Ws& W, int l, int it, ConvDesc& d) {
    int r = it; d.ks = nullptr;
    if (r < CV_E) {
        const int e = r / 384, w = (r % 384) >> 7, t = r & 127;
        if (w < 2) {
            d.W = e < 64 ? P->in[19 + w] + ((size_t)l * 64 + e) * 262144 : P->in[22 + w] + (size_t)l * 262144;
            d.N = 256; d.k0 = (t >> 3) * 64; d.n0 = (t & 7) * 32; d.Bt = W.WB + WB_WGU + (size_t)e * 524288; d.ldo = 1024; d.mode = 1 + w;
        } else {
            d.W = e < 64 ? P->in[21] + ((size_t)l * 64 + e) * 262144 : P->in[24] + (size_t)l * 262144;
            d.N = 1024; d.k0 = (t >> 5) * 64; d.n0 = (t & 31) * 32; d.Bt = W.WB + WB_WD + (size_t)e * 262144; d.ldo = 256; d.mode = 3;
        }
        return;
    }
    r -= CV_E;
    if (r < CV_IN) { d.W = P->in[8] + (size_t)l * 1024 * INC; d.N = INC; d.k0 = (r / 61) * 64; d.n0 = (r % 61) * 32; d.Bt = W.WB + WB_WIN; d.ldo = 1024; d.mode = 4; return; }
    r -= CV_IN;
    if (r < CV_OUT) { d.W = P->in[16] + (size_t)l * 1024 * 1024; d.N = 1024; d.k0 = (r >> 5) * 64; d.n0 = (r & 31) * 32; d.Bt = W.WB + WB_WOUT; d.ldo = 1024; d.mode = 0; return; }
    r -= CV_OUT;
    if (r < CV_UQ) { d.W = P->in[13] + (size_t)l * 256 * 768; d.N = 768; d.k0 = (r / 24) * 64; d.n0 = (r % 24) * 32; d.Bt = W.WB + WB_WUQ; d.ldo = 256; d.mode = 4; d.ks = P->in[12] + l * 256; return; }
    r -= CV_UQ;
    d.W = P->in[15] + (size_t)l * 128 * 1024; d.N = 1024; d.k0 = (r >> 5) * 64; d.n0 = (r & 31) * 32; d.Bt = W.WB + WB_WUKV; d.ldo = 256; d.mode = 4; d.ks = P->in[14] + l * 128;
}
__device__ __forceinline__ void conv_expert_items(const KP P, const Ws& W, int l, int k0, int gwave, int nwaves, LAS float* scr, int lane) {
    const int itA = gwave + k0 * nwaves, itB = itA + nwaves;
    if (itA >= CV_E) return;
    ConvDesc dA, dB; float vA[32], vB[32];
    conv_decode(P, W, l, itA, dA); conv_load(dA, vA, lane);
    const bool hB = itB < CV_E;
    if (hB) { conv_decode(P, W, l, itB, dB); conv_load(dB, vB, lane); }
    conv_store(dA, vA, scr, lane);
    if (hB) conv_store(dB, vB, scr, lane);
}
__device__ __forceinline__ void phase_convert(const int L_, const int CH_, LAS unsigned char* lds) {
    const KP P = kparams();
    const Ws W(P->ws);
    const int l = L_, tid = tid_opaque(), c = pblk<ID_CONV>(), G = pgrid<ID_CONV>();
    if (c < 0) return;
    const int wave = __builtin_amdgcn_readfirstlane(tid >> 6), lane = tid & 63;
    LAS float* scr = (LAS float*)(lds + wave * 8704);
    {
        const int stride = G * 8;
        int it = CV_E + c * 8 + wave;
        ConvDesc dA, dB; float vA[32], vB[32];
        bool hA = it < CV_ITEMS;
        if (hA) { conv_decode(P, W, l, it, dA); conv_load(dA, vA, lane); }
        while (hA) {
            const int itn = it + stride; const bool hB = itn < CV_ITEMS;
            if (hB) { conv_decode(P, W, l, itn, dB); conv_load(dB, vB, lane); }
            conv_store(dA, vA, scr, lane);
            if (!hB) break;
            it = itn + stride; hA = it < CV_ITEMS;
            if (hA) { conv_decode(P, W, l, it, dA); conv_load(dA, vA, lane); }
            conv_store(dB, vB, scr, lane);
        }
    }
    __syncthreads();
    {
        const int gid = c * NTHREADS + tid, gsz = G * NTHREADS;
        unsigned zz = 0u; asm volatile("" : "+v"(zz));
        const u32x4 z = {zz, zz, zz, zz};
        for (int i = gid; i < 96 * 128; i += gsz) *(u32x4*)(W.WB + WB_WIN + (size_t)conv_drow(1952 + (i >> 7), 4) * 1024 + (size_t)(i & 127) * 8) = z;
        for (int i = gid; i < 1024 * 16; i += gsz) *(u32x4*)(W.WB + WB_WUKV + (size_t)(i >> 4) * 256 + 128 + (i & 15) * 8) = z;
    }
    if (l == 0) {
        LAS float* st = (LAS float*)lds;
        LAS float* red = st + 17 * 1024;
        for (int u = c; u < 192; u += G) {
            const int l2 = u / 96, cg = u % 96;
            for (int i = tid; i < 17 * 1024; i += NTHREADS) { const int r = i >> 10, k = i & 1023; const float v = r < 16 ? P->in[1][r * 1024 + k] : P->in[3][k]; st[i] = v / (1.f + expf(-v)); }
            __syncthreads();
            const float* w = P->in[4] + (size_t)l2 * 1024 * MODW + cg * 64 + lane;
            float a[17];
#pragma unroll
            for (int r = 0; r < 17; ++r) a[r] = 0.f;
            for (int k = wave * 128; k < wave * 128 + 128; ++k) {
                const float wv = w[(size_t)k * MODW];
#pragma unroll
                for (int r = 0; r < 17; ++r) a[r] += st[r * 1024 + k] * wv;
            }
#pragma unroll
            for (int r = 0; r < 17; ++r) red[(wave * 17 + r) * 64 + lane] = a[r];
            __syncthreads();
            for (int i = tid; i < 17 * 64; i += NTHREADS) {
                const int r = i >> 6, col = i & 63; float s = 0.f;
#pragma unroll
                for (int w8 = 0; w8 < 8; ++w8) s += red[(w8 * 17 + r) * 64 + col];
                W.mod[((size_t)l2 * 17 + r) * MODW + cg * 64 + col] = s + P->in[5][l2 * MODW + cg * 64 + col];
            }
            __syncthreads();
        }
        for (int i = c * NTHREADS + tid; i < 2048 * 16; i += G * NTHREADS) { float cs, sn; rope_cs(i >> 4, i & 15, cs, sn); W.rope[2 * i] = cs; W.rope[2 * i + 1] = sn; }
        if (c == G - 1 && wave == 0) {
            for (int l2 = 0; l2 < 2; ++l2) {
                const float* lv = P->in[10] + l2 * 128;
                float a = lane < 32 ? lv[lane] * lv[32 + lane] : 0.f, b = lane < 32 ? lv[64 + lane] * lv[96 + lane] : 0.f;
                a = wave_sum(a); b = wave_sum(b);
                const float li = 0.8f - 0.6f * expf(-0.3f * (float)l2);
                if (lane == 0) W.lam[l2] = expf(a) - expf(b) + li;
            }
        }
    }
}

struct ProbInProj {
    typedef g8::Unit2 Unit; static constexpr int K = 1024;
    __device__ __forceinline__ void a_ready(const Unit&) const {}
    static constexpr bool HAS_DONE = false;
    __device__ __forceinline__ void done(int) const {}
    __device__ __forceinline__ int done_token(const Unit&) const { return -1; }
    g8::DenseOrder ord; const bf16_t* A; const bf16_t* Bt; bf16_t* PB; const float* rope; float* ssq; float* sskv;
    __device__ __forceinline__ bool next(int i, Unit& u) const { return ord.next(i, u); }
    __device__ __forceinline__ const char* a_base() const { return (const char*)A; }
    __device__ __forceinline__ void a_offsets(const Unit& u, const int (&R)[2], const int (&C)[2], unsigned (&o)[2][2]) const {
#pragma unroll
        for (int h = 0; h < 2; ++h)
#pragma unroll
            for (int i = 0; i < 2; ++i) o[h][i] = (unsigned)((u.pm * 256 + h * 128 + R[i]) * K + C[i]) * 2u;
    }
    __device__ __forceinline__ const char* b_ptr(const Unit& u) const { return (const char*)(Bt + (size_t)u.pn * 256 * K); }
    __device__ __forceinline__ void epilogue(const f32x4 (&acc)[2][2][4][2], const Unit& u, int wr, int wc, int fr, int fq) const {
        const int pn = u.pn; const bool lat = u.pm < NLAT / 256;
        const int g = 2 * wc + (fq >> 1);
        const int rowb = u.pm * 256 + wr * 64 + fr, colb = pn * 256 + 32 * g + 8 * (fq & 1);
        const bool want_ss = pn >= 6;
        const bool rp = lat && (pn == 3 || pn == 4 || (pn == 7 && g == 4));
        const bool ss_on = pn == 6 || (pn == 7 && g < 4);
#pragma unroll
        for (int ai = 0; ai < 2; ++ai)
#pragma unroll
            for (int m = 0; m < 4; ++m) {
                const int row = rowb + ai * 128 + m * 16;
                f32x4 x1[2] = {acc[ai][0][m][0], acc[ai][1][m][0]}, x2[2] = {acc[ai][0][m][1], acc[ai][1][m][1]};
                if (rp) {
                    const f32x4* tb = (const f32x4*)(rope + ((size_t)(row & 2047) * 16 + 8 * (fq & 1)) * 2);
#pragma unroll
                    for (int bj = 0; bj < 2; ++bj) {
                        const f32x4 t0 = tb[2 * bj], t1 = tb[2 * bj + 1];
                        const f32x4 cs = {t0[0], t0[2], t1[0], t1[2]}, sn = {t0[1], t0[3], t1[1], t1[3]};
                        const f32x4 o1 = x1[bj] * cs - x2[bj] * sn, o2 = x1[bj] * sn + x2[bj] * cs;
                        x1[bj] = o1; x2[bj] = o2;
                    }
                }
                u32x4 w1, w2;
                w1.x = pk_bf16(x1[0][0], x1[0][1]); w1.y = pk_bf16(x1[0][2], x1[0][3]); w1.z = pk_bf16(x1[1][0], x1[1][1]); w1.w = pk_bf16(x1[1][2], x1[1][3]);
                w2.x = pk_bf16(x2[0][0], x2[0][1]); w2.y = pk_bf16(x2[0][2], x2[0][3]); w2.z = pk_bf16(x2[1][0], x2[1][1]); w2.w = pk_bf16(x2[1][2], x2[1][3]);
                bf16_t* prow = PB + (size_t)row * PBS + colb;
                *(u32x4*)prow = w1; *(u32x4*)(prow + 16) = w2;
                if (want_ss) {
                    float ss = 0.f;
                    if (ss_on) {
#pragma unroll
                        for (int q = 0; q < 4; ++q) {
                            const float a0 = __uint_as_float(w1[q] << 16), a1 = __uint_as_float(w1[q] & 0xffff0000u), b0 = __uint_as_float(w2[q] << 16), b1 = __uint_as_float(w2[q] & 0xffff0000u);
                            ss += a0 * a0 + a1 * a1 + b0 * b0 + b1 * b1;
                        }
                    }
                    ss += __shfl_xor(ss, 16); ss += __shfl_xor(ss, 32);
                    if (fq == 0) (pn == 6 ? ssq : sskv)[(size_t)row * 4 + wc] = ss;
                }
            }
    }
};
__device__ __forceinline__ void phase_inproj(const int L_, const int CH_, LAS unsigned char* lds) {
    const KP P = kparams();
    const Ws W(P->ws);
    if (pblk<ID_INPROJ>() < 0) return;
    ProbInProj pr; pr.ord.init(NTOK / 256, 8, pgrid<ID_INPROJ>(), pblk<ID_INPROJ>());
    pr.A = W.HB; pr.Bt = W.WB + WB_WIN; pr.PB = W.PB; pr.rope = W.rope; pr.ssq = W.ssq; pr.sskv = W.sskv;
    g8::gemm_phase(lds, pr);
}

struct UnitM { int pm, pn, kv; };
struct ProbMla {
    typedef UnitM Unit; static constexpr int K = 256;
    __device__ __forceinline__ void a_ready(const Unit&) const {}
    static constexpr bool HAS_DONE = false;
    __device__ __forceinline__ void done(int) const {}
    __device__ __forceinline__ int done_token(const Unit&) const { return -1; }
    int nq_units, n_units, G, c;
    const bf16_t* PBp; const bf16_t* Wuq; const bf16_t* Wukv; bf16_t* QM; bf16_t* KVM; const float* rope; const float* ssq; const float* sskv;
    __device__ __forceinline__ bool next(int i, Unit& u) const {
        const int L = i * G + c; if (L >= n_units) return false;
        if (L < nq_units) { u.kv = 0; u.pm = L / 3; u.pn = L % 3; } else { const int r = L - nq_units; u.kv = 1; u.pm = r >> 2; u.pn = r & 3; }
        return true;
    }
    __device__ __forceinline__ const char* a_base() const { return (const char*)PBp; }
    __device__ __forceinline__ void a_offsets(const Unit& u, const int (&R)[2], const int (&C)[2], unsigned (&o)[2][2]) const {
        const int cb = u.kv ? O_CKV : O_CQ;
#pragma unroll
        for (int h = 0; h < 2; ++h)
#pragma unroll
            for (int i = 0; i < 2; ++i) o[h][i] = (unsigned)((u.pm * 256 + h * 128 + R[i]) * PBS + cb + C[i]) * 2u;
    }
    __device__ __forceinline__ const char* b_ptr(const Unit& u) const { return (const char*)((u.kv ? Wukv : Wuq) + (size_t)u.pn * 256 * K); }
    __device__ __forceinline__ void epilogue(const f32x4 (&acc)[2][2][4][2], const Unit& u, int wr, int wc, int fr, int fq) const {
        const bool lat = u.pm < NLAT / 256;
        const int g = 2 * wc + (fq >> 1);
        const int rowb = u.pm * 256 + wr * 64 + fr, colb = u.pn * 256 + 32 * g + 8 * (fq & 1);
        const float* ssp = u.kv ? sskv : ssq; const float inv = u.kv ? (1.f / 128.f) : (1.f / 256.f);
        bf16_t* O = u.kv ? KVM : QM; const int ldo = u.kv ? 1024 : 768;
        const bool rp = !u.kv && lat && ((u.pn * 8 + g) % 3) == 2;
        float rs[2][4];
#pragma unroll
        for (int ai = 0; ai < 2; ++ai)
#pragma unroll
            for (int m = 0; m < 4; ++m) { const f32x4 s4 = *(const f32x4*)(ssp + (size_t)(rowb + ai * 128 + m * 16) * 4); rs[ai][m] = rsqrtf((s4[0] + s4[1] + s4[2] + s4[3]) * inv + 1e-6f); }
#pragma unroll
        for (int ai = 0; ai < 2; ++ai)
#pragma unroll
            for (int m = 0; m < 4; ++m) {
                const int row = rowb + ai * 128 + m * 16;
                const float rstd = rs[ai][m];
                f32x4 x1[2] = {acc[ai][0][m][0] * rstd, acc[ai][1][m][0] * rstd}, x2[2] = {acc[ai][0][m][1] * rstd, acc[ai][1][m][1] * rstd};
                if (rp) {
                    const f32x4* tb = (const f32x4*)(rope + ((size_t)(row & 2047) * 16 + 8 * (fq & 1)) * 2);
#pragma unroll
                    for (int bj = 0; bj < 2; ++bj) {
                        const f32x4 t0 = tb[2 * bj], t1 = tb[2 * bj + 1];
                        const f32x4 cs = {t0[0], t0[2], t1[0], t1[2]}, sn = {t0[1], t0[3], t1[1], t1[3]};
                        const f32x4 o1 = x1[bj] * cs - x2[bj] * sn, o2 = x1[bj] * sn + x2[bj] * cs;
                        x1[bj] = o1; x2[bj] = o2;
                    }
                }
                u32x4 w1, w2;
                w1.x = pk_bf16(x1[0][0], x1[0][1]); w1.y = pk_bf16(x1[0][2], x1[0][3]); w1.z = pk_bf16(x1[1][0], x1[1][1]); w1.w = pk_bf16(x1[1][2], x1[1][3]);
                w2.x = pk_bf16(x2[0][0], x2[0][1]); w2.y = pk_bf16(x2[0][2], x2[0][3]); w2.z = pk_bf16(x2[1][0], x2[1][1]); w2.w = pk_bf16(x2[1][2], x2[1][3]);
                bf16_t* prow = O + (size_t)row * ldo + colb;
                *(u32x4*)prow = w1; *(u32x4*)(prow + 16) = w2;
            }
    }
};
__device__ __forceinline__ void phase_mla(const int L_, const int CH_, LAS unsigned char* lds) {
    const KP P = kparams();
    const Ws W(P->ws);
    const int nq = L_ == 0 ? NTOK : NLAT;
    ProbMla pr; pr.nq_units = (nq / 256) * 3; pr.n_units = pr.nq_units + (NTOK / 256) * 4; pr.G = pgrid<ID_MLA>(); pr.c = pblk<ID_MLA>();
    if (pr.c < 0) return;
    pr.PBp = W.PB; pr.Wuq = W.WB + WB_WUQ; pr.Wukv = W.WB + WB_WUKV; pr.QM = W.QM; pr.KVM = W.KVM; pr.rope = W.rope; pr.ssq = W.ssq; pr.sskv = W.sskv;
    g8::gemm_phase(lds, pr);
}

struct ProbOut {
    typedef g8::Unit2 Unit; static constexpr int K = 1024;
    __device__ __forceinline__ void a_ready(const Unit&) const {}
    static constexpr bool HAS_DONE = false;
    __device__ __forceinline__ void done(int) const {}
    __device__ __forceinline__ int done_token(const Unit&) const { return -1; }
    g8::DenseOrder ord; const bf16_t* A; const bf16_t* Bt; bf16_t* XS; const float* x_in; const float* ctx_in; const float* mod_l; int layer;
    __device__ __forceinline__ bool next(int i, Unit& u) const { return ord.next(i, u); }
    __device__ __forceinline__ const char* a_base() const { return (const char*)A; }
    __device__ __forceinline__ void a_offsets(const Unit& u, const int (&R)[2], const int (&C)[2], unsigned (&o)[2][2]) const {
#pragma unroll
        for (int h = 0; h < 2; ++h)
#pragma unroll
            for (int i = 0; i < 2; ++i) o[h][i] = (unsigned)((u.pm * 256 + h * 128 + R[i]) * K + C[i]) * 2u;
    }
    __device__ __forceinline__ const char* b_ptr(const Unit& u) const { return (const char*)(Bt + (size_t)u.pn * 256 * K); }
    template <int LAYER> __device__ __forceinline__ void res_load(f32x4 (&b)[2][2], int row, int colb) const {
        if (LAYER == 0) {
            const float* xi = (row < NLAT ? x_in + (size_t)row * DM : ctx_in + (size_t)(row - NLAT) * DM) + colb;
#pragma unroll
            for (int bj = 0; bj < 2; ++bj)
#pragma unroll
                for (int n = 0; n < 2; ++n) b[bj][n] = *(const f32x4*)(xi + bj * 128 + n * 16);
        } else {
            const bf16_t* xo = XS + (size_t)row * DM + colb;
#pragma unroll
            for (int bj = 0; bj < 2; ++bj)
#pragma unroll
                for (int n = 0; n < 2; ++n) { const u32x2 w = *(const u32x2*)(xo + bj * 128 + n * 16); b[bj][n] = (f32x4){__uint_as_float(w.x << 16), __uint_as_float(w.x & 0xffff0000u), __uint_as_float(w.y << 16), __uint_as_float(w.y & 0xffff0000u)}; }
        }
    }
    template <int LAYER> __device__ __forceinline__ void epi(const f32x4 (&acc)[2][2][4][2], const Unit& u, int wr, int wc, int fr, int fq) const {
        const int r = u.pm < NLAT / 256 ? (u.pm >> 3) : 16;
        const int rowb = u.pm * 256 + wr * 64 + fr, colb = u.pn * 256 + wc * 32 + 4 * fq;
        const float* gate = mod_l + r * MODW + 2 * DM + colb;
        f32x4 gv[2][2];
#pragma unroll
        for (int bj = 0; bj < 2; ++bj)
#pragma unroll
            for (int n = 0; n < 2; ++n) gv[bj][n] = *(const f32x4*)(gate + bj * 128 + n * 16);
        if (LAYER == 1) {
#pragma unroll
            for (int ai = 0; ai < 2; ++ai) {
                u32x2 raw[4][2][2];
#pragma unroll
                for (int m = 0; m < 4; ++m)
#pragma unroll
                    for (int bj = 0; bj < 2; ++bj)
#pragma unroll
                        for (int n = 0; n < 2; ++n) raw[m][bj][n] = *(const u32x2*)(XS + (size_t)(rowb + ai * 128 + m * 16) * DM + colb + bj * 128 + n * 16);
                __builtin_amdgcn_sched_barrier(0);
#pragma unroll
                for (int m = 0; m < 4; ++m) {
                    bf16_t* xo = XS + (size_t)(rowb + ai * 128 + m * 16) * DM + colb;
#pragma unroll
                    for (int bj = 0; bj < 2; ++bj)
#pragma unroll
                        for (int n = 0; n < 2; ++n) {
                            const u32x2 w = raw[m][bj][n];
                            const f32x4 b = {__uint_as_float(w.x << 16), __uint_as_float(w.x & 0xffff0000u), __uint_as_float(w.y << 16), __uint_as_float(w.y & 0xffff0000u)};
                            const f32x4 o = b + gv[bj][n] * acc[ai][bj][m][n];
                            u32x2 ow; ow.x = pk_bf16(o[0], o[1]); ow.y = pk_bf16(o[2], o[3]);
                            *(u32x2*)(xo + bj * 128 + n * 16) = ow;
                        }
                }
                __builtin_amdgcn_sched_barrier(0);
            }
            return;
        }
        f32x4 bc[2][2], bn[2][2];
        res_load<LAYER>(bc, rowb, colb);
#pragma unroll
        for (int g = 0; g < 8; ++g) {
            const int ai = g >> 2, m = g & 3;
            const int row = rowb + ai * 128 + m * 16;
            if (g + 1 < 8) res_load<LAYER>(bn, rowb + ((g + 1) >> 2) * 128 + ((g + 1) & 3) * 16, colb);
            bf16_t* xo = XS + (size_t)row * DM + colb;
#pragma unroll
            for (int bj = 0; bj < 2; ++bj)
#pragma unroll
                for (int n = 0; n < 2; ++n) {
                    const f32x4 o = bc[bj][n] + gv[bj][n] * acc[ai][bj][m][n];
                    u32x2 ow; ow.x = pk_bf16(o[0], o[1]); ow.y = pk_bf16(o[2], o[3]);
                    *(u32x2*)(xo + bj * 128 + n * 16) = ow;
                }
#pragma unroll
            for (int bj = 0; bj < 2; ++bj)
#pragma unroll
                for (int n = 0; n < 2; ++n) bc[bj][n] = bn[bj][n];
        }
    }
    __device__ __forceinline__ void epilogue(const f32x4 (&acc)[2][2][4][2], const Unit& u, int wr, int wc, int fr, int fq) const {
        if (layer == 0) epi<0>(acc, u, wr, wc, fr, fq); else epi<1>(acc, u, wr, wc, fr, fq);
    }
};
__device__ __forceinline__ void phase_outproj(const int L_, const int CH_, LAS unsigned char* lds) {
    const KP P = kparams();
    const Ws W(P->ws);
    const int nq = L_ == 0 ? NTOK : NLAT;
    if (pblk<ID_OUTPROJ>() < 0) return;
    ProbOut pr; pr.ord.init(nq / 256, 4, pgrid<ID_OUTPROJ>(), pblk<ID_OUTPROJ>());
    pr.A = W.HB; pr.Bt = W.WB + WB_WOUT; pr.XS = W.XS; pr.x_in = P->in[0]; pr.ctx_in = P->in[2]; pr.mod_l = W.mod + (size_t)L_ * 17 * MODW; pr.layer = L_;
    g8::gemm_phase(lds, pr);
}

constexpr int NCHUNK = 2;
constexpr int CAPC = NTOK / NCHUNK;
constexpr size_t WS_LIST2 = WS_PB;
constexpr size_t WS_ACT = WS_PB + 18 * MiB;
constexpr size_t WS_Y = WS_PB + 108 * MiB;
constexpr size_t ACT_BYTES = 90 * MiB;
static_assert(WS_Y + (size_t)CAPC * 9 * 1024 <= WS_WB && (size_t)(CAPC * 9 + 65 * 255 + 256) * 512 <= ACT_BYTES, "MoE overlay fits");
constexpr int CW_CNT = 8192, CNT_STRIDE = 64;
constexpr int CW_RT = 32768;
constexpr size_t CTL_ZERO_BYTES = (size_t)(CW_RT + 2 * NCHUNK * 1024 * 16) * 4;
constexpr float Y_SCALE = 8.f;
constexpr int LDS_TAB = 131072;

typedef float f32x16 __attribute__((ext_vector_type(16)));
template <int CTRL> __device__ __forceinline__ float dppf(float v) { return __int_as_float(__builtin_amdgcn_update_dpp(0, __float_as_int(v), CTRL, 0xf, 0xf, true)); }
template <int CTRL> __device__ __forceinline__ int dppi(int v) { return __builtin_amdgcn_update_dpp(0, v, CTRL, 0xf, 0xf, true); }
__device__ __forceinline__ float gmax8f(float x) { x = fmaxf(x, dppf<0xB1>(x)); x = fmaxf(x, dppf<0x4E>(x)); return fmaxf(x, dppf<0x141>(x)); }
__device__ __forceinline__ int gmin8i(int x) { x = min(x, dppi<0xB1>(x)); x = min(x, dppi<0x4E>(x)); return min(x, dppi<0x141>(x)); }
__device__ __forceinline__ unsigned wmaxu(unsigned x) {
    x = max(x, (unsigned)dppi<0xB1>((int)x)); x = max(x, (unsigned)dppi<0x4E>((int)x)); x = max(x, (unsigned)dppi<0x141>((int)x)); x = max(x, (unsigned)dppi<0x140>((int)x));
    const unsigned a = (unsigned)__builtin_amdgcn_readlane((int)x, 0), b = (unsigned)__builtin_amdgcn_readlane((int)x, 16), c = (unsigned)__builtin_amdgcn_readlane((int)x, 32), d = (unsigned)__builtin_amdgcn_readlane((int)x, 48);
    return max(max(a, b), max(c, d));
}
__device__ __forceinline__ float wsumf(float x) {
    x += dppf<0xB1>(x); x += dppf<0x4E>(x); x += dppf<0x141>(x); x += dppf<0x140>(x);
    const float a = __int_as_float(__builtin_amdgcn_readlane(__float_as_int(x), 0)), b = __int_as_float(__builtin_amdgcn_readlane(__float_as_int(x), 16));
    const float c = __int_as_float(__builtin_amdgcn_readlane(__float_as_int(x), 32)), d = __int_as_float(__builtin_amdgcn_readlane(__float_as_int(x), 48));
    return (a + b) + (c + d);
}
#define N2_BAR() do { asm volatile("s_waitcnt lgkmcnt(0)" ::: "memory"); __builtin_amdgcn_s_barrier(); asm volatile("" ::: "memory"); } while (0)
__device__ __forceinline__ void phase_norm2(const int L_, const int CH_, LAS unsigned char* lds) {
    const KP P = kparams();
    const Ws W(P->ws);
    const int l = L_, tid = tid_opaque(), wave = __builtin_amdgcn_readfirstlane(tid >> 6), lane = tid & 63, G = pgrid<ID_NORM2>(), c = pblk<ID_NORM2>();
    if (c < 0) return;
    const int nq = l == 0 ? NTOK : NLAT, csz = nq / NCHUNK, nunits = nq / 32;
    const float* mod_l = W.mod + (size_t)l * 17 * MODW;
    const float* gn = P->in[7] + l * DM;
    const float* rw = P->in[17] + (size_t)l * DM * NEXP;
    const float* rb = P->in[18] + l * NEXP;
    int* cnt = (int*)(W.ctl + CW_CNT) + L_ * NCHUNK * 64 * CNT_STRIDE;
    uint2* list = (uint2*)(P->ws + WS_LIST2);
    constexpr int AST = 1028;
    LAS float* At = (LAS float*)lds;
    constexpr int NRES = 48;
    float Br[NRES][2];
    const float* rwl = rw + (size_t)(128 * wave + 4 * (lane >> 5)) * NEXP + (lane & 31);
#pragma unroll
    for (int p = 0; p < NRES; ++p)
#pragma unroll
        for (int n = 0; n < 2; ++n) Br[p][n] = rwl[(8 * (p >> 2) + (p & 3)) * NEXP + n * 32];
    const float rbe = rb[lane];
    u32x2 nx[4][4];
    int u = c;
    if (u < nunits) {
#pragma unroll
        for (int j = 0; j < 4; ++j)
#pragma unroll
            for (int q = 0; q < 4; ++q) nx[j][q] = *(const u32x2*)(W.XS + (size_t)(u * 32 + wave * 4 + j) * DM + 256 * q + lane * 4);
    }
    for (; u < nunits; u += G) {
        const int t0 = u * 32, r = mod_row(t0);
        {
            const float* sh = mod_l + r * MODW + 3 * DM; const float* sc = mod_l + r * MODW + 4 * DM;
            float rstd[4];
#pragma unroll
            for (int j = 0; j < 4; ++j) {
                float ss = 0.f;
#pragma unroll
                for (int q = 0; q < 4; ++q) { const u32x2 w = nx[j][q];
                    const float a0 = __uint_as_float(w.x << 16), a1 = __uint_as_float(w.x & 0xffff0000u), a2 = __uint_as_float(w.y << 16), a3 = __uint_as_float(w.y & 0xffff0000u); ss += a0 * a0 + a1 * a1 + a2 * a2 + a3 * a3; }
                rstd[j] = rsqrtf(wsumf(ss) * (1.f / DM) + 1e-6f);
            }
#pragma unroll
            for (int q = 0; q < 4; ++q) {
                const int col = 256 * q + lane * 4;
                __builtin_amdgcn_sched_barrier(0);
                const f32x4 ga = *(const f32x4*)(gn + col) * (*(const f32x4*)(sc + col) + 1.f), hb = *(const f32x4*)(sh + col);
#pragma unroll
                for (int j = 0; j < 4; ++j) {
                    const int tl = wave * 4 + j, t = t0 + tl;
                    const u32x2 w = nx[j][q];
                    const f32x4 v = {__uint_as_float(w.x << 16), __uint_as_float(w.x & 0xffff0000u), __uint_as_float(w.y << 16), __uint_as_float(w.y & 0xffff0000u)};
                    const f32x4 o = v * rstd[j] * ga + hb;
                    u32x2 ow; ow.x = pk_bf16(o[0], o[1]); ow.y = pk_bf16(o[2], o[3]);
                    *(u32x2*)(W.HB + (size_t)t * DM + col) = ow;
                    *(LAS f32x4*)(At + tl * AST + col) = o;
                }
            }
        }
        if (u + G < nunits) {
#pragma unroll
            for (int j = 0; j < 4; ++j)
#pragma unroll
                for (int q = 0; q < 4; ++q) nx[j][q] = *(const u32x2*)(W.XS + (size_t)((u + G) * 32 + wave * 4 + j) * DM + 256 * q + lane * 4);
        }
        float Bs[64 - NRES][2];
        {
            const float* rws = rwl; asm volatile("" : "+v"(rws));
#pragma unroll
            for (int p = NRES; p < 64; ++p)
#pragma unroll
                for (int n = 0; n < 2; ++n) Bs[p - NRES][n] = rws[(8 * (p >> 2) + (p & 3)) * NEXP + n * 32];
        }
        N2_BAR();
        f32x16 acc0, acc1;
#pragma unroll
        for (int i = 0; i < 16; ++i) { acc0[i] = 0.f; acc1[i] = 0.f; }
        const LAS float* arow = At + (lane & 31) * AST + 128 * wave + 4 * (lane >> 5);
#pragma unroll
        for (int i = 0; i < 16; ++i) {
            const f32x4 a4 = *(const LAS f32x4*)(arow + 8 * i);
#pragma unroll
            for (int s = 0; s < 4; ++s) {
                const int p = 4 * i + s;
                acc0 = __builtin_amdgcn_mfma_f32_32x32x2f32(a4[s], p < NRES ? Br[p < NRES ? p : 0][0] : Bs[p < NRES ? 0 : p - NRES][0], acc0, 0, 0, 0);
                acc1 = __builtin_amdgcn_mfma_f32_32x32x2f32(a4[s], p < NRES ? Br[p < NRES ? p : 0][1] : Bs[p < NRES ? 0 : p - NRES][1], acc1, 0, 0, 0);
            }
        }
        N2_BAR();
        LAS float* part = At;
#pragma unroll
        for (int i = 0; i < 16; ++i) {
            const int tok = (i & 3) + 8 * (i >> 2) + 4 * (lane >> 5);
            part[(wave * 32 + tok) * 64 + (lane & 31)] = acc0[i];
            part[(wave * 32 + tok) * 64 + 32 + (lane & 31)] = acc1[i];
        }
        N2_BAR();
        int slot_[4]; float w_[4]; int rk_[4];
#pragma unroll
        for (int j = 0; j < 4; ++j) {
            const int tl = wave * 4 + j, t = t0 + tl, e = lane;
            float lg = 0.f;
#pragma unroll
            for (int w8 = 0; w8 < 8; ++w8) lg += part[(w8 * 32 + tl) * 64 + e];
            const float sc = __builtin_amdgcn_rcpf(1.f + __expf(-lg));
            const float sel = sc + rbe;
            const float m1 = gmax8f(sel);
            const int cand = gmin8i((sel == m1) ? (e & 7) : 8);
            const float m2 = gmax8f(((e & 7) == cand) ? -INFINITY : sel);
            const float grp = m1 + m2;
            const int g = e >> 3;
            int grank = 0;
#pragma unroll
            for (int gg = 0; gg < 8; ++gg) { const float og = __int_as_float(__builtin_amdgcn_readlane(__float_as_int(grp), gg * 8)); grank += (og > grp || (og == grp && gg < g)) ? 1 : 0; }
            const bool gsel = grank < 4;
            const unsigned sb = __float_as_uint(sel);
            unsigned key = gsel ? (sb ^ ((sb >> 31) ? 0xffffffffu : 0x80000000u)) : 0u;
            int rk = 8;
#pragma unroll
            for (int k = 0; k < 8; ++k) {
                const unsigned M = wmaxu(key);
                const unsigned long long bal = __ballot(key == M);
                const int idx = __builtin_ctzll(bal);
                if (e == idx) { rk = k; key = 0u; }
            }
            const bool chosen = rk < 8;
            const float wsum = wsumf(chosen ? sc : 0.f);
            w_[j] = sc / wsum * 2.5f; rk_[j] = rk; slot_[j] = 0;
            if (chosen) slot_[j] = atomicAdd(&cnt[((t / csz) * 64 + e) * CNT_STRIDE], 1);
        }
#pragma unroll
        for (int j = 0; j < 4; ++j) {
            const int t = t0 + wave * 4 + j;
            if (rk_[j] < 8) list[((size_t)(t / csz) * 64 + lane) * CAPC + slot_[j]] = make_uint2((unsigned)(t * 8 + rk_[j]), __float_as_uint(w_[j]));
        }
        N2_BAR();
    }
}
#undef N2_BAR

struct UnitG { int e, t, pn, cnt, pb; };
struct MoeTab {
    const LAS int* cnts; const LAS int* pre;
    const LAS int* xpre; int ntiles, xl, x, nb, j, nseg, st0, xtiles;
    __device__ __forceinline__ void locate(int rtl, int& e, int& t) const {
        int sg = 0; while (xpre[sg + 1] <= rtl) ++sg;
        t = rtl - xpre[sg];
        if (sg < nseg - 1) e = x + xl * sg; else { e = 64; t += st0; }
    }
};
__device__ __forceinline__ MoeTab moe_table(const KP P, const int L_, LAS unsigned char* lds, int ch, int csz) {
    const Ws W(P->ws);
    LAS int* cnts = (LAS int*)(lds + LDS_TAB); LAS int* pre = cnts + 80; LAS int* xpre = pre + 80;
    const int tid = tid_opaque();
    const int G = pgrid<ID_MOE>(), c = pblk<ID_MOE>();
    MoeTab T; T.cnts = cnts; T.pre = pre; T.xpre = xpre;
    if ((G & 7) == 0) { T.xl = 8; T.x = c & 7; T.nb = G >> 3; T.j = c >> 3; } else { T.xl = 1; T.x = 0; T.nb = G; T.j = c; }
    T.nseg = 64 / T.xl + 1;
    if (tid < 64) cnts[tid] = (int)__hip_atomic_load(W.ctl + CW_CNT + ((L_ * NCHUNK + ch) * 64 + tid) * CNT_STRIDE, __ATOMIC_RELAXED, __HIP_MEMORY_SCOPE_AGENT);
    if (tid == 64) cnts[64] = csz;
    __syncthreads();
    const int stiles = (csz + 255) >> 8, sper = (stiles + T.xl - 1) / T.xl;
    T.st0 = T.x * sper;
    if (tid == 0) {
        int s = 0; for (int e = 0; e < 65; ++e) { pre[e] = s; s += (cnts[e] + 255) >> 8; } pre[65] = s;
        int q = 0;
        for (int sg = 0; sg < T.nseg - 1; ++sg) { xpre[sg] = q; q += (cnts[T.x + T.xl * sg] + 255) >> 8; }
        xpre[T.nseg - 1] = q; { int n = stiles - T.st0; n = n < 0 ? 0 : (n > sper ? sper : n); q += n; }
        xpre[T.nseg] = q;
    }
    __syncthreads();
    T.ntiles = pre[65]; T.xtiles = xpre[T.nseg];
    return T;
}
struct ProbMoe1 {
    typedef UnitG Unit; static constexpr int K = 1024;
    int G, c, chunk_base; MoeTab T;
    const uint2* list; const bf16_t* HB; const bf16_t* Wgu; __amdgpu_buffer_rsrc_t act_rs; unsigned* rtcnt;
    __device__ __forceinline__ bool next(int i, Unit& u) const {
        const int L = i * T.nb + T.j; if (L >= 2 * T.xtiles) return false;
        u.pn = L & 1;
        int e, t; T.locate(L >> 1, e, t);
        e = __builtin_amdgcn_readfirstlane(e); t = __builtin_amdgcn_readfirstlane(t);
        u.e = e; u.t = t; u.cnt = __builtin_amdgcn_readfirstlane(T.cnts[e]); u.pb = __builtin_amdgcn_readfirstlane((T.pre[e] + t) * 256); return true;
    }
    __device__ __forceinline__ void a_ready(const Unit&) const {}
    static constexpr bool HAS_DONE = true;
    __device__ __forceinline__ int done_token(const Unit& u) const { return __builtin_amdgcn_readfirstlane(u.pb >> 8); }
    __device__ __forceinline__ void done(int rt) const {
        if ((threadIdx.x & 63) == 0) (void)__hip_atomic_fetch_add(rtcnt + 16 * rt, 1u, __ATOMIC_RELAXED, __HIP_MEMORY_SCOPE_AGENT);
    }
    __device__ __forceinline__ const char* a_base() const { return (const char*)HB; }
    __device__ __forceinline__ void a_offsets(const Unit& u, const int (&R)[2], const int (&C)[2], unsigned (&o)[2][2]) const {
#pragma unroll
        for (int h = 0; h < 2; ++h)
#pragma unroll
            for (int i = 0; i < 2; ++i) {
                const int slot = u.t * 256 + h * 128 + R[i]; int tok = 0;
                if (slot < u.cnt) tok = u.e < 64 ? (int)(list[(size_t)u.e * CAPC + slot].x >> 3) : chunk_base + slot;
                o[h][i] = (unsigned)tok * 2048u + (unsigned)C[i] * 2u;
            }
    }
    __device__ __forceinline__ const char* b_ptr(const Unit& u) const { return (const char*)(Wgu + (size_t)u.e * 524288 + (size_t)u.pn * 256 * K); }
    __device__ __forceinline__ void epilogue(const f32x4 (&acc)[2][2][4][2], const Unit& u, int wr, int wc, int fr, int fq) const {
        float wv[2][4];
#pragma unroll
        for (int ai = 0; ai < 2; ++ai)
#pragma unroll
            for (int m = 0; m < 4; ++m) {
                const int slot = u.t * 256 + ai * 128 + wr * 64 + m * 16 + fr;
                wv[ai][m] = 0.f;
                if (slot < u.cnt) wv[ai][m] = u.e < 64 ? __uint_as_float(list[(size_t)u.e * CAPC + slot].y) : 1.f;
            }
#pragma unroll
        for (int ai = 0; ai < 2; ++ai)
#pragma unroll
            for (int m = 0; m < 4; ++m) {
                const int rl = ai * 128 + wr * 64 + m * 16 + fr;
                const float w = wv[ai][m];
                float a[8];
#pragma unroll
                for (int bj = 0; bj < 2; ++bj) {
                    const f32x4 g = acc[ai][bj][m][0], up = acc[ai][bj][m][1];
#pragma unroll
                    for (int j = 0; j < 4; ++j) a[4 * bj + j] = g[j] * __builtin_amdgcn_rcpf(1.f + __expf(-g[j])) * up[j] * w;
                }
                u32x4 o; o.x = pk_bf16(a[0], a[1]); o.y = pk_bf16(a[2], a[3]); o.z = pk_bf16(a[4], a[5]); o.w = pk_bf16(a[6], a[7]);
                __builtin_amdgcn_raw_buffer_store_b128(o, act_rs, (int)(((unsigned)(u.pb + rl) * 256u + 128u * u.pn + 32u * wc + 8u * fq) * 2u), 0, 16);
            }
    }
};
struct MoeDown {
    int G, c, chunk_base, shift; MoeTab T;
    const uint2* list; const bf16_t* act; const bf16_t* Wd; unsigned char* ws; unsigned junk; unsigned* rtcnt; unsigned* tmo;
};
__device__ __forceinline__ void moe_down_phase(LAS unsigned char* lds, const MoeDown& D) {
    const int tid = tid_opaque(), wave = __builtin_amdgcn_readfirstlane(tid >> 6), lane = tid & 63, fr = lane & 15, fq = lane >> 4;
    const int jblk = (D.T.j - D.shift + D.T.nb) % D.T.nb;
    unsigned goff[4];
#pragma unroll
    for (int i = 0; i < 4; ++i) { const int row = 2 * (4 * wave + i) + (lane >> 5), p = lane & 31; goff[i] = (unsigned)(row * 256 + ((p ^ (row & 15)) * 8)) * 2u; }
    const unsigned ldsw = (unsigned)wave * 4096u;
    for (int rtl = jblk; rtl < D.T.xtiles; rtl += D.T.nb) {
        int e, t_in; D.T.locate(rtl, e, t_in);
        e = __builtin_amdgcn_readfirstlane(e); t_in = __builtin_amdgcn_readfirstlane(t_in);
        const int rt = __builtin_amdgcn_readfirstlane(D.T.pre[e] + t_in), cnt = __builtin_amdgcn_readfirstlane(D.T.cnts[e]), pb = rt * 256;
        if (tid < 64) {
            unsigned* w = D.rtcnt + 16 * rt; unsigned sp = 0u;
            while ((unsigned)__builtin_amdgcn_readfirstlane(__hip_atomic_load(w, __ATOMIC_RELAXED, __HIP_MEMORY_SCOPE_AGENT)) < 16u) {
                __builtin_amdgcn_s_sleep(2);
                if ((++sp & 255u) == 0u) { if (__hip_atomic_load(D.tmo, __ATOMIC_RELAXED, __HIP_MEMORY_SCOPE_AGENT)) break; if (sp > (1u << 20)) { atomicAdd(D.tmo, 1u); break; } }
            }
            __builtin_amdgcn_fence(__ATOMIC_ACQUIRE, "agent");
            asm volatile("s_waitcnt vmcnt(0)" ::: "memory");
        }
        __syncthreads();
        bf16x8 af[2][8];
#pragma unroll
        for (int m = 0; m < 2; ++m)
#pragma unroll
            for (int ks = 0; ks < 8; ++ks) af[m][ks] = *(const bf16x8*)(D.act + (size_t)(pb + 32 * wave + 16 * m + fr) * 256 + 32 * ks + 8 * fq);
        unsigned yo[2];
#pragma unroll
        for (int m = 0; m < 2; ++m) {
            const int slot = t_in * 256 + 32 * wave + 16 * m + fr;
            yo[m] = D.junk;
            if (slot < cnt) {
                if (e < 64) { const unsigned x = D.list[(size_t)e * CAPC + slot].x; yo[m] = (unsigned)WS_Y + (unsigned)(((int)(x >> 3) - D.chunk_base) * 9 + (int)(x & 7u)) * 1024u; }
                else yo[m] = (unsigned)WS_Y + (unsigned)(slot * 9 + 8) * 1024u;
            }
        }
        const char* wb = (const char*)(D.Wd + (size_t)e * 262144);
#define MD_ISSUE(ch) do { _Pragma("unroll") for (int i = 0; i < 4; ++i) \
        __builtin_amdgcn_global_load_lds((const unsigned*)(wb + (size_t)(ch) * 32768 + goff[i]), (LAS unsigned*)(lds + ((ch) & 3) * 32768 + ldsw + i * 1024), 16, 0, 0); } while (0)
        MD_ISSUE(0); MD_ISSUE(1); MD_ISSUE(2);
#pragma unroll 1
        for (int ch = 0; ch < 16; ++ch) {
            if (ch >= 3 && ch < 14) asm volatile("s_waitcnt vmcnt(14)" ::: "memory");
            else if (ch < 3) asm volatile("s_waitcnt vmcnt(8)" ::: "memory");
            else asm volatile("s_waitcnt vmcnt(6)" ::: "memory");
            __builtin_amdgcn_s_barrier();
            asm volatile("" ::: "memory");
            if (ch + 3 < 16) MD_ISSUE(ch + 3);
            f32x4 acc[2][4];
#pragma unroll
            for (int m = 0; m < 2; ++m)
#pragma unroll
                for (int n = 0; n < 4; ++n) acc[m][n] = (f32x4){0.f, 0.f, 0.f, 0.f};
            const LAS unsigned char* bb = lds + (ch & 3) * 32768 + fr * 512;
            bf16x8 bq[3][4];
#pragma unroll
            for (int n = 0; n < 4; ++n) { bq[0][n] = *(const LAS bf16x8*)(bb + n * 8192 + ((fq ^ fr) * 16)); bq[1][n] = *(const LAS bf16x8*)(bb + n * 8192 + (((4 + fq) ^ fr) * 16)); }
#pragma unroll
            for (int ks = 0; ks < 8; ++ks) {
                __builtin_amdgcn_s_waitcnt(0xC07F);
                if (ks + 2 < 8) {
#pragma unroll
                    for (int n = 0; n < 4; ++n) bq[(ks + 2) % 3][n] = *(const LAS bf16x8*)(bb + n * 8192 + (((4 * (ks + 2) + fq) ^ fr) * 16));
                }
                __builtin_amdgcn_sched_barrier(0);
#pragma unroll
                for (int n = 0; n < 4; ++n) {
                    acc[0][n] = __builtin_amdgcn_mfma_f32_16x16x32_bf16(bq[ks % 3][n], af[0][ks], acc[0][n], 0, 0, 0);
                    acc[1][n] = __builtin_amdgcn_mfma_f32_16x16x32_bf16(bq[ks % 3][n], af[1][ks], acc[1][n], 0, 0, 0);
                }
                __builtin_amdgcn_sched_barrier(0);
            }
            asm volatile("s_waitcnt lgkmcnt(0)" ::: "memory");
#pragma unroll
            for (int m = 0; m < 2; ++m) {
                {
                    u32x4 o; int w;
#pragma unroll
                    for (int n = 0; n < 4; ++n) {
                        f32x4 v = acc[m][n] * Y_SCALE;
#pragma unroll
                        for (int q = 0; q < 4; ++q) v[q] = __builtin_amdgcn_fmed3f(v[q], -440.f, 440.f);
                        w = __builtin_amdgcn_cvt_pk_fp8_f32(v[0], v[1], 0, false); w = __builtin_amdgcn_cvt_pk_fp8_f32(v[2], v[3], w, true); o[n] = (unsigned)w;
                    }
                    *(u32x4*)(D.ws + yo[m] + 64 * ch + 16 * fq) = o;
                }
            }
        }
        asm volatile("s_waitcnt vmcnt(0)" ::: "memory");
        __syncthreads();
#undef MD_ISSUE
    }
}
__device__ __forceinline__ void phase_moe(const int L_, const int CH_, LAS unsigned char* lds) {
    const KP P = kparams();
    const Ws W(P->ws);
    const int nq = L_ == 0 ? NTOK : NLAT, csz = nq / NCHUNK, ch = CH_;
    unsigned* rtcnt = W.ctl + CW_RT + (size_t)(L_ * NCHUNK + ch) * 1024 * 16;
    if (pblk<ID_MOE>() < 0) return;
    const MoeTab T = moe_table(P, L_, lds, ch, csz);
    {
        ProbMoe1 pr; pr.G = pgrid<ID_MOE>(); pr.c = pblk<ID_MOE>(); pr.chunk_base = ch * csz; pr.T = T;
        pr.list = (const uint2*)(P->ws + WS_LIST2) + (size_t)ch * 64 * CAPC; pr.HB = W.HB; pr.Wgu = W.WB + WB_WGU;
        pr.act_rs = __builtin_amdgcn_make_buffer_rsrc((void*)(P->ws + WS_ACT), 0, (int)ACT_BYTES, 0x00020000); pr.rtcnt = rtcnt;
        g8::gemm_phase(lds, pr);
    }
    {
        MoeDown D; D.G = pgrid<ID_MOE>(); D.c = pblk<ID_MOE>(); D.chunk_base = ch * csz; D.shift = (2 * T.xtiles) % T.nb; D.T = T;
        D.list = (const uint2*)(P->ws + WS_LIST2) + (size_t)ch * 64 * CAPC; D.act = (const bf16_t*)(P->ws + WS_ACT); D.Wd = W.WB + WB_WD;
        D.ws = P->ws; D.junk = (unsigned)WS_JUNK + (unsigned)pblk<ID_MOE>() * 1024u; D.rtcnt = rtcnt; D.tmo = W.ctl + 128;
        moe_down_phase(lds, D);
    }
}
__device__ __forceinline__ void phase_comb(const int L_, const int CH_, LAS unsigned char* lds) {
    const KP P = kparams();
    const Ws W(P->ws);
    const int nq = L_ == 0 ? NTOK : NLAT, csz = nq / NCHUNK, ch = CH_, base = ch * csz;
    const int tid = tid_opaque(), wave = tid >> 6, lane = tid & 63;
    const float* mod_l = W.mod + (size_t)L_ * 17 * MODW;
    const float* mod_n = W.mod + (size_t)17 * MODW;
    const float* gn1 = P->in[6] + DM;
    const float* fg = P->in[25];
    const unsigned char* Y = (const unsigned char*)(P->ws + WS_Y);
    const int col = lane * 16;
    if (pblk<ID_COMB>() < 0) return;
    f32x4 gfix[4];
#pragma unroll
    for (int q = 0; q < 4; ++q) gfix[q] = *(const f32x4*)((L_ == 0 ? gn1 : fg) + col + 4 * q);
    for (int tl = pblk<ID_COMB>() * 8 + wave; tl < csz; tl += pgrid<ID_COMB>() * 8) {
        const int t = base + tl, r = mod_row(t);
        const float* g2 = mod_l + r * MODW + 5 * DM + col;
        bf16_t* xr = W.XS + (size_t)t * DM + col;
        f32x4 s4v[4], h4v[4];
        if (L_ == 0) {
            const float* sh = mod_n + r * MODW + col; const float* sc = mod_n + r * MODW + DM + col;
#pragma unroll
            for (int q = 0; q < 4; ++q) { s4v[q] = *(const f32x4*)(sc + 4 * q); h4v[q] = *(const f32x4*)(sh + 4 * q); }
        }
        float s[16];
#pragma unroll
        for (int i = 0; i < 16; ++i) s[i] = 0.f;
#pragma unroll
        for (int k = 0; k < 9; ++k) {
            const u32x4 v = *(const u32x4*)(Y + ((size_t)tl * 9 + k) * 1024 + col);
            const unsigned wv[4] = {v.x, v.y, v.z, v.w};
#pragma unroll
            for (int q = 0; q < 4; ++q) {
                const f32x2 lo = __builtin_amdgcn_cvt_pk_f32_fp8((int)wv[q], false), hi = __builtin_amdgcn_cvt_pk_f32_fp8((int)wv[q], true);
                s[4 * q] += lo[0]; s[4 * q + 1] += lo[1]; s[4 * q + 2] += hi[0]; s[4 * q + 3] += hi[1];
            }
        }
        f32x4 xn[4]; float ss = 0.f;
        const u32x4 xw0 = *(const u32x4*)xr, xw1 = *(const u32x4*)(xr + 8);
        const unsigned xw[8] = {xw0.x, xw0.y, xw0.z, xw0.w, xw1.x, xw1.y, xw1.z, xw1.w};
        u32x4 xo[2];
#pragma unroll
        for (int q = 0; q < 4; ++q) {
            const f32x4 x = {__uint_as_float(xw[2 * q] << 16), __uint_as_float(xw[2 * q] & 0xffff0000u), __uint_as_float(xw[2 * q + 1] << 16), __uint_as_float(xw[2 * q + 1] & 0xffff0000u)};
            const f32x4 g = *(const f32x4*)(g2 + 4 * q);
            const f32x4 sv = {s[4 * q], s[4 * q + 1], s[4 * q + 2], s[4 * q + 3]};
            xn[q] = x + g * sv * (1.f / Y_SCALE);
            ss += xn[q][0] * xn[q][0] + xn[q][1] * xn[q][1] + xn[q][2] * xn[q][2] + xn[q][3] * xn[q][3];
            xo[q >> 1][2 * (q & 1)] = pk_bf16(xn[q][0], xn[q][1]); xo[q >> 1][2 * (q & 1) + 1] = pk_bf16(xn[q][2], xn[q][3]);
        }
        if (L_ == 0) { *(u32x4*)xr = xo[0]; *(u32x4*)(xr + 8) = xo[1]; }
        ss = wave_sum(ss);
        const float rstd = rsqrtf(ss * (1.f / DM) + 1e-6f);
        if (L_ == 0) {
            u32x4 o[2];
#pragma unroll
            for (int q = 0; q < 4; ++q) {
                const f32x4 g4 = gfix[q], s4 = s4v[q], h4 = h4v[q];
                const f32x4 ov = xn[q] * rstd * g4 * (s4 + 1.f) + h4;
                o[q >> 1][2 * (q & 1)] = pk_bf16(ov[0], ov[1]); o[q >> 1][2 * (q & 1) + 1] = pk_bf16(ov[2], ov[3]);
            }
            *(u32x4*)(W.HB + (size_t)t * DM + col) = o[0]; *(u32x4*)(W.HB + (size_t)t * DM + col + 8) = o[1];
        } else {
#pragma unroll
            for (int q = 0; q < 4; ++q) {
                *(f32x4*)(P->out + (size_t)t * DM + col + 4 * q) = xn[q] * rstd * gfix[q];
            }
        }
    }
}

__device__ __forceinline__ void phase_norm1(const int L_, const int CH_, LAS unsigned char* lds) {
    const KP P = kparams();
    const Ws W(P->ws);
    const int l = L_, tid = tid_opaque(), wave = tid >> 6, lane = tid & 63;
    const float* mod_l = W.mod + (size_t)l * 17 * MODW;
    const float* gn = P->in[6] + l * DM;
    if (pblk<ID_NORM1>() < 0) return;
    for (int t = pblk<ID_NORM1>() * 8 + wave; t < NTOK; t += pgrid<ID_NORM1>() * 8) {
        const int r = mod_row(t);
        const float* xr = t < NLAT ? P->in[0] + (size_t)t * DM : P->in[2] + (size_t)(t - NLAT) * DM;
        const float* sh = mod_l + r * MODW; const float* sc = mod_l + r * MODW + DM;
        f32x4 v[4]; float ss = 0.f;
#pragma unroll
        for (int q = 0; q < 4; ++q) { v[q] = *(const f32x4*)(xr + 256 * q + lane * 4); ss += v[q][0] * v[q][0] + v[q][1] * v[q][1] + v[q][2] * v[q][2] + v[q][3] * v[q][3]; }
        ss = wave_sum(ss);
        const float rstd = rsqrtf(ss * (1.f / DM) + 1e-6f);
#pragma unroll
        for (int q = 0; q < 4; ++q) {
            const int col = 256 * q + lane * 4;
            const f32x4 g4 = *(const f32x4*)(gn + col), s4 = *(const f32x4*)(sc + col), h4 = *(const f32x4*)(sh + col);
            const f32x4 o = v[q] * rstd * g4 * (s4 + 1.f) + h4;
            u32x2 w; w.x = pk_bf16(o[0], o[1]); w.y = pk_bf16(o[2], o[3]);
            *(u32x2*)(W.HB + (size_t)t * DM + col) = w;
        }
    }
}

typedef short v4i16_t __attribute__((ext_vector_type(4)));
__device__ __forceinline__ bf16x8 pack8(float a0, float a1, float a2, float a3, float a4, float a5, float a6, float a7) {
    u32x4 w; w.x = pk_bf16(a0, a1); w.y = pk_bf16(a2, a3); w.z = pk_bf16(a4, a5); w.w = pk_bf16(a6, a7); return __builtin_bit_cast(bf16x8, w);
}
__device__ __forceinline__ float max3f_w(float a, float b, float c) { float r; asm volatile("s_nop 7\n\ts_nop 7\n\ts_nop 3\n\tv_max3_f32 %0, %1, %2, %3" : "=v"(r) : "v"(a), "v"(b), "v"(c)); return r; }
__device__ __forceinline__ float max3f(float a, float b, float c) { float r; asm volatile("v_max3_f32 %0, %1, %2, %3" : "=v"(r) : "v"(a), "v"(b), "v"(c)); return r; }
__device__ __forceinline__ float max32(const f32x16& a, const f32x16& b) {
    float m0 = max3f_w(a[0], a[1], a[2]);
    float m1 = max3f_w(b[0], b[1], b[2]);
    m0 = max3f(m0, a[3], a[4]); m1 = max3f(m1, b[3], b[4]); m0 = max3f(m0, a[5], a[6]); m1 = max3f(m1, b[5], b[6]);
    m0 = max3f(m0, a[7], a[8]); m1 = max3f(m1, b[7], b[8]); m0 = max3f(m0, a[9], a[10]); m1 = max3f(m1, b[9], b[10]);
    m0 = max3f(m0, a[11], a[12]); m1 = max3f(m1, b[11], b[12]); m0 = max3f(m0, a[13], a[14]); m1 = max3f(m1, b[13], b[14]);
    return max3f(m0, m1, fmaxf(a[15], b[15]));
}
__device__ __forceinline__ bf16x8 scale8(bf16x8 v, float c) {
    u32x4 w = __builtin_bit_cast(u32x4, v);
#pragma unroll
    for (int i = 0; i < 4; ++i) w[i] = pk_bf16(__uint_as_float(w[i] << 16) * c, __uint_as_float(w[i] & 0xffff0000u) * c);
    return __builtin_bit_cast(bf16x8, w);
}
constexpr int AT_KBUF = 64 * 208, AT_STAGE = AT_KBUF + 8192, AT_BT = 3 * AT_STAGE;
template <int MODE>
__device__ __forceinline__ void attn_unit(const KP P, const int L_, const Ws& W, LAS unsigned char* lds, const int b, const int h, const int qb, const bool ctxq) {
    constexpr int NST = MODE == 2 ? 6 : (MODE == 1 ? 2 : 4);
    constexpr int NMAP = MODE == 1 ? 2 : 1;
    constexpr int KSTR = MODE == 2 ? 208 : 144;
    constexpr float CS = MODE == 2 ? 0.14724444602590306f : (MODE == 1 ? 0.25503486164919736f : 0.18033688011112042f);
    constexpr float NEG = -1e30f;
    const int tid = tid_opaque(), wave = __builtin_amdgcn_readfirstlane(tid >> 6), lane = tid & 63, r32 = lane & 31, hh = lane >> 5;
    const int l = L_;
    const int t0 = ctxq ? NLAT + b * CTX : b * SEQ + qb * 256;
    const int tq = t0 + wave * 32 + r32;
    bf16x8 qf[NMAP][NST];
    {
        const bf16_t* src = MODE == 2 ? W.QM + (size_t)tq * 768 + h * 96 : W.PB + (size_t)tq * PBS + (MODE == 1 ? O_DQ : O_NAQ) + h * 64;
#pragma unroll
        for (int mp = 0; mp < NMAP; ++mp)
#pragma unroll
            for (int st = 0; st < NST; ++st) qf[mp][st] = scale8(*(const bf16x8*)(src + 32 * mp + 16 * st + 8 * hh), CS);
    }
    int ntiles = 36, nwin = 0, krs = 0;
    if (ctxq) ntiles = 4;
    else if (MODE == 0) { krs = min(max(4 * qb - 4, 0), 24); nwin = min(max(4 * qb - 1, 0), 24) + 8 - krs; ntiles = nwin + 4; }
    LAS float* btab = (LAS float*)(lds + AT_BT);
    if (MODE == 0 && !ctxq) { const float* rbp = P->in[9] + ((size_t)l * 4 + h) * 465; for (int i = tid; i < 465; i += NTHREADS) btab[i] = 1.4426950408889634f * rbp[i]; }
    const int kkey = tid >> 3, kch = tid & 7;
    const unsigned kw_off = (unsigned)(kkey * KSTR + kch * 16);
    const unsigned rw_off = (unsigned)((tid >> 2) * KSTR + 128 + (tid & 3) * 16);
    const unsigned vw_off = (unsigned)(AT_KBUF + ((kkey >> 2) * 2 + (kch >> 2)) * 256 + (kkey & 3) * 64 + (kch & 3) * 16);
    u32x4 kregA, vregA, rregA = {0u, 0u, 0u, 0u}, kregB, vregB, rregB = {0u, 0u, 0u, 0u};
#define AT_ROW0(i) (ctxq ? NLAT + b * CTX + 64 * (i) : (MODE == 0 ? ((i) < nwin ? b * SEQ + 64 * (krs + (i)) : NLAT + b * CTX + 64 * ((i) - nwin)) : ((i) < 32 ? b * SEQ + 64 * (i) : NLAT + b * CTX + 64 * ((i) - 32))))
#define AT_LOAD(i, X) do { const int row0_ = AT_ROW0(i); \
        if (MODE == 2) { const bf16_t* kp_ = W.KVM + (size_t)(row0_ + kkey) * 1024 + h * 128 + 8 * kch; kreg##X = *(const u32x4*)kp_; vreg##X = *(const u32x4*)(kp_ + 64); \
                         if (tid < 256) rreg##X = *(const u32x4*)(W.PB + (size_t)(row0_ + (tid >> 2)) * PBS + O_KR + 8 * (tid & 3)); } \
        else { const bf16_t* kp_ = W.PB + (size_t)(row0_ + kkey) * PBS + h * 64 + 8 * kch; kreg##X = *(const u32x4*)(kp_ + (MODE == 1 ? O_DK : O_NAK)); vreg##X = *(const u32x4*)(kp_ + (MODE == 1 ? O_DV : O_NAV)); } } while (0)
#define AT_WRITE(buf, X) do { LAS unsigned char* sb_ = lds + (buf) * AT_STAGE; *(LAS u32x4*)(sb_ + kw_off) = kreg##X; *(LAS u32x4*)(sb_ + vw_off) = vreg##X; \
        if (MODE == 2 && tid < 256) *(LAS u32x4*)(sb_ + rw_off) = rreg##X; } while (0)
    constexpr float THR = 8.f;
    f32x16 O[NMAP][2], NM[NMAP]; float lrun[NMAP]; int started = 0;
#pragma unroll
    for (int mp = 0; mp < NMAP; ++mp) { lrun[mp] = 0.f;
#pragma unroll
        for (int i = 0; i < 16; ++i) NM[mp][i] = 0.f;
#pragma unroll
        for (int d = 0; d < 2; ++d)
#pragma unroll
            for (int i = 0; i < 16; ++i) O[mp][d][i] = 0.f; }
    const unsigned kr_off = (unsigned)(r32 * KSTR + hh * 16);
    const unsigned vr_off = (unsigned)(AT_KBUF + hh * 512 + ((lane & 15) >> 2) * 64 + (((lane >> 4) & 1) * 16 + (lane & 3) * 4) * 2);
#define AT_BAR() do { asm volatile("s_waitcnt lgkmcnt(0)" ::: "memory"); __builtin_amdgcn_s_barrier(); asm volatile("" ::: "memory"); } while (0)
    constexpr bool DEEP = (MODE != 1);
#define AT_QK(mp, Sa, Sb, sbp) do { \
        _Pragma("unroll") for (int st = 0; st < NST; ++st) { \
            const bf16x8 k0_ = *(const LAS bf16x8*)((sbp) + kr_off + ((MODE == 1 ? 4 * (mp) : 0) + 2 * st) * 16); \
            const bf16x8 k1_ = *(const LAS bf16x8*)((sbp) + kr_off + 32 * KSTR + ((MODE == 1 ? 4 * (mp) : 0) + 2 * st) * 16); \
            Sa = __builtin_amdgcn_mfma_f32_32x32x16_bf16(k0_, qf[mp][st], st == 0 ? NM[mp] : Sa, 0, 0, 0); \
            Sb = __builtin_amdgcn_mfma_f32_32x32x16_bf16(k1_, qf[mp][st], st == 0 ? NM[mp] : Sb, 0, 0, 0); \
            if (MODE == 2 && (st & 1)) __builtin_amdgcn_sched_barrier(0); } } while (0)
#define AT_SMPV(mp, Sa, Sb, Xa, Xb, sbp, wt, krv, rqv) do { \
        if (wt) { const int cq_ = 32 * (wave & 1) + r32, cs_ = min(max(cq_ - 8, 0), 48); const LAS float* bt_ = btab + ((krv) - (rqv) + 7) * 31 + 15 - cq_; \
            _Pragma("unroll") for (int q = 0; q < 16; ++q) { const int kc0_ = (q & 3) + 8 * (q >> 2) + 4 * hh, kc1_ = kc0_ + 32; \
                Sa[q] = ((unsigned)(kc0_ - cs_) < 16u) ? Sa[q] + bt_[kc0_] : NEG; Sb[q] = ((unsigned)(kc1_ - cs_) < 16u) ? Sb[q] + bt_[kc1_] : NEG; } } \
        float mx_ = max32(Sa, Sb); mx_ = fmaxf(mx_, __shfl_xor(mx_, 32)); \
        if (!started || __any(mx_ > THR)) { \
            const float d_ = started ? fmaxf(mx_, 0.f) : mx_, f_ = __builtin_amdgcn_exp2f(-d_); \
            lrun[mp] *= f_; \
            _Pragma("unroll") for (int d = 0; d < 2; ++d) _Pragma("unroll") for (int q = 0; q < 16; ++q) O[mp][d][q] *= f_; \
              \
            _Pragma("unroll") for (int q = 0; q < 16; ++q) { Sa[q] -= d_; Sb[q] -= d_; Xa[q] -= d_; Xb[q] -= d_; } \
            __builtin_amdgcn_sched_barrier(0); \
            asm volatile("s_nop 7\n\ts_nop 7" :: "v"(Xa[15]), "v"(Xb[15])); \
            __builtin_amdgcn_sched_barrier(0); \
            _Pragma("unroll") for (int q = 0; q < 16; ++q) NM[mp][q] -= d_; } \
        float ls_ = 0.f; \
        _Pragma("unroll") for (int q = 0; q < 16; ++q) { Sa[q] = __builtin_amdgcn_exp2f(Sa[q]); Sb[q] = __builtin_amdgcn_exp2f(Sb[q]); ls_ += Sa[q] + Sb[q]; } \
        lrun[mp] += ls_; \
        bf16x8 pf_[4]; \
        pf_[0] = pack8(Sa[0], Sa[1], Sa[2], Sa[3], Sa[4], Sa[5], Sa[6], Sa[7]); pf_[1] = pack8(Sa[8], Sa[9], Sa[10], Sa[11], Sa[12], Sa[13], Sa[14], Sa[15]); \
        pf_[2] = pack8(Sb[0], Sb[1], Sb[2], Sb[3], Sb[4], Sb[5], Sb[6], Sb[7]); pf_[3] = pack8(Sb[8], Sb[9], Sb[10], Sb[11], Sb[12], Sb[13], Sb[14], Sb[15]); \
        _Pragma("unroll") for (int d = 0; d < 2; ++d) _Pragma("unroll") for (int s4 = 0; s4 < 4; ++s4) { \
            const LAS unsigned char* vp_ = (sbp) + vr_off + (8 * s4 + d) * 256; \
            const v4i16_t va_ = __builtin_amdgcn_ds_read_tr16_b64_v4i16((LAS v4i16_t*)vp_); \
            const v4i16_t vb_ = __builtin_amdgcn_ds_read_tr16_b64_v4i16((LAS v4i16_t*)(vp_ + 1024)); \
            bf16x8 vf_; vf_[0] = va_[0]; vf_[1] = va_[1]; vf_[2] = va_[2]; vf_[3] = va_[3]; vf_[4] = vb_[0]; vf_[5] = vb_[1]; vf_[6] = vb_[2]; vf_[7] = vb_[3]; \
            O[mp][d] = __builtin_amdgcn_mfma_f32_32x32x16_bf16(vf_, pf_[s4], O[mp][d], 0, 0, 0); \
            if (NMAP == 2 && (s4 & 1)) __builtin_amdgcn_sched_barrier(0); } } while (0)
#define AT_ACTIVE(i, wt, act, krv, rqv) const bool wt = (MODE == 0) && !ctxq && (i) < nwin; bool act = true; int krv = 0, rqv = 0; \
        if (wt) { krv = krs + (i); rqv = 4 * qb + (wave >> 1); const int rsq_ = min(max(rqv - 4, 0), 24); act = krv >= rsq_ && krv < rsq_ + 8; }
    if (DEEP) {
        f32x16 SA0, SA1, SB0, SB1;
        AT_LOAD(0, A); AT_WRITE(0, A);
        if (ntiles > 1) { AT_LOAD(1, B); AT_WRITE(1, B); }
        if (ntiles > 2) AT_LOAD(2, A);
        if (ntiles > 3) AT_LOAD(3, B);
        AT_BAR();
        { AT_ACTIVE(0, wt0, act0, kr0, rq0); if (act0) AT_QK(0, SA0, SA1, lds); (void)wt0; (void)kr0; (void)rq0; }
        int s0 = 0;
#pragma unroll 1
        for (int i0 = 0; i0 < ntiles; i0 += 2) {
            const int s1 = s0 == 2 ? 0 : s0 + 1, s2 = s1 == 2 ? 0 : s1 + 1;
            {
                const int i = i0;
                if (i + 2 < ntiles) AT_WRITE(s2, A);
                if (i + 4 < ntiles) AT_LOAD(i + 4, A);
                if (i + 1 < ntiles) { AT_ACTIVE(i + 1, wtn, actn, krn, rqn); if (actn) AT_QK(0, SB0, SB1, lds + s1 * AT_STAGE); (void)wtn; (void)krn; (void)rqn; }
                __builtin_amdgcn_sched_barrier(0);
                AT_ACTIVE(i, wt, act, kr, rq);
                if (act) { AT_SMPV(0, SA0, SA1, SB0, SB1, lds + s0 * AT_STAGE, wt, kr, rq); started = 1; }
                AT_BAR();
            }
            if (i0 + 1 < ntiles) {
                const int i = i0 + 1;
                if (i + 2 < ntiles) AT_WRITE(s0, B);
                if (i + 4 < ntiles) AT_LOAD(i + 4, B);
                if (i + 1 < ntiles) { AT_ACTIVE(i + 1, wtn, actn, krn, rqn); if (actn) AT_QK(0, SA0, SA1, lds + s2 * AT_STAGE); (void)wtn; (void)krn; (void)rqn; }
                __builtin_amdgcn_sched_barrier(0);
                AT_ACTIVE(i, wt, act, kr, rq);
                if (act) { AT_SMPV(0, SB0, SB1, SA0, SA1, lds + s1 * AT_STAGE, wt, kr, rq); started = 1; }
                AT_BAR();
            }
            s0 = s2;
        }
    } else {
        AT_LOAD(0, A); AT_WRITE(0, A); if (ntiles > 1) AT_LOAD(1, A);
        AT_BAR();
#pragma unroll 1
        for (int i = 0; i < ntiles; ++i) {
            if (i + 1 < ntiles) AT_WRITE((i + 1) & 1, A);
            if (i + 2 < ntiles) AT_LOAD(i + 2, A);
            const LAS unsigned char* sb = lds + (i & 1) * AT_STAGE;
#pragma unroll
            for (int mp = 0; mp < NMAP; ++mp) {
                f32x16 S0, S1, X0, X1;
#pragma unroll
                for (int q = 0; q < 16; ++q) { X0[q] = 0.f; X1[q] = 0.f; }
                AT_QK(mp, S0, S1, sb);
                AT_SMPV(mp, S0, S1, X0, X1, sb, false, 0, 0);
                if (NMAP == 2) __builtin_amdgcn_sched_barrier(0);
            }
            started = 1;
            AT_BAR();
        }
    }
#undef AT_QK
#undef AT_SMPV
#undef AT_ACTIVE
#undef AT_BAR
    float inv[NMAP];
#pragma unroll
    for (int mp = 0; mp < NMAP; ++mp) { const float lt = lrun[mp] + __shfl_xor(lrun[mp], 32); inv[mp] = 1.f / lt; }
    bf16_t* orow = W.HB + (size_t)tq * DM + (MODE == 0 ? 0 : (MODE == 1 ? 256 : 512)) + h * 64 + 4 * hh;
    if (MODE == 1) {
        const float lam = W.lam[l], li = 0.8f - 0.6f * expf(-0.3f * (float)l);
        const float* sg = P->in[11] + l * 64;
        const float c2 = lam * inv[1];
        float ss = 0.f;
#pragma unroll
        for (int d = 0; d < 2; ++d)
#pragma unroll
            for (int q = 0; q < 16; ++q) { const float o = O[0][d][q] * inv[0] - c2 * O[NMAP - 1][d][q]; O[0][d][q] = o; ss += o * o; }
        ss += __shfl_xor(ss, 32);
        const float rs = rsqrtf(ss * (1.f / 64.f) + 1e-6f) * (1.f - li);
#pragma unroll
        for (int d = 0; d < 2; ++d)
#pragma unroll
            for (int g4 = 0; g4 < 4; ++g4) {
                const int dv = 32 * d + 8 * g4 + 4 * hh;
                const f32x4 gg = *(const f32x4*)(sg + dv);
                u32x2 w; w.x = pk_bf16(O[0][d][4 * g4] * rs * gg[0], O[0][d][4 * g4 + 1] * rs * gg[1]); w.y = pk_bf16(O[0][d][4 * g4 + 2] * rs * gg[2], O[0][d][4 * g4 + 3] * rs * gg[3]);
                *(u32x2*)(orow + 32 * d + 8 * g4) = w;
            }
    } else {
#pragma unroll
        for (int d = 0; d < 2; ++d)
#pragma unroll
            for (int g4 = 0; g4 < 4; ++g4) {
                u32x2 w; w.x = pk_bf16(O[0][d][4 * g4] * inv[0], O[0][d][4 * g4 + 1] * inv[0]); w.y = pk_bf16(O[0][d][4 * g4 + 2] * inv[0], O[0][d][4 * g4 + 3] * inv[0]);
                *(u32x2*)(orow + 32 * d + 8 * g4) = w;
            }
    }
#undef AT_ROW0
#undef AT_LOAD
#undef AT_WRITE
}
__device__ __forceinline__ void phase_attn(const int L_, const int CH_, LAS unsigned char* lds) {
    const KP P = kparams();
    const Ws W(P->ws);
    const int G = pgrid<ID_ATTN>(), c = pblk<ID_ATTN>();
    if (c < 0) return;
    const int gwave = c * 8 + __builtin_amdgcn_readfirstlane(tid_opaque() >> 6), nwaves = G * 8;
    int ck = 0;
#define AT_CONV() do { const int tid0_ = tid_opaque(), cwave_ = __builtin_amdgcn_readfirstlane(tid0_ >> 6); \
        conv_expert_items(P, W, L_, ck, gwave, nwaves, (LAS float*)(lds + 73728 + cwave_ * 8704)  , tid0_ & 63); ck += 2; } while (0)
    for (int u = c; u < 1024; u += G) { const int x = u & 7, j = u >> 3, qb = j & 7, bh = (j >> 3) * 8 + x; attn_unit<2>(P, L_, W, lds, bh >> 3, bh & 7, qb, false); AT_CONV(); }
    for (int u = c; u < 512; u += G) { const int x = u & 7, j = u >> 3, qb = j & 7, bh = (j >> 3) * 8 + x; attn_unit<1>(P, L_, W, lds, bh >> 2, bh & 3, qb, false); AT_CONV(); }
    for (int u = c; u < 512; u += G) { const int x = u & 7, j = u >> 3, qb = j & 7, bh = (j >> 3) * 8 + x; attn_unit<0>(P, L_, W, lds, bh >> 2, bh & 3, qb, false); AT_CONV(); }
    if (L_ == 0) {
        for (int u = c; u < 256; u += G) {
            if (u < 128) attn_unit<2>(P, L_, W, lds, u >> 3, u & 7, 0, true);
            else if (u < 192) attn_unit<1>(P, L_, W, lds, (u - 128) >> 2, (u - 128) & 3, 0, true);
            else attn_unit<0>(P, L_, W, lds, (u - 192) >> 2, (u - 192) & 3, 0, true);
        }
    }
    while (gwave + ck * nwaves < CV_E) AT_CONV();
#undef AT_CONV
}

#define XB_TMO      128
#define XB_XCNT(j)  (256  + 64 * (j))
#define XB_XSUB(j)  (1280 + 64 * (j))
#define XB_XGEN(j)  (2304 + 64 * (j))
#define XB_TOP      3328
#define XB_TOPGEN   3392
#define XCD_BAR_WORDS 3456
#define XB_SPIN_CAP (1u << 18)

__device__ __forceinline__ unsigned xb_ld(unsigned* p)              { return __hip_atomic_load(p, __ATOMIC_RELAXED, __HIP_MEMORY_SCOPE_AGENT); }
__device__ __forceinline__ unsigned xb_add(unsigned* p, unsigned v) { return __hip_atomic_fetch_add(p, v, __ATOMIC_RELAXED, __HIP_MEMORY_SCOPE_AGENT); }
__device__ __forceinline__ unsigned xb_xcc_id() { return (unsigned)__builtin_amdgcn_s_getreg((3 << 11) | 20) & 0xFu; }
#define XB_SPIN(cond, bar) do { unsigned _sp = 0; while (cond) { __builtin_amdgcn_s_sleep(1); \
    if ((++_sp & 255u) == 0u) { if (xb_ld(&(bar)[XB_TMO])) break; if (_sp > XB_SPIN_CAP) { atomicAdd(&(bar)[XB_TMO], 1u); break; } } } } while (0)

struct XcdBarrier {
    unsigned* bar; unsigned x;
    volatile LAS unsigned* st;
};

__device__ __forceinline__ XcdBarrier xcd_barrier_post(unsigned* bar, volatile LAS unsigned* st) {
    XcdBarrier b; b.bar = bar; b.x = xb_xcc_id(); b.st = st;
    if (threadIdx.x == 0) (void)xb_add(&bar[XB_XCNT(b.x)], 1u);
    return b;
}
__device__ __forceinline__ void xcd_barrier_complete(unsigned* bar, unsigned x, unsigned& nloc, unsigned& nx) {
    const unsigned G = gridDim.x * gridDim.y * gridDim.z;
    unsigned sum, cnt, mine, sp = 0u;
    for (;;) {
        sum = 0u; cnt = 0u; mine = 0u;
#pragma unroll
        for (unsigned j = 0; j < 16; ++j) { const unsigned c = xb_ld(&bar[XB_XCNT(j)]); sum += c; cnt += (c > 0u) ? 1u : 0u; mine = (j == x) ? c : mine; }
        if (sum == G) break;
        __builtin_amdgcn_s_sleep(1);
        if ((++sp & 255u) == 0u) { if (xb_ld(&bar[XB_TMO])) break; if (sp > XB_SPIN_CAP) { atomicAdd(&bar[XB_TMO], 1u); break; } }
    }
    nloc = mine > 0u ? mine : 1u; nx = cnt > 0u ? cnt : 1u;
}

__device__ __forceinline__ void xcd_barrier(const XcdBarrier& b) {
    asm volatile("s_waitcnt vmcnt(0)" ::: "memory");
    __syncthreads();
    if (threadIdx.x == 0) {
        unsigned* bar = b.bar;
        __builtin_amdgcn_s_waitcnt(0);
        unsigned nloc = b.st[0], nx = b.st[1];
        if (nloc == 0u) { xcd_barrier_complete(bar, b.x, nloc, nx); b.st[0] = nloc; b.st[1] = nx; }
        const unsigned old = xb_add(&bar[XB_XSUB(b.x)], 1u);
        const unsigned gen = old / nloc;
        if (old + 1u == (gen + 1u) * nloc) {
            __builtin_amdgcn_fence(__ATOMIC_RELEASE, "agent");
            asm volatile("s_waitcnt vmcnt(0)" ::: "memory");
            const unsigned og = xb_add(&bar[XB_TOP], 1u);
            const unsigned tg = og / nx;
            if (og + 1u == (tg + 1u) * nx) xb_add(&bar[XB_TOPGEN], 1u);
            else XB_SPIN(xb_ld(&bar[XB_TOPGEN]) == tg, bar);
            __builtin_amdgcn_fence(__ATOMIC_ACQUIRE, "agent");
            xb_add(&bar[XB_XGEN(b.x)], 1u);
            asm volatile("s_waitcnt vmcnt(0)" ::: "memory");
        } else {
            XB_SPIN(xb_ld(&bar[XB_XGEN(b.x)]) == gen, bar);
            __builtin_amdgcn_fence(__ATOMIC_ACQUIRE, "agent");
            asm volatile("s_waitcnt vmcnt(0)" ::: "memory");
        }
    }
    __syncthreads();
}

constexpr int NSTEPS = 2 + 2 * (5 + 2 * NCHUNK);
constexpr int LDS_BARW = LDS_BYTES - 64;
__global__ void __launch_bounds__(NTHREADS, 2) k_fwd(Params P) {
    extern __shared__ __attribute__((aligned(16))) unsigned char dyn_lds[];
    LAS unsigned char* lds = (LAS unsigned char*)dyn_lds;
    volatile LAS unsigned* st = (volatile LAS unsigned*)(lds + LDS_BARW);
    if (threadIdx.x == 0) { st[0] = 0u; st[1] = 0u; st[2] = 0u; st[3] = 0u; }
    __syncthreads();
    const XcdBarrier bar = xcd_barrier_post((unsigned*)(P.ws + WS_CTL), st);
    const int lo = P.ph_lo, hi = P.ph_hi;
    int step = 0;
#ifndef REP_ATTN
#define REP_ATTN 1
#endif
#ifndef REP_MOE1
#define REP_MOE1 1
#endif
#ifndef REP_MOE2
#define REP_MOE2 1
#endif
#ifndef REP_INPROJ
#define REP_INPROJ 1
#endif
#ifndef REP_MLA
#define REP_MLA 1
#endif
#ifndef REP_CONV
#define REP_CONV 1
#endif
#define STEP(body) do { const int s_ = step++; if (s_ >= lo && s_ < hi) { body; if (s_ + 1 < hi && s_ + 1 < NSTEPS) xcd_barrier(bar); } } while (0)
    STEP(for (int rep = 0; rep < REP_CONV; ++rep) { if (rep) xcd_barrier(bar); phase_convert(0, 0, lds); });
    STEP(phase_norm1(0, 0, lds));
#pragma unroll 1
    for (int l = 0; l < 2; ++l) {
        STEP(for (int rep = 0; rep < REP_INPROJ; ++rep) { if (rep) xcd_barrier(bar); phase_inproj(l, 0, lds); });
        STEP(for (int rep = 0; rep < REP_MLA; ++rep) { if (rep) xcd_barrier(bar); phase_mla(l, 0, lds); });
        STEP(for (int rep = 0; rep < REP_ATTN; ++rep) { if (rep) xcd_barrier(bar); phase_attn(l, 0, lds); });
        STEP(phase_outproj(l, 0, lds));
        STEP(phase_norm2(l, 0, lds));
#pragma unroll 1
        for (int ch = 0; ch < NCHUNK; ++ch) {
            STEP(phase_moe(l, ch, lds));
            STEP(phase_comb(l, ch, lds); if (l == 0 && ch == NCHUNK - 1) phase_convert(1, 0, lds));
        }
    }
#undef STEP
}

#ifndef MK_N_LAUNCHES
#define MK_N_LAUNCHES 1
#endif
extern "C" void kernel_launch(void* const* d_in, const int* in_sizes, int n_in, void* d_out, int out_size, void* d_ws, size_t ws_size, hipStream_t stream) {
    static int grid = 0;
    if (grid == 0) {
        if (ws_size < WS_END || n_in != 26 || out_size != NLAT * DM) { fprintf(stderr, "kernel_launch: workspace %zu < %zu or n_in %d != 26 or out %d; nothing launched\n", ws_size, (size_t)WS_END, n_in, out_size); grid = -1; return; }
        int dev = 0, cus = 0, per_cu = 0;
        if (hipGetDevice(&dev) != hipSuccess || hipDeviceGetAttribute(&cus, hipDeviceAttributeMultiprocessorCount, dev) != hipSuccess || cus <= 0) { fprintf(stderr, "kernel_launch: device query failed\n"); grid = -1; return; }
        if (hipFuncSetAttribute((const void*)k_fwd, hipFuncAttributeMaxDynamicSharedMemorySize, LDS_BYTES) != hipSuccess) { fprintf(stderr, "kernel_launch: hipFuncSetAttribute failed\n"); grid = -1; return; }
        if (hipOccupancyMaxActiveBlocksPerMultiprocessor(&per_cu, (const void*)k_fwd, NTHREADS, LDS_BYTES) != hipSuccess || per_cu < 1) { fprintf(stderr, "kernel_launch: occupancy query says %d workgroups per CU\n", per_cu); grid = -1; (void)hipGetLastError(); return; }
        grid = cus;
    }
    if (grid < 0) return;
    Params P{};
    for (int i = 0; i < 26; ++i) P.in[i] = (const float*)d_in[i];
    P.out = (float*)d_out; P.ws = (unsigned char*)d_ws;
    (void)hipMemsetAsync((unsigned char*)d_ws + WS_CTL, 0, CTL_ZERO_BYTES, stream);
    if (MK_N_LAUNCHES == 1) {
        P.ph_lo = 0; P.ph_hi = NSTEPS;
        hipLaunchKernelGGL(k_fwd, dim3(grid), dim3(NTHREADS), LDS_BYTES, stream, P);
#ifdef PROBE_STEP
        (void)hipMemsetAsync((unsigned char*)d_ws + WS_CTL, 0, XCD_BAR_WORDS * 4, stream);
        if (!(PROBE_I2 & 1)) (void)hipMemsetAsync((unsigned char*)d_ws + WS_CTL + (size_t)CW_RT * 4 + (size_t)2 * 1024 * 16 * 4, 0, (size_t)2 * 1024 * 16 * 4, stream);
        P.ph_lo = PROBE_STEP; P.ph_hi = PROBE_STEP + 1; P.i2 = PROBE_I2;
        hipLaunchKernelGGL(k_fwd, dim3(grid), dim3(NTHREADS), LDS_BYTES, stream, P);
#endif
    } else {
        for (int s = 0; s < NSTEPS; ++s) { P.ph_lo = s; P.ph_hi = s + 1; hipLaunchKernelGGL(k_fwd, dim3(grid), dim3(NTHREADS), LDS_BYTES, stream, P); }
    }
}
```

```cpp
#include <hip/hip_runtime.h>
#include <cstdint>
#include <cstdio>
#include <cmath>

typedef unsigned short bf16_t;

constexpr int NB = 16, SEQ = 2048, DM = 1024, CTX = 256;
constexpr int NLAT = NB * SEQ, NCTX = NB * CTX, NTOK = NLAT + NCTX;
constexpr int INC = 1952;
constexpr int PBS = 2048;
constexpr int O_NAQ = 0, O_NAK = 256, O_NAV = 512, O_DQ = 768, O_DK = 1024, O_DV = 1280, O_CQ = 1536, O_CKV = 1792, O_KR = 1920;
constexpr int NEXP = 64, EFF = 256;
constexpr int LCAP = NTOK;
constexpr int MODW = 6 * DM;

constexpr size_t MiB = 1u << 20;
constexpr size_t WS_CTL = 0;
constexpr size_t WS_MOD = 1 * MiB;
constexpr size_t WS_ROPE = 2 * MiB;
constexpr size_t WS_SSQ = 3 * MiB;
constexpr size_t WS_JUNK = 6 * MiB;
constexpr size_t WS_XS = 8 * MiB;
constexpr size_t WS_HB = 152 * MiB;
constexpr size_t WS_PB = 224 * MiB;
constexpr size_t WS_QM = 368 * MiB;
constexpr size_t WS_KVM = 422 * MiB;
constexpr size_t WS_WB = 494 * MiB;
constexpr size_t WS_END = 600 * MiB;
constexpr size_t WS_LOG = WS_PB;
constexpr size_t WS_LIST = WS_PB + 16 * MiB;
constexpr size_t WB_WIN = 0;
constexpr size_t WB_WUQ = WB_WIN + (size_t)2048 * 1024;
constexpr size_t WB_WUKV = WB_WUQ + (size_t)768 * 256;
constexpr size_t WB_WOUT = WB_WUKV + (size_t)1024 * 256;
constexpr size_t WB_WGU = WB_WOUT + (size_t)1024 * 1024;
constexpr size_t WB_WD = WB_WGU + (size_t)65 * 512 * 1024;
constexpr size_t WB_END = WB_WD + (size_t)65 * 1024 * 256;
static_assert(WS_WB + WB_END * 2 <= WS_END, "weights fit");

__device__ __forceinline__ float bf2f(bf16_t v) { return __uint_as_float(((unsigned)v) << 16); }
__device__ __forceinline__ bf16_t f2bf(float f) { unsigned u = __float_as_uint(f); u += 0x7fffu + ((u >> 16) & 1u); return (bf16_t)(u >> 16); }
__device__ __forceinline__ float wave_sum(float v) {
#pragma unroll
    for (int o = 32; o > 0; o >>= 1) v += __shfl_xor(v, o);
    return v;
}
__device__ __forceinline__ float wave_max(float v) {
#pragma unroll
    for (int o = 32; o > 0; o >>= 1) v = fmaxf(v, __shfl_xor(v, o));
    return v;
}
__device__ __forceinline__ int mod_row(int t) { return t < NLAT ? (t >> 11) : 16; }

__device__ __forceinline__ void rope_cs(int s, int j, float& cs, float& sn) {
    const int rowi = s >> 6, coli = s & 63;
    const float freq = powf(10000.f, -(float)(j & 7) / 8.f);
    const float ang = (float)(j < 8 ? rowi : coli) * freq;
    cs = cosf(ang); sn = sinf(ang);
}
#define LAS __attribute__((address_space(3)))
typedef short bf16x8 __attribute__((ext_vector_type(8)));
typedef float f32x4 __attribute__((ext_vector_type(4)));
typedef float f32x2 __attribute__((ext_vector_type(2)));
typedef unsigned u32x2 __attribute__((ext_vector_type(2)));
typedef unsigned u32x4 __attribute__((ext_vector_type(4)));
typedef __bf16 bf16x2_t __attribute__((ext_vector_type(2)));

struct Params { const float* in[26]; float* out; unsigned char* ws; int ph_lo, ph_hi, i2, i3; };
typedef const Params __attribute__((address_space(4)))* KP;
__device__ __forceinline__ KP kparams() { KP p = (KP)__builtin_amdgcn_kernarg_segment_ptr(); asm volatile("" : "+s"(p)); return p; }
#ifndef PROBE_HALF
#define PROBE_HALF -1
#endif
enum { ID_CONV = 0, ID_NORM1, ID_INPROJ, ID_MLA, ID_ATTN, ID_OUTPROJ, ID_NORM2, ID_MOE, ID_COMB };
template <int ID> __device__ __forceinline__ int pgrid() { int g = (int)gridDim.x; asm volatile("" : "+s"(g)); return ID == PROBE_HALF ? g / 2 : g; }
template <int ID> __device__ __forceinline__ int pblk() { int b = (int)blockIdx.x; asm volatile("" : "+s"(b)); return ID == PROBE_HALF ? ((b & 1) ? -1 : b >> 1) : b; }
__device__ __forceinline__ int tid_opaque() { int t = (int)threadIdx.x; asm volatile("" : "+v"(t)); return t; }

constexpr int NTHREADS = 512;
constexpr int LDS_BYTES = 147456;

__device__ __forceinline__ unsigned pk_bf16(float lo, float hi) { f32x2 v = {lo, hi}; bf16x2_t b = __builtin_convertvector(v, bf16x2_t); return __builtin_bit_cast(unsigned, b); }

namespace g8 {
constexpr int BM = 256, BK = 64, HALF = 128, HTB = HALF * BK * 2, STAGE_BYTES = 8 * HTB, NXCD = 8, WGM = 8;
__host__ __device__ __forceinline__ int lds_byte(int r, int c) { const int st = (r >> 4) * 2 + (c >> 5), rr = r & 15, cc = c & 31, ob = rr * 64 + cc * 2; return st * 1024 + (ob ^ (((ob >> 9) & 1) << 5)); }
__host__ __device__ __forceinline__ void stage_rc(int b, int& R, int& C) { const int st = b / 1024, sb = b % 1024, swz = sb ^ (((sb >> 9) & 1) << 5); R = (st >> 1) * 16 + swz / 64; C = (st & 1) * 32 + (swz % 64) / 2; }

struct Unit2 { int pm, pn; };
struct DenseOrder {
    int nM, nN, nwg, G, c;
    __device__ __forceinline__ void init(int nM_, int nN_, int G_, int c_) { nM = nM_; nN = nN_; nwg = nM * nN; G = G_; c = c_; }
    __device__ __forceinline__ bool next(int i, Unit2& u) const {
        const long L = (long)i * G + c; if (L >= nwg) return false;
        int wgid = (int)L; { const int q = nwg / NXCD, r = nwg % NXCD, xcd = wgid % NXCD, off = wgid / NXCD; wgid = (xcd < r ? xcd * (q + 1) : r * (q + 1) + (xcd - r) * q) + off; }
        const int nig = WGM * nN, gid = wgid / nig, fm = gid * WGM, gsz = (nM - fm) < WGM ? (nM - fm) : WGM;
        u.pm = fm + ((wgid % nig) % gsz); u.pn = (wgid % nig) / gsz; return true;
    }
};

#define G8_SA(b, h) (((b) * 2 + (h)) * g8::HTB)
#define G8_SB(b, h) ((4 + (b) * 2 + (h)) * g8::HTB)
#define G8_GLDS(gp, ldsoff) __builtin_amdgcn_global_load_lds((const unsigned*)(gp), (LAS unsigned*)(lds + (ldsoff)), 16, 0, 0)
#define G8_STAGE_A(bufoff, o0, o1, kb) do { G8_GLDS(Ab + (o0) + (kb), (bufoff) + ldsw); G8_GLDS(Ab + (o1) + (kb), (bufoff) + ldsw + 8192); } while (0)
#define G8_STAGE_B(bufoff, bp, kb) do { G8_GLDS((bp) + voffB[0] + (kb), (bufoff) + ldsw); G8_GLDS((bp) + voffB[1] + (kb), (bufoff) + ldsw + 8192); } while (0)
#define G8_LDA(dst, b, h) do { _Pragma("unroll") for (int m = 0; m < 4; ++m) _Pragma("unroll") for (int k = 0; k < 2; ++k) dst[m][k] = *(const LAS bf16x8*)(lds + G8_SA(b, h) + aoff + m * 2048 + k * 1024); } while (0)
#define G8_LDB(dst, b, h) do { _Pragma("unroll") for (int n = 0; n < 2; ++n) _Pragma("unroll") for (int k = 0; k < 2; ++k) dst[n][k] = *(const LAS bf16x8*)(lds + G8_SB(b, h) + boff + n * 2048 + k * 1024); } while (0)
#define G8_MMA(ai, bj, At, Bt) do { __builtin_amdgcn_s_setprio(1); _Pragma("unroll") for (int m = 0; m < 4; ++m) _Pragma("unroll") for (int n = 0; n < 2; ++n) _Pragma("unroll") for (int k = 0; k < 2; ++k) \
        acc[ai][bj][m][n] = __builtin_amdgcn_mfma_f32_16x16x32_bf16(Bt[n][k], At[m][k], acc[ai][bj][m][n], 0, 0, 0); __builtin_amdgcn_s_setprio(0); } while (0)
#define G8_WAIT_V(n) asm volatile("s_waitcnt vmcnt(" #n ")" ::: "memory")
#define G8_WAIT_L(n) asm volatile("s_waitcnt lgkmcnt(" #n ")" ::: "memory")
#define G8_BAR __builtin_amdgcn_s_barrier()
#define G8_SCHED __builtin_amdgcn_sched_barrier(0)

template <class P>
__device__ __forceinline__ void gemm_phase(LAS unsigned char* lds, const P& pr) {
    typedef typename P::Unit Unit;
    constexpr int K = P::K, nt = K / BK;
    static_assert(K % 128 == 0 && nt >= 2, "K must be a multiple of 128");
    const int tid = tid_opaque(), wid = __builtin_amdgcn_readfirstlane(tid >> 6), lane = tid & 63, wr = wid >> 2, wc = wid & 3, fr = lane & 15, fq = lane >> 4;
    int Rr[2], Cc[2]; unsigned voffB[2];
#pragma unroll
    for (int i = 0; i < 2; ++i) { stage_rc(tid * 16 + i * 8192, Rr[i], Cc[i]); voffB[i] = (unsigned)(Rr[i] * K + Cc[i]) * 2u; }
    constexpr unsigned kstep = BK * 2;
    constexpr size_t hstepB = (size_t)HALF * K * 2;
    const unsigned ldsw = (unsigned)wid * 1024u;
    const int aoff = lds_byte(wr * 64 + fr, fq * 8), boff = lds_byte(wc * 32 + fr, fq * 8);
    Unit cur, nxt; int ui = 0;
    int pend = -1;
    if (!pr.next(0, cur)) return;
    f32x4 acc[2][2][4][2];
#pragma unroll
    for (int a = 0; a < 2; ++a)
#pragma unroll
        for (int b = 0; b < 2; ++b)
#pragma unroll
            for (int m = 0; m < 4; ++m)
#pragma unroll
                for (int n = 0; n < 2; ++n) acc[a][b][m][n] = (f32x4){0.f, 0.f, 0.f, 0.f};
    bf16x8 At[4][2], B0[2][2], B1[2][2];
    const char* Ab = pr.a_base();
    unsigned ca[2][2], na[2][2];
    pr.a_ready(cur);
    pr.a_offsets(cur, Rr, Cc, ca);
    const char* cB = pr.b_ptr(cur);
    G8_STAGE_B(G8_SB(0, 0), cB, 0); G8_STAGE_B(G8_SB(0, 1), cB + hstepB, 0); G8_STAGE_A(G8_SA(0, 0), ca[0][0], ca[0][1], 0); G8_STAGE_A(G8_SA(0, 1), ca[1][0], ca[1][1], 0);
    if (wr == 1) G8_BAR;
    G8_WAIT_V(2); G8_BAR;
    G8_STAGE_B(G8_SB(1, 0), cB, kstep); G8_STAGE_A(G8_SA(1, 0), ca[0][0], ca[0][1], kstep); G8_STAGE_B(G8_SB(1, 1), cB + hstepB, kstep);
    G8_WAIT_V(6); G8_BAR;
    for (;;) {
        const bool has_next = pr.next(ui + 1, nxt);
        const char* nB = cB;
#pragma unroll
        for (int h = 0; h < 2; ++h)
#pragma unroll
            for (int i = 0; i < 2; ++i) na[h][i] = ca[h][i];
        if (has_next) { pr.a_offsets(nxt, Rr, Cc, na); nB = pr.b_ptr(nxt); }
#pragma unroll 1
        for (int t = 0; t < nt; t += 2) {
            const bool last = (t == nt - 2);
            if (last && has_next) pr.a_ready(nxt);
            const unsigned k1 = (unsigned)(t + 1) * kstep, k2 = (unsigned)(t + 2) * kstep;
            unsigned a2[2][2];
#pragma unroll
            for (int h = 0; h < 2; ++h)
#pragma unroll
                for (int i = 0; i < 2; ++i) a2[h][i] = last ? na[h][i] : ca[h][i] + k2;
            const char* b2 = last ? nB : cB + k2;
            G8_LDB(B0, 0, 0); G8_LDB(B1, 0, 1); G8_SCHED; G8_LDA(At, 0, 0); G8_STAGE_A(G8_SA(1, 1), ca[1][0], ca[1][1], k1);
            G8_WAIT_V(8); G8_WAIT_L(0); G8_BAR; G8_MMA(0, 0, At, B0); G8_MMA(0, 1, At, B1); G8_BAR; G8_SCHED;
            G8_LDA(At, 0, 1); G8_STAGE_B(G8_SB(0, 0), b2, 0); G8_STAGE_B(G8_SB(0, 1), b2 + hstepB, 0); G8_STAGE_A(G8_SA(0, 0), a2[0][0], a2[0][1], 0);
            G8_WAIT_V(8); G8_WAIT_L(0); G8_BAR; G8_MMA(1, 0, At, B0); G8_MMA(1, 1, At, B1); G8_BAR; G8_SCHED;
            if (P::HAS_DONE && t == 0 && pend >= 0) { pr.done(pend); pend = -1; }
            G8_LDB(B0, 1, 0); G8_LDB(B1, 1, 1); G8_SCHED; G8_LDA(At, 1, 0); G8_STAGE_A(G8_SA(0, 1), a2[1][0], a2[1][1], 0);
            G8_WAIT_V(8); G8_WAIT_L(0); G8_BAR; G8_MMA(0, 0, At, B0); G8_MMA(0, 1, At, B1); G8_BAR; G8_SCHED;
            G8_LDA(At, 1, 1); G8_STAGE_B(G8_SB(1, 0), b2, kstep); G8_STAGE_B(G8_SB(1, 1), b2 + hstepB, kstep); G8_STAGE_A(G8_SA(1, 0), a2[0][0], a2[0][1], kstep);
            G8_WAIT_V(8); G8_WAIT_L(0); G8_BAR; G8_MMA(1, 0, At, B0); G8_MMA(1, 1, At, B1); G8_BAR; G8_SCHED;
        }
        if (wr == 0) G8_BAR;
        pr.epilogue(acc, cur, wr, wc, fr, fq);
        if (P::HAS_DONE) pend = pr.done_token(cur);
        if (!has_next) break;
#pragma unroll
        for (int a = 0; a < 2; ++a)
#pragma unroll
            for (int b = 0; b < 2; ++b)
#pragma unroll
                for (int m = 0; m < 4; ++m)
#pragma unroll
                    for (int n = 0; n < 2; ++n) acc[a][b][m][n] = (f32x4){0.f, 0.f, 0.f, 0.f};
        cur = nxt; cB = nB; ++ui;
#pragma unroll
        for (int h = 0; h < 2; ++h)
#pragma unroll
            for (int i = 0; i < 2; ++i) ca[h][i] = na[h][i];
        if (wr == 1) G8_BAR;
    }
    G8_WAIT_V(0);
    if (P::HAS_DONE && pend >= 0) pr.done(pend);
    G8_BAR;
}
}

struct Ws {
    unsigned* ctl; float* mod; float* lam; float* rope; float* ssq; float* sskv;
    bf16_t* XS; bf16_t* HB; bf16_t* PB; bf16_t* QM; bf16_t* KVM; bf16_t* WB;
    __device__ __host__ __forceinline__ explicit Ws(unsigned char* ws) {
        ctl = (unsigned*)(ws + WS_CTL); mod = (float*)(ws + WS_MOD); lam = mod + 2 * 17 * MODW; rope = (float*)(ws + WS_ROPE);
        ssq = (float*)(ws + WS_SSQ); sskv = ssq + (size_t)NTOK * 4;
        XS = (bf16_t*)(ws + WS_XS); HB = (bf16_t*)(ws + WS_HB); PB = (bf16_t*)(ws + WS_PB); QM = (bf16_t*)(ws + WS_QM); KVM = (bf16_t*)(ws + WS_KVM); WB = (bf16_t*)(ws + WS_WB);
    }
};

__device__ __forceinline__ int conv_drow(int ng, int mode) {
    if (mode == 1 || mode == 2) { const int a = ng & 127; return (ng & ~127) * 2 + 128 * ((a >> 2) & 1) + 32 * (a >> 5) + 16 * (mode - 1) + 4 * ((a >> 3) & 3) + (a & 3); }
    if (mode == 3) { const int c = ng & 63; return (ng & ~63) + 16 * ((c >> 2) & 3) + 4 * (c >> 4) + (c & 3); }
    if (mode == 4) { const int c = ng & 255, g = c >> 5; return (ng & ~255) + 128 * ((c >> 2) & 1) + 32 * (g >> 1) + 16 * ((c >> 4) & 1) + 4 * (2 * (g & 1) + ((c >> 3) & 1)) + (c & 3); }
    return ng;
}
struct ConvDesc { const float* W; const float* ks; bf16_t* Bt; int N, k0, n0, ldo, mode; };
__device__ __forceinline__ void conv_load(const ConvDesc& d, float (&v)[32], int lane) {
#pragma unroll
    for (int i = 0; i < 32; ++i) v[i] = d.W[(size_t)(d.k0 + 2 * i + (lane >> 5)) * d.N + d.n0 + (lane & 31)];
}
__device__ __forceinline__ void conv_store(const ConvDesc& d, float (&v)[32], LAS float* scr, int lane) {
    if (d.ks) {
#pragma unroll
        for (int i = 0; i < 32; ++i) v[i] *= d.ks[d.k0 + 2 * i + (lane >> 5)];
    }
#pragma unroll
    for (int i = 0; i < 32; ++i) scr[(2 * i + (lane >> 5)) * 33 + (lane & 31)] = v[i];
    asm volatile("s_waitcnt lgkmcnt(0)" ::: "memory");
    const int c = lane & 7;
#pragma unroll
    for (int j = 0; j < 4; ++j) {
        const int n = (lane >> 3) + 8 * j;
        const LAS float* sp = scr + (8 * c) * 33 + n;
        u32x4 o; o.x = pk_bf16(sp[0], sp[33]); o.y = pk_bf16(sp[66], sp[99]); o.z = pk_bf16(sp[132], sp[165]); o.w = pk_bf16(sp[198], sp[231]);
        *(u32x4*)(d.Bt + (size_t)conv_drow(d.n0 + n, d.mode) * d.ldo + d.k0 + 8 * c) = o;
    }
    asm volatile("s_waitcnt lgkmcnt(0)" ::: "memory");
}
constexpr int CV_E = 65 * 384, CV_IN = 16 * 61, CV_OUT = 512, CV_UQ = 96, CV_UKV = 64, CV_ITEMS = CV_E + CV_IN + CV_OUT + CV_UQ + CV_UKV;
__device__ __forceinline__ void conv_decode(const KP P, const Ws& W, int l, int it, ConvDesc& d) {
    int r = it; d.ks = nullptr;
    if (r < CV_E) {
        const int e = r / 384, w = (r % 384) >> 7, t = r & 127;
        if (w < 2) {
            d.W = e < 64 ? P->in[19 + w] + ((size_t)l * 64 + e) * 262144 : P->in[22 + w] + (size_t)l * 262144;
            d.N = 256; d.k0 = (t >> 3) * 64; d.n0 = (t & 7) * 32; d.Bt = W.WB + WB_WGU + (size_t)e * 524288; d.ldo = 1024; d.mode = 1 + w;
        } else {
            d.W = e < 64 ? P->in[21] + ((size_t)l * 64 + e) * 262144 : P->in[24] + (size_t)l * 262144;
            d.N = 1024; d.k0 = (t >> 5) * 64; d.n0 = (t & 31) * 32; d.Bt = W.WB + WB_WD + (size_t)e * 262144; d.ldo = 256; d.mode = 3;
        }
        return;
    }
    r -= CV_E;
    if (r < CV_IN) { d.W = P->in[8] + (size_t)l * 1024 * INC; d.N = INC; d.k0 = (r / 61) * 64; d.n0 = (r % 61) * 32; d.Bt = W.WB + WB_WIN; d.ldo = 1024; d.mode = 4; return; }
    r -= CV_IN;
    if (r < CV_OUT) { d.W = P->in[16] + (size_t)l * 1024 * 1024; d.N = 1024; d.k0 = (r >> 5) * 64; d.n0 = (r & 31) * 32; d.Bt = W.WB + WB_WOUT; d.ldo = 1024; d.mode = 0; return; }
    r -= CV_OUT;
    if (r < CV_UQ) { d.W = P->in[13] + (size_t)l * 256 * 768; d.N = 768; d.k0 = (r / 24) * 64; d.n0 = (r % 24) * 32; d.Bt = W.WB + WB_WUQ; d.ldo = 256; d.mode = 4; d.ks = P->in[12] + l * 256; return; }
    r -= CV_UQ;
    d.W = P->in[15] + (size_t)l * 128 * 1024; d.N = 1024; d.k0 = (r >> 5) * 64; d.n0 = (r & 31) * 32; d.Bt = W.WB + WB_WUKV; d.ldo = 256; d.mode = 4; d.ks = P->in[14] + l * 128;
}
__device__ __forceinline__ void conv_expert_items(const KP P, const Ws& W, int l, int k0, int gwave, int nwaves, LAS float* scr, int lane) {
    const int itA = gwave + k0 * nwaves, itB = itA + nwaves;
    if (itA >= CV_E) return;
    ConvDesc dA, dB; float vA[32], vB[32];
    conv_decode(P, W, l, itA, dA); conv_load(dA, vA, lane);
    const bool hB = itB < CV_E;
    if (hB) { conv_decode(P, W, l, itB, dB); conv_load(dB, vB, lane); }
    conv_store(dA, vA, scr, lane);
    if (hB) conv_store(dB, vB, scr, lane);
}
__device__ __forceinline__ void phase_convert(const int L_, const int CH_, LAS unsigned char* lds) {
    const KP P = kparams();
    const Ws W(P->ws);
    const int l = L_, tid = tid_opaque(), c = pblk<ID_CONV>(), G = pgrid<ID_CONV>();
    if (c < 0) return;
    const int wave = __builtin_amdgcn_readfirstlane(tid >> 6), lane = tid & 63;
    LAS float* scr = (LAS float*)(lds + wave * 8704);
    {
        const int stride = G * 8;
        int it = CV_E + c * 8 + wave;
        ConvDesc dA, dB; float vA[32], vB[32];
        bool hA = it < CV_ITEMS;
        if (hA) { conv_decode(P, W, l, it, dA); conv_load(dA, vA, lane); }
        while (hA) {
            const int itn = it + stride; const bool hB = itn < CV_ITEMS;
            if (hB) { conv_decode(P, W, l, itn, dB); conv_load(dB, vB, lane); }
            conv_store(dA, vA, scr, lane);
            if (!hB) break;
            it = itn + stride; hA = it < CV_ITEMS;
            if (hA) { conv_decode(P, W, l, it, dA); conv_load(dA, vA, lane); }
            conv_store(dB, vB, scr, lane);
        }
    }
    __syncthreads();
    {
        const int gid = c * NTHREADS + tid, gsz = G * NTHREADS;
        unsigned zz = 0u; asm volatile("" : "+v"(zz));
        const u32x4 z = {zz, zz, zz, zz};
        for (int i = gid; i < 96 * 128; i += gsz) *(u32x4*)(W.WB + WB_WIN + (size_t)conv_drow(1952 + (i >> 7), 4) * 1024 + (size_t)(i & 127) * 8) = z;
        for (int i = gid; i < 1024 * 16; i += gsz) *(u32x4*)(W.WB + WB_WUKV + (size_t)(i >> 4) * 256 + 128 + (i & 15) * 8) = z;
    }
    if (l == 0) {
        LAS float* st = (LAS float*)lds;
        LAS float* red = st + 17 * 1024;
        for (int u = c; u < 192; u += G) {
            const int l2 = u / 96, cg = u % 96;
            for (int i = tid; i < 17 * 1024; i += NTHREADS) { const int r = i >> 10, k = i & 1023; const float v = r < 16 ? P->in[1][r * 1024 + k] : P->in[3][k]; st[i] = v / (1.f + expf(-v)); }
            __syncthreads();
            const float* w = P->in[4] + (size_t)l2 * 1024 * MODW + cg * 64 + lane;
            float a[17];
#pragma unroll
            for (int r = 0; r < 17; ++r) a[r] = 0.f;
            for (int k = wave * 128; k < wave * 128 + 128; ++k) {
                const float wv = w[(size_t)k * MODW];
#pragma unroll
                for (int r = 0; r < 17; ++r) a[r] += st[r * 1024 + k] * wv;
            }
#pragma unroll
            for (int r = 0; r < 17; ++r) red[(wave * 17 + r) * 64 + lane] = a[r];
            __syncthreads();
            for (int i = tid; i < 17 * 64; i += NTHREADS) {
                const int r = i >> 6, col = i & 63; float s = 0.f;
#pragma unroll
                for (int w8 = 0; w8 < 8; ++w8) s += red[(w8 * 17 + r) * 64 + col];
                W.mod[((size_t)l2 * 17 + r) * MODW + cg * 64 + col] = s + P->in[5][l2 * MODW + cg * 64 + col];
            }
            __syncthreads();
        }
        for (int i = c * NTHREADS + tid; i < 2048 * 16; i += G * NTHREADS) { float cs, sn; rope_cs(i >> 4, i & 15, cs, sn); W.rope[2 * i] = cs; W.rope[2 * i + 1] = sn; }
        if (c == G - 1 && wave == 0) {
            for (int l2 = 0; l2 < 2; ++l2) {
                const float* lv = P->in[10] + l2 * 128;
                float a = lane < 32 ? lv[lane] * lv[32 + lane] : 0.f, b = lane < 32 ? lv[64 + lane] * lv[96 + lane] : 0.f;
                a = wave_sum(a); b = wave_sum(b);
                const float li = 0.8f - 0.6f * expf(-0.3f * (float)l2);
                if (lane == 0) W.lam[l2] = expf(a) - expf(b) + li;
            }
        }
    }
}

struct ProbInProj {
    typedef g8::Unit2 Unit; static constexpr int K = 1024;
    __device__ __forceinline__ void a_ready(const Unit&) const {}
    static constexpr bool HAS_DONE = false;
    __device__ __forceinline__ void done(int) const {}
    __device__ __forceinline__ int done_token(const Unit&) const { return -1; }
    g8::DenseOrder ord; const bf16_t* A; const bf16_t* Bt; bf16_t* PB; const float* rope; float* ssq; float* sskv;
    __device__ __forceinline__ bool next(int i, Unit& u) const { return ord.next(i, u); }
    __device__ __forceinline__ const char* a_base() const { return (const char*)A; }
    __device__ __forceinline__ void a_offsets(const Unit& u, const int (&R)[2], const int (&C)[2], unsigned (&o)[2][2]) const {
#pragma unroll
        for (int h = 0; h < 2; ++h)
#pragma unroll
            for (int i = 0; i < 2; ++i) o[h][i] = (unsigned)((u.pm * 256 + h * 128 + R[i]) * K + C[i]) * 2u;
    }
    __device__ __forceinline__ const char* b_ptr(const Unit& u) const { return (const char*)(Bt + (size_t)u.pn * 256 * K); }
    __device__ __forceinline__ void epilogue(const f32x4 (&acc)[2][2][4][2], const Unit& u, int wr, int wc, int fr, int fq) const {
        const int pn = u.pn; const bool lat = u.pm < NLAT / 256;
        const int g = 2 * wc + (fq >> 1);
        const int rowb = u.pm * 256 + wr * 64 + fr, colb = pn * 256 + 32 * g + 8 * (fq & 1);
        const bool want_ss = pn >= 6;
        const bool rp = lat && (pn == 3 || pn == 4 || (pn == 7 && g == 4));
        const bool ss_on = pn == 6 || (pn == 7 && g < 4);
#pragma unroll
        for (int ai = 0; ai < 2; ++ai)
#pragma unroll
            for (int m = 0; m < 4; ++m) {
                const int row = rowb + ai * 128 + m * 16;
                f32x4 x1[2] = {acc[ai][0][m][0], acc[ai][1][m][0]}, x2[2] = {acc[ai][0][m][1], acc[ai][1][m][1]};
                if (rp) {
                    const f32x4* tb = (const f32x4*)(rope + ((size_t)(row & 2047) * 16 + 8 * (fq & 1)) * 2);
#pragma unroll
                    for (int bj = 0; bj < 2; ++bj) {
                        const f32x4 t0 = tb[2 * bj], t1 = tb[2 * bj + 1];
                        const f32x4 cs = {t0[0], t0[2], t1[0], t1[2]}, sn = {t0[1], t0[3], t1[1], t1[3]};
                        const f32x4 o1 = x1[bj] * cs - x2[bj] * sn, o2 = x1[bj] * sn + x2[bj] * cs;
                        x1[bj] = o1; x2[bj] = o2;
                    }
                }
                u32x4 w1, w2;
                w1.x = pk_bf16(x1[0][0], x1[0][1]); w1.y = pk_bf16(x1[0][2], x1[0][3]); w1.z = pk_bf16(x1[1][0], x1[1][1]); w1.w = pk_bf16(x1[1][2], x1[1][3]);
                w2.x = pk_bf16(x2[0][0], x2[0][1]); w2.y = pk_bf16(x2[0][2], x2[0][3]); w2.z = pk_bf16(x2[1][0], x2[1][1]); w2.w = pk_bf16(x2[1][2], x2[1][3]);
                bf16_t* prow = PB + (size_t)row * PBS + colb;
                *(u32x4*)prow = w1; *(u32x4*)(prow + 16) = w2;
                if (want_ss) {
                    float ss = 0.f;
                    if (ss_on) {
#pragma unroll
                        for (int q = 0; q < 4; ++q) {
                            const float a0 = __uint_as_float(w1[q] << 16), a1 = __uint_as_float(w1[q] & 0xffff0000u), b0 = __uint_as_float(w2[q] << 16), b1 = __uint_as_float(w2[q] & 0xffff0000u);
                            ss += a0 * a0 + a1 * a1 + b0 * b0 + b1 * b1;
                        }
                    }
                    ss += __shfl_xor(ss, 16); ss += __shfl_xor(ss, 32);
                    if (fq == 0) (pn == 6 ? ssq : sskv)[(size_t)row * 4 + wc] = ss;
                }
            }
    }
};
__device__ __forceinline__ void phase_inproj(const int L_, const int CH_, LAS unsigned char* lds) {
    const KP P = kparams();
    const Ws W(P->ws);
    if (pblk<ID_INPROJ>() < 0) return;
    ProbInProj pr; pr.ord.init(NTOK / 256, 8, pgrid<ID_INPROJ>(), pblk<ID_INPROJ>());
    pr.A = W.HB; pr.Bt = W.WB + WB_WIN; pr.PB = W.PB; pr.rope = W.rope; pr.ssq = W.ssq; pr.sskv = W.sskv;
    g8::gemm_phase(lds, pr);
}

struct UnitM { int pm, pn, kv; };
struct ProbMla {
    typedef UnitM Unit; static constexpr int K = 256;
    __device__ __forceinline__ void a_ready(const Unit&) const {}
    static constexpr bool HAS_DONE = false;
    __device__ __forceinline__ void done(int) const {}
    __device__ __forceinline__ int done_token(const Unit&) const { return -1; }
    int nq_units, n_units, G, c;
    const bf16_t* PBp; const bf16_t* Wuq; const bf16_t* Wukv; bf16_t* QM; bf16_t* KVM; const float* rope; const float* ssq; const float* sskv;
    __device__ __forceinline__ bool next(int i, Unit& u) const {
        const int L = i * G + c; if (L >= n_units) return false;
        if (L < nq_units) { u.kv = 0; u.pm = L / 3; u.pn = L % 3; } else { const int r = L - nq_units; u.kv = 1; u.pm = r >> 2; u.pn = r & 3; }
        return true;
    }
    __device__ __forceinline__ const char* a_base() const { return (const char*)PBp; }
    __device__ __forceinline__ void a_offsets(const Unit& u, const int (&R)[2], const int (&C)[2], unsigned (&o)[2][2]) const {
        const int cb = u.kv ? O_CKV : O_CQ;
#pragma unroll
        for (int h = 0; h < 2; ++h)
#pragma unroll
            for (int i = 0; i < 2; ++i) o[h][i] = (unsigned)((u.pm * 256 + h * 128 + R[i]) * PBS + cb + C[i]) * 2u;
    }
    __device__ __forceinline__ const char* b_ptr(const Unit& u) const { return (const char*)((u.kv ? Wukv : Wuq) + (size_t)u.pn * 256 * K); }
    __device__ __forceinline__ void epilogue(const f32x4 (&acc)[2][2][4][2], const Unit& u, int wr, int wc, int fr, int fq) const {
        const bool lat = u.pm < NLAT / 256;
        const int g = 2 * wc + (fq >> 1);
        const int rowb = u.pm * 256 + wr * 64 + fr, colb = u.pn * 256 + 32 * g + 8 * (fq & 1);
        const float* ssp = u.kv ? sskv : ssq; const float inv = u.kv ? (1.f / 128.f) : (1.f / 256.f);
        bf16_t* O = u.kv ? KVM : QM; const int ldo = u.kv ? 1024 : 768;
        const bool rp = !u.kv && lat && ((u.pn * 8 + g) % 3) == 2;
        float rs[2][4];
#pragma unroll
        for (int ai = 0; ai < 2; ++ai)
#pragma unroll
            for (int m = 0; m < 4; ++m) { const f32x4 s4 = *(const f32x4*)(ssp + (size_t)(rowb + ai * 128 + m * 16) * 4); rs[ai][m] = rsqrtf((s4[0] + s4[1] + s4[2] + s4[3]) * inv + 1e-6f); }
#pragma unroll
        for (int ai = 0; ai < 2; ++ai)
#pragma unroll
            for (int m = 0; m < 4; ++m) {
                const int row = rowb + ai * 128 + m * 16;
                const float rstd = rs[ai][m];
                f32x4 x1[2] = {acc[ai][0][m][0] * rstd, acc[ai][1][m][0] * rstd}, x2[2] = {acc[ai][0][m][1] * rstd, acc[ai][1][m][1] * rstd};
                if (rp) {
                    const f32x4* tb = (const f32x4*)(rope + ((size_t)(row & 2047) * 16 + 8 * (fq & 1)) * 2);
#pragma unroll
                    for (int bj = 0; bj < 2; ++bj) {
                        const f32x4 t0 = tb[2 * bj], t1 = tb[2 * bj + 1];
                        const f32x4 cs = {t0[0], t0[2], t1[0], t1[2]}, sn = {t0[1], t0[3], t1[1], t1[3]};
                        const f32x4 o1 = x1[bj] * cs - x2[bj] * sn, o2 = x1[bj] * sn + x2[bj] * cs;
                        x1[bj] = o1; x2[bj] = o2;
                    }
                }
                u32x4 w1, w2;
                w1.x = pk_bf16(x1[0][0], x1[0][1]); w1.y = pk_bf16(x1[0][2], x1[0][3]); w1.z = pk_bf16(x1[1][0], x1[1][1]); w1.w = pk_bf16(x1[1][2], x1[1][3]);
                w2.x = pk_bf16(x2[0][0], x2[0][1]); w2.y = pk_bf16(x2[0][2], x2[0][3]); w2.z = pk_bf16(x2[1][0], x2[1][1]); w2.w = pk_bf16(x2[1][2], x2[1][3]);
                bf16_t* prow = O + (size_t)row * ldo + colb;
                *(u32x4*)prow = w1; *(u32x4*)(prow + 16) = w2;
            }
    }
};
__device__ __forceinline__ void phase_mla(const int L_, const int CH_, LAS unsigned char* lds) {
    const KP P = kparams();
    const Ws W(P->ws);
    const int nq = L_ == 0 ? NTOK : NLAT;
    ProbMla pr; pr.nq_units = (nq / 256) * 3; pr.n_units = pr.nq_units + (NTOK / 256) * 4; pr.G = pgrid<ID_MLA>(); pr.c = pblk<ID_MLA>();
    if (pr.c < 0) return;
    pr.PBp = W.PB; pr.Wuq = W.WB + WB_WUQ; pr.Wukv = W.WB + WB_WUKV; pr.QM = W.QM; pr.KVM = W.KVM; pr.rope = W.rope; pr.ssq = W.ssq; pr.sskv = W.sskv;
    g8::gemm_phase(lds, pr);
}

struct ProbOut {
    typedef g8::Unit2 Unit; static constexpr int K = 1024;
    __device__ __forceinline__ void a_ready(const Unit&) const {}
    static constexpr bool HAS_DONE = false;
    __device__ __forceinline__ void done(int) const {}
    __device__ __forceinline__ int done_token(const Unit&) const { return -1; }
    g8::DenseOrder ord; const bf16_t* A; const bf16_t* Bt; bf16_t* XS; const float* x_in; const float* ctx_in; const float* mod_l; int layer;
    __device__ __forceinline__ bool next(int i, Unit& u) const { return ord.next(i, u); }
    __device__ __forceinline__ const char* a_base() const { return (const char*)A; }
    __device__ __forceinline__ void a_offsets(const Unit& u, const int (&R)[2], const int (&C)[2], unsigned (&o)[2][2]) const {
#pragma unroll
        for (int h = 0; h < 2; ++h)
#pragma unroll
            for (int i = 0; i < 2; ++i) o[h][i] = (unsigned)((u.pm * 256 + h * 128 + R[i]) * K + C[i]) * 2u;
    }
    __device__ __forceinline__ const char* b_ptr(const Unit& u) const { return (const char*)(Bt + (size_t)u.pn * 256 * K); }
    template <int LAYER> __device__ __forceinline__ void res_load(f32x4 (&b)[2][2], int row, int colb) const {
        if (LAYER == 0) {
            const float* xi = (row < NLAT ? x_in + (size_t)row * DM : ctx_in + (size_t)(row - NLAT) * DM) + colb;
#pragma unroll
            for (int bj = 0; bj < 2; ++bj)
#pragma unroll
                for (int n = 0; n < 2; ++n) b[bj][n] = *(const f32x4*)(xi + bj * 128 + n * 16);
        } else {
            const bf16_t* xo = XS + (size_t)row * DM + colb;
#pragma unroll
            for (int bj = 0; bj < 2; ++bj)
#pragma unroll
                for (int n = 0; n < 2; ++n) { const u32x2 w = *(const u32x2*)(xo + bj * 128 + n * 16); b[bj][n] = (f32x4){__uint_as_float(w.x << 16), __uint_as_float(w.x & 0xffff0000u), __uint_as_float(w.y << 16), __uint_as_float(w.y & 0xffff0000u)}; }
        }
    }
    template <int LAYER> __device__ __forceinline__ void epi(const f32x4 (&acc)[2][2][4][2], const Unit& u, int wr, int wc, int fr, int fq) const {
        const int r = u.pm < NLAT / 256 ? (u.pm >> 3) : 16;
        const int rowb = u.pm * 256 + wr * 64 + fr, colb = u.pn * 256 + wc * 32 + 4 * fq;
        const float* gate = mod_l + r * MODW + 2 * DM + colb;
        f32x4 gv[2][2];
#pragma unroll
        for (int bj = 0; bj < 2; ++bj)
#pragma unroll
            for (int n = 0; n < 2; ++n) gv[bj][n] = *(const f32x4*)(gate + bj * 128 + n * 16);
        if (LAYER == 1) {
#pragma unroll
            for (int ai = 0; ai < 2; ++ai) {
                u32x2 raw[4][2][2];
#pragma unroll
                for (int m = 0; m < 4; ++m)
#pragma unroll
                    for (int bj = 0; bj < 2; ++bj)
#pragma unroll
                        for (int n = 0; n < 2; ++n) raw[m][bj][n] = *(const u32x2*)(XS + (size_t)(rowb + ai * 128 + m * 16) * DM + colb + bj * 128 + n * 16);
                __builtin_amdgcn_sched_barrier(0);
#pragma unroll
                for (int m = 0; m < 4; ++m) {
                    bf16_t* xo = XS + (size_t)(rowb + ai * 128 + m * 16) * DM + colb;
#pragma unroll
                    for (int bj = 0; bj < 2; ++bj)
#pragma unroll
                        for (int n = 0; n < 2; ++n) {
                            const u32x2 w = raw[m][bj][n];
                            const f32x4 b = {__uint_as_float(w.x << 16), __uint_as_float(w.x & 0xffff0000u), __uint_as_float(w.y << 16), __uint_as_float(w.y & 0xffff0000u)};
                            const f32x4 o = b + gv[bj][n] * acc[ai][bj][m][n];
                            u32x2 ow; ow.x = pk_bf16(o[0], o[1]); ow.y = pk_bf16(o[2], o[3]);
                            *(u32x2*)(xo + bj * 128 + n * 16) = ow;
                        }
                }
                __builtin_amdgcn_sched_barrier(0);
            }
            return;
        }
        f32x4 bc[2][2], bn[2][2];
        res_load<LAYER>(bc, rowb, colb);
#pragma unroll
        for (int g = 0; g < 8; ++g) {
            const int ai = g >> 2, m = g & 3;
            const int row = rowb + ai * 128 + m * 16;
            if (g + 1 < 8) res_load<LAYER>(bn, rowb + ((g + 1) >> 2) * 128 + ((g + 1) & 3) * 16, colb);
            bf16_t* xo = XS + (size_t)row * DM + colb;
#pragma unroll
            for (int bj = 0; bj < 2; ++bj)
#pragma unroll
                for (int n = 0; n < 2; ++n) {
                    const f32x4 o = bc[bj][n] + gv[bj][n] * acc[ai][bj][m][n];
                    u32x2 ow; ow.x = pk_bf16(o[0], o[1]); ow.y = pk_bf16(o[2], o[3]);
                    *(u32x2*)(xo + bj * 128 + n * 16) = ow;
                }
#pragma unroll
            for (int bj = 0; bj < 2; ++bj)
#pragma unroll
                for (int n = 0; n < 2; ++n) bc[bj][n] = bn[bj][n];
        }
    }
    __device__ __forceinline__ void epilogue(const f32x4 (&acc)[2][2][4][2], const Unit& u, int wr, int wc, int fr, int fq) const {
        if (layer == 0) epi<0>(acc, u, wr, wc, fr, fq); else epi<1>(acc, u, wr, wc, fr, fq);
    }
};
__device__ __forceinline__ void phase_outproj(const int L_, const int CH_, LAS unsigned char* lds) {
    const KP P = kparams();
    const Ws W(P->ws);
    const int nq = L_ == 0 ? NTOK : NLAT;
    if (pblk<ID_OUTPROJ>() < 0) return;
    ProbOut pr; pr.ord.init(nq / 256, 4, pgrid<ID_OUTPROJ>(), pblk<ID_OUTPROJ>());
    pr.A = W.HB; pr.Bt = W.WB + WB_WOUT; pr.XS = W.XS; pr.x_in = P->in[0]; pr.ctx_in = P->in[2]; pr.mod_l = W.mod + (size_t)L_ * 17 * MODW; pr.layer = L_;
    g8::gemm_phase(lds, pr);
}

constexpr int NCHUNK = 2;
constexpr int CAPC = NTOK / NCHUNK;
constexpr size_t WS_LIST2 = WS_PB;
constexpr size_t WS_ACT = WS_PB + 18 * MiB;
constexpr size_t WS_Y = WS_PB + 108 * MiB;
constexpr size_t ACT_BYTES = 90 * MiB;
static_assert(WS_Y + (size_t)CAPC * 9 * 1024 <= WS_WB && (size_t)(CAPC * 9 + 65 * 255 + 256) * 512 <= ACT_BYTES, "MoE overlay fits");
constexpr int CW_CNT = 8192, CNT_STRIDE = 64;
constexpr int CW_RT = 32768;
constexpr size_t CTL_ZERO_BYTES = (size_t)(CW_RT + 2 * NCHUNK * 1024 * 16) * 4;
constexpr float Y_SCALE = 8.f;
constexpr int LDS_TAB = 131072;

typedef float f32x16 __attribute__((ext_vector_type(16)));
template <int CTRL> __device__ __forceinline__ float dppf(float v) { return __int_as_float(__builtin_amdgcn_update_dpp(0, __float_as_int(v), CTRL, 0xf, 0xf, true)); }
template <int CTRL> __device__ __forceinline__ int dppi(int v) { return __builtin_amdgcn_update_dpp(0, v, CTRL, 0xf, 0xf, true); }
__device__ __forceinline__ float gmax8f(float x) { x = fmaxf(x, dppf<0xB1>(x)); x = fmaxf(x, dppf<0x4E>(x)); return fmaxf(x, dppf<0x141>(x)); }
__device__ __forceinline__ int gmin8i(int x) { x = min(x, dppi<0xB1>(x)); x = min(x, dppi<0x4E>(x)); return min(x, dppi<0x141>(x)); }
__device__ __forceinline__ unsigned wmaxu(unsigned x) {
    x = max(x, (unsigned)dppi<0xB1>((int)x)); x = max(x, (unsigned)dppi<0x4E>((int)x)); x = max(x, (unsigned)dppi<0x141>((int)x)); x = max(x, (unsigned)dppi<0x140>((int)x));
    const unsigned a = (unsigned)__builtin_amdgcn_readlane((int)x, 0), b = (unsigned)__builtin_amdgcn_readlane((int)x, 16), c = (unsigned)__builtin_amdgcn_readlane((int)x, 32), d = (unsigned)__builtin_amdgcn_readlane((int)x, 48);
    return max(max(a, b), max(c, d));
}
__device__ __forceinline__ float wsumf(float x) {
    x += dppf<0xB1>(x); x += dppf<0x4E>(x); x += dppf<0x141>(x); x += dppf<0x140>(x);
    const float a = __int_as_float(__builtin_amdgcn_readlane(__float_as_int(x), 0)), b = __int_as_float(__builtin_amdgcn_readlane(__float_as_int(x), 16));
    const float c = __int_as_float(__builtin_amdgcn_readlane(__float_as_int(x), 32)), d = __int_as_float(__builtin_amdgcn_readlane(__float_as_int(x), 48));
    return (a + b) + (c + d);
}
#define N2_BAR() do { asm volatile("s_waitcnt lgkmcnt(0)" ::: "memory"); __builtin_amdgcn_s_barrier(); asm volatile("" ::: "memory"); } while (0)
__device__ __forceinline__ void phase_norm2(const int L_, const int CH_, LAS unsigned char* lds) {
    const KP P = kparams();
    const Ws W(P->ws);
    const int l = L_, tid = tid_opaque(), wave = __builtin_amdgcn_readfirstlane(tid >> 6), lane = tid & 63, G = pgrid<ID_NORM2>(), c = pblk<ID_NORM2>();
    if (c < 0) return;
    const int nq = l == 0 ? NTOK : NLAT, csz = nq / NCHUNK, nunits = nq / 32;
    const float* mod_l = W.mod + (size_t)l * 17 * MODW;
    const float* gn = P->in[7] + l * DM;
    const float* rw = P->in[17] + (size_t)l * DM * NEXP;
    const float* rb = P->in[18] + l * NEXP;
    int* cnt = (int*)(W.ctl + CW_CNT) + L_ * NCHUNK * 64 * CNT_STRIDE;
    uint2* list = (uint2*)(P->ws + WS_LIST2);
    constexpr int AST = 1028;
    LAS float* At = (LAS float*)lds;
    constexpr int NRES = 48;
    float Br[NRES][2];
    const float* rwl = rw + (size_t)(128 * wave + 4 * (lane >> 5)) * NEXP + (lane & 31);
#pragma unroll
    for (int p = 0; p < NRES; ++p)
#pragma unroll
        for (int n = 0; n < 2; ++n) Br[p][n] = rwl[(8 * (p >> 2) + (p & 3)) * NEXP + n * 32];
    const float rbe = rb[lane];
    u32x2 nx[4][4];
    int u = c;
    if (u < nunits) {
#pragma unroll
        for (int j = 0; j < 4; ++j)
#pragma unroll
            for (int q = 0; q < 4; ++q) nx[j][q] = *(const u32x2*)(W.XS + (size_t)(u * 32 + wave * 4 + j) * DM + 256 * q + lane * 4);
    }
    for (; u < nunits; u += G) {
        const int t0 = u * 32, r = mod_row(t0);
        {
            const float* sh = mod_l + r * MODW + 3 * DM; const float* sc = mod_l + r * MODW + 4 * DM;
            float rstd[4];
#pragma unroll
            for (int j = 0; j < 4; ++j) {
                float ss = 0.f;
#pragma unroll
                for (int q = 0; q < 4; ++q) { const u32x2 w = nx[j][q];
                    const float a0 = __uint_as_float(w.x << 16), a1 = __uint_as_float(w.x & 0xffff0000u), a2 = __uint_as_float(w.y << 16), a3 = __uint_as_float(w.y & 0xffff0000u); ss += a0 * a0 + a1 * a1 + a2 * a2 + a3 * a3; }
                rstd[j] = rsqrtf(wsumf(ss) * (1.f / DM) + 1e-6f);
            }
#pragma unroll
            for (int q = 0; q < 4; ++q) {
                const int col = 256 * q + lane * 4;
                __builtin_amdgcn_sched_barrier(0);
                const f32x4 ga = *(const f32x4*)(gn + col) * (*(const f32x4*)(sc + col) + 1.f), hb = *(const f32x4*)(sh + col);
#pragma unroll
                for (int j = 0; j < 4; ++j) {
                    const int tl = wave * 4 + j, t = t0 + tl;
                    const u32x2 w = nx[j][q];
                    const f32x4 v = {__uint_as_float(w.x << 16), __uint_as_float(w.x & 0xffff0000u), __uint_as_float(w.y << 16), __uint_as_float(w.y & 0xffff0000u)};
                    const f32x4 o = v * rstd[j] * ga + hb;
                    u32x2 ow; ow.x = pk_bf16(o[0], o[1]); ow.y = pk_bf16(o[2], o[3]);
                    *(u32x2*)(W.HB + (size_t)t * DM + col) = ow;
                    *(LAS f32x4*)(At + tl * AST + col) = o;
                }
            }
        }
        if (u + G < nunits) {
#pragma unroll
            for (int j = 0; j < 4; ++j)
#pragma unroll
                for (int q = 0; q < 4; ++q) nx[j][q] = *(const u32x2*)(W.XS + (size_t)((u + G) * 32 + wave * 4 + j) * DM + 256 * q + lane * 4);
        }
        float Bs[64 - NRES][2];
        {
            const float* rws = rwl; asm volatile("" : "+v"(rws));
#pragma unroll
            for (int p = NRES; p < 64; ++p)
#pragma unroll
                for (int n = 0; n < 2; ++n) Bs[p - NRES][n] = rws[(8 * (p >> 2) + (p & 3)) * NEXP + n * 32];
        }
        N2_BAR();
        f32x16 acc0, acc1;
#pragma unroll
        for (int i = 0; i < 16; ++i) { acc0[i] = 0.f; acc1[i] = 0.f; }
        const LAS float* arow = At + (lane & 31) * AST + 128 * wave + 4 * (lane >> 5);
#pragma unroll
        for (int i = 0; i < 16; ++i) {
            const f32x4 a4 = *(const LAS f32x4*)(arow + 8 * i);
#pragma unroll
            for (int s = 0; s < 4; ++s) {
                const int p = 4 * i + s;
                acc0 = __builtin_amdgcn_mfma_f32_32x32x2f32(a4[s], p < NRES ? Br[p < NRES ? p : 0][0] : Bs[p < NRES ? 0 : p - NRES][0], acc0, 0, 0, 0);
                acc1 = __builtin_amdgcn_mfma_f32_32x32x2f32(a4[s], p < NRES ? Br[p < NRES ? p : 0][1] : Bs[p < NRES ? 0 : p - NRES][1], acc1, 0, 0, 0);
            }
        }
        N2_BAR();
        LAS float* part = At;
#pragma unroll
        for (int i = 0; i < 16; ++i) {
            const int tok = (i & 3) + 8 * (i >> 2) + 4 * (lane >> 5);
            part[(wave * 32 + tok) * 64 + (lane & 31)] = acc0[i];
            part[(wave * 32 + tok) * 64 + 32 + (lane & 31)] = acc1[i];
        }
        N2_BAR();
        int slot_[4]; float w_[4]; int rk_[4];
#pragma unroll
        for (int j = 0; j < 4; ++j) {
            const int tl = wave * 4 + j, t = t0 + tl, e = lane;
            float lg = 0.f;
#pragma unroll
            for (int w8 = 0; w8 < 8; ++w8) lg += part[(w8 * 32 + tl) * 64 + e];
            const float sc = __builtin_amdgcn_rcpf(1.f + __expf(-lg));
            const float sel = sc + rbe;
            const float m1 = gmax8f(sel);
            const int cand = gmin8i((sel == m1) ? (e & 7) : 8);
            const float m2 = gmax8f(((e & 7) == cand) ? -INFINITY : sel);
            const float grp = m1 + m2;
            const int g = e >> 3;
            int grank = 0;
#pragma unroll
            for (int gg = 0; gg < 8; ++gg) { const float og = __int_as_float(__builtin_amdgcn_readlane(__float_as_int(grp), gg * 8)); grank += (og > grp || (og == grp && gg < g)) ? 1 : 0; }
            const bool gsel = grank < 4;
            const unsigned sb = __float_as_uint(sel);
            unsigned key = gsel ? (sb ^ ((sb >> 31) ? 0xffffffffu : 0x80000000u)) : 0u;
            int rk = 8;
#pragma unroll
            for (int k = 0; k < 8; ++k) {
                const unsigned M = wmaxu(key);
                const unsigned long long bal = __ballot(key == M);
                const int idx = __builtin_ctzll(bal);
                if (e == idx) { rk = k; key = 0u; }
            }
            const bool chosen = rk < 8;
            const float wsum = wsumf(chosen ? sc : 0.f);
            w_[j] = sc / wsum * 2.5f; rk_[j] = rk; slot_[j] = 0;
            if (chosen) slot_[j] = atomicAdd(&cnt[((t / csz) * 64 + e) * CNT_STRIDE], 1);
        }
#pragma unroll
        for (int j = 0; j < 4; ++j) {
            const int t = t0 + wave * 4 + j;
            if (rk_[j] < 8) list[((size_t)(t / csz) * 64 + lane) * CAPC + slot_[j]] = make_uint2((unsigned)(t * 8 + rk_[j]), __float_as_uint(w_[j]));
        }
        N2_BAR();
    }
}
#undef N2_BAR

struct UnitG { int e, t, pn, cnt, pb; };
struct MoeTab {
    const LAS int* cnts; const LAS int* pre;
    const LAS int* xpre; int ntiles, xl, x, nb, j, nseg, st0, xtiles;
    __device__ __forceinline__ void locate(int rtl, int& e, int& t) const {
        int sg = 0; while (xpre[sg + 1] <= rtl) ++sg;
        t = rtl - xpre[sg];
        if (sg < nseg - 1) e = x + xl * sg; else { e = 64; t += st0; }
    }
};
__device__ __forceinline__ MoeTab moe_table(const KP P, const int L_, LAS unsigned char* lds, int ch, int csz) {
    const Ws W(P->ws);
    LAS int* cnts = (LAS int*)(lds + LDS_TAB); LAS int* pre = cnts + 80; LAS int* xpre = pre + 80;
    const int tid = tid_opaque();
    const int G = pgrid<ID_MOE>(), c = pblk<ID_MOE>();
    MoeTab T; T.cnts = cnts; T.pre = pre; T.xpre = xpre;
    if ((G & 7) == 0) { T.xl = 8; T.x = c & 7; T.nb = G >> 3; T.j = c >> 3; } else { T.xl = 1; T.x = 0; T.nb = G; T.j = c; }
    T.nseg = 64 / T.xl + 1;
    if (tid < 64) cnts[tid] = (int)__hip_atomic_load(W.ctl + CW_CNT + ((L_ * NCHUNK + ch) * 64 + tid) * CNT_STRIDE, __ATOMIC_RELAXED, __HIP_MEMORY_SCOPE_AGENT);
    if (tid == 64) cnts[64] = csz;
    __syncthreads();
    const int stiles = (csz + 255) >> 8, sper = (stiles + T.xl - 1) / T.xl;
    T.st0 = T.x * sper;
    if (tid == 0) {
        int s = 0; for (int e = 0; e < 65; ++e) { pre[e] = s; s += (cnts[e] + 255) >> 8; } pre[65] = s;
        int q = 0;
        for (int sg = 0; sg < T.nseg - 1; ++sg) { xpre[sg] = q; q += (cnts[T.x + T.xl * sg] + 255) >> 8; }
        xpre[T.nseg - 1] = q; { int n = stiles - T.st0; n = n < 0 ? 0 : (n > sper ? sper : n); q += n; }
        xpre[T.nseg] = q;
    }
    __syncthreads();
    T.ntiles = pre[65]; T.xtiles = xpre[T.nseg];
    return T;
}
struct ProbMoe1 {
    typedef UnitG Unit; static constexpr int K = 1024;
    int G, c, chunk_base; MoeTab T;
    const uint2* list; const bf16_t* HB; const bf16_t* Wgu; __amdgpu_buffer_rsrc_t act_rs; unsigned* rtcnt;
    __device__ __forceinline__ bool next(int i, Unit& u) const {
        const int L = i * T.nb + T.j; if (L >= 2 * T.xtiles) return false;
        u.pn = L & 1;
        int e, t; T.locate(L >> 1, e, t);
        e = __builtin_amdgcn_readfirstlane(e); t = __builtin_amdgcn_readfirstlane(t);
        u.e = e; u.t = t; u.cnt = __builtin_amdgcn_readfirstlane(T.cnts[e]); u.pb = __builtin_amdgcn_readfirstlane((T.pre[e] + t) * 256); return true;
    }
    __device__ __forceinline__ void a_ready(const Unit&) const {}
    static constexpr bool HAS_DONE = true;
    __device__ __forceinline__ int done_token(const Unit& u) const { return __builtin_amdgcn_readfirstlane(u.pb >> 8); }
    __device__ __forceinline__ void done(int rt) const {
        if ((threadIdx.x & 63) == 0) (void)__hip_atomic_fetch_add(rtcnt + 16 * rt, 1u, __ATOMIC_RELAXED, __HIP_MEMORY_SCOPE_AGENT);
    }
    __device__ __forceinline__ const char* a_base() const { return (const char*)HB; }
    __device__ __forceinline__ void a_offsets(const Unit& u, const int (&R)[2], const int (&C)[2], unsigned (&o)[2][2]) const {
#pragma unroll
        for (int h = 0; h < 2; ++h)
#pragma unroll
            for (int i = 0; i < 2; ++i) {
                const int slot = u.t * 256 + h * 128 + R[i]; int tok = 0;
                if (slot < u.cnt) tok = u.e < 64 ? (int)(list[(size_t)u.e * CAPC + slot].x >> 3) : chunk_base + slot;
                o[h][i] = (unsigned)tok * 2048u + (unsigned)C[i] * 2u;
            }
    }
    __device__ __forceinline__ const char* b_ptr(const Unit& u) const { return (const char*)(Wgu + (size_t)u.e * 524288 + (size_t)u.pn * 256 * K); }
    __device__ __forceinline__ void epilogue(const f32x4 (&acc)[2][2][4][2], const Unit& u, int wr, int wc, int fr, int fq) const {
        float wv[2][4];
#pragma unroll
        for (int ai = 0; ai < 2; ++ai)
#pragma unroll
            for (int m = 0; m < 4; ++m) {
                const int slot = u.t * 256 + ai * 128 + wr * 64 + m * 16 + fr;
                wv[ai][m] = 0.f;
                if (slot < u.cnt) wv[ai][m] = u.e < 64 ? __uint_as_float(list[(size_t)u.e * CAPC + slot].y) : 1.f;
            }
#pragma unroll
        for (int ai = 0; ai < 2; ++ai)
#pragma unroll
            for (int m = 0; m < 4; ++m) {
                const int rl = ai * 128 + wr * 64 + m * 16 + fr;
                const float w = wv[ai][m];
                float a[8];
#pragma unroll
                for (int bj = 0; bj < 2; ++bj) {
                    const f32x4 g = acc[ai][bj][m][0], up = acc[ai][bj][m][1];
#pragma unroll
                    for (int j = 0; j < 4; ++j) a[4 * bj + j] = g[j] * __builtin_amdgcn_rcpf(1.f + __expf(-g[j])) * up[j] * w;
                }
                u32x4 o; o.x = pk_bf16(a[0], a[1]); o.y = pk_bf16(a[2], a[3]); o.z = pk_bf16(a[4], a[5]); o.w = pk_bf16(a[6], a[7]);
                __builtin_amdgcn_raw_buffer_store_b128(o, act_rs, (int)(((unsigned)(u.pb + rl) * 256u + 128u * u.pn + 32u * wc + 8u * fq) * 2u), 0, 16);
            }
    }
};
struct MoeDown {
    int G, c, chunk_base, shift; MoeTab T;
    const uint2* list; const bf16_t* act; const bf16_t* Wd; unsigned char* ws; unsigned junk; unsigned* rtcnt; unsigned* tmo;
};
__device__ __forceinline__ void moe_down_phase(LAS unsigned char* lds, const MoeDown& D) {
    const int tid = tid_opaque(), wave = __builtin_amdgcn_readfirstlane(tid >> 6), lane = tid & 63, fr = lane & 15, fq = lane >> 4;
    const int jblk = (D.T.j - D.shift + D.T.nb) % D.T.nb;
    unsigned goff[4];
#pragma unroll
    for (int i = 0; i < 4; ++i) { const int row = 2 * (4 * wave + i) + (lane >> 5), p = lane & 31; goff[i] = (unsigned)(row * 256 + ((p ^ (row & 15)) * 8)) * 2u; }
    const unsigned ldsw = (unsigned)wave * 4096u;
    for (int rtl = jblk; rtl < D.T.xtiles; rtl += D.T.nb) {
        int e, t_in; D.T.locate(rtl, e, t_in);
        e = __builtin_amdgcn_readfirstlane(e); t_in = __builtin_amdgcn_readfirstlane(t_in);
        const int rt = __builtin_amdgcn_readfirstlane(D.T.pre[e] + t_in), cnt = __builtin_amdgcn_readfirstlane(D.T.cnts[e]), pb = rt * 256;
        if (tid < 64) {
            unsigned* w = D.rtcnt + 16 * rt; unsigned sp = 0u;
            while ((unsigned)__builtin_amdgcn_readfirstlane(__hip_atomic_load(w, __ATOMIC_RELAXED, __HIP_MEMORY_SCOPE_AGENT)) < 16u) {
                __builtin_amdgcn_s_sleep(2);
                if ((++sp & 255u) == 0u) { if (__hip_atomic_load(D.tmo, __ATOMIC_RELAXED, __HIP_MEMORY_SCOPE_AGENT)) break; if (sp > (1u << 20)) { atomicAdd(D.tmo, 1u); break; } }
            }
            __builtin_amdgcn_fence(__ATOMIC_ACQUIRE, "agent");
            asm volatile("s_waitcnt vmcnt(0)" ::: "memory");
        }
        __syncthreads();
        bf16x8 af[2][8];
#pragma unroll
        for (int m = 0; m < 2; ++m)
#pragma unroll
            for (int ks = 0; ks < 8; ++ks) af[m][ks] = *(const bf16x8*)(D.act + (size_t)(pb + 32 * wave + 16 * m + fr) * 256 + 32 * ks + 8 * fq);
        unsigned yo[2];
#pragma unroll
        for (int m = 0; m < 2; ++m) {
            const int slot = t_in * 256 + 32 * wave + 16 * m + fr;
            yo[m] = D.junk;
            if (slot < cnt) {
                if (e < 64) { const unsigned x = D.list[(size_t)e * CAPC + slot].x; yo[m] = (unsigned)WS_Y + (unsigned)(((int)(x >> 3) - D.chunk_base) * 9 + (int)(x & 7u)) * 1024u; }
                else yo[m] = (unsigned)WS_Y + (unsigned)(slot * 9 + 8) * 1024u;
            }
        }
        const char* wb = (const char*)(D.Wd + (size_t)e * 262144);
#define MD_ISSUE(ch) do { _Pragma("unroll") for (int i = 0; i < 4; ++i) \
        __builtin_amdgcn_global_load_lds((const unsigned*)(wb + (size_t)(ch) * 32768 + goff[i]), (LAS unsigned*)(lds + ((ch) & 3) * 32768 + ldsw + i * 1024), 16, 0, 0); } while (0)
        MD_ISSUE(0); MD_ISSUE(1); MD_ISSUE(2);
#pragma unroll 1
        for (int ch = 0; ch < 16; ++ch) {
            if (ch >= 3 && ch < 14) asm volatile("s_waitcnt vmcnt(14)" ::: "memory");
            else if (ch < 3) asm volatile("s_waitcnt vmcnt(8)" ::: "memory");
            else asm volatile("s_waitcnt vmcnt(6)" ::: "memory");
            __builtin_amdgcn_s_barrier();
            asm volatile("" ::: "memory");
            if (ch + 3 < 16) MD_ISSUE(ch + 3);
            f32x4 acc[2][4];
#pragma unroll
            for (int m = 0; m < 2; ++m)
#pragma unroll
                for (int n = 0; n < 4; ++n) acc[m][n] = (f32x4){0.f, 0.f, 0.f, 0.f};
            const LAS unsigned char* bb = lds + (ch & 3) * 32768 + fr * 512;
            bf16x8 bq[3][4];
#pragma unroll
            for (int n = 0; n < 4; ++n) { bq[0][n] = *(const LAS bf16x8*)(bb + n * 8192 + ((fq ^ fr) * 16)); bq[1][n] = *(const LAS bf16x8*)(bb + n * 8192 + (((4 + fq) ^ fr) * 16)); }
#pragma unroll
            for (int ks = 0; ks < 8; ++ks) {
                __builtin_amdgcn_s_waitcnt(0xC07F);
                if (ks + 2 < 8) {
#pragma unroll
                    for (int n = 0; n < 4; ++n) bq[(ks + 2) % 3][n] = *(const LAS bf16x8*)(bb + n * 8192 + (((4 * (ks + 2) + fq) ^ fr) * 16));
                }
                __builtin_amdgcn_sched_barrier(0);
#pragma unroll
                for (int n = 0; n < 4; ++n) {
                    acc[0][n] = __builtin_amdgcn_mfma_f32_16x16x32_bf16(bq[ks % 3][n], af[0][ks], acc[0][n], 0, 0, 0);
                    acc[1][n] = __builtin_amdgcn_mfma_f32_16x16x32_bf16(bq[ks % 3][n], af[1][ks], acc[1][n], 0, 0, 0);
                }
                __builtin_amdgcn_sched_barrier(0);
            }
            asm volatile("s_waitcnt lgkmcnt(0)" ::: "memory");
#pragma unroll
            for (int m = 0; m < 2; ++m) {
                {
                    u32x4 o; int w;
#pragma unroll
                    for (int n = 0; n < 4; ++n) {
                        f32x4 v = acc[m][n] * Y_SCALE;
#pragma unroll
                        for (int q = 0; q < 4; ++q) v[q] = __builtin_amdgcn_fmed3f(v[q], -440.f, 440.f);
                        w = __builtin_amdgcn_cvt_pk_fp8_f32(v[0], v[1], 0, false); w = __builtin_amdgcn_cvt_pk_fp8_f32(v[2], v[3], w, true); o[n] = (unsigned)w;
                    }
                    *(u32x4*)(D.ws + yo[m] + 64 * ch + 16 * fq) = o;
                }
            }
        }
        asm volatile("s_waitcnt vmcnt(0)" ::: "memory");
        __syncthreads();
#undef MD_ISSUE
    }
}
__device__ __forceinline__ void phase_moe(const int L_, const int CH_, LAS unsigned char* lds) {
    const KP P = kparams();
    const Ws W(P->ws);
    const int nq = L_ == 0 ? NTOK : NLAT, csz = nq / NCHUNK, ch = CH_;
    unsigned* rtcnt = W.ctl + CW_RT + (size_t)(L_ * NCHUNK + ch) * 1024 * 16;
    if (pblk<ID_MOE>() < 0) return;
    const MoeTab T = moe_table(P, L_, lds, ch, csz);
    {
        ProbMoe1 pr; pr.G = pgrid<ID_MOE>(); pr.c = pblk<ID_MOE>(); pr.chunk_base = ch * csz; pr.T = T;
        pr.list = (const uint2*)(P->ws + WS_LIST2) + (size_t)ch * 64 * CAPC; pr.HB = W.HB; pr.Wgu = W.WB + WB_WGU;
        pr.act_rs = __builtin_amdgcn_make_buffer_rsrc((void*)(P->ws + WS_ACT), 0, (int)ACT_BYTES, 0x00020000); pr.rtcnt = rtcnt;
        g8::gemm_phase(lds, pr);
    }
    {
        MoeDown D; D.G = pgrid<ID_MOE>(); D.c = pblk<ID_MOE>(); D.chunk_base = ch * csz; D.shift = (2 * T.xtiles) % T.nb; D.T = T;
        D.list = (const uint2*)(P->ws + WS_LIST2) + (size_t)ch * 64 * CAPC; D.act = (const bf16_t*)(P->ws + WS_ACT); D.Wd = W.WB + WB_WD;
        D.ws = P->ws; D.junk = (unsigned)WS_JUNK + (unsigned)pblk<ID_MOE>() * 1024u; D.rtcnt = rtcnt; D.tmo = W.ctl + 128;
        moe_down_phase(lds, D);
    }
}
__device__ __forceinline__ void phase_comb(const int L_, const int CH_, LAS unsigned char* lds) {
    const KP P = kparams();
    const Ws W(P->ws);
    const int nq = L_ == 0 ? NTOK : NLAT, csz = nq / NCHUNK, ch = CH_, base = ch * csz;
    const int tid = tid_opaque(), wave = tid >> 6, lane = tid & 63;
    const float* mod_l = W.mod + (size_t)L_ * 17 * MODW;
    const float* mod_n = W.mod + (size_t)17 * MODW;
    const float* gn1 = P->in[6] + DM;
    const float* fg = P->in[25];
    const unsigned char* Y = (const unsigned char*)(P->ws + WS_Y);
    const int col = lane * 16;
    if (pblk<ID_COMB>() < 0) return;
    for (int tl = pblk<ID_COMB>() * 8 + wave; tl < csz; tl += pgrid<ID_COMB>() * 8) {
        const int t = base + tl, r = mod_row(t);
        const float* g2 = mod_l + r * MODW + 5 * DM + col;
        bf16_t* xr = W.XS + (size_t)t * DM + col;
        float s[16];
#pragma unroll
        for (int i = 0; i < 16; ++i) s[i] = 0.f;
#pragma unroll
        for (int k = 0; k < 9; ++k) {
            const u32x4 v = *(const u32x4*)(Y + ((size_t)tl * 9 + k) * 1024 + col);
            const unsigned wv[4] = {v.x, v.y, v.z, v.w};
#pragma unroll
            for (int q = 0; q < 4; ++q) {
                const f32x2 lo = __builtin_amdgcn_cvt_pk_f32_fp8((int)wv[q], false), hi = __builtin_amdgcn_cvt_pk_f32_fp8((int)wv[q], true);
                s[4 * q] += lo[0]; s[4 * q + 1] += lo[1]; s[4 * q + 2] += hi[0]; s[4 * q + 3] += hi[1];
            }
        }
        f32x4 xn[4]; float ss = 0.f;
        const u32x4 xw0 = *(const u32x4*)xr, xw1 = *(const u32x4*)(xr + 8);
        const unsigned xw[8] = {xw0.x, xw0.y, xw0.z, xw0.w, xw1.x, xw1.y, xw1.z, xw1.w};
        u32x4 xo[2];
#pragma unroll
        for (int q = 0; q < 4; ++q) {
            const f32x4 x = {__uint_as_float(xw[2 * q] << 16), __uint_as_float(xw[2 * q] & 0xffff0000u), __uint_as_float(xw[2 * q + 1] << 16), __uint_as_float(xw[2 * q + 1] & 0xffff0000u)};
            const f32x4 g = *(const f32x4*)(g2 + 4 * q);
            const f32x4 sv = {s[4 * q], s[4 * q + 1], s[4 * q + 2], s[4 * q + 3]};
            xn[q] = x + g * sv * (1.f / Y_SCALE);
            ss += xn[q][0] * xn[q][0] + xn[q][1] * xn[q][1] + xn[q][2] * xn[q][2] + xn[q][3] * xn[q][3];
            xo[q >> 1][2 * (q & 1)] = pk_bf16(xn[q][0], xn[q][1]); xo[q >> 1][2 * (q & 1) + 1] = pk_bf16(xn[q][2], xn[q][3]);
        }
        if (L_ == 0) { *(u32x4*)xr = xo[0]; *(u32x4*)(xr + 8) = xo[1]; }
        ss = wave_sum(ss);
        const float rstd = rsqrtf(ss * (1.f / DM) + 1e-6f);
        if (L_ == 0) {
            const float* sh = mod_n + r * MODW + col; const float* sc = mod_n + r * MODW + DM + col;
            u32x4 o[2];
#pragma unroll
            for (int q = 0; q < 4; ++q) {
                const f32x4 g4 = *(const f32x4*)(gn1 + col + 4 * q), s4 = *(const f32x4*)(sc + 4 * q), h4 = *(const f32x4*)(sh + 4 * q);
                const f32x4 ov = xn[q] * rstd * g4 * (s4 + 1.f) + h4;
                o[q >> 1][2 * (q & 1)] = pk_bf16(ov[0], ov[1]); o[q >> 1][2 * (q & 1) + 1] = pk_bf16(ov[2], ov[3]);
            }
            *(u32x4*)(W.HB + (size_t)t * DM + col) = o[0]; *(u32x4*)(W.HB + (size_t)t * DM + col + 8) = o[1];
        } else {
#pragma unroll
            for (int q = 0; q < 4; ++q) {
                const f32x4 g4 = *(const f32x4*)(fg + col + 4 * q);
                *(f32x4*)(P->out + (size_t)t * DM + col + 4 * q) = xn[q] * rstd * g4;
            }
        }
    }
}

__device__ __forceinline__ void phase_norm1(const int L_, const int CH_, LAS unsigned char* lds) {
    const KP P = kparams();
    const Ws W(P->ws);
    const int l = L_, tid = tid_opaque(), wave = tid >> 6, lane = tid & 63;
    const float* mod_l = W.mod + (size_t)l * 17 * MODW;
    const float* gn = P->in[6] + l * DM;
    if (pblk<ID_NORM1>() < 0) return;
    for (int t = pblk<ID_NORM1>() * 8 + wave; t < NTOK; t += pgrid<ID_NORM1>() * 8) {
        const int r = mod_row(t);
        const float* xr = t < NLAT ? P->in[0] + (size_t)t * DM : P->in[2] + (size_t)(t - NLAT) * DM;
        const float* sh = mod_l + r * MODW; const float* sc = mod_l + r * MODW + DM;
        f32x4 v[4]; float ss = 0.f;
#pragma unroll
        for (int q = 0; q < 4; ++q) { v[q] = *(const f32x4*)(xr + 256 * q + lane * 4); ss += v[q][0] * v[q][0] + v[q][1] * v[q][1] + v[q][2] * v[q][2] + v[q][3] * v[q][3]; }
        ss = wave_sum(ss);
        const float rstd = rsqrtf(ss * (1.f / DM) + 1e-6f);
#pragma unroll
        for (int q = 0; q < 4; ++q) {
            const int col = 256 * q + lane * 4;
            const f32x4 g4 = *(const f32x4*)(gn + col), s4 = *(const f32x4*)(sc + col), h4 = *(const f32x4*)(sh + col);
            const f32x4 o = v[q] * rstd * g4 * (s4 + 1.f) + h4;
            u32x2 w; w.x = pk_bf16(o[0], o[1]); w.y = pk_bf16(o[2], o[3]);
            *(u32x2*)(W.HB + (size_t)t * DM + col) = w;
        }
    }
}

typedef short v4i16_t __attribute__((ext_vector_type(4)));
__device__ __forceinline__ bf16x8 pack8(float a0, float a1, float a2, float a3, float a4, float a5, float a6, float a7) {
    u32x4 w; w.x = pk_bf16(a0, a1); w.y = pk_bf16(a2, a3); w.z = pk_bf16(a4, a5); w.w = pk_bf16(a6, a7); return __builtin_bit_cast(bf16x8, w);
}
__device__ __forceinline__ float max3f_w(float a, float b, float c) { float r; asm volatile("s_nop 7\n\ts_nop 7\n\ts_nop 3\n\tv_max3_f32 %0, %1, %2, %3" : "=v"(r) : "v"(a), "v"(b), "v"(c)); return r; }
__device__ __forceinline__ float max3f(float a, float b, float c) { float r; asm volatile("v_max3_f32 %0, %1, %2, %3" : "=v"(r) : "v"(a), "v"(b), "v"(c)); return r; }
__device__ __forceinline__ float max32(const f32x16& a, const f32x16& b) {
    float m0 = max3f_w(a[0], a[1], a[2]);
    float m1 = max3f_w(b[0], b[1], b[2]);
    m0 = max3f(m0, a[3], a[4]); m1 = max3f(m1, b[3], b[4]); m0 = max3f(m0, a[5], a[6]); m1 = max3f(m1, b[5], b[6]);
    m0 = max3f(m0, a[7], a[8]); m1 = max3f(m1, b[7], b[8]); m0 = max3f(m0, a[9], a[10]); m1 = max3f(m1, b[9], b[10]);
    m0 = max3f(m0, a[11], a[12]); m1 = max3f(m1, b[11], b[12]); m0 = max3f(m0, a[13], a[14]); m1 = max3f(m1, b[13], b[14]);
    return max3f(m0, m1, fmaxf(a[15], b[15]));
}
__device__ __forceinline__ bf16x8 scale8(bf16x8 v, float c) {
    u32x4 w = __builtin_bit_cast(u32x4, v);
#pragma unroll
    for (int i = 0; i < 4; ++i) w[i] = pk_bf16(__uint_as_float(w[i] << 16) * c, __uint_as_float(w[i] & 0xffff0000u) * c);
    return __builtin_bit_cast(bf16x8, w);
}
constexpr int AT_KBUF = 64 * 208, AT_STAGE = AT_KBUF + 8192, AT_BT = 3 * AT_STAGE;
template <int MODE>
__device__ __forceinline__ void attn_unit(const KP P, const int L_, const Ws& W, LAS unsigned char* lds, const int b, const int h, const int qb, const bool ctxq) {
    constexpr int NST = MODE == 2 ? 6 : (MODE == 1 ? 2 : 4);
    constexpr int NMAP = MODE == 1 ? 2 : 1;
    constexpr int KSTR = MODE == 2 ? 208 : 144;
    constexpr float CS = MODE == 2 ? 0.14724444602590306f : (MODE == 1 ? 0.25503486164919736f : 0.18033688011112042f);
    constexpr float NEG = -1e30f;
    const int tid = tid_opaque(), wave = __builtin_amdgcn_readfirstlane(tid >> 6), lane = tid & 63, r32 = lane & 31, hh = lane >> 5;
    const int l = L_;
    const int t0 = ctxq ? NLAT + b * CTX : b * SEQ + qb * 256;
    const int tq = t0 + wave * 32 + r32;
    bf16x8 qf[NMAP][NST];
    {
        const bf16_t* src = MODE == 2 ? W.QM + (size_t)tq * 768 + h * 96 : W.PB + (size_t)tq * PBS + (MODE == 1 ? O_DQ : O_NAQ) + h * 64;
#pragma unroll
        for (int mp = 0; mp < NMAP; ++mp)
#pragma unroll
            for (int st = 0; st < NST; ++st) qf[mp][st] = scale8(*(const bf16x8*)(src + 32 * mp + 16 * st + 8 * hh), CS);
    }
    int ntiles = 36, nwin = 0, krs = 0;
    if (ctxq) ntiles = 4;
    else if (MODE == 0) { krs = min(max(4 * qb - 4, 0), 24); nwin = min(max(4 * qb - 1, 0), 24) + 8 - krs; ntiles = nwin + 4; }
    LAS float* btab = (LAS float*)(lds + AT_BT);
    if (MODE == 0 && !ctxq) { const float* rbp = P->in[9] + ((size_t)l * 4 + h) * 465; for (int i = tid; i < 465; i += NTHREADS) btab[i] = 1.4426950408889634f * rbp[i]; }
    const int kkey = tid >> 3, kch = tid & 7;
    const unsigned kw_off = (unsigned)(kkey * KSTR + kch * 16);
    const unsigned rw_off = (unsigned)((tid >> 2) * KSTR + 128 + (tid & 3) * 16);
    const unsigned vw_off = (unsigned)(AT_KBUF + ((kkey >> 2) * 2 + (kch >> 2)) * 256 + (kkey & 3) * 64 + (kch & 3) * 16);
    u32x4 kregA, vregA, rregA = {0u, 0u, 0u, 0u}, kregB, vregB, rregB = {0u, 0u, 0u, 0u};
#define AT_ROW0(i) (ctxq ? NLAT + b * CTX + 64 * (i) : (MODE == 0 ? ((i) < nwin ? b * SEQ + 64 * (krs + (i)) : NLAT + b * CTX + 64 * ((i) - nwin)) : ((i) < 32 ? b * SEQ + 64 * (i) : NLAT + b * CTX + 64 * ((i) - 32))))
#define AT_LOAD(i, X) do { const int row0_ = AT_ROW0(i); \
        if (MODE == 2) { const bf16_t* kp_ = W.KVM + (size_t)(row0_ + kkey) * 1024 + h * 128 + 8 * kch; kreg##X = *(const u32x4*)kp_; vreg##X = *(const u32x4*)(kp_ + 64); \
                         if (tid < 256) rreg##X = *(const u32x4*)(W.PB + (size_t)(row0_ + (tid >> 2)) * PBS + O_KR + 8 * (tid & 3)); } \
        else { const bf16_t* kp_ = W.PB + (size_t)(row0_ + kkey) * PBS + h * 64 + 8 * kch; kreg##X = *(const u32x4*)(kp_ + (MODE == 1 ? O_DK : O_NAK)); vreg##X = *(const u32x4*)(kp_ + (MODE == 1 ? O_DV : O_NAV)); } } while (0)
#define AT_WRITE(buf, X) do { LAS unsigned char* sb_ = lds + (buf) * AT_STAGE; *(LAS u32x4*)(sb_ + kw_off) = kreg##X; *(LAS u32x4*)(sb_ + vw_off) = vreg##X; \
        if (MODE == 2 && tid < 256) *(LAS u32x4*)(sb_ + rw_off) = rreg##X; } while (0)
    constexpr float THR = 8.f;
    f32x16 O[NMAP][2], NM[NMAP]; float lrun[NMAP]; int started = 0;
    float one_a = 1.f, one_b = 1.f; asm volatile("" : "+v"(one_a)); asm volatile("" : "+v"(one_b));
#pragma unroll
    for (int mp = 0; mp < NMAP; ++mp) { lrun[mp] = 0.f;
#pragma unroll
        for (int i = 0; i < 16; ++i) NM[mp][i] = 0.f;
#pragma unroll
        for (int d = 0; d < 2; ++d)
#pragma unroll
            for (int i = 0; i < 16; ++i) O[mp][d][i] = 0.f; }
    const unsigned kr_off = (unsigned)(r32 * KSTR + hh * 16);
    const unsigned vr_off = (unsigned)(AT_KBUF + hh * 512 + ((lane & 15) >> 2) * 64 + (((lane >> 4) & 1) * 16 + (lane & 3) * 4) * 2);
#define AT_BAR() do { asm volatile("s_waitcnt lgkmcnt(0)" ::: "memory"); __builtin_amdgcn_s_barrier(); asm volatile("" ::: "memory"); } while (0)
    constexpr bool DEEP = (MODE != 1);
#define AT_QK(mp, Sa, Sb, sbp) do { \
        _Pragma("unroll") for (int st = 0; st < NST; ++st) { \
            const bf16x8 k0_ = *(const LAS bf16x8*)((sbp) + kr_off + ((MODE == 1 ? 4 * (mp) : 0) + 2 * st) * 16); \
            const bf16x8 k1_ = *(const LAS bf16x8*)((sbp) + kr_off + 32 * KSTR + ((MODE == 1 ? 4 * (mp) : 0) + 2 * st) * 16); \
            Sa = __builtin_amdgcn_mfma_f32_32x32x16_bf16(k0_, qf[mp][st], st == 0 ? NM[mp] : Sa, 0, 0, 0); \
            Sb = __builtin_amdgcn_mfma_f32_32x32x16_bf16(k1_, qf[mp][st], st == 0 ? NM[mp] : Sb, 0, 0, 0); \
            if (MODE == 2 && (st & 1)) __builtin_amdgcn_sched_barrier(0); } } while (0)
#define AT_SMPV(mp, Sa, Sb, Xa, Xb, sbp, wt, krv, rqv) do { \
        if (wt) { const int cq_ = 32 * (wave & 1) + r32, cs_ = min(max(cq_ - 8, 0), 48); const LAS float* bt_ = btab + ((krv) - (rqv) + 7) * 31 + 15 - cq_; \
            _Pragma("unroll") for (int q = 0; q < 16; ++q) { const int kc0_ = (q & 3) + 8 * (q >> 2) + 4 * hh, kc1_ = kc0_ + 32; \
                Sa[q] = ((unsigned)(kc0_ - cs_) < 16u) ? Sa[q] + bt_[kc0_] : NEG; Sb[q] = ((unsigned)(kc1_ - cs_) < 16u) ? Sb[q] + bt_[kc1_] : NEG; } } \
        float mx_ = max32(Sa, Sb); mx_ = fmaxf(mx_, __shfl_xor(mx_, 32)); \
        if (!started || __any(mx_ > THR)) { \
            const float d_ = started ? fmaxf(mx_, 0.f) : mx_, f_ = __builtin_amdgcn_exp2f(-d_); \
            lrun[mp] *= f_; \
            _Pragma("unroll") for (int d = 0; d < 2; ++d) _Pragma("unroll") for (int q = 0; q < 16; ++q) O[mp][d][q] *= f_; \
              \
            _Pragma("unroll") for (int q = 0; q < 16; ++q) { Sa[q] -= d_; Sb[q] -= d_; Xa[q] -= d_; Xb[q] -= d_; } \
            __builtin_amdgcn_sched_barrier(0); \
            asm volatile("s_nop 7\n\ts_nop 7" :: "v"(Xa[15]), "v"(Xb[15])); \
            __builtin_amdgcn_sched_barrier(0); \
            _Pragma("unroll") for (int q = 0; q < 16; ++q) NM[mp][q] -= d_; } \
          \
        float la_ = 0.f, lb_ = 0.f; \
        _Pragma("unroll") for (int q = 0; q < 16; ++q) { Sa[q] = __builtin_amdgcn_exp2f(Sa[q]); Sb[q] = __builtin_amdgcn_exp2f(Sb[q]); la_ = __builtin_fmaf(Sa[q], one_a, la_); lb_ = __builtin_fmaf(Sb[q], one_b, lb_); } \
        lrun[mp] += la_ + lb_; \
        bf16x8 pf_[4]; \
        pf_[0] = pack8(Sa[0], Sa[1], Sa[2], Sa[3], Sa[4], Sa[5], Sa[6], Sa[7]); pf_[1] = pack8(Sa[8], Sa[9], Sa[10], Sa[11], Sa[12], Sa[13], Sa[14], Sa[15]); \
        pf_[2] = pack8(Sb[0], Sb[1], Sb[2], Sb[3], Sb[4], Sb[5], Sb[6], Sb[7]); pf_[3] = pack8(Sb[8], Sb[9], Sb[10], Sb[11], Sb[12], Sb[13], Sb[14], Sb[15]); \
        _Pragma("unroll") for (int d = 0; d < 2; ++d) _Pragma("unroll") for (int s4 = 0; s4 < 4; ++s4) { \
            const LAS unsigned char* vp_ = (sbp) + vr_off + (8 * s4 + d) * 256; \
            const v4i16_t va_ = __builtin_amdgcn_ds_read_tr16_b64_v4i16((LAS v4i16_t*)vp_); \
            const v4i16_t vb_ = __builtin_amdgcn_ds_read_tr16_b64_v4i16((LAS v4i16_t*)(vp_ + 1024)); \
            bf16x8 vf_; vf_[0] = va_[0]; vf_[1] = va_[1]; vf_[2] = va_[2]; vf_[3] = va_[3]; vf_[4] = vb_[0]; vf_[5] = vb_[1]; vf_[6] = vb_[2]; vf_[7] = vb_[3]; \
            O[mp][d] = __builtin_amdgcn_mfma_f32_32x32x16_bf16(vf_, pf_[s4], O[mp][d], 0, 0, 0); \
            if (NMAP == 2 && (s4 & 1)) __builtin_amdgcn_sched_barrier(0); } } while (0)
#define AT_ACTIVE(i, wt, act, krv, rqv) const bool wt = (MODE == 0) && !ctxq && (i) < nwin; bool act = true; int krv = 0, rqv = 0; \
        if (wt) { krv = krs + (i); rqv = 4 * qb + (wave >> 1); const int rsq_ = min(max(rqv - 4, 0), 24); act = krv >= rsq_ && krv < rsq_ + 8; }
    if (DEEP) {
        f32x16 SA0, SA1, SB0, SB1;
        AT_LOAD(0, A); AT_WRITE(0, A);
        if (ntiles > 1) { AT_LOAD(1, B); AT_WRITE(1, B); }
        if (ntiles > 2) AT_LOAD(2, A);
        if (ntiles > 3) AT_LOAD(3, B);
        AT_BAR();
        { AT_ACTIVE(0, wt0, act0, kr0, rq0); if (act0) AT_QK(0, SA0, SA1, lds); (void)wt0; (void)kr0; (void)rq0; }
        int s0 = 0;
#pragma unroll 1
        for (int i0 = 0; i0 < ntiles; i0 += 2) {
            const int s1 = s0 == 2 ? 0 : s0 + 1, s2 = s1 == 2 ? 0 : s1 + 1;
            {
                const int i = i0;
                if (i + 2 < ntiles) AT_WRITE(s2, A);
                if (i + 4 < ntiles) AT_LOAD(i + 4, A);
                if (i + 1 < ntiles) { AT_ACTIVE(i + 1, wtn, actn, krn, rqn); if (actn) AT_QK(0, SB0, SB1, lds + s1 * AT_STAGE); (void)wtn; (void)krn; (void)rqn; }
                __builtin_amdgcn_sched_barrier(0);
                AT_ACTIVE(i, wt, act, kr, rq);
                if (act) { AT_SMPV(0, SA0, SA1, SB0, SB1, lds + s0 * AT_STAGE, wt, kr, rq); started = 1; }
                AT_BAR();
            }
            if (i0 + 1 < ntiles) {
                const int i = i0 + 1;
                if (i + 2 < ntiles) AT_WRITE(s0, B);
                if (i + 4 < ntiles) AT_LOAD(i + 4, B);
                if (i + 1 < ntiles) { AT_ACTIVE(i + 1, wtn, actn, krn, rqn); if (actn) AT_QK(0, SA0, SA1, lds + s2 * AT_STAGE); (void)wtn; (void)krn; (void)rqn; }
                __builtin_amdgcn_sched_barrier(0);
                AT_ACTIVE(i, wt, act, kr, rq);
                if (act) { AT_SMPV(0, SB0, SB1, SA0, SA1, lds + s1 * AT_STAGE, wt, kr, rq); started = 1; }
                AT_BAR();
            }
            s0 = s2;
        }
    } else {
        AT_LOAD(0, A); AT_WRITE(0, A); if (ntiles > 1) AT_LOAD(1, A);
        AT_BAR();
#pragma unroll 1
        for (int i = 0; i < ntiles; ++i) {
            if (i + 1 < ntiles) AT_WRITE((i + 1) & 1, A);
            if (i + 2 < ntiles) AT_LOAD(i + 2, A);
            const LAS unsigned char* sb = lds + (i & 1) * AT_STAGE;
#pragma unroll
            for (int mp = 0; mp < NMAP; ++mp) {
                f32x16 S0, S1, X0, X1;
#pragma unroll
                for (int q = 0; q < 16; ++q) { X0[q] = 0.f; X1[q] = 0.f; }
                AT_QK(mp, S0, S1, sb);
                AT_SMPV(mp, S0, S1, X0, X1, sb, false, 0, 0);
                if (NMAP == 2) __builtin_amdgcn_sched_barrier(0);
            }
            started = 1;
            AT_BAR();
        }
    }
#undef AT_QK
#undef AT_SMPV
#undef AT_ACTIVE
#undef AT_BAR
    float inv[NMAP];
#pragma unroll
    for (int mp = 0; mp < NMAP; ++mp) { const float lt = lrun[mp] + __shfl_xor(lrun[mp], 32); inv[mp] = 1.f / lt; }
    bf16_t* orow = W.HB + (size_t)tq * DM + (MODE == 0 ? 0 : (MODE == 1 ? 256 : 512)) + h * 64 + 4 * hh;
    if (MODE == 1) {
        const float lam = W.lam[l], li = 0.8f - 0.6f * expf(-0.3f * (float)l);
        const float* sg = P->in[11] + l * 64;
        const float c2 = lam * inv[1];
        float ss = 0.f;
#pragma unroll
        for (int d = 0; d < 2; ++d)
#pragma unroll
            for (int q = 0; q < 16; ++q) { const float o = O[0][d][q] * inv[0] - c2 * O[NMAP - 1][d][q]; O[0][d][q] = o; ss += o * o; }
        ss += __shfl_xor(ss, 32);
        const float rs = rsqrtf(ss * (1.f / 64.f) + 1e-6f) * (1.f - li);
#pragma unroll
        for (int d = 0; d < 2; ++d)
#pragma unroll
            for (int g4 = 0; g4 < 4; ++g4) {
                const int dv = 32 * d + 8 * g4 + 4 * hh;
                const f32x4 gg = *(const f32x4*)(sg + dv);
                u32x2 w; w.x = pk_bf16(O[0][d][4 * g4] * rs * gg[0], O[0][d][4 * g4 + 1] * rs * gg[1]); w.y = pk_bf16(O[0][d][4 * g4 + 2] * rs * gg[2], O[0][d][4 * g4 + 3] * rs * gg[3]);
                *(u32x2*)(orow + 32 * d + 8 * g4) = w;
            }
    } else {
#pragma unroll
        for (int d = 0; d < 2; ++d)
#pragma unroll
            for (int g4 = 0; g4 < 4; ++g4) {
                u32x2 w; w.x = pk_bf16(O[0][d][4 * g4] * inv[0], O[0][d][4 * g4 + 1] * inv[0]); w.y = pk_bf16(O[0][d][4 * g4 + 2] * inv[0], O[0][d][4 * g4 + 3] * inv[0]);
                *(u32x2*)(orow + 32 * d + 8 * g4) = w;
            }
    }
#undef AT_ROW0
#undef AT_LOAD
#undef AT_WRITE
}
__device__ __forceinline__ void phase_attn(const int L_, const int CH_, LAS unsigned char* lds) {
    const KP P = kparams();
    const Ws W(P->ws);
    const int G = pgrid<ID_ATTN>(), c = pblk<ID_ATTN>();
    if (c < 0) return;
    const int gwave = c * 8 + __builtin_amdgcn_readfirstlane(tid_opaque() >> 6), nwaves = G * 8;
    int ck = 0;
#define AT_CONV() do { const int tid0_ = tid_opaque(), cwave_ = __builtin_amdgcn_readfirstlane(tid0_ >> 6); \
        conv_expert_items(P, W, L_, ck, gwave, nwaves, (LAS float*)(lds + 73728 + cwave_ * 8704)  , tid0_ & 63); ck += 2; } while (0)
    for (int u = c; u < 1024; u += G) { const int x = u & 7, j = u >> 3, qb = j & 7, bh = (j >> 3) * 8 + x; attn_unit<2>(P, L_, W, lds, bh >> 3, bh & 7, qb, false); AT_CONV(); }
    for (int u = c; u < 512; u += G) { const int x = u & 7, j = u >> 3, qb = j & 7, bh = (j >> 3) * 8 + x; attn_unit<1>(P, L_, W, lds, bh >> 2, bh & 3, qb, false); AT_CONV(); }
    for (int u = c; u < 512; u += G) { const int x = u & 7, j = u >> 3, qb = j & 7, bh = (j >> 3) * 8 + x; attn_unit<0>(P, L_, W, lds, bh >> 2, bh & 3, qb, false); AT_CONV(); }
    if (L_ == 0) {
        for (int u = c; u < 256; u += G) {
            if (u < 128) attn_unit<2>(P, L_, W, lds, u >> 3, u & 7, 0, true);
            else if (u < 192) attn_unit<1>(P, L_, W, lds, (u - 128) >> 2, (u - 128) & 3, 0, true);
            else attn_unit<0>(P, L_, W, lds, (u - 192) >> 2, (u - 192) & 3, 0, true);
        }
    }
    while (gwave + ck * nwaves < CV_E) AT_CONV();
#undef AT_CONV
}

#define XB_TMO      128
#define XB_XCNT(j)  (256  + 64 * (j))
#define XB_XSUB(j)  (1280 + 64 * (j))
#define XB_XGEN(j)  (2304 + 64 * (j))
#define XB_TOP      3328
#define XB_TOPGEN   3392
#define XCD_BAR_WORDS 3456
#define XB_SPIN_CAP (1u << 18)

__device__ __forceinline__ unsigned xb_ld(unsigned* p)              { return __hip_atomic_load(p, __ATOMIC_RELAXED, __HIP_MEMORY_SCOPE_AGENT); }
__device__ __forceinline__ unsigned xb_add(unsigned* p, unsigned v) { return __hip_atomic_fetch_add(p, v, __ATOMIC_RELAXED, __HIP_MEMORY_SCOPE_AGENT); }
__device__ __forceinline__ unsigned xb_xcc_id() { return (unsigned)__builtin_amdgcn_s_getreg((3 << 11) | 20) & 0xFu; }
#define XB_SPIN(cond, bar) do { unsigned _sp = 0; while (cond) { __builtin_amdgcn_s_sleep(1); \
    if ((++_sp & 255u) == 0u) { if (xb_ld(&(bar)[XB_TMO])) break; if (_sp > XB_SPIN_CAP) { atomicAdd(&(bar)[XB_TMO], 1u); break; } } } } while (0)

struct XcdBarrier {
    unsigned* bar; unsigned x;
    volatile LAS unsigned* st;
};

__device__ __forceinline__ XcdBarrier xcd_barrier_post(unsigned* bar, volatile LAS unsigned* st) {
    XcdBarrier b; b.bar = bar; b.x = xb_xcc_id(); b.st = st;
    if (threadIdx.x == 0) (void)xb_add(&bar[XB_XCNT(b.x)], 1u);
    return b;
}
__device__ __forceinline__ void xcd_barrier_complete(unsigned* bar, unsigned x, unsigned& nloc, unsigned& nx) {
    const unsigned G = gridDim.x * gridDim.y * gridDim.z;
    unsigned sum, cnt, mine, sp = 0u;
    for (;;) {
        sum = 0u; cnt = 0u; mine = 0u;
#pragma unroll
        for (unsigned j = 0; j < 16; ++j) { const unsigned c = xb_ld(&bar[XB_XCNT(j)]); sum += c; cnt += (c > 0u) ? 1u : 0u; mine = (j == x) ? c : mine; }
        if (sum == G) break;
        __builtin_amdgcn_s_sleep(1);
        if ((++sp & 255u) == 0u) { if (xb_ld(&bar[XB_TMO])) break; if (sp > XB_SPIN_CAP) { atomicAdd(&bar[XB_TMO], 1u); break; } }
    }
    nloc = mine > 0u ? mine : 1u; nx = cnt > 0u ? cnt : 1u;
}

__device__ __forceinline__ void xcd_barrier(const XcdBarrier& b) {
    asm volatile("s_waitcnt vmcnt(0)" ::: "memory");
    __syncthreads();
    if (threadIdx.x == 0) {
        unsigned* bar = b.bar;
        __builtin_amdgcn_s_waitcnt(0);
        unsigned nloc = b.st[0], nx = b.st[1];
        if (nloc == 0u) { xcd_barrier_complete(bar, b.x, nloc, nx); b.st[0] = nloc; b.st[1] = nx; }
        const unsigned old = xb_add(&bar[XB_XSUB(b.x)], 1u);
        const unsigned gen = old / nloc;
        if (old + 1u == (gen + 1u) * nloc) {
            __builtin_amdgcn_fence(__ATOMIC_RELEASE, "agent");
            asm volatile("s_waitcnt vmcnt(0)" ::: "memory");
            const unsigned og = xb_add(&bar[XB_TOP], 1u);
            const unsigned tg = og / nx;
            if (og + 1u == (tg + 1u) * nx) xb_add(&bar[XB_TOPGEN], 1u);
            else XB_SPIN(xb_ld(&bar[XB_TOPGEN]) == tg, bar);
            __builtin_amdgcn_fence(__ATOMIC_ACQUIRE, "agent");
            xb_add(&bar[XB_XGEN(b.x)], 1u);
            asm volatile("s_waitcnt vmcnt(0)" ::: "memory");
        } else {
            XB_SPIN(xb_ld(&bar[XB_XGEN(b.x)]) == gen, bar);
            __builtin_amdgcn_fence(__ATOMIC_ACQUIRE, "agent");
            asm volatile("s_waitcnt vmcnt(0)" ::: "memory");
        }
    }
    __syncthreads();
}

constexpr int NSTEPS = 2 + 2 * (5 + 2 * NCHUNK);
constexpr int LDS_BARW = LDS_BYTES - 64;
__global__ void __launch_bounds__(NTHREADS, 2) k_fwd(Params P) {
    extern __shared__ __attribute__((aligned(16))) unsigned char dyn_lds[];
    LAS unsigned char* lds = (LAS unsigned char*)dyn_lds;
    volatile LAS unsigned* st = (volatile LAS unsigned*)(lds + LDS_BARW);
    if (threadIdx.x == 0) { st[0] = 0u; st[1] = 0u; st[2] = 0u; st[3] = 0u; }
    __syncthreads();
    const XcdBarrier bar = xcd_barrier_post((unsigned*)(P.ws + WS_CTL), st);
    const int lo = P.ph_lo, hi = P.ph_hi;
    int step = 0;
#ifndef REP_ATTN
#define REP_ATTN 1
#endif
#ifndef REP_MOE1
#define REP_MOE1 1
#endif
#ifndef REP_MOE2
#define REP_MOE2 1
#endif
#ifndef REP_INPROJ
#define REP_INPROJ 1
#endif
#ifndef REP_MLA
#define REP_MLA 1
#endif
#ifndef REP_CONV
#define REP_CONV 1
#endif
#define STEP(body) do { const int s_ = step++; if (s_ >= lo && s_ < hi) { body; if (s_ + 1 < hi && s_ + 1 < NSTEPS) xcd_barrier(bar); } } while (0)
    STEP(for (int rep = 0; rep < REP_CONV; ++rep) { if (rep) xcd_barrier(bar); phase_convert(0, 0, lds); });
    STEP(phase_norm1(0, 0, lds));
#pragma unroll 1
    for (int l = 0; l < 2; ++l) {
        STEP(for (int rep = 0; rep < REP_INPROJ; ++rep) { if (rep) xcd_barrier(bar); phase_inproj(l, 0, lds); });
        STEP(for (int rep = 0; rep < REP_MLA; ++rep) { if (rep) xcd_barrier(bar); phase_mla(l, 0, lds); });
        STEP(for (int rep = 0; rep < REP_ATTN; ++rep) { if (rep) xcd_barrier(bar); phase_attn(l, 0, lds); });
        STEP(phase_outproj(l, 0, lds));
        STEP(phase_norm2(l, 0, lds));
#pragma unroll 1
        for (int ch = 0; ch < NCHUNK; ++ch) {
            STEP(phase_moe(l, ch, lds));
            STEP(phase_comb(l, ch, lds); if (l == 0 && ch == NCHUNK - 1) phase_convert(1, 0, lds));
        }
    }
#undef STEP
}

#ifndef MK_N_LAUNCHES
#define MK_N_LAUNCHES 1
#endif
extern "C" void kernel_launch(void* const* d_in, const int* in_sizes, int n_in, void* d_out, int out_size, void* d_ws, size_t ws_size, hipStream_t stream) {
    static int grid = 0;
    if (grid == 0) {
        if (ws_size < WS_END || n_in != 26 || out_size != NLAT * DM) { fprintf(stderr, "kernel_launch: workspace %zu < %zu or n_in %d != 26 or out %d; nothing launched\n", ws_size, (size_t)WS_END, n_in, out_size); grid = -1; return; }
        int dev = 0, cus = 0, per_cu = 0;
        if (hipGetDevice(&dev) != hipSuccess || hipDeviceGetAttribute(&cus, hipDeviceAttributeMultiprocessorCount, dev) != hipSuccess || cus <= 0) { fprintf(stderr, "kernel_launch: device query failed\n"); grid = -1; return; }
        if (hipFuncSetAttribute((const void*)k_fwd, hipFuncAttributeMaxDynamicSharedMemorySize, LDS_BYTES) != hipSuccess) { fprintf(stderr, "kernel_launch: hipFuncSetAttribute failed\n"); grid = -1; return; }
        if (hipOccupancyMaxActiveBlocksPerMultiprocessor(&per_cu, (const void*)k_fwd, NTHREADS, LDS_BYTES) != hipSuccess || per_cu < 1) { fprintf(stderr, "kernel_launch: occupancy query says %d workgroups per CU\n", per_cu); grid = -1; (void)hipGetLastError(); return; }
        grid = cus;
    }
    if (grid < 0) return;
    Params P{};
    for (int i = 0; i < 26; ++i) P.in[i] = (const float*)d_in[i];
    P.out = (float*)d_out; P.ws = (unsigned char*)d_ws;
    (void)hipMemsetAsync((unsigned char*)d_ws + WS_CTL, 0, CTL_ZERO_BYTES, stream);
    if (MK_N_LAUNCHES == 1) {
        P.ph_lo = 0; P.ph_hi = NSTEPS;
        hipLaunchKernelGGL(k_fwd, dim3(grid), dim3(NTHREADS), LDS_BYTES, stream, P);
#ifdef PROBE_STEP
        (void)hipMemsetAsync((unsigned char*)d_ws + WS_CTL, 0, XCD_BAR_WORDS * 4, stream);
        if (!(PROBE_I2 & 1)) (void)hipMemsetAsync((unsigned char*)d_ws + WS_CTL + (size_t)CW_RT * 4 + (size_t)2 * 1024 * 16 * 4, 0, (size_t)2 * 1024 * 16 * 4, stream);
        P.ph_lo = PROBE_STEP; P.ph_hi = PROBE_STEP + 1; P.i2 = PROBE_I2;
        hipLaunchKernelGGL(k_fwd, dim3(grid), dim3(NTHREADS), LDS_BYTES, stream, P);
#endif
    } else {
        for (int s = 0; s < NSTEPS; ++s) { P.ph_lo = s; P.ph_hi = s + 1; hipLaunchKernelGGL(k_fwd, dim3(grid), dim3(NTHREADS), LDS_BYTES, stream, P); }
    }
}
```

```cpp
#include <hip/hip_runtime.h>
#include <cstdint>
#include <cstdio>
#include <cmath>

typedef unsigned short bf16_t;

constexpr int NB = 16, SEQ = 2048, DM = 1024, CTX = 256;
constexpr int NLAT = NB * SEQ, NCTX = NB * CTX, NTOK = NLAT + NCTX;
constexpr int INC = 1952;
constexpr int PBS = 2048;
constexpr int O_NAQ = 0, O_NAK = 256, O_NAV = 512, O_DQ = 768, O_DK = 1024, O_DV = 1280, O_CQ = 1536, O_CKV = 1792, O_KR = 1920;
constexpr int NEXP = 64, EFF = 256;
constexpr int LCAP = NTOK;
constexpr int MODW = 6 * DM;

constexpr size_t MiB = 1u << 20;
constexpr size_t WS_CTL = 0;
constexpr size_t WS_MOD = 1 * MiB;
constexpr size_t WS_ROPE = 2 * MiB;
constexpr size_t WS_SSQ = 3 * MiB;
constexpr size_t WS_JUNK = 6 * MiB;
constexpr size_t WS_XS = 8 * MiB;
constexpr size_t WS_HB = 152 * MiB;
constexpr size_t WS_PB = 224 * MiB;
constexpr size_t WS_QM = 368 * MiB;
constexpr size_t WS_KVM = 422 * MiB;
constexpr size_t WS_WB = 494 * MiB;
constexpr size_t WS_END = 600 * MiB;
constexpr size_t WS_LOG = WS_PB;
constexpr size_t WS_LIST = WS_PB + 16 * MiB;
constexpr size_t WB_WIN = 0;
constexpr size_t WB_WUQ = WB_WIN + (size_t)2048 * 1024;
constexpr size_t WB_WUKV = WB_WUQ + (size_t)768 * 256;
constexpr size_t WB_WOUT = WB_WUKV + (size_t)1024 * 256;
constexpr size_t WB_WGU = WB_WOUT + (size_t)1024 * 1024;
constexpr size_t WB_WD = WB_WGU + (size_t)65 * 512 * 1024;
constexpr size_t WB_END = WB_WD + (size_t)65 * 1024 * 256;
constexpr size_t WB_RW = WB_END;
static_assert(WS_WB + (WB_RW + (size_t)8 * 8 * 2 * 2 * 64 * 8) * 2 <= WS_END, "weights fit");

__device__ __forceinline__ float bf2f(bf16_t v) { return __uint_as_float(((unsigned)v) << 16); }
__device__ __forceinline__ bf16_t f2bf(float f) { unsigned u = __float_as_uint(f); u += 0x7fffu + ((u >> 16) & 1u); return (bf16_t)(u >> 16); }
__device__ __forceinline__ float wave_sum(float v) {
#pragma unroll
    for (int o = 32; o > 0; o >>= 1) v += __shfl_xor(v, o);
    return v;
}
__device__ __forceinline__ float wave_max(float v) {
#pragma unroll
    for (int o = 32; o > 0; o >>= 1) v = fmaxf(v, __shfl_xor(v, o));
    return v;
}
__device__ __forceinline__ int mod_row(int t) { return t < NLAT ? (t >> 11) : 16; }

__device__ __forceinline__ void rope_cs(int s, int j, float& cs, float& sn) {
    const int rowi = s >> 6, coli = s & 63;
    const float freq = powf(10000.f, -(float)(j & 7) / 8.f);
    const float ang = (float)(j < 8 ? rowi : coli) * freq;
    cs = cosf(ang); sn = sinf(ang);
}
#define LAS __attribute__((address_space(3)))
typedef short bf16x8 __attribute__((ext_vector_type(8)));
typedef float f32x4 __attribute__((ext_vector_type(4)));
typedef float f32x2 __attribute__((ext_vector_type(2)));
typedef unsigned u32x2 __attribute__((ext_vector_type(2)));
typedef unsigned u32x4 __attribute__((ext_vector_type(4)));
typedef __bf16 bf16x2_t __attribute__((ext_vector_type(2)));

struct Params { const float* in[26]; float* out; unsigned char* ws; int ph_lo, ph_hi, i2, i3; };
typedef const Params __attribute__((address_space(4)))* KP;
__device__ __forceinline__ KP kparams() { KP p = (KP)__builtin_amdgcn_kernarg_segment_ptr(); asm volatile("" : "+s"(p)); return p; }
#ifndef PROBE_HALF
#define PROBE_HALF -1
#endif
enum { ID_CONV = 0, ID_NORM1, ID_INPROJ, ID_MLA, ID_ATTN, ID_OUTPROJ, ID_NORM2, ID_MOE, ID_COMB };
template <int ID> __device__ __forceinline__ int pgrid() { int g = (int)gridDim.x; asm volatile("" : "+s"(g)); return ID == PROBE_HALF ? g / 2 : g; }
template <int ID> __device__ __forceinline__ int pblk() { int b = (int)blockIdx.x; asm volatile("" : "+s"(b)); return ID == PROBE_HALF ? ((b & 1) ? -1 : b >> 1) : b; }
__device__ __forceinline__ int tid_opaque() { int t = (int)threadIdx.x; asm volatile("" : "+v"(t)); return t; }

constexpr int NTHREADS = 512;
constexpr int LDS_BYTES = 150528;

__device__ __forceinline__ unsigned pk_bf16(float lo, float hi) { f32x2 v = {lo, hi}; bf16x2_t b = __builtin_convertvector(v, bf16x2_t); return __builtin_bit_cast(unsigned, b); }

namespace g8 {
constexpr int BM = 256, BK = 64, HALF = 128, HTB = HALF * BK * 2, STAGE_BYTES = 8 * HTB, NXCD = 8, WGM = 8;
__host__ __device__ __forceinline__ int lds_byte(int r, int c) { const int st = (r >> 4) * 2 + (c >> 5), rr = r & 15, cc = c & 31, ob = rr * 64 + cc * 2; return st * 1024 + (ob ^ (((ob >> 9) & 1) << 5)); }
__host__ __device__ __forceinline__ void stage_rc(int b, int& R, int& C) { const int st = b / 1024, sb = b % 1024, swz = sb ^ (((sb >> 9) & 1) << 5); R = (st >> 1) * 16 + swz / 64; C = (st & 1) * 32 + (swz % 64) / 2; }

struct Unit2 { int pm, pn; };
struct DenseOrder {
    int nM, nN, nwg, G, c;
    __device__ __forceinline__ void init(int nM_, int nN_, int G_, int c_) { nM = nM_; nN = nN_; nwg = nM * nN; G = G_; c = c_; }
    __device__ __forceinline__ bool next(int i, Unit2& u) const {
        const long L = (long)i * G + c; if (L >= nwg) return false;
        int wgid = (int)L; { const int q = nwg / NXCD, r = nwg % NXCD, xcd = wgid % NXCD, off = wgid / NXCD; wgid = (xcd < r ? xcd * (q + 1) : r * (q + 1) + (xcd - r) * q) + off; }
        const int nig = WGM * nN, gid = wgid / nig, fm = gid * WGM, gsz = (nM - fm) < WGM ? (nM - fm) : WGM;
        u.pm = fm + ((wgid % nig) % gsz); u.pn = (wgid % nig) / gsz; return true;
    }
};

#define G8_SA(b, h) (((b) * 2 + (h)) * g8::HTB)
#define G8_SB(b, h) ((4 + (b) * 2 + (h)) * g8::HTB)
#define G8_GLDS(gp, ldsoff) __builtin_amdgcn_global_load_lds((const unsigned*)(gp), (LAS unsigned*)(lds + (ldsoff)), 16, 0, 0)
#define G8_STAGE_A(bufoff, o0, o1, kb) do { G8_GLDS(Ab + (o0) + (kb), (bufoff) + ldsw); G8_GLDS(Ab + (o1) + (kb), (bufoff) + ldsw + 8192); } while (0)
#define G8_STAGE_B(bufoff, bp, kb) do { G8_GLDS((bp) + voffB[0] + (kb), (bufoff) + ldsw); G8_GLDS((bp) + voffB[1] + (kb), (bufoff) + ldsw + 8192); } while (0)
#define G8_LDA(dst, b, h) do { _Pragma("unroll") for (int m = 0; m < 4; ++m) _Pragma("unroll") for (int k = 0; k < 2; ++k) dst[m][k] = *(const LAS bf16x8*)(lds + G8_SA(b, h) + aoff + m * 2048 + k * 1024); } while (0)
#define G8_LDB(dst, b, h) do { _Pragma("unroll") for (int n = 0; n < 2; ++n) _Pragma("unroll") for (int k = 0; k < 2; ++k) dst[n][k] = *(const LAS bf16x8*)(lds + G8_SB(b, h) + boff + n * 2048 + k * 1024); } while (0)
#define G8_MMA(ai, bj, At, Bt) do { __builtin_amdgcn_s_setprio(1); _Pragma("unroll") for (int m = 0; m < 4; ++m) _Pragma("unroll") for (int n = 0; n < 2; ++n) _Pragma("unroll") for (int k = 0; k < 2; ++k) \
        acc[ai][bj][m][n] = __builtin_amdgcn_mfma_f32_16x16x32_bf16(Bt[n][k], At[m][k], acc[ai][bj][m][n], 0, 0, 0); __builtin_amdgcn_s_setprio(0); } while (0)
#define G8_WAIT_V(n) asm volatile("s_waitcnt vmcnt(" #n ")" ::: "memory")
#define G8_WAIT_L(n) asm volatile("s_waitcnt lgkmcnt(" #n ")" ::: "memory")
#define G8_BAR __builtin_amdgcn_s_barrier()
#define G8_SCHED __builtin_amdgcn_sched_barrier(0)

template <class P>
__device__ __forceinline__ void gemm_phase(LAS unsigned char* lds, const P& pr) {
    typedef typename P::Unit Unit;
    constexpr int K = P::K, nt = K / BK;
    static_assert(K % 128 == 0 && nt >= 2, "K must be a multiple of 128");
    const int tid = tid_opaque(), wid = __builtin_amdgcn_readfirstlane(tid >> 6), lane = tid & 63, wr = wid >> 2, wc = wid & 3, fr = lane & 15, fq = lane >> 4;
    int Rr[2], Cc[2]; unsigned voffB[2];
#pragma unroll
    for (int i = 0; i < 2; ++i) { stage_rc(tid * 16 + i * 8192, Rr[i], Cc[i]); voffB[i] = (unsigned)(Rr[i] * K + Cc[i]) * 2u; }
    constexpr unsigned kstep = BK * 2;
    constexpr size_t hstepB = (size_t)HALF * K * 2;
    const unsigned ldsw = (unsigned)wid * 1024u;
    const int aoff = lds_byte(wr * 64 + fr, fq * 8), boff = lds_byte(wc * 32 + fr, fq * 8);
    Unit cur, nxt; int ui = 0;
    int pend = -1;
    if (!pr.next(0, cur)) return;
    f32x4 acc[2][2][4][2];
#pragma unroll
    for (int a = 0; a < 2; ++a)
#pragma unroll
        for (int b = 0; b < 2; ++b)
#pragma unroll
            for (int m = 0; m < 4; ++m)
#pragma unroll
                for (int n = 0; n < 2; ++n) acc[a][b][m][n] = (f32x4){0.f, 0.f, 0.f, 0.f};
    bf16x8 At[4][2], B0[2][2], B1[2][2];
    const char* Ab = pr.a_base();
    unsigned ca[2][2], na[2][2];
    pr.a_ready(cur);
    pr.a_offsets(cur, Rr, Cc, ca);
    const char* cB = pr.b_ptr(cur);
    G8_STAGE_B(G8_SB(0, 0), cB, 0); G8_STAGE_B(G8_SB(0, 1), cB + hstepB, 0); G8_STAGE_A(G8_SA(0, 0), ca[0][0], ca[0][1], 0); G8_STAGE_A(G8_SA(0, 1), ca[1][0], ca[1][1], 0);
    if (wr == 1) G8_BAR;
    G8_WAIT_V(2); G8_BAR;
    G8_STAGE_B(G8_SB(1, 0), cB, kstep); G8_STAGE_A(G8_SA(1, 0), ca[0][0], ca[0][1], kstep); G8_STAGE_B(G8_SB(1, 1), cB + hstepB, kstep);
    G8_WAIT_V(6); G8_BAR;
    for (;;) {
        const bool has_next = pr.next(ui + 1, nxt);
        const char* nB = cB;
#pragma unroll
        for (int h = 0; h < 2; ++h)
#pragma unroll
            for (int i = 0; i < 2; ++i) na[h][i] = ca[h][i];
        if (has_next) { pr.a_offsets(nxt, Rr, Cc, na); nB = pr.b_ptr(nxt); }
#pragma unroll 1
        for (int t = 0; t < nt; t += 2) {
            const bool last = (t == nt - 2);
            if (last && has_next) pr.a_ready(nxt);
            const unsigned k1 = (unsigned)(t + 1) * kstep, k2 = (unsigned)(t + 2) * kstep;
            unsigned a2[2][2];
#pragma unroll
            for (int h = 0; h < 2; ++h)
#pragma unroll
                for (int i = 0; i < 2; ++i) a2[h][i] = last ? na[h][i] : ca[h][i] + k2;
            const char* b2 = last ? nB : cB + k2;
            G8_LDB(B0, 0, 0); G8_LDB(B1, 0, 1); G8_SCHED; G8_LDA(At, 0, 0); G8_STAGE_A(G8_SA(1, 1), ca[1][0], ca[1][1], k1);
            G8_WAIT_V(8); G8_WAIT_L(0); G8_BAR; G8_MMA(0, 0, At, B0); G8_MMA(0, 1, At, B1); G8_BAR; G8_SCHED;
            G8_LDA(At, 0, 1); G8_STAGE_B(G8_SB(0, 0), b2, 0); G8_STAGE_B(G8_SB(0, 1), b2 + hstepB, 0); G8_STAGE_A(G8_SA(0, 0), a2[0][0], a2[0][1], 0);
            G8_WAIT_V(8); G8_WAIT_L(0); G8_BAR; G8_MMA(1, 0, At, B0); G8_MMA(1, 1, At, B1); G8_BAR; G8_SCHED;
            if (P::HAS_DONE && t == 0 && pend >= 0) { pr.done(pend); pend = -1; }
            G8_LDB(B0, 1, 0); G8_LDB(B1, 1, 1); G8_SCHED; G8_LDA(At, 1, 0); G8_STAGE_A(G8_SA(0, 1), a2[1][0], a2[1][1], 0);
            G8_WAIT_V(8); G8_WAIT_L(0); G8_BAR; G8_MMA(0, 0, At, B0); G8_MMA(0, 1, At, B1); G8_BAR; G8_SCHED;
            G8_LDA(At, 1, 1); G8_STAGE_B(G8_SB(1, 0), b2, kstep); G8_STAGE_B(G8_SB(1, 1), b2 + hstepB, kstep); G8_STAGE_A(G8_SA(1, 0), a2[0][0], a2[0][1], kstep);
            G8_WAIT_V(8); G8_WAIT_L(0); G8_BAR; G8_MMA(1, 0, At, B0); G8_MMA(1, 1, At, B1); G8_BAR; G8_SCHED;
        }
        if (wr == 0) G8_BAR;
        pr.epilogue(acc, cur, wr, wc, fr, fq);
        if (P::HAS_DONE) pend = pr.done_token(cur);
        if (!has_next) break;
#pragma unroll
        for (int a = 0; a < 2; ++a)
#pragma unroll
            for (int b = 0; b < 2; ++b)
#pragma unroll
                for (int m = 0; m < 4; ++m)
#pragma unroll
                    for (int n = 0; n < 2; ++n) acc[a][b][m][n] = (f32x4){0.f, 0.f, 0.f, 0.f};
        cur = nxt; cB = nB; ++ui;
#pragma unroll
        for (int h = 0; h < 2; ++h)
#pragma unroll
            for (int i = 0; i < 2; ++i) ca[h][i] = na[h][i];
        if (wr == 1) G8_BAR;
    }
    G8_WAIT_V(0);
    if (P::HAS_DONE && pend >= 0) pr.done(pend);
    G8_BAR;
}
}

struct Ws {
    unsigned* ctl; float* mod; float* lam; float* rope; float* ssq; float* sskv;
    bf16_t* XS; bf16_t* HB; bf16_t* PB; bf16_t* QM; bf16_t* KVM; bf16_t* WB;
    __device__ __host__ __forceinline__ explicit Ws(unsigned char* ws) {
        ctl = (unsigned*)(ws + WS_CTL); mod = (float*)(ws + WS_MOD); lam = mod + 2 * 17 * MODW; rope = (float*)(ws + WS_ROPE);
        ssq = (float*)(ws + WS_SSQ); sskv = ssq + (size_t)NTOK * 4;
        XS = (bf16_t*)(ws + WS_XS); HB = (bf16_t*)(ws + WS_HB); PB = (bf16_t*)(ws + WS_PB); QM = (bf16_t*)(ws + WS_QM); KVM = (bf16_t*)(ws + WS_KVM); WB = (bf16_t*)(ws + WS_WB);
    }
};

__device__ __forceinline__ int conv_drow(int ng, int mode) {
    if (mode == 1 || mode == 2) { const int a = ng & 127; return (ng & ~127) * 2 + 128 * ((a >> 2) & 1) + 32 * (a >> 5) + 16 * (mode - 1) + 4 * ((a >> 3) & 3) + (a & 3); }
    if (mode == 3) { const int c = ng & 63; return (ng & ~63) + 16 * ((c >> 2) & 3) + 4 * (c >> 4) + (c & 3); }
    if (mode == 4) { const int c = ng & 255, g = c >> 5; return (ng & ~255) + 128 * ((c >> 2) & 1) + 32 * (g >> 1) + 16 * ((c >> 4) & 1) + 4 * (2 * (g & 1) + ((c >> 3) & 1)) + (c & 3); }
    return ng;
}
struct ConvDesc { const float* W; const float* ks; bf16_t* Bt; int N, k0, n0, ldo, mode; };
__device__ __forceinline__ void conv_load(const ConvDesc& d, float (&v)[32], int lane) {
#pragma unroll
    for (int i = 0; i < 32; ++i) v[i] = d.W[(size_t)(d.k0 + 2 * i + (lane >> 5)) * d.N + d.n0 + (lane & 31)];
}
__device__ __forceinline__ void conv_store(const ConvDesc& d, float (&v)[32], LAS float* scr, int lane) {
    if (d.ks) {
#pragma unroll
        for (int i = 0; i < 32; ++i) v[i] *= d.ks[d.k0 + 2 * i + (lane >> 5)];
    }
#pragma unroll
    for (int i = 0; i < 32; ++i) scr[(2 * i + (lane >> 5)) * 33 + (lane & 31)] = v[i];
    asm volatile("s_waitcnt lgkmcnt(0)" ::: "memory");
    const int c = lane & 7;
#pragma unroll
    for (int j = 0; j < 4; ++j) {
        const int n = (lane >> 3) + 8 * j;
        const LAS float* sp = scr + (8 * c) * 33 + n;
        u32x4 o; o.x = pk_bf16(sp[0], sp[33]); o.y = pk_bf16(sp[66], sp[99]); o.z = pk_bf16(sp[132], sp[165]); o.w = pk_bf16(sp[198], sp[231]);
        *(u32x4*)(d.Bt + (size_t)conv_drow(d.n0 + n, d.mode) * d.ldo + d.k0 + 8 * c) = o;
    }
    asm volatile("s_waitcnt lgkmcnt(0)" ::: "memory");
}
constexpr int CV_E = 65 * 384, CV_IN = 16 * 61, CV_OUT = 512, CV_UQ = 96, CV_UKV = 64, CV_ITEMS = CV_E + CV_IN + CV_OUT + CV_UQ + CV_UKV;
__device__ __forceinline__ void conv_decode(const KP P, const Ws& W, int l, int it, ConvDesc& d) {
    int r = it; d.ks = nullptr;
    if (r < CV_E) {
        const int e = r / 384, w = (r % 384) >> 7, t = r & 127;
        if (w < 2) {
            d.W = e < 64 ? P->in[19 + w] + ((size_t)l * 64 + e) * 262144 : P->in[22 + w] + (size_t)l * 262144;
            d.N = 256; d.k0 = (t >> 3) * 64; d.n0 = (t & 7) * 32; d.Bt = W.WB + WB_WGU + (size_t)e * 524288; d.ldo = 1024; d.mode = 1 + w;
        } else {
            d.W = e < 64 ? P->in[21] + ((size_t)l * 64 + e) * 262144 : P->in[24] + (size_t)l * 262144;
            d.N = 1024; d.k0 = (t >> 5) * 64; d.n0 = (t & 31) * 32; d.Bt = W.WB + WB_WD + (size_t)e * 262144; d.ldo = 256; d.mode = 3;
        }
        return;
    }
    r -= CV_E;
    if (r < CV_IN) { d.W = P->in[8] + (size_t)l * 1024 * INC; d.N = INC; d.k0 = (r / 61) * 64; d.n0 = (r % 61) * 32; d.Bt = W.WB + WB_WIN; d.ldo = 1024; d.mode = 4; return; }
    r -= CV_IN;
    if (r < CV_OUT) { d.W = P->in[16] + (size_t)l * 1024 * 1024; d.N = 1024; d.k0 = (r >> 5) * 64; d.n0 = (r & 31) * 32; d.Bt = W.WB + WB_WOUT; d.ldo = 1024; d.mode = 0; return; }
    r -= CV_OUT;
    if (r < CV_UQ) { d.W = P->in[13] + (size_t)l * 256 * 768; d.N = 768; d.k0 = (r / 24) * 64; d.n0 = (r % 24) * 32; d.Bt = W.WB + WB_WUQ; d.ldo = 256; d.mode = 4; d.ks = P->in[12] + l * 256; return; }
    r -= CV_UQ;
    d.W = P->in[15] + (size_t)l * 128 * 1024; d.N = 1024; d.k0 = (r >> 5) * 64; d.n0 = (r & 31) * 32; d.Bt = W.WB + WB_WUKV; d.ldo = 256; d.mode = 4; d.ks = P->in[14] + l * 128;
}
__device__ __forceinline__ void conv_expert_items(const KP P, const Ws& W, int l, int k0, int gwave, int nwaves, LAS float* scr, int lane) {
    const int itA = gwave + k0 * nwaves, itB = itA + nwaves;
    if (itA >= CV_E) return;
    ConvDesc dA, dB; float vA[32], vB[32];
    conv_decode(P, W, l, itA, dA); conv_load(dA, vA, lane);
    const bool hB = itB < CV_E;
    if (hB) { conv_decode(P, W, l, itB, dB); conv_load(dB, vB, lane); }
    conv_store(dA, vA, scr, lane);
    if (hB) conv_store(dB, vB, scr, lane);
}
__device__ __forceinline__ void phase_convert(const int L_, const int CH_, LAS unsigned char* lds) {
    const KP P = kparams();
    const Ws W(P->ws);
    const int l = L_, tid = tid_opaque(), c = pblk<ID_CONV>(), G = pgrid<ID_CONV>();
    if (c < 0) return;
    const int wave = __builtin_amdgcn_readfirstlane(tid >> 6), lane = tid & 63;
    LAS float* scr = (LAS float*)(lds + wave * 8704);
    {
        const int stride = G * 8;
        int it = CV_E + c * 8 + wave;
        ConvDesc dA, dB; float vA[32], vB[32];
        bool hA = it < CV_ITEMS;
        if (hA) { conv_decode(P, W, l, it, dA); conv_load(dA, vA, lane); }
        while (hA) {
            const int itn = it + stride; const bool hB = itn < CV_ITEMS;
            if (hB) { conv_decode(P, W, l, itn, dB); conv_load(dB, vB, lane); }
            conv_store(dA, vA, scr, lane);
            if (!hB) break;
            it = itn + stride; hA = it < CV_ITEMS;
            if (hA) { conv_decode(P, W, l, it, dA); conv_load(dA, vA, lane); }
            conv_store(dB, vB, scr, lane);
        }
    }
    {
        const float* rw = P->in[17] + (size_t)l * DM * NEXP;
        for (int it = c * NTHREADS + tid; it < 8 * 8 * 2 * 64; it += G * NTHREADS) {
            const int ln = it & 63, n = (it >> 6) & 1, ks = (it >> 7) & 7, w = it >> 10;
            const float* p = rw + (size_t)(128 * w + 16 * ks + 8 * (ln >> 5)) * NEXP + 32 * n + (ln & 31);
            u32x4 h4, l4;
#pragma unroll
            for (int t = 0; t < 4; ++t) { const float w0 = p[(2 * t) * NEXP], w1 = p[(2 * t + 1) * NEXP]; const unsigned hi = pk_bf16(w0, w1); h4[t] = hi; l4[t] = pk_bf16(w0 - __uint_as_float(hi << 16), w1 - __uint_as_float(hi & 0xffff0000u)); }
            bf16_t* dst = W.WB + WB_RW + ((size_t)((w * 8 + ks) * 2 + n) * 2 * 64 + ln) * 8;
            *(u32x4*)dst = h4; *(u32x4*)(dst + 64 * 8) = l4;
        }
    }
    __syncthreads();
    {
        const int gid = c * NTHREADS + tid, gsz = G * NTHREADS;
        unsigned zz = 0u; asm volatile("" : "+v"(zz));
        const u32x4 z = {zz, zz, zz, zz};
        for (int i = gid; i < 96 * 128; i += gsz) *(u32x4*)(W.WB + WB_WIN + (size_t)conv_drow(1952 + (i >> 7), 4) * 1024 + (size_t)(i & 127) * 8) = z;
        for (int i = gid; i < 1024 * 16; i += gsz) *(u32x4*)(W.WB + WB_WUKV + (size_t)(i >> 4) * 256 + 128 + (i & 15) * 8) = z;
    }
    if (l == 0) {
        LAS float* st = (LAS float*)lds;
        LAS float* red = st + 17 * 1024;
        for (int u = c; u < 192; u += G) {
            const int l2 = u / 96, cg = u % 96;
            for (int i = tid; i < 17 * 1024; i += NTHREADS) { const int r = i >> 10, k = i & 1023; const float v = r < 16 ? P->in[1][r * 1024 + k] : P->in[3][k]; st[i] = v / (1.f + expf(-v)); }
            __syncthreads();
            const float* w = P->in[4] + (size_t)l2 * 1024 * MODW + cg * 64 + lane;
            float a[17];
#pragma unroll
            for (int r = 0; r < 17; ++r) a[r] = 0.f;
            for (int k = wave * 128; k < wave * 128 + 128; ++k) {
                const float wv = w[(size_t)k * MODW];
#pragma unroll
                for (int r = 0; r < 17; ++r) a[r] += st[r * 1024 + k] * wv;
            }
#pragma unroll
            for (int r = 0; r < 17; ++r) red[(wave * 17 + r) * 64 + lane] = a[r];
            __syncthreads();
            for (int i = tid; i < 17 * 64; i += NTHREADS) {
                const int r = i >> 6, col = i & 63; float s = 0.f;
#pragma unroll
                for (int w8 = 0; w8 < 8; ++w8) s += red[(w8 * 17 + r) * 64 + col];
                W.mod[((size_t)l2 * 17 + r) * MODW + cg * 64 + col] = s + P->in[5][l2 * MODW + cg * 64 + col];
            }
            __syncthreads();
        }
        for (int i = c * NTHREADS + tid; i < 2048 * 16; i += G * NTHREADS) { float cs, sn; rope_cs(i >> 4, i & 15, cs, sn); W.rope[2 * i] = cs; W.rope[2 * i + 1] = sn; }
        if (c == G - 1 && wave == 0) {
            for (int l2 = 0; l2 < 2; ++l2) {
                const float* lv = P->in[10] + l2 * 128;
                float a = lane < 32 ? lv[lane] * lv[32 + lane] : 0.f, b = lane < 32 ? lv[64 + lane] * lv[96 + lane] : 0.f;
                a = wave_sum(a); b = wave_sum(b);
                const float li = 0.8f - 0.6f * expf(-0.3f * (float)l2);
                if (lane == 0) W.lam[l2] = expf(a) - expf(b) + li;
            }
        }
    }
}

struct ProbInProj {
    typedef g8::Unit2 Unit; static constexpr int K = 1024;
    __device__ __forceinline__ void a_ready(const Unit&) const {}
    static constexpr bool HAS_DONE = false;
    __device__ __forceinline__ void done(int) const {}
    __device__ __forceinline__ int done_token(const Unit&) const { return -1; }
    g8::DenseOrder ord; const bf16_t* A; const bf16_t* Bt; bf16_t* PB; const float* rope; float* ssq; float* sskv;
    __device__ __forceinline__ bool next(int i, Unit& u) const { return ord.next(i, u); }
    __device__ __forceinline__ const char* a_base() const { return (const char*)A; }
    __device__ __forceinline__ void a_offsets(const Unit& u, const int (&R)[2], const int (&C)[2], unsigned (&o)[2][2]) const {
#pragma unroll
        for (int h = 0; h < 2; ++h)
#pragma unroll
            for (int i = 0; i < 2; ++i) o[h][i] = (unsigned)((u.pm * 256 + h * 128 + R[i]) * K + C[i]) * 2u;
    }
    __device__ __forceinline__ const char* b_ptr(const Unit& u) const { return (const char*)(Bt + (size_t)u.pn * 256 * K); }
    __device__ __forceinline__ void epilogue(const f32x4 (&acc)[2][2][4][2], const Unit& u, int wr, int wc, int fr, int fq) const {
        const int pn = u.pn; const bool lat = u.pm < NLAT / 256;
        const int g = 2 * wc + (fq >> 1);
        const int rowb = u.pm * 256 + wr * 64 + fr, colb = pn * 256 + 32 * g + 8 * (fq & 1);
        const bool want_ss = pn >= 6;
        const bool rp = lat && (pn == 3 || pn == 4 || (pn == 7 && g == 4));
        const bool ss_on = pn == 6 || (pn == 7 && g < 4);
#pragma unroll
        for (int ai = 0; ai < 2; ++ai)
#pragma unroll
            for (int m = 0; m < 4; ++m) {
                const int row = rowb + ai * 128 + m * 16;
                f32x4 x1[2] = {acc[ai][0][m][0], acc[ai][1][m][0]}, x2[2] = {acc[ai][0][m][1], acc[ai][1][m][1]};
                if (rp) {
                    const f32x4* tb = (const f32x4*)(rope + ((size_t)(row & 2047) * 16 + 8 * (fq & 1)) * 2);
#pragma unroll
                    for (int bj = 0; bj < 2; ++bj) {
                        const f32x4 t0 = tb[2 * bj], t1 = tb[2 * bj + 1];
                        const f32x4 cs = {t0[0], t0[2], t1[0], t1[2]}, sn = {t0[1], t0[3], t1[1], t1[3]};
                        const f32x4 o1 = x1[bj] * cs - x2[bj] * sn, o2 = x1[bj] * sn + x2[bj] * cs;
                        x1[bj] = o1; x2[bj] = o2;
                    }
                }
                u32x4 w1, w2;
                w1.x = pk_bf16(x1[0][0], x1[0][1]); w1.y = pk_bf16(x1[0][2], x1[0][3]); w1.z = pk_bf16(x1[1][0], x1[1][1]); w1.w = pk_bf16(x1[1][2], x1[1][3]);
                w2.x = pk_bf16(x2[0][0], x2[0][1]); w2.y = pk_bf16(x2[0][2], x2[0][3]); w2.z = pk_bf16(x2[1][0], x2[1][1]); w2.w = pk_bf16(x2[1][2], x2[1][3]);
                bf16_t* prow = PB + (size_t)row * PBS + colb;
                *(u32x4*)prow = w1; *(u32x4*)(prow + 16) = w2;
                if (want_ss) {
                    float ss = 0.f;
                    if (ss_on) {
#pragma unroll
                        for (int q = 0; q < 4; ++q) {
                            const float a0 = __uint_as_float(w1[q] << 16), a1 = __uint_as_float(w1[q] & 0xffff0000u), b0 = __uint_as_float(w2[q] << 16), b1 = __uint_as_float(w2[q] & 0xffff0000u);
                            ss += a0 * a0 + a1 * a1 + b0 * b0 + b1 * b1;
                        }
                    }
                    ss += __shfl_xor(ss, 16); ss += __shfl_xor(ss, 32);
                    if (fq == 0) (pn == 6 ? ssq : sskv)[(size_t)row * 4 + wc] = ss;
                }
            }
    }
};
__device__ __forceinline__ void phase_inproj(const int L_, const int CH_, LAS unsigned char* lds) {
    const KP P = kparams();
    const Ws W(P->ws);
    if (pblk<ID_INPROJ>() < 0) return;
    ProbInProj pr; pr.ord.init(NTOK / 256, 8, pgrid<ID_INPROJ>(), pblk<ID_INPROJ>());
    pr.A = W.HB; pr.Bt = W.WB + WB_WIN; pr.PB = W.PB; pr.rope = W.rope; pr.ssq = W.ssq; pr.sskv = W.sskv;
    g8::gemm_phase(lds, pr);
}

struct UnitM { int pm, pn, kv; };
struct ProbMla {
    typedef UnitM Unit; static constexpr int K = 256;
    __device__ __forceinline__ void a_ready(const Unit&) const {}
    static constexpr bool HAS_DONE = false;
    __device__ __forceinline__ void done(int) const {}
    __device__ __forceinline__ int done_token(const Unit&) const { return -1; }
    int nq_units, n_units, G, c;
    const bf16_t* PBp; const bf16_t* Wuq; const bf16_t* Wukv; bf16_t* QM; bf16_t* KVM; const float* rope; const float* ssq; const float* sskv;
    __device__ __forceinline__ bool next(int i, Unit& u) const {
        const int L = i * G + c; if (L >= n_units) return false;
        if (L < nq_units) { u.kv = 0; u.pm = L / 3; u.pn = L % 3; } else { const int r = L - nq_units; u.kv = 1; u.pm = r >> 2; u.pn = r & 3; }
        return true;
    }
    __device__ __forceinline__ const char* a_base() const { return (const char*)PBp; }
    __device__ __forceinline__ void a_offsets(const Unit& u, const int (&R)[2], const int (&C)[2], unsigned (&o)[2][2]) const {
        const int cb = u.kv ? O_CKV : O_CQ;
#pragma unroll
        for (int h = 0; h < 2; ++h)
#pragma unroll
            for (int i = 0; i < 2; ++i) o[h][i] = (unsigned)((u.pm * 256 + h * 128 + R[i]) * PBS + cb + C[i]) * 2u;
    }
    __device__ __forceinline__ const char* b_ptr(const Unit& u) const { return (const char*)((u.kv ? Wukv : Wuq) + (size_t)u.pn * 256 * K); }
    __device__ __forceinline__ void epilogue(const f32x4 (&acc)[2][2][4][2], const Unit& u, int wr, int wc, int fr, int fq) const {
        const bool lat = u.pm < NLAT / 256;
        const int g = 2 * wc + (fq >> 1);
        const int rowb = u.pm * 256 + wr * 64 + fr, colb = u.pn * 256 + 32 * g + 8 * (fq & 1);
        const float* ssp = u.kv ? sskv : ssq; const float inv = u.kv ? (1.f / 128.f) : (1.f / 256.f);
        bf16_t* O = u.kv ? KVM : QM; const int ldo = u.kv ? 1024 : 768;
        const bool rp = !u.kv && lat && ((u.pn * 8 + g) % 3) == 2;
        float rs[2][4];
#pragma unroll
        for (int ai = 0; ai < 2; ++ai)
#pragma unroll
            for (int m = 0; m < 4; ++m) { const f32x4 s4 = *(const f32x4*)(ssp + (size_t)(rowb + ai * 128 + m * 16) * 4); rs[ai][m] = rsqrtf((s4[0] + s4[1] + s4[2] + s4[3]) * inv + 1e-6f); }
#pragma unroll
        for (int ai = 0; ai < 2; ++ai)
#pragma unroll
            for (int m = 0; m < 4; ++m) {
                const int row = rowb + ai * 128 + m * 16;
                const float rstd = rs[ai][m];
                f32x4 x1[2] = {acc[ai][0][m][0] * rstd, acc[ai][1][m][0] * rstd}, x2[2] = {acc[ai][0][m][1] * rstd, acc[ai][1][m][1] * rstd};
                if (rp) {
                    const f32x4* tb = (const f32x4*)(rope + ((size_t)(row & 2047) * 16 + 8 * (fq & 1)) * 2);
#pragma unroll
                    for (int bj = 0; bj < 2; ++bj) {
                        const f32x4 t0 = tb[2 * bj], t1 = tb[2 * bj + 1];
                        const f32x4 cs = {t0[0], t0[2], t1[0], t1[2]}, sn = {t0[1], t0[3], t1[1], t1[3]};
                        const f32x4 o1 = x1[bj] * cs - x2[bj] * sn, o2 = x1[bj] * sn + x2[bj] * cs;
                        x1[bj] = o1; x2[bj] = o2;
                    }
                }
                u32x4 w1, w2;
                w1.x = pk_bf16(x1[0][0], x1[0][1]); w1.y = pk_bf16(x1[0][2], x1[0][3]); w1.z = pk_bf16(x1[1][0], x1[1][1]); w1.w = pk_bf16(x1[1][2], x1[1][3]);
                w2.x = pk_bf16(x2[0][0], x2[0][1]); w2.y = pk_bf16(x2[0][2], x2[0][3]); w2.z = pk_bf16(x2[1][0], x2[1][1]); w2.w = pk_bf16(x2[1][2], x2[1][3]);
                bf16_t* prow = O + (size_t)row * ldo + colb;
                *(u32x4*)prow = w1; *(u32x4*)(prow + 16) = w2;
            }
    }
};
__device__ __forceinline__ void phase_mla(const int L_, const int CH_, LAS unsigned char* lds) {
    const KP P = kparams();
    const Ws W(P->ws);
    const int nq = L_ == 0 ? NTOK : NLAT;
    ProbMla pr; pr.nq_units = (nq / 256) * 3; pr.n_units = pr.nq_units + (NTOK / 256) * 4; pr.G = pgrid<ID_MLA>(); pr.c = pblk<ID_MLA>();
    if (pr.c < 0) return;
    pr.PBp = W.PB; pr.Wuq = W.WB + WB_WUQ; pr.Wukv = W.WB + WB_WUKV; pr.QM = W.QM; pr.KVM = W.KVM; pr.rope = W.rope; pr.ssq = W.ssq; pr.sskv = W.sskv;
    g8::gemm_phase(lds, pr);
}

struct ProbOut {
    typedef g8::Unit2 Unit; static constexpr int K = 1024;
    __device__ __forceinline__ void a_ready(const Unit&) const {}
    static constexpr bool HAS_DONE = false;
    __device__ __forceinline__ void done(int) const {}
    __device__ __forceinline__ int done_token(const Unit&) const { return -1; }
    g8::DenseOrder ord; const bf16_t* A; const bf16_t* Bt; bf16_t* XS; const float* x_in; const float* ctx_in; const float* mod_l; int layer;
    __device__ __forceinline__ bool next(int i, Unit& u) const { return ord.next(i, u); }
    __device__ __forceinline__ const char* a_base() const { return (const char*)A; }
    __device__ __forceinline__ void a_offsets(const Unit& u, const int (&R)[2], const int (&C)[2], unsigned (&o)[2][2]) const {
#pragma unroll
        for (int h = 0; h < 2; ++h)
#pragma unroll
            for (int i = 0; i < 2; ++i) o[h][i] = (unsigned)((u.pm * 256 + h * 128 + R[i]) * K + C[i]) * 2u;
    }
    __device__ __forceinline__ const char* b_ptr(const Unit& u) const { return (const char*)(Bt + (size_t)u.pn * 256 * K); }
    template <int LAYER> __device__ __forceinline__ void res_load(f32x4 (&b)[2][2], int row, int colb) const {
        if (LAYER == 0) {
            const float* xi = (row < NLAT ? x_in + (size_t)row * DM : ctx_in + (size_t)(row - NLAT) * DM) + colb;
#pragma unroll
            for (int bj = 0; bj < 2; ++bj)
#pragma unroll
                for (int n = 0; n < 2; ++n) b[bj][n] = *(const f32x4*)(xi + bj * 128 + n * 16);
        } else {
            const bf16_t* xo = XS + (size_t)row * DM + colb;
#pragma unroll
            for (int bj = 0; bj < 2; ++bj)
#pragma unroll
                for (int n = 0; n < 2; ++n) { const u32x2 w = *(const u32x2*)(xo + bj * 128 + n * 16); b[bj][n] = (f32x4){__uint_as_float(w.x << 16), __uint_as_float(w.x & 0xffff0000u), __uint_as_float(w.y << 16), __uint_as_float(w.y & 0xffff0000u)}; }
        }
    }
    template <int LAYER> __device__ __forceinline__ void epi(const f32x4 (&acc)[2][2][4][2], const Unit& u, int wr, int wc, int fr, int fq) const {
        const int r = u.pm < NLAT / 256 ? (u.pm >> 3) : 16;
        const int rowb = u.pm * 256 + wr * 64 + fr, colb = u.pn * 256 + wc * 32 + 4 * fq;
        const float* gate = mod_l + r * MODW + 2 * DM + colb;
        f32x4 gv[2][2];
#pragma unroll
        for (int bj = 0; bj < 2; ++bj)
#pragma unroll
            for (int n = 0; n < 2; ++n) gv[bj][n] = *(const f32x4*)(gate + bj * 128 + n * 16);
        if (LAYER == 1) {
#pragma unroll
            for (int ai = 0; ai < 2; ++ai) {
                u32x2 raw[4][2][2];
#pragma unroll
                for (int m = 0; m < 4; ++m)
#pragma unroll
                    for (int bj = 0; bj < 2; ++bj)
#pragma unroll
                        for (int n = 0; n < 2; ++n) raw[m][bj][n] = *(const u32x2*)(XS + (size_t)(rowb + ai * 128 + m * 16) * DM + colb + bj * 128 + n * 16);
                __builtin_amdgcn_sched_barrier(0);
#pragma unroll
                for (int m = 0; m < 4; ++m) {
                    bf16_t* xo = XS + (size_t)(rowb + ai * 128 + m * 16) * DM + colb;
#pragma unroll
                    for (int bj = 0; bj < 2; ++bj)
#pragma unroll
                        for (int n = 0; n < 2; ++n) {
                            const u32x2 w = raw[m][bj][n];
                            const f32x4 b = {__uint_as_float(w.x << 16), __uint_as_float(w.x & 0xffff0000u), __uint_as_float(w.y << 16), __uint_as_float(w.y & 0xffff0000u)};
                            const f32x4 o = b + gv[bj][n] * acc[ai][bj][m][n];
                            u32x2 ow; ow.x = pk_bf16(o[0], o[1]); ow.y = pk_bf16(o[2], o[3]);
                            *(u32x2*)(xo + bj * 128 + n * 16) = ow;
                        }
                }
                __builtin_amdgcn_sched_barrier(0);
            }
            return;
        }
        f32x4 bc[2][2], bn[2][2];
        res_load<LAYER>(bc, rowb, colb);
#pragma unroll
        for (int g = 0; g < 8; ++g) {
            const int ai = g >> 2, m = g & 3;
            const int row = rowb + ai * 128 + m * 16;
            if (g + 1 < 8) res_load<LAYER>(bn, rowb + ((g + 1) >> 2) * 128 + ((g + 1) & 3) * 16, colb);
            bf16_t* xo = XS + (size_t)row * DM + colb;
#pragma unroll
            for (int bj = 0; bj < 2; ++bj)
#pragma unroll
                for (int n = 0; n < 2; ++n) {
                    const f32x4 o = bc[bj][n] + gv[bj][n] * acc[ai][bj][m][n];
                    u32x2 ow; ow.x = pk_bf16(o[0], o[1]); ow.y = pk_bf16(o[2], o[3]);
                    *(u32x2*)(xo + bj * 128 + n * 16) = ow;
                }
#pragma unroll
            for (int bj = 0; bj < 2; ++bj)
#pragma unroll
                for (int n = 0; n < 2; ++n) bc[bj][n] = bn[bj][n];
        }
    }
    __device__ __forceinline__ void epilogue(const f32x4 (&acc)[2][2][4][2], const Unit& u, int wr, int wc, int fr, int fq) const {
        if (layer == 0) epi<0>(acc, u, wr, wc, fr, fq); else epi<1>(acc, u, wr, wc, fr, fq);
    }
};
__device__ __forceinline__ void phase_outproj(const int L_, const int CH_, LAS unsigned char* lds) {
    const KP P = kparams();
    const Ws W(P->ws);
    const int nq = L_ == 0 ? NTOK : NLAT;
    if (pblk<ID_OUTPROJ>() < 0) return;
    ProbOut pr; pr.ord.init(nq / 256, 4, pgrid<ID_OUTPROJ>(), pblk<ID_OUTPROJ>());
    pr.A = W.HB; pr.Bt = W.WB + WB_WOUT; pr.XS = W.XS; pr.x_in = P->in[0]; pr.ctx_in = P->in[2]; pr.mod_l = W.mod + (size_t)L_ * 17 * MODW; pr.layer = L_;
    g8::gemm_phase(lds, pr);
}

constexpr int NCHUNK = 2;
constexpr int CAPC = NTOK / NCHUNK;
constexpr size_t WS_LIST2 = WS_PB;
constexpr size_t WS_ACT = WS_PB + 18 * MiB;
constexpr size_t WS_Y = WS_PB + 108 * MiB;
constexpr size_t ACT_BYTES = 90 * MiB;
static_assert(WS_Y + (size_t)CAPC * 9 * 1024 <= WS_WB && (size_t)(CAPC * 9 + 65 * 255 + 256) * 512 <= ACT_BYTES, "MoE overlay fits");
constexpr int CW_CNT = 8192, CNT_STRIDE = 64;
constexpr int CW_RT = 32768;
constexpr size_t CTL_ZERO_BYTES = (size_t)(CW_RT + 2 * NCHUNK * 1024 * 16) * 4;
constexpr float Y_SCALE = 8.f;
constexpr int LDS_TAB = 131072;

typedef float f32x16 __attribute__((ext_vector_type(16)));
template <int CTRL> __device__ __forceinline__ float dppf(float v) { return __int_as_float(__builtin_amdgcn_update_dpp(0, __float_as_int(v), CTRL, 0xf, 0xf, true)); }
template <int CTRL> __device__ __forceinline__ int dppi(int v) { return __builtin_amdgcn_update_dpp(0, v, CTRL, 0xf, 0xf, true); }
__device__ __forceinline__ float gmax8f(float x) { x = fmaxf(x, dppf<0xB1>(x)); x = fmaxf(x, dppf<0x4E>(x)); return fmaxf(x, dppf<0x141>(x)); }
__device__ __forceinline__ int gmin8i(int x) { x = min(x, dppi<0xB1>(x)); x = min(x, dppi<0x4E>(x)); return min(x, dppi<0x141>(x)); }
__device__ __forceinline__ unsigned wmaxu(unsigned x) {
    x = max(x, (unsigned)dppi<0xB1>((int)x)); x = max(x, (unsigned)dppi<0x4E>((int)x)); x = max(x, (unsigned)dppi<0x141>((int)x)); x = max(x, (unsigned)dppi<0x140>((int)x));
    const unsigned a = (unsigned)__builtin_amdgcn_readlane((int)x, 0), b = (unsigned)__builtin_amdgcn_readlane((int)x, 16), c = (unsigned)__builtin_amdgcn_readlane((int)x, 32), d = (unsigned)__builtin_amdgcn_readlane((int)x, 48);
    return max(max(a, b), max(c, d));
}
__device__ __forceinline__ float wsumf(float x) {
    x += dppf<0xB1>(x); x += dppf<0x4E>(x); x += dppf<0x141>(x); x += dppf<0x140>(x);
    const float a = __int_as_float(__builtin_amdgcn_readlane(__float_as_int(x), 0)), b = __int_as_float(__builtin_amdgcn_readlane(__float_as_int(x), 16));
    const float c = __int_as_float(__builtin_amdgcn_readlane(__float_as_int(x), 32)), d = __int_as_float(__builtin_amdgcn_readlane(__float_as_int(x), 48));
    return (a + b) + (c + d);
}
#define N2_BAR() do { asm volatile("s_waitcnt lgkmcnt(0)" ::: "memory"); __builtin_amdgcn_s_barrier(); asm volatile("" ::: "memory"); } while (0)
__device__ __forceinline__ void phase_norm2(const int L_, const int CH_, LAS unsigned char* lds) {
    const KP P = kparams();
    const Ws W(P->ws);
    const int l = L_, tid = tid_opaque(), wave = __builtin_amdgcn_readfirstlane(tid >> 6), lane = tid & 63, G = pgrid<ID_NORM2>(), c = pblk<ID_NORM2>();
    if (c < 0) return;
    const int nq = l == 0 ? NTOK : NLAT, csz = nq / NCHUNK, nunits = nq / 32;
    const float* mod_l = W.mod + (size_t)l * 17 * MODW;
    const float* gn = P->in[7] + l * DM;
    const float* rw = P->in[17] + (size_t)l * DM * NEXP;
    const float* rb = P->in[18] + l * NEXP;
    int* cnt = (int*)(W.ctl + CW_CNT) + L_ * NCHUNK * 64 * CNT_STRIDE;
    uint2* list = (uint2*)(P->ws + WS_LIST2);
    constexpr int ASB = 1032;
    LAS unsigned char* Ah = lds;
    LAS unsigned char* Al = lds + 32 * ASB * 2;
    LAS float* At = (LAS float*)lds;
    constexpr int NRES = 6;
    const bf16_t* rwf = W.WB + WB_RW + ((size_t)wave * 8 * 2 * 2 * 64 + lane) * 8;
    u32x4 Bh[NRES][2], Bl[NRES][2];
#pragma unroll
    for (int ks = 0; ks < NRES; ++ks)
#pragma unroll
        for (int n = 0; n < 2; ++n) { Bh[ks][n] = *(const u32x4*)(rwf + ((ks * 2 + n) * 2) * 512); if (ks + n > 0 && !(ks == 1 && n == 1)) Bl[ks][n] = *(const u32x4*)(rwf + ((ks * 2 + n) * 2 + 1) * 512); }
    LAS unsigned char* bx = lds + 2 * 32 * ASB * 2 + wave * 2048 + lane * 16;
    static_assert(2 * 32 * ASB * 2 + 8 * 2048 <= LDS_BYTES - 64, "parked fragments fit below the barrier words");
    *(LAS u32x4*)bx = *(const u32x4*)(rwf + 512); *(LAS u32x4*)(bx + 1024) = *(const u32x4*)(rwf + ((1 * 2 + 1) * 2 + 1) * 512);
    const float rbe = rb[lane];
    u32x2 nx[4][4];
    int u = c;
    if (u < nunits) {
#pragma unroll
        for (int j = 0; j < 4; ++j)
#pragma unroll
            for (int q = 0; q < 4; ++q) nx[j][q] = *(const u32x2*)(W.XS + (size_t)(u * 32 + wave * 4 + j) * DM + 256 * q + lane * 4);
    }
    for (; u < nunits; u += G) {
        const int t0 = u * 32, r = mod_row(t0);
        {
            const float* sh = mod_l + r * MODW + 3 * DM; const float* sc = mod_l + r * MODW + 4 * DM;
            float rstd[4];
#pragma unroll
            for (int j = 0; j < 4; ++j) {
                float ss = 0.f;
#pragma unroll
                for (int q = 0; q < 4; ++q) { const u32x2 w = nx[j][q];
                    const float a0 = __uint_as_float(w.x << 16), a1 = __uint_as_float(w.x & 0xffff0000u), a2 = __uint_as_float(w.y << 16), a3 = __uint_as_float(w.y & 0xffff0000u); ss += a0 * a0 + a1 * a1 + a2 * a2 + a3 * a3; }
                rstd[j] = rsqrtf(wsumf(ss) * (1.f / DM) + 1e-6f);
            }
#pragma unroll
            for (int q = 0; q < 4; ++q) {
                const int col = 256 * q + lane * 4;
                __builtin_amdgcn_sched_barrier(0);
                const f32x4 ga = *(const f32x4*)(gn + col) * (*(const f32x4*)(sc + col) + 1.f), hb = *(const f32x4*)(sh + col);
#pragma unroll
                for (int j = 0; j < 4; ++j) {
                    const int tl = wave * 4 + j, t = t0 + tl;
                    const u32x2 w = nx[j][q];
                    const f32x4 v = {__uint_as_float(w.x << 16), __uint_as_float(w.x & 0xffff0000u), __uint_as_float(w.y << 16), __uint_as_float(w.y & 0xffff0000u)};
                    const f32x4 o = v * rstd[j] * ga + hb;
                    u32x2 ow; ow.x = pk_bf16(o[0], o[1]); ow.y = pk_bf16(o[2], o[3]);
                    *(u32x2*)(W.HB + (size_t)t * DM + col) = ow;
                    u32x2 lw; lw.x = pk_bf16(o[0] - __uint_as_float(ow.x << 16), o[1] - __uint_as_float(ow.x & 0xffff0000u)); lw.y = pk_bf16(o[2] - __uint_as_float(ow.y << 16), o[3] - __uint_as_float(ow.y & 0xffff0000u));
                    *(LAS u32x2*)(Ah + (tl * ASB + col) * 2) = ow;
                    *(LAS u32x2*)(Al + (tl * ASB + col) * 2) = lw;
                }
            }
        }
        if (u + G < nunits) {
#pragma unroll
            for (int j = 0; j < 4; ++j)
#pragma unroll
                for (int q = 0; q < 4; ++q) nx[j][q] = *(const u32x2*)(W.XS + (size_t)((u + G) * 32 + wave * 4 + j) * DM + 256 * q + lane * 4);
        }
        u32x4 Bsh[8 - NRES][2], Bsl[8 - NRES][2];
        {
            const bf16_t* rws = rwf; asm volatile("" : "+v"(rws));
#pragma unroll
            for (int ks = NRES; ks < 8; ++ks)
#pragma unroll
                for (int n = 0; n < 2; ++n) { Bsh[ks - NRES][n] = *(const u32x4*)(rws + ((ks * 2 + n) * 2) * 512); Bsl[ks - NRES][n] = *(const u32x4*)(rws + ((ks * 2 + n) * 2 + 1) * 512); }
        }
        N2_BAR();
        f32x16 acc0, acc1;
#pragma unroll
        for (int i = 0; i < 16; ++i) { acc0[i] = 0.f; acc1[i] = 0.f; }
        const unsigned aoff = (unsigned)(((lane & 31) * ASB + 128 * wave + 8 * (lane >> 5)) * 2);
#pragma unroll
        for (int ks = 0; ks < 8; ++ks) {
            const bf16x8 arh = *(const LAS bf16x8*)(Ah + aoff + 32 * ks), arl = *(const LAS bf16x8*)(Al + aoff + 32 * ks);
#pragma unroll
            for (int n = 0; n < 2; ++n) {
                const bf16x8 bh = __builtin_bit_cast(bf16x8, ks < NRES ? Bh[ks < NRES ? ks : 0][n] : Bsh[ks < NRES ? 0 : ks - NRES][n]);
                const bf16x8 bl = (ks == 0 && n == 0) ? *(const LAS bf16x8*)bx : ((ks == 1 && n == 1) ? *(const LAS bf16x8*)(bx + 1024) : __builtin_bit_cast(bf16x8, ks < NRES ? Bl[ks < NRES ? ks : 0][n] : Bsl[ks < NRES ? 0 : ks - NRES][n]));
                f32x16& acc = n == 0 ? acc0 : acc1;
                acc = __builtin_amdgcn_mfma_f32_32x32x16_bf16(arh, bh, acc, 0, 0, 0);
                acc = __builtin_amdgcn_mfma_f32_32x32x16_bf16(arl, bh, acc, 0, 0, 0);
                acc = __builtin_amdgcn_mfma_f32_32x32x16_bf16(arh, bl, acc, 0, 0, 0);
            }
            __builtin_amdgcn_sched_barrier(0);
        }
        N2_BAR();
        LAS float* part = At;
#pragma unroll
        for (int i = 0; i < 16; ++i) {
            const int tok = (i & 3) + 8 * (i >> 2) + 4 * (lane >> 5);
            part[(wave * 32 + tok) * 64 + (lane & 31)] = acc0[i];
            part[(wave * 32 + tok) * 64 + 32 + (lane & 31)] = acc1[i];
        }
        N2_BAR();
        int slot_[4]; float w_[4]; int rk_[4];
#pragma unroll
        for (int j = 0; j < 4; ++j) {
            const int tl = wave * 4 + j, t = t0 + tl, e = lane;
            float lg = 0.f;
#pragma unroll
            for (int w8 = 0; w8 < 8; ++w8) lg += part[(w8 * 32 + tl) * 64 + e];
            const float sc = __builtin_amdgcn_rcpf(1.f + __expf(-lg));
            const float sel = sc + rbe;
            const float m1 = gmax8f(sel);
            const int cand = gmin8i((sel == m1) ? (e & 7) : 8);
            const float m2 = gmax8f(((e & 7) == cand) ? -INFINITY : sel);
            const float grp = m1 + m2;
            const int g = e >> 3;
            int grank = 0;
#pragma unroll
            for (int gg = 0; gg < 8; ++gg) { const float og = __int_as_float(__builtin_amdgcn_readlane(__float_as_int(grp), gg * 8)); grank += (og > grp || (og == grp && gg < g)) ? 1 : 0; }
            const bool gsel = grank < 4;
            const unsigned sb = __float_as_uint(sel);
            unsigned key = gsel ? (sb ^ ((sb >> 31) ? 0xffffffffu : 0x80000000u)) : 0u;
            int rk = 8;
#pragma unroll
            for (int k = 0; k < 8; ++k) {
                const unsigned M = wmaxu(key);
                const unsigned long long bal = __ballot(key == M);
                const int idx = __builtin_ctzll(bal);
                if (e == idx) { rk = k; key = 0u; }
            }
            const bool chosen = rk < 8;
            const float wsum = wsumf(chosen ? sc : 0.f);
            w_[j] = sc / wsum * 2.5f; rk_[j] = rk; slot_[j] = 0;
            if (chosen) slot_[j] = atomicAdd(&cnt[((t / csz) * 64 + e) * CNT_STRIDE], 1);
        }
#pragma unroll
        for (int j = 0; j < 4; ++j) {
            const int t = t0 + wave * 4 + j;
            if (rk_[j] < 8) list[((size_t)(t / csz) * 64 + lane) * CAPC + slot_[j]] = make_uint2((unsigned)(t * 8 + rk_[j]), __float_as_uint(w_[j]));
        }
        N2_BAR();
    }
}
#undef N2_BAR

struct UnitG { int e, t, pn, cnt, pb; };
struct MoeTab {
    const LAS int* cnts; const LAS int* pre;
    const LAS int* xpre; int ntiles, xl, x, nb, j, nseg, st0, xtiles;
    __device__ __forceinline__ void locate(int rtl, int& e, int& t) const {
        int sg = 0; while (xpre[sg + 1] <= rtl) ++sg;
        t = rtl - xpre[sg];
        if (sg < nseg - 1) e = x + xl * sg; else { e = 64; t += st0; }
    }
};
__device__ __forceinline__ MoeTab moe_table(const KP P, const int L_, LAS unsigned char* lds, int ch, int csz) {
    const Ws W(P->ws);
    LAS int* cnts = (LAS int*)(lds + LDS_TAB); LAS int* pre = cnts + 80; LAS int* xpre = pre + 80;
    const int tid = tid_opaque();
    const int G = pgrid<ID_MOE>(), c = pblk<ID_MOE>();
    MoeTab T; T.cnts = cnts; T.pre = pre; T.xpre = xpre;
    if ((G & 7) == 0) { T.xl = 8; T.x = c & 7; T.nb = G >> 3; T.j = c >> 3; } else { T.xl = 1; T.x = 0; T.nb = G; T.j = c; }
    T.nseg = 64 / T.xl + 1;
    if (tid < 64) cnts[tid] = (int)__hip_atomic_load(W.ctl + CW_CNT + ((L_ * NCHUNK + ch) * 64 + tid) * CNT_STRIDE, __ATOMIC_RELAXED, __HIP_MEMORY_SCOPE_AGENT);
    if (tid == 64) cnts[64] = csz;
    __syncthreads();
    const int stiles = (csz + 255) >> 8, sper = (stiles + T.xl - 1) / T.xl;
    T.st0 = T.x * sper;
    if (tid == 0) {
        int s = 0; for (int e = 0; e < 65; ++e) { pre[e] = s; s += (cnts[e] + 255) >> 8; } pre[65] = s;
        int q = 0;
        for (int sg = 0; sg < T.nseg - 1; ++sg) { xpre[sg] = q; q += (cnts[T.x + T.xl * sg] + 255) >> 8; }
        xpre[T.nseg - 1] = q; { int n = stiles - T.st0; n = n < 0 ? 0 : (n > sper ? sper : n); q += n; }
        xpre[T.nseg] = q;
    }
    __syncthreads();
    T.ntiles = pre[65]; T.xtiles = xpre[T.nseg];
    return T;
}
struct ProbMoe1 {
    typedef UnitG Unit; static constexpr int K = 1024;
    int G, c, chunk_base; MoeTab T;
    const uint2* list; const bf16_t* HB; const bf16_t* Wgu; __amdgpu_buffer_rsrc_t act_rs; unsigned* rtcnt;
    __device__ __forceinline__ bool next(int i, Unit& u) const {
        const int L = i * T.nb + T.j; if (L >= 2 * T.xtiles) return false;
        u.pn = L & 1;
        int e, t; T.locate(L >> 1, e, t);
        e = __builtin_amdgcn_readfirstlane(e); t = __builtin_amdgcn_readfirstlane(t);
        u.e = e; u.t = t; u.cnt = __builtin_amdgcn_readfirstlane(T.cnts[e]); u.pb = __builtin_amdgcn_readfirstlane((T.pre[e] + t) * 256); return true;
    }
    __device__ __forceinline__ void a_ready(const Unit&) const {}
    static constexpr bool HAS_DONE = true;
    __device__ __forceinline__ int done_token(const Unit& u) const { return __builtin_amdgcn_readfirstlane(u.pb >> 8); }
    __device__ __forceinline__ void done(int rt) const {
        if ((threadIdx.x & 63) == 0) (void)__hip_atomic_fetch_add(rtcnt + 16 * rt, 1u, __ATOMIC_RELAXED, __HIP_MEMORY_SCOPE_AGENT);
    }
    __device__ __forceinline__ const char* a_base() const { return (const char*)HB; }
    __device__ __forceinline__ void a_offsets(const Unit& u, const int (&R)[2], const int (&C)[2], unsigned (&o)[2][2]) const {
#pragma unroll
        for (int h = 0; h < 2; ++h)
#pragma unroll
            for (int i = 0; i < 2; ++i) {
                const int slot = u.t * 256 + h * 128 + R[i]; int tok = 0;
                if (slot < u.cnt) tok = u.e < 64 ? (int)(list[(size_t)u.e * CAPC + slot].x >> 3) : chunk_base + slot;
                o[h][i] = (unsigned)tok * 2048u + (unsigned)C[i] * 2u;
            }
    }
    __device__ __forceinline__ const char* b_ptr(const Unit& u) const { return (const char*)(Wgu + (size_t)u.e * 524288 + (size_t)u.pn * 256 * K); }
    __device__ __forceinline__ void epilogue(const f32x4 (&acc)[2][2][4][2], const Unit& u, int wr, int wc, int fr, int fq) const {
        float wv[2][4];
#pragma unroll
        for (int ai = 0; ai < 2; ++ai)
#pragma unroll
            for (int m = 0; m < 4; ++m) {
                const int slot = u.t * 256 + ai * 128 + wr * 64 + m * 16 + fr;
                wv[ai][m] = 0.f;
                if (slot < u.cnt) wv[ai][m] = u.e < 64 ? __uint_as_float(list[(size_t)u.e * CAPC + slot].y) : 1.f;
            }
#pragma unroll
        for (int ai = 0; ai < 2; ++ai)
#pragma unroll
            for (int m = 0; m < 4; ++m) {
                const int rl = ai * 128 + wr * 64 + m * 16 + fr;
                const float w = wv[ai][m];
                float a[8];
#pragma unroll
                for (int bj = 0; bj < 2; ++bj) {
                    const f32x4 g = acc[ai][bj][m][0], up = acc[ai][bj][m][1];
#pragma unroll
                    for (int j = 0; j < 4; ++j) a[4 * bj + j] = g[j] * __builtin_amdgcn_rcpf(1.f + __expf(-g[j])) * up[j] * w;
                }
                u32x4 o; o.x = pk_bf16(a[0], a[1]); o.y = pk_bf16(a[2], a[3]); o.z = pk_bf16(a[4], a[5]); o.w = pk_bf16(a[6], a[7]);
                __builtin_amdgcn_raw_buffer_store_b128(o, act_rs, (int)(((unsigned)(u.pb + rl) * 256u + 128u * u.pn + 32u * wc + 8u * fq) * 2u), 0, 16);
            }
    }
};
struct MoeDown {
    int G, c, chunk_base, shift; MoeTab T;
    const uint2* list; const bf16_t* act; const bf16_t* Wd; unsigned char* ws; unsigned junk; unsigned* rtcnt; unsigned* tmo;
};
__device__ __forceinline__ void moe_down_phase(LAS unsigned char* lds, const MoeDown& D) {
    const int tid = tid_opaque(), wave = __builtin_amdgcn_readfirstlane(tid >> 6), lane = tid & 63, fr = lane & 15, fq = lane >> 4;
    const int jblk = (D.T.j - D.shift + D.T.nb) % D.T.nb;
    unsigned goff[4];
#pragma unroll
    for (int i = 0; i < 4; ++i) { const int row = 2 * (4 * wave + i) + (lane >> 5), p = lane & 31; goff[i] = (unsigned)(row * 256 + ((p ^ (row & 15)) * 8)) * 2u; }
    const unsigned ldsw = (unsigned)wave * 4096u;
    for (int rtl = jblk; rtl < D.T.xtiles; rtl += D.T.nb) {
        int e, t_in; D.T.locate(rtl, e, t_in);
        e = __builtin_amdgcn_readfirstlane(e); t_in = __builtin_amdgcn_readfirstlane(t_in);
        const int rt = __builtin_amdgcn_readfirstlane(D.T.pre[e] + t_in), cnt = __builtin_amdgcn_readfirstlane(D.T.cnts[e]), pb = rt * 256;
        if (tid < 64) {
            unsigned* w = D.rtcnt + 16 * rt; unsigned sp = 0u;
            while ((unsigned)__builtin_amdgcn_readfirstlane(__hip_atomic_load(w, __ATOMIC_RELAXED, __HIP_MEMORY_SCOPE_AGENT)) < 16u) {
                __builtin_amdgcn_s_sleep(2);
                if ((++sp & 255u) == 0u) { if (__hip_atomic_load(D.tmo, __ATOMIC_RELAXED, __HIP_MEMORY_SCOPE_AGENT)) break; if (sp > (1u << 20)) { atomicAdd(D.tmo, 1u); break; } }
            }
            __builtin_amdgcn_fence(__ATOMIC_ACQUIRE, "agent");
            asm volatile("s_waitcnt vmcnt(0)" ::: "memory");
        }
        __syncthreads();
        bf16x8 af[2][8];
#pragma unroll
        for (int m = 0; m < 2; ++m)
#pragma unroll
            for (int ks = 0; ks < 8; ++ks) af[m][ks] = *(const bf16x8*)(D.act + (size_t)(pb + 32 * wave + 16 * m + fr) * 256 + 32 * ks + 8 * fq);
        unsigned yo[2];
#pragma unroll
        for (int m = 0; m < 2; ++m) {
            const int slot = t_in * 256 + 32 * wave + 16 * m + fr;
            yo[m] = D.junk;
            if (slot < cnt) {
                if (e < 64) { const unsigned x = D.list[(size_t)e * CAPC + slot].x; yo[m] = (unsigned)WS_Y + (unsigned)(((int)(x >> 3) - D.chunk_base) * 9 + (int)(x & 7u)) * 1024u; }
                else yo[m] = (unsigned)WS_Y + (unsigned)(slot * 9 + 8) * 1024u;
            }
        }
        const char* wb = (const char*)(D.Wd + (size_t)e * 262144);
#define MD_ISSUE(ch) do { _Pragma("unroll") for (int i = 0; i < 4; ++i) \
        __builtin_amdgcn_global_load_lds((const unsigned*)(wb + (size_t)(ch) * 32768 + goff[i]), (LAS unsigned*)(lds + ((ch) & 3) * 32768 + ldsw + i * 1024), 16, 0, 0); } while (0)
        MD_ISSUE(0); MD_ISSUE(1); MD_ISSUE(2);
#pragma unroll 1
        for (int ch = 0; ch < 16; ++ch) {
            if (ch >= 3 && ch < 14) asm volatile("s_waitcnt vmcnt(14)" ::: "memory");
            else if (ch < 3) asm volatile("s_waitcnt vmcnt(8)" ::: "memory");
            else asm volatile("s_waitcnt vmcnt(6)" ::: "memory");
            __builtin_amdgcn_s_barrier();
            asm volatile("" ::: "memory");
            if (ch + 3 < 16) MD_ISSUE(ch + 3);
            f32x4 acc[2][4];
#pragma unroll
            for (int m = 0; m < 2; ++m)
#pragma unroll
                for (int n = 0; n < 4; ++n) acc[m][n] = (f32x4){0.f, 0.f, 0.f, 0.f};
            const LAS unsigned char* bb = lds + (ch & 3) * 32768 + fr * 512;
            bf16x8 bq[3][4];
#pragma unroll
            for (int n = 0; n < 4; ++n) { bq[0][n] = *(const LAS bf16x8*)(bb + n * 8192 + ((fq ^ fr) * 16)); bq[1][n] = *(const LAS bf16x8*)(bb + n * 8192 + (((4 + fq) ^ fr) * 16)); }
#pragma unroll
            for (int ks = 0; ks < 8; ++ks) {
                __builtin_amdgcn_s_waitcnt(0xC07F);
                if (ks + 2 < 8) {
#pragma unroll
                    for (int n = 0; n < 4; ++n) bq[(ks + 2) % 3][n] = *(const LAS bf16x8*)(bb + n * 8192 + (((4 * (ks + 2) + fq) ^ fr) * 16));
                }
                __builtin_amdgcn_sched_barrier(0);
#pragma unroll
                for (int n = 0; n < 4; ++n) {
                    acc[0][n] = __builtin_amdgcn_mfma_f32_16x16x32_bf16(bq[ks % 3][n], af[0][ks], acc[0][n], 0, 0, 0);
                    acc[1][n] = __builtin_amdgcn_mfma_f32_16x16x32_bf16(bq[ks % 3][n], af[1][ks], acc[1][n], 0, 0, 0);
                }
                __builtin_amdgcn_sched_barrier(0);
            }
            asm volatile("s_waitcnt lgkmcnt(0)" ::: "memory");
#pragma unroll
            for (int m = 0; m < 2; ++m) {
                {
                    u32x4 o; int w;
#pragma unroll
                    for (int n = 0; n < 4; ++n) {
                        f32x4 v = acc[m][n] * Y_SCALE;
#pragma unroll
                        for (int q = 0; q < 4; ++q) v[q] = __builtin_amdgcn_fmed3f(v[q], -440.f, 440.f);
                        w = __builtin_amdgcn_cvt_pk_fp8_f32(v[0], v[1], 0, false); w = __builtin_amdgcn_cvt_pk_fp8_f32(v[2], v[3], w, true); o[n] = (unsigned)w;
                    }
                    *(u32x4*)(D.ws + yo[m] + 64 * ch + 16 * fq) = o;
                }
            }
        }
        asm volatile("s_waitcnt vmcnt(0)" ::: "memory");
        __syncthreads();
#undef MD_ISSUE
    }
}
__device__ __forceinline__ void phase_moe(const int L_, const int CH_, LAS unsigned char* lds) {
    const KP P = kparams();
    const Ws W(P->ws);
    const int nq = L_ == 0 ? NTOK : NLAT, csz = nq / NCHUNK, ch = CH_;
    unsigned* rtcnt = W.ctl + CW_RT + (size_t)(L_ * NCHUNK + ch) * 1024 * 16;
    if (pblk<ID_MOE>() < 0) return;
    const MoeTab T = moe_table(P, L_, lds, ch, csz);
    {
        ProbMoe1 pr; pr.G = pgrid<ID_MOE>(); pr.c = pblk<ID_MOE>(); pr.chunk_base = ch * csz; pr.T = T;
        pr.list = (const uint2*)(P->ws + WS_LIST2) + (size_t)ch * 64 * CAPC; pr.HB = W.HB; pr.Wgu = W.WB + WB_WGU;
        pr.act_rs = __builtin_amdgcn_make_buffer_rsrc((void*)(P->ws + WS_ACT), 0, (int)ACT_BYTES, 0x00020000); pr.rtcnt = rtcnt;
        g8::gemm_phase(lds, pr);
    }
    {
        MoeDown D; D.G = pgrid<ID_MOE>(); D.c = pblk<ID_MOE>(); D.chunk_base = ch * csz; D.shift = (2 * T.xtiles) % T.nb; D.T = T;
        D.list = (const uint2*)(P->ws + WS_LIST2) + (size_t)ch * 64 * CAPC; D.act = (const bf16_t*)(P->ws + WS_ACT); D.Wd = W.WB + WB_WD;
        D.ws = P->ws; D.junk = (unsigned)WS_JUNK + (unsigned)pblk<ID_MOE>() * 1024u; D.rtcnt = rtcnt; D.tmo = W.ctl + 128;
        moe_down_phase(lds, D);
    }
}
__device__ __forceinline__ void phase_comb(const int L_, const int CH_, LAS unsigned char* lds) {
    const KP P = kparams();
    const Ws W(P->ws);
    const int nq = L_ == 0 ? NTOK : NLAT, csz = nq / NCHUNK, ch = CH_, base = ch * csz;
    const int tid = tid_opaque(), wave = tid >> 6, lane = tid & 63;
    const float* mod_l = W.mod + (size_t)L_ * 17 * MODW;
    const float* mod_n = W.mod + (size_t)17 * MODW;
    const float* gn1 = P->in[6] + DM;
    const float* fg = P->in[25];
    const unsigned char* Y = (const unsigned char*)(P->ws + WS_Y);
    const int col = lane * 16;
    if (pblk<ID_COMB>() < 0) return;
    for (int tl = pblk<ID_COMB>() * 8 + wave; tl < csz; tl += pgrid<ID_COMB>() * 8) {
        const int t = base + tl, r = mod_row(t);
        const float* g2 = mod_l + r * MODW + 5 * DM + col;
        bf16_t* xr = W.XS + (size_t)t * DM + col;
        float s[16];
#pragma unroll
        for (int i = 0; i < 16; ++i) s[i] = 0.f;
#pragma unroll
        for (int k = 0; k < 9; ++k) {
            const u32x4 v = *(const u32x4*)(Y + ((size_t)tl * 9 + k) * 1024 + col);
            const unsigned wv[4] = {v.x, v.y, v.z, v.w};
#pragma unroll
            for (int q = 0; q < 4; ++q) {
                const f32x2 lo = __builtin_amdgcn_cvt_pk_f32_fp8((int)wv[q], false), hi = __builtin_amdgcn_cvt_pk_f32_fp8((int)wv[q], true);
                s[4 * q] += lo[0]; s[4 * q + 1] += lo[1]; s[4 * q + 2] += hi[0]; s[4 * q + 3] += hi[1];
            }
        }
        f32x4 xn[4]; float ss = 0.f;
        const u32x4 xw0 = *(const u32x4*)xr, xw1 = *(const u32x4*)(xr + 8);
        const unsigned xw[8] = {xw0.x, xw0.y, xw0.z, xw0.w, xw1.x, xw1.y, xw1.z, xw1.w};
        u32x4 xo[2];
#pragma unroll
        for (int q = 0; q < 4; ++q) {
            const f32x4 x = {__uint_as_float(xw[2 * q] << 16), __uint_as_float(xw[2 * q] & 0xffff0000u), __uint_as_float(xw[2 * q + 1] << 16), __uint_as_float(xw[2 * q + 1] & 0xffff0000u)};
            const f32x4 g = *(const f32x4*)(g2 + 4 * q);
            const f32x4 sv = {s[4 * q], s[4 * q + 1], s[4 * q + 2], s[4 * q + 3]};
            xn[q] = x + g * sv * (1.f / Y_SCALE);
            ss += xn[q][0] * xn[q][0] + xn[q][1] * xn[q][1] + xn[q][2] * xn[q][2] + xn[q][3] * xn[q][3];
            xo[q >> 1][2 * (q & 1)] = pk_bf16(xn[q][0], xn[q][1]); xo[q >> 1][2 * (q & 1) + 1] = pk_bf16(xn[q][2], xn[q][3]);
        }
        if (L_ == 0) { *(u32x4*)xr = xo[0]; *(u32x4*)(xr + 8) = xo[1]; }
        ss = wave_sum(ss);
        const float rstd = rsqrtf(ss * (1.f / DM) + 1e-6f);
        if (L_ == 0) {
            const float* sh = mod_n + r * MODW + col; const float* sc = mod_n + r * MODW + DM + col;
            u32x4 o[2];
#pragma unroll
            for (int q = 0; q < 4; ++q) {
                const f32x4 g4 = *(const f32x4*)(gn1 + col + 4 * q), s4 = *(const f32x4*)(sc + 4 * q), h4 = *(const f32x4*)(sh + 4 * q);
                const f32x4 ov = xn[q] * rstd * g4 * (s4 + 1.f) + h4;
                o[q >> 1][2 * (q & 1)] = pk_bf16(ov[0], ov[1]); o[q >> 1][2 * (q & 1) + 1] = pk_bf16(ov[2], ov[3]);
            }
            *(u32x4*)(W.HB + (size_t)t * DM + col) = o[0]; *(u32x4*)(W.HB + (size_t)t * DM + col + 8) = o[1];
        } else {
#pragma unroll
            for (int q = 0; q < 4; ++q) {
                const f32x4 g4 = *(const f32x4*)(fg + col + 4 * q);
                *(f32x4*)(P->out + (size_t)t * DM + col + 4 * q) = xn[q] * rstd * g4;
            }
        }
    }
}

__device__ __forceinline__ void phase_norm1(const int L_, const int CH_, LAS unsigned char* lds) {
    const KP P = kparams();
    const Ws W(P->ws);
    const int l = L_, tid = tid_opaque(), wave = tid >> 6, lane = tid & 63;
    const float* mod_l = W.mod + (size_t)l * 17 * MODW;
    const float* gn = P->in[6] + l * DM;
    if (pblk<ID_NORM1>() < 0) return;
    for (int t = pblk<ID_NORM1>() * 8 + wave; t < NTOK; t += pgrid<ID_NORM1>() * 8) {
        const int r = mod_row(t);
        const float* xr = t < NLAT ? P->in[0] + (size_t)t * DM : P->in[2] + (size_t)(t - NLAT) * DM;
        const float* sh = mod_l + r * MODW; const float* sc = mod_l + r * MODW + DM;
        f32x4 v[4]; float ss = 0.f;
#pragma unroll
        for (int q = 0; q < 4; ++q) { v[q] = *(const f32x4*)(xr + 256 * q + lane * 4); ss += v[q][0] * v[q][0] + v[q][1] * v[q][1] + v[q][2] * v[q][2] + v[q][3] * v[q][3]; }
        ss = wave_sum(ss);
        const float rstd = rsqrtf(ss * (1.f / DM) + 1e-6f);
#pragma unroll
        for (int q = 0; q < 4; ++q) {
            const int col = 256 * q + lane * 4;
            const f32x4 g4 = *(const f32x4*)(gn + col), s4 = *(const f32x4*)(sc + col), h4 = *(const f32x4*)(sh + col);
            const f32x4 o = v[q] * rstd * g4 * (s4 + 1.f) + h4;
            u32x2 w; w.x = pk_bf16(o[0], o[1]); w.y = pk_bf16(o[2], o[3]);
            *(u32x2*)(W.HB + (size_t)t * DM + col) = w;
        }
    }
}

typedef short v4i16_t __attribute__((ext_vector_type(4)));
__device__ __forceinline__ bf16x8 pack8(float a0, float a1, float a2, float a3, float a4, float a5, float a6, float a7) {
    u32x4 w; w.x = pk_bf16(a0, a1); w.y = pk_bf16(a2, a3); w.z = pk_bf16(a4, a5); w.w = pk_bf16(a6, a7); return __builtin_bit_cast(bf16x8, w);
}
__device__ __forceinline__ float max3f_w(float a, float b, float c) { float r; asm volatile("s_nop 7\n\ts_nop 7\n\ts_nop 3\n\tv_max3_f32 %0, %1, %2, %3" : "=v"(r) : "v"(a), "v"(b), "v"(c)); return r; }
__device__ __forceinline__ float max3f(float a, float b, float c) { float r; asm volatile("v_max3_f32 %0, %1, %2, %3" : "=v"(r) : "v"(a), "v"(b), "v"(c)); return r; }
__device__ __forceinline__ float max32(const f32x16& a, const f32x16& b) {
    float m0 = max3f_w(a[0], a[1], a[2]);
    float m1 = max3f_w(b[0], b[1], b[2]);
    m0 = max3f(m0, a[3], a[4]); m1 = max3f(m1, b[3], b[4]); m0 = max3f(m0, a[5], a[6]); m1 = max3f(m1, b[5], b[6]);
    m0 = max3f(m0, a[7], a[8]); m1 = max3f(m1, b[7], b[8]); m0 = max3f(m0, a[9], a[10]); m1 = max3f(m1, b[9], b[10]);
    m0 = max3f(m0, a[11], a[12]); m1 = max3f(m1, b[11], b[12]); m0 = max3f(m0, a[13], a[14]); m1 = max3f(m1, b[13], b[14]);
    return max3f(m0, m1, fmaxf(a[15], b[15]));
}
__device__ __forceinline__ bf16x8 scale8(bf16x8 v, float c) {
    u32x4 w = __builtin_bit_cast(u32x4, v);
#pragma unroll
    for (int i = 0; i < 4; ++i) w[i] = pk_bf16(__uint_as_float(w[i] << 16) * c, __uint_as_float(w[i] & 0xffff0000u) * c);
    return __builtin_bit_cast(bf16x8, w);
}
constexpr int AT_KBUF = 64 * 208, AT_STAGE = AT_KBUF + 8192, AT_BT = 3 * AT_STAGE;
template <int MODE>
__device__ __forceinline__ void attn_unit(const KP P, const int L_, const Ws& W, LAS unsigned char* lds, const int b, const int h, const int qb, const bool ctxq) {
    constexpr int NST = MODE == 2 ? 6 : (MODE == 1 ? 2 : 4);
    constexpr int NMAP = MODE == 1 ? 2 : 1;
    constexpr int KSTR = MODE == 2 ? 208 : 144;
    constexpr float CS = MODE == 2 ? 0.14724444602590306f : (MODE == 1 ? 0.25503486164919736f : 0.18033688011112042f);
    constexpr float NEG = -1e30f;
    const int tid = tid_opaque(), wave = __builtin_amdgcn_readfirstlane(tid >> 6), lane = tid & 63, r32 = lane & 31, hh = lane >> 5;
    const int l = L_;
    const int t0 = ctxq ? NLAT + b * CTX : b * SEQ + qb * 256;
    const int tq = t0 + wave * 32 + r32;
    bf16x8 qf[NMAP][NST];
    {
        const bf16_t* src = MODE == 2 ? W.QM + (size_t)tq * 768 + h * 96 : W.PB + (size_t)tq * PBS + (MODE == 1 ? O_DQ : O_NAQ) + h * 64;
#pragma unroll
        for (int mp = 0; mp < NMAP; ++mp)
#pragma unroll
            for (int st = 0; st < NST; ++st) qf[mp][st] = scale8(*(const bf16x8*)(src + 32 * mp + 16 * st + 8 * hh), CS);
    }
    int ntiles = 36, nwin = 0, krs = 0;
    if (ctxq) ntiles = 4;
    else if (MODE == 0) { krs = min(max(4 * qb - 4, 0), 24); nwin = min(max(4 * qb - 1, 0), 24) + 8 - krs; ntiles = nwin + 4; }
    LAS float* btab = (LAS float*)(lds + AT_BT);
    if (MODE == 0 && !ctxq) { const float* rbp = P->in[9] + ((size_t)l * 4 + h) * 465; for (int i = tid; i < 465; i += NTHREADS) btab[i] = 1.4426950408889634f * rbp[i]; }
    const int kkey = tid >> 3, kch = tid & 7;
    const unsigned kw_off = (unsigned)(kkey * KSTR + kch * 16);
    const unsigned rw_off = (unsigned)((tid >> 2) * KSTR + 128 + (tid & 3) * 16);
    const unsigned vw_off = (unsigned)(AT_KBUF + ((kkey >> 2) * 2 + (kch >> 2)) * 256 + (kkey & 3) * 64 + (kch & 3) * 16);
    u32x4 kregA, vregA, rregA = {0u, 0u, 0u, 0u}, kregB, vregB, rregB = {0u, 0u, 0u, 0u};
#define AT_ROW0(i) (ctxq ? NLAT + b * CTX + 64 * (i) : (MODE == 0 ? ((i) < nwin ? b * SEQ + 64 * (krs + (i)) : NLAT + b * CTX + 64 * ((i) - nwin)) : ((i) < 32 ? b * SEQ + 64 * (i) : NLAT + b * CTX + 64 * ((i) - 32))))
#define AT_LOAD(i, X) do { const int row0_ = AT_ROW0(i); \
        if (MODE == 2) { const bf16_t* kp_ = W.KVM + (size_t)(row0_ + kkey) * 1024 + h * 128 + 8 * kch; kreg##X = *(const u32x4*)kp_; vreg##X = *(const u32x4*)(kp_ + 64); \
                         if (tid < 256) rreg##X = *(const u32x4*)(W.PB + (size_t)(row0_ + (tid >> 2)) * PBS + O_KR + 8 * (tid & 3)); } \
        else { const bf16_t* kp_ = W.PB + (size_t)(row0_ + kkey) * PBS + h * 64 + 8 * kch; kreg##X = *(const u32x4*)(kp_ + (MODE == 1 ? O_DK : O_NAK)); vreg##X = *(const u32x4*)(kp_ + (MODE == 1 ? O_DV : O_NAV)); } } while (0)
#define AT_WRITE(buf, X) do { LAS unsigned char* sb_ = lds + (buf) * AT_STAGE; *(LAS u32x4*)(sb_ + kw_off) = kreg##X; *(LAS u32x4*)(sb_ + vw_off) = vreg##X; \
        if (MODE == 2 && tid < 256) *(LAS u32x4*)(sb_ + rw_off) = rreg##X; } while (0)
    constexpr float THR = 8.f;
    f32x16 O[NMAP][2], NM[NMAP]; float lrun[NMAP]; int started = 0;
    float one_a = 1.f, one_b = 1.f; asm volatile("" : "+v"(one_a)); asm volatile("" : "+v"(one_b));
#pragma unroll
    for (int mp = 0; mp < NMAP; ++mp) { lrun[mp] = 0.f;
#pragma unroll
        for (int i = 0; i < 16; ++i) NM[mp][i] = 0.f;
#pragma unroll
        for (int d = 0; d < 2; ++d)
#pragma unroll
            for (int i = 0; i < 16; ++i) O[mp][d][i] = 0.f; }
    const unsigned kr_off = (unsigned)(r32 * KSTR + hh * 16);
    const unsigned vr_off = (unsigned)(AT_KBUF + hh * 512 + ((lane & 15) >> 2) * 64 + (((lane >> 4) & 1) * 16 + (lane & 3) * 4) * 2);
#define AT_BAR() do { asm volatile("s_waitcnt lgkmcnt(0)" ::: "memory"); __builtin_amdgcn_s_barrier(); asm volatile("" ::: "memory"); } while (0)
    constexpr bool DEEP = (MODE != 1);
#define AT_QK(mp, Sa, Sb, sbp) do { \
        _Pragma("unroll") for (int st = 0; st < NST; ++st) { \
            const bf16x8 k0_ = *(const LAS bf16x8*)((sbp) + kr_off + ((MODE == 1 ? 4 * (mp) : 0) + 2 * st) * 16); \
            const bf16x8 k1_ = *(const LAS bf16x8*)((sbp) + kr_off + 32 * KSTR + ((MODE == 1 ? 4 * (mp) : 0) + 2 * st) * 16); \
            Sa = __builtin_amdgcn_mfma_f32_32x32x16_bf16(k0_, qf[mp][st], st == 0 ? NM[mp] : Sa, 0, 0, 0); \
            Sb = __builtin_amdgcn_mfma_f32_32x32x16_bf16(k1_, qf[mp][st], st == 0 ? NM[mp] : Sb, 0, 0, 0); \
            if (MODE == 2 && (st & 1)) __builtin_amdgcn_sched_barrier(0); } } while (0)
#define AT_SMPV(mp, Sa, Sb, Xa, Xb, sbp, wt, krv, rqv) do { \
        if (wt) { const int cq_ = 32 * (wave & 1) + r32, cs_ = min(max(cq_ - 8, 0), 48); const LAS float* bt_ = btab + ((krv) - (rqv) + 7) * 31 + 15 - cq_; \
            _Pragma("unroll") for (int q = 0; q < 16; ++q) { const int kc0_ = (q & 3) + 8 * (q >> 2) + 4 * hh, kc1_ = kc0_ + 32; \
                Sa[q] = ((unsigned)(kc0_ - cs_) < 16u) ? Sa[q] + bt_[kc0_] : NEG; Sb[q] = ((unsigned)(kc1_ - cs_) < 16u) ? Sb[q] + bt_[kc1_] : NEG; } } \
        float mx_ = max32(Sa, Sb); mx_ = fmaxf(mx_, __shfl_xor(mx_, 32)); \
        if (!started || __any(mx_ > THR)) { \
            const float d_ = started ? fmaxf(mx_, 0.f) : mx_, f_ = __builtin_amdgcn_exp2f(-d_); \
            lrun[mp] *= f_; \
            _Pragma("unroll") for (int d = 0; d < 2; ++d) _Pragma("unroll") for (int q = 0; q < 16; ++q) O[mp][d][q] *= f_; \
              \
            _Pragma("unroll") for (int q = 0; q < 16; ++q) { Sa[q] -= d_; Sb[q] -= d_; Xa[q] -= d_; Xb[q] -= d_; } \
            __builtin_amdgcn_sched_barrier(0); \
            asm volatile("s_nop 7\n\ts_nop 7" :: "v"(Xa[15]), "v"(Xb[15])); \
            __builtin_amdgcn_sched_barrier(0); \
            _Pragma("unroll") for (int q = 0; q < 16; ++q) NM[mp][q] -= d_; } \
          \
        float la_ = 0.f, lb_ = 0.f; \
        _Pragma("unroll") for (int q = 0; q < 16; ++q) { Sa[q] = __builtin_amdgcn_exp2f(Sa[q]); Sb[q] = __builtin_amdgcn_exp2f(Sb[q]); la_ = __builtin_fmaf(Sa[q], one_a, la_); lb_ = __builtin_fmaf(Sb[q], one_b, lb_); } \
        lrun[mp] += la_ + lb_; \
        bf16x8 pf_[4]; \
        pf_[0] = pack8(Sa[0], Sa[1], Sa[2], Sa[3], Sa[4], Sa[5], Sa[6], Sa[7]); pf_[1] = pack8(Sa[8], Sa[9], Sa[10], Sa[11], Sa[12], Sa[13], Sa[14], Sa[15]); \
        pf_[2] = pack8(Sb[0], Sb[1], Sb[2], Sb[3], Sb[4], Sb[5], Sb[6], Sb[7]); pf_[3] = pack8(Sb[8], Sb[9], Sb[10], Sb[11], Sb[12], Sb[13], Sb[14], Sb[15]); \
        _Pragma("unroll") for (int d = 0; d < 2; ++d) _Pragma("unroll") for (int s4 = 0; s4 < 4; ++s4) { \
            const LAS unsigned char* vp_ = (sbp) + vr_off + (8 * s4 + d) * 256; \
            const v4i16_t va_ = __builtin_amdgcn_ds_read_tr16_b64_v4i16((LAS v4i16_t*)vp_); \
            const v4i16_t vb_ = __builtin_amdgcn_ds_read_tr16_b64_v4i16((LAS v4i16_t*)(vp_ + 1024)); \
            bf16x8 vf_; vf_[0] = va_[0]; vf_[1] = va_[1]; vf_[2] = va_[2]; vf_[3] = va_[3]; vf_[4] = vb_[0]; vf_[5] = vb_[1]; vf_[6] = vb_[2]; vf_[7] = vb_[3]; \
            O[mp][d] = __builtin_amdgcn_mfma_f32_32x32x16_bf16(vf_, pf_[s4], O[mp][d], 0, 0, 0); \
            if (NMAP == 2 && (s4 & 1)) __builtin_amdgcn_sched_barrier(0); } } while (0)
#define AT_ACTIVE(i, wt, act, krv, rqv) const bool wt = (MODE == 0) && !ctxq && (i) < nwin; bool act = true; int krv = 0, rqv = 0; \
        if (wt) { krv = krs + (i); rqv = 4 * qb + (wave >> 1); const int rsq_ = min(max(rqv - 4, 0), 24); act = krv >= rsq_ && krv < rsq_ + 8; }
    if (DEEP) {
        f32x16 SA0, SA1, SB0, SB1;
        AT_LOAD(0, A); AT_WRITE(0, A);
        if (ntiles > 1) { AT_LOAD(1, B); AT_WRITE(1, B); }
        if (ntiles > 2) AT_LOAD(2, A);
        if (ntiles > 3) AT_LOAD(3, B);
        AT_BAR();
        { AT_ACTIVE(0, wt0, act0, kr0, rq0); if (act0) AT_QK(0, SA0, SA1, lds); (void)wt0; (void)kr0; (void)rq0; }
        int s0 = 0;
#pragma unroll 1
        for (int i0 = 0; i0 < ntiles; i0 += 2) {
            const int s1 = s0 == 2 ? 0 : s0 + 1, s2 = s1 == 2 ? 0 : s1 + 1;
            {
                const int i = i0;
                if (i + 2 < ntiles) AT_WRITE(s2, A);
                if (i + 4 < ntiles) AT_LOAD(i + 4, A);
                if (i + 1 < ntiles) { AT_ACTIVE(i + 1, wtn, actn, krn, rqn); if (actn) AT_QK(0, SB0, SB1, lds + s1 * AT_STAGE); (void)wtn; (void)krn; (void)rqn; }
                __builtin_amdgcn_sched_barrier(0);
                AT_ACTIVE(i, wt, act, kr, rq);
                if (act) { AT_SMPV(0, SA0, SA1, SB0, SB1, lds + s0 * AT_STAGE, wt, kr, rq); started = 1; }
                AT_BAR();
            }
            if (i0 + 1 < ntiles) {
                const int i = i0 + 1;
                if (i + 2 < ntiles) AT_WRITE(s0, B);
                if (i + 4 < ntiles) AT_LOAD(i + 4, B);
                if (i + 1 < ntiles) { AT_ACTIVE(i + 1, wtn, actn, krn, rqn); if (actn) AT_QK(0, SA0, SA1, lds + s2 * AT_STAGE); (void)wtn; (void)krn; (void)rqn; }
                __builtin_amdgcn_sched_barrier(0);
                AT_ACTIVE(i, wt, act, kr, rq);
                if (act) { AT_SMPV(0, SB0, SB1, SA0, SA1, lds + s1 * AT_STAGE, wt, kr, rq); started = 1; }
                AT_BAR();
            }
            s0 = s2;
        }
    } else {
        AT_LOAD(0, A); AT_WRITE(0, A); if (ntiles > 1) AT_LOAD(1, A);
        AT_BAR();
#pragma unroll 1
        for (int i = 0; i < ntiles; ++i) {
            if (i + 1 < ntiles) AT_WRITE((i + 1) & 1, A);
            if (i + 2 < ntiles) AT_LOAD(i + 2, A);
            const LAS unsigned char* sb = lds + (i & 1) * AT_STAGE;
#pragma unroll
            for (int mp = 0; mp < NMAP; ++mp) {
                f32x16 S0, S1, X0, X1;
#pragma unroll
                for (int q = 0; q < 16; ++q) { X0[q] = 0.f; X1[q] = 0.f; }
                AT_QK(mp, S0, S1, sb);
                AT_SMPV(mp, S0, S1, X0, X1, sb, false, 0, 0);
                if (NMAP == 2) __builtin_amdgcn_sched_barrier(0);
            }
            started = 1;
            AT_BAR();
        }
    }
#undef AT_QK
#undef AT_SMPV
#undef AT_ACTIVE
#undef AT_BAR
    float inv[NMAP];
#pragma unroll
    for (int mp = 0; mp < NMAP; ++mp) { const float lt = lrun[mp] + __shfl_xor(lrun[mp], 32); inv[mp] = 1.f / lt; }
    bf16_t* orow = W.HB + (size_t)tq * DM + (MODE == 0 ? 0 : (MODE == 1 ? 256 : 512)) + h * 64 + 4 * hh;
    if (MODE == 1) {
        const float lam = W.lam[l], li = 0.8f - 0.6f * expf(-0.3f * (float)l);
        const float* sg = P->in[11] + l * 64;
        const float c2 = lam * inv[1];
        float ss = 0.f;
#pragma unroll
        for (int d = 0; d < 2; ++d)
#pragma unroll
            for (int q = 0; q < 16; ++q) { const float o = O[0][d][q] * inv[0] - c2 * O[NMAP - 1][d][q]; O[0][d][q] = o; ss += o * o; }
        ss += __shfl_xor(ss, 32);
        const float rs = rsqrtf(ss * (1.f / 64.f) + 1e-6f) * (1.f - li);
#pragma unroll
        for (int d = 0; d < 2; ++d)
#pragma unroll
            for (int g4 = 0; g4 < 4; ++g4) {
                const int dv = 32 * d + 8 * g4 + 4 * hh;
                const f32x4 gg = *(const f32x4*)(sg + dv);
                u32x2 w; w.x = pk_bf16(O[0][d][4 * g4] * rs * gg[0], O[0][d][4 * g4 + 1] * rs * gg[1]); w.y = pk_bf16(O[0][d][4 * g4 + 2] * rs * gg[2], O[0][d][4 * g4 + 3] * rs * gg[3]);
                *(u32x2*)(orow + 32 * d + 8 * g4) = w;
            }
    } else {
#pragma unroll
        for (int d = 0; d < 2; ++d)
#pragma unroll
            for (int g4 = 0; g4 < 4; ++g4) {
                u32x2 w; w.x = pk_bf16(O[0][d][4 * g4] * inv[0], O[0][d][4 * g4 + 1] * inv[0]); w.y = pk_bf16(O[0][d][4 * g4 + 2] * inv[0], O[0][d][4 * g4 + 3] * inv[0]);
                *(u32x2*)(orow + 32 * d + 8 * g4) = w;
            }
    }
#undef AT_ROW0
#undef AT_LOAD
#undef AT_WRITE
}
__device__ __forceinline__ void phase_attn(const int L_, const int CH_, LAS unsigned char* lds) {
    const KP P = kparams();
    const Ws W(P->ws);
    const int G = pgrid<ID_ATTN>(), c = pblk<ID_ATTN>();
    if (c < 0) return;
    const int gwave = c * 8 + __builtin_amdgcn_readfirstlane(tid_opaque() >> 6), nwaves = G * 8;
    int ck = 0;
#define AT_CONV() do { const int tid0_ = tid_opaque(), cwave_ = __builtin_amdgcn_readfirstlane(tid0_ >> 6); \
        conv_expert_items(P, W, L_, ck, gwave, nwaves, (LAS float*)(lds + 73728 + cwave_ * 8704)  , tid0_ & 63); ck += 2; } while (0)
    for (int u = c; u < 1024; u += G) { const int x = u & 7, j = u >> 3, qb = j & 7, bh = (j >> 3) * 8 + x; attn_unit<2>(P, L_, W, lds, bh >> 3, bh & 7, qb, false); AT_CONV(); }
    for (int u = c; u < 512; u += G) { const int x = u & 7, j = u >> 3, qb = j & 7, bh = (j >> 3) * 8 + x; attn_unit<1>(P, L_, W, lds, bh >> 2, bh & 3, qb, false); AT_CONV(); }
    for (int u = c; u < 512; u += G) { const int x = u & 7, j = u >> 3, qb = j & 7, bh = (j >> 3) * 8 + x; attn_unit<0>(P, L_, W, lds, bh >> 2, bh & 3, qb, false); AT_CONV(); }
    if (L_ == 0) {
        for (int u = c; u < 256; u += G) {
            if (u < 128) attn_unit<2>(P, L_, W, lds, u >> 3, u & 7, 0, true);
            else if (u < 192) attn_unit<1>(P, L_, W, lds, (u - 128) >> 2, (u - 128) & 3, 0, true);
            else attn_unit<0>(P, L_, W, lds, (u - 192) >> 2, (u - 192) & 3, 0, true);
        }
    }
    while (gwave + ck * nwaves < CV_E) AT_CONV();
#undef AT_CONV
}

#define XB_TMO      128
#define XB_XCNT(j)  (256  + 64 * (j))
#define XB_XSUB(j)  (1280 + 64 * (j))
#define XB_XGEN(j)  (2304 + 64 * (j))
#define XB_TOP      3328
#define XB_TOPGEN   3392
#define XCD_BAR_WORDS 3456
#define XB_SPIN_CAP (1u << 18)

__device__ __forceinline__ unsigned xb_ld(unsigned* p)              { return __hip_atomic_load(p, __ATOMIC_RELAXED, __HIP_MEMORY_SCOPE_AGENT); }
__device__ __forceinline__ unsigned xb_add(unsigned* p, unsigned v) { return __hip_atomic_fetch_add(p, v, __ATOMIC_RELAXED, __HIP_MEMORY_SCOPE_AGENT); }
__device__ __forceinline__ unsigned xb_xcc_id() { return (unsigned)__builtin_amdgcn_s_getreg((3 << 11) | 20) & 0xFu; }
#define XB_SPIN(cond, bar) do { unsigned _sp = 0; while (cond) { __builtin_amdgcn_s_sleep(1); \
    if ((++_sp & 255u) == 0u) { if (xb_ld(&(bar)[XB_TMO])) break; if (_sp > XB_SPIN_CAP) { atomicAdd(&(bar)[XB_TMO], 1u); break; } } } } while (0)

struct XcdBarrier {
    unsigned* bar; unsigned x;
    volatile LAS unsigned* st;
};

__device__ __forceinline__ XcdBarrier xcd_barrier_post(unsigned* bar, volatile LAS unsigned* st) {
    XcdBarrier b; b.bar = bar; b.x = xb_xcc_id(); b.st = st;
    if (threadIdx.x == 0) (void)xb_add(&bar[XB_XCNT(b.x)], 1u);
    return b;
}
__device__ __forceinline__ void xcd_barrier_complete(unsigned* bar, unsigned x, unsigned& nloc, unsigned& nx) {
    const unsigned G = gridDim.x * gridDim.y * gridDim.z;
    unsigned sum, cnt, mine, sp = 0u;
    for (;;) {
        sum = 0u; cnt = 0u; mine = 0u;
#pragma unroll
        for (unsigned j = 0; j < 16; ++j) { const unsigned c = xb_ld(&bar[XB_XCNT(j)]); sum += c; cnt += (c > 0u) ? 1u : 0u; mine = (j == x) ? c : mine; }
        if (sum == G) break;
        __builtin_amdgcn_s_sleep(1);
        if ((++sp & 255u) == 0u) { if (xb_ld(&bar[XB_TMO])) break; if (sp > XB_SPIN_CAP) { atomicAdd(&bar[XB_TMO], 1u); break; } }
    }
    nloc = mine > 0u ? mine : 1u; nx = cnt > 0u ? cnt : 1u;
}

__device__ __forceinline__ void xcd_barrier(const XcdBarrier& b) {
    asm volatile("s_waitcnt vmcnt(0)" ::: "memory");
    __syncthreads();
    if (threadIdx.x == 0) {
        unsigned* bar = b.bar;
        __builtin_amdgcn_s_waitcnt(0);
        unsigned nloc = b.st[0], nx = b.st[1];
        if (nloc == 0u) { xcd_barrier_complete(bar, b.x, nloc, nx); b.st[0] = nloc; b.st[1] = nx; }
        const unsigned old = xb_add(&bar[XB_XSUB(b.x)], 1u);
        const unsigned gen = old / nloc;
        if (old + 1u == (gen + 1u) * nloc) {
            __builtin_amdgcn_fence(__ATOMIC_RELEASE, "agent");
            asm volatile("s_waitcnt vmcnt(0)" ::: "memory");
            const unsigned og = xb_add(&bar[XB_TOP], 1u);
            const unsigned tg = og / nx;
            if (og + 1u == (tg + 1u) * nx) xb_add(&bar[XB_TOPGEN], 1u);
            else XB_SPIN(xb_ld(&bar[XB_TOPGEN]) == tg, bar);
            __builtin_amdgcn_fence(__ATOMIC_ACQUIRE, "agent");
            xb_add(&bar[XB_XGEN(b.x)], 1u);
            asm volatile("s_waitcnt vmcnt(0)" ::: "memory");
        } else {
            XB_SPIN(xb_ld(&bar[XB_XGEN(b.x)]) == gen, bar);
            __builtin_amdgcn_fence(__ATOMIC_ACQUIRE, "agent");
            asm volatile("s_waitcnt vmcnt(0)" ::: "memory");
        }
    }
    __syncthreads();
}

constexpr int NSTEPS = 2 + 2 * (5 + 2 * NCHUNK);
constexpr int LDS_BARW = LDS_BYTES - 64;
__global__ void __launch_bounds__(NTHREADS, 2) k_fwd(Params P) {
    extern __shared__ __attribute__((aligned(16))) unsigned char dyn_lds[];
    LAS unsigned char* lds = (LAS unsigned char*)dyn_lds;
    volatile LAS unsigned* st = (volatile LAS unsigned*)(lds + LDS_BARW);
    if (threadIdx.x == 0) { st[0] = 0u; st[1] = 0u; st[2] = 0u; st[3] = 0u; }
    __syncthreads();
    const XcdBarrier bar = xcd_barrier_post((unsigned*)(P.ws + WS_CTL), st);
    const int lo = P.ph_lo, hi = P.ph_hi;
    int step = 0;
#ifndef REP_ATTN
#define REP_ATTN 1
#endif
#ifndef REP_MOE1
#define REP_MOE1 1
#endif
#ifndef REP_MOE2
#define REP_MOE2 1
#endif
#ifndef REP_INPROJ
#define REP_INPROJ 1
#endif
#ifndef REP_MLA
#define REP_MLA 1
#endif
#ifndef REP_CONV
#define REP_CONV 1
#endif
#define STEP(body) do { const int s_ = step++; if (s_ >= lo && s_ < hi) { body; if (s_ + 1 < hi && s_ + 1 < NSTEPS) xcd_barrier(bar); } } while (0)
    STEP(for (int rep = 0; rep < REP_CONV; ++rep) { if (rep) xcd_barrier(bar); phase_convert(0, 0, lds); });
    STEP(phase_norm1(0, 0, lds));
#pragma unroll 1
    for (int l = 0; l < 2; ++l) {
        STEP(for (int rep = 0; rep < REP_INPROJ; ++rep) { if (rep) xcd_barrier(bar); phase_inproj(l, 0, lds); });
        STEP(for (int rep = 0; rep < REP_MLA; ++rep) { if (rep) xcd_barrier(bar); phase_mla(l, 0, lds); });
        STEP(for (int rep = 0; rep < REP_ATTN; ++rep) { if (rep) xcd_barrier(bar); phase_attn(l, 0, lds); });
        STEP(phase_outproj(l, 0, lds));
        STEP(phase_norm2(l, 0, lds));
#pragma unroll 1
        for (int ch = 0; ch < NCHUNK; ++ch) {
            STEP(phase_moe(l, ch, lds));
            STEP(phase_comb(l, ch, lds); if (l == 0 && ch == NCHUNK - 1) phase_convert(1, 0, lds));
        }
    }
#undef STEP
}

#ifndef MK_N_LAUNCHES
#define MK_N_LAUNCHES 1
#endif
extern "C" void kernel_launch(void* const* d_in, const int* in_sizes, int n_in, void* d_out, int out_size, void* d_ws, size_t ws_size, hipStream_t stream) {
    static int grid = 0;
    if (grid == 0) {
        if (ws_size < WS_END || n_in != 26 || out_size != NLAT * DM) { fprintf(stderr, "kernel_launch: workspace %zu < %zu or n_in %d != 26 or out %d; nothing launched\n", ws_size, (size_t)WS_END, n_in, out_size); grid = -1; return; }
        int dev = 0, cus = 0, per_cu = 0;
        if (hipGetDevice(&dev) != hipSuccess || hipDeviceGetAttribute(&cus, hipDeviceAttributeMultiprocessorCount, dev) != hipSuccess || cus <= 0) { fprintf(stderr, "kernel_launch: device query failed\n"); grid = -1; return; }
        if (hipFuncSetAttribute((const void*)k_fwd, hipFuncAttributeMaxDynamicSharedMemorySize, LDS_BYTES) != hipSuccess) { fprintf(stderr, "kernel_launch: hipFuncSetAttribute failed\n"); grid = -1; return; }
        if (hipOccupancyMaxActiveBlocksPerMultiprocessor(&per_cu, (const void*)k_fwd, NTHREADS, LDS_BYTES) != hipSuccess || per_cu < 1) { fprintf(stderr, "kernel_launch: occupancy query says %d workgroups per CU\n", per_cu); grid = -1; (void)hipGetLastError(); return; }
        grid = cus;
    }
    if (grid < 0) return;
    Params P{};
    for (int i = 0; i < 26; ++i) P.in[i] = (const float*)d_in[i];
    P.out = (float*)d_out; P.ws = (unsigned char*)d_ws;
    (void)hipMemsetAsync((unsigned char*)d_ws + WS_CTL, 0, CTL_ZERO_BYTES, stream);
    if (MK_N_LAUNCHES == 1) {
        P.ph_lo = 0; P.ph_hi = NSTEPS;
        hipLaunchKernelGGL(k_fwd, dim3(grid), dim3(NTHREADS), LDS_BYTES, stream, P);
#ifdef PROBE_STEP
        (void)hipMemsetAsync((unsigned char*)d_ws + WS_CTL, 0, XCD_BAR_WORDS * 4, stream);
        if (!(PROBE_I2 & 1)) (void)hipMemsetAsync((unsigned char*)d_ws + WS_CTL + (size_t)CW_RT * 4 + (size_t)2 * 1024 * 16 * 4, 0, (size_t)2 * 1024 * 16 * 4, stream);
        P.ph_lo = PROBE_STEP; P.ph_hi = PROBE_STEP + 1; P.i2 = PROBE_I2;
        hipLaunchKernelGGL(k_fwd, dim3(grid), dim3(NTHREADS), LDS_BYTES, stream, P);
#endif
    } else {
        for (int s = 0; s < NSTEPS; ++s) { P.ph_lo = s; P.ph_hi = s + 1; hipLaunchKernelGGL(k_fwd, dim3(grid), dim3(NTHREADS), LDS_BYTES, stream, P); }
    }
}
```

```cpp
#include <hip/hip_runtime.h>
#include <cstdint>
#include <cstdio>
#include <cmath>

typedef unsigned short bf16_t;

constexpr int NB = 16, SEQ = 2048, DM = 1024, CTX = 256;
constexpr int NLAT = NB * SEQ, NCTX = NB * CTX, NTOK = NLAT + NCTX;
constexpr int INC = 1952;
constexpr int PBS = 2048;
constexpr int O_NAQ = 0, O_NAK = 256, O_NAV = 512, O_DQ = 768, O_DK = 1024, O_DV = 1280, O_CQ = 1536, O_CKV = 1792, O_KR = 1920;
constexpr int NEXP = 64, EFF = 256;
constexpr int LCAP = NTOK;
constexpr int MODW = 6 * DM;

constexpr size_t MiB = 1u << 20;
constexpr size_t WS_CTL = 0;
constexpr size_t WS_MOD = 1 * MiB;
constexpr size_t WS_ROPE = 2 * MiB;
constexpr size_t WS_SSQ = 3 * MiB;
constexpr size_t WS_JUNK = 6 * MiB;
constexpr size_t WS_XS = 8 * MiB;
constexpr size_t WS_HB = 152 * MiB;
constexpr size_t WS_PB = 224 * MiB;
constexpr size_t WS_QM = 368 * MiB;
constexpr size_t WS_KVM = 422 * MiB;
constexpr size_t WS_WB = 494 * MiB;
constexpr size_t WS_END = 600 * MiB;
constexpr size_t WS_LOG = WS_PB;
constexpr size_t WS_LIST = WS_PB + 16 * MiB;
constexpr size_t WB_WIN = 0;
constexpr size_t WB_WUQ = WB_WIN + (size_t)2048 * 1024;
constexpr size_t WB_WUKV = WB_WUQ + (size_t)768 * 256;
constexpr size_t WB_WOUT = WB_WUKV + (size_t)1024 * 256;
constexpr size_t WB_WGU = WB_WOUT + (size_t)1024 * 1024;
constexpr size_t WB_WD = WB_WGU + (size_t)65 * 512 * 1024;
constexpr size_t WB_END = WB_WD + (size_t)65 * 1024 * 256;
constexpr size_t WB_RW = WB_END;
static_assert(WS_WB + (WB_RW + (size_t)8 * 8 * 2 * 2 * 64 * 8) * 2 <= WS_END, "weights fit");

__device__ __forceinline__ float bf2f(bf16_t v) { return __uint_as_float(((unsigned)v) << 16); }
__device__ __forceinline__ bf16_t f2bf(float f) { unsigned u = __float_as_uint(f); u += 0x7fffu + ((u >> 16) & 1u); return (bf16_t)(u >> 16); }
__device__ __forceinline__ float wave_sum(float v) {
#pragma unroll
    for (int o = 32; o > 0; o >>= 1) v += __shfl_xor(v, o);
    return v;
}
__device__ __forceinline__ float wave_max(float v) {
#pragma unroll
    for (int o = 32; o > 0; o >>= 1) v = fmaxf(v, __shfl_xor(v, o));
    return v;
}
__device__ __forceinline__ int mod_row(int t) { return t < NLAT ? (t >> 11) : 16; }

__device__ __forceinline__ void rope_cs(int s, int j, float& cs, float& sn) {
    const int rowi = s >> 6, coli = s & 63;
    const float freq = powf(10000.f, -(float)(j & 7) / 8.f);
    const float ang = (float)(j < 8 ? rowi : coli) * freq;
    cs = cosf(ang); sn = sinf(ang);
}
#define LAS __attribute__((address_space(3)))
typedef short bf16x8 __attribute__((ext_vector_type(8)));
typedef float f32x4 __attribute__((ext_vector_type(4)));
typedef float f32x2 __attribute__((ext_vector_type(2)));
typedef unsigned u32x2 __attribute__((ext_vector_type(2)));
typedef unsigned u32x4 __attribute__((ext_vector_type(4)));
typedef __bf16 bf16x2_t __attribute__((ext_vector_type(2)));

struct Params { const float* in[26]; float* out; unsigned char* ws; int ph_lo, ph_hi, i2, i3; };
typedef const Params __attribute__((address_space(4)))* KP;
__device__ __forceinline__ KP kparams() { KP p = (KP)__builtin_amdgcn_kernarg_segment_ptr(); asm volatile("" : "+s"(p)); return p; }
#ifndef PROBE_HALF
#define PROBE_HALF -1
#endif
enum { ID_CONV = 0, ID_NORM1, ID_INPROJ, ID_MLA, ID_ATTN, ID_OUTPROJ, ID_NORM2, ID_MOE, ID_COMB };
template <int ID> __device__ __forceinline__ int pgrid() { int g = (int)gridDim.x; asm volatile("" : "+s"(g)); return ID == PROBE_HALF ? g / 2 : g; }
template <int ID> __device__ __forceinline__ int pblk() { int b = (int)blockIdx.x; asm volatile("" : "+s"(b)); return ID == PROBE_HALF ? ((b & 1) ? -1 : b >> 1) : b; }
__device__ __forceinline__ int tid_opaque() { int t = (int)threadIdx.x; asm volatile("" : "+v"(t)); return t; }

constexpr int NTHREADS = 512;
constexpr int LDS_BYTES = 150528;

__device__ __forceinline__ unsigned pk_bf16(float lo, float hi) { f32x2 v = {lo, hi}; bf16x2_t b = __builtin_convertvector(v, bf16x2_t); return __builtin_bit_cast(unsigned, b); }

namespace g8 {
constexpr int BM = 256, BK = 64, HALF = 128, HTB = HALF * BK * 2, STAGE_BYTES = 8 * HTB, NXCD = 8, WGM = 8;
__host__ __device__ __forceinline__ int lds_byte(int r, int c) { const int st = (r >> 4) * 2 + (c >> 5), rr = r & 15, cc = c & 31, ob = rr * 64 + cc * 2; return st * 1024 + (ob ^ (((ob >> 9) & 1) << 5)); }
__host__ __device__ __forceinline__ void stage_rc(int b, int& R, int& C) { const int st = b / 1024, sb = b % 1024, swz = sb ^ (((sb >> 9) & 1) << 5); R = (st >> 1) * 16 + swz / 64; C = (st & 1) * 32 + (swz % 64) / 2; }

struct Unit2 { int pm, pn; };
struct DenseOrder {
    int nM, nN, nwg, G, c;
    __device__ __forceinline__ void init(int nM_, int nN_, int G_, int c_) { nM = nM_; nN = nN_; nwg = nM * nN; G = G_; c = c_; }
    __device__ __forceinline__ bool next(int i, Unit2& u) const {
        const long L = (long)i * G + c; if (L >= nwg) return false;
        int wgid = (int)L; { const int q = nwg / NXCD, r = nwg % NXCD, xcd = wgid % NXCD, off = wgid / NXCD; wgid = (xcd < r ? xcd * (q + 1) : r * (q + 1) + (xcd - r) * q) + off; }
        const int nig = WGM * nN, gid = wgid / nig, fm = gid * WGM, gsz = (nM - fm) < WGM ? (nM - fm) : WGM;
        u.pm = fm + ((wgid % nig) % gsz); u.pn = (wgid % nig) / gsz; return true;
    }
};

#define G8_SA(b, h) (((b) * 2 + (h)) * g8::HTB)
#define G8_SB(b, h) ((4 + (b) * 2 + (h)) * g8::HTB)
#define G8_GLDS(gp, ldsoff) __builtin_amdgcn_global_load_lds((const unsigned*)(gp), (LAS unsigned*)(lds + (ldsoff)), 16, 0, 0)
#define G8_STAGE_A(bufoff, o0, o1, kb) do { G8_GLDS(Ab + (o0) + (kb), (bufoff) + ldsw); G8_GLDS(Ab + (o1) + (kb), (bufoff) + ldsw + 8192); } while (0)
#define G8_STAGE_B(bufoff, bp, kb) do { G8_GLDS((bp) + voffB[0] + (kb), (bufoff) + ldsw); G8_GLDS((bp) + voffB[1] + (kb), (bufoff) + ldsw + 8192); } while (0)
#define G8_LDA(dst, b, h) do { _Pragma("unroll") for (int m = 0; m < 4; ++m) _Pragma("unroll") for (int k = 0; k < 2; ++k) dst[m][k] = *(const LAS bf16x8*)(lds + G8_SA(b, h) + aoff + m * 2048 + k * 1024); } while (0)
#define G8_LDB(dst, b, h) do { _Pragma("unroll") for (int n = 0; n < 2; ++n) _Pragma("unroll") for (int k = 0; k < 2; ++k) dst[n][k] = *(const LAS bf16x8*)(lds + G8_SB(b, h) + boff + n * 2048 + k * 1024); } while (0)
#define G8_MMA(ai, bj, At, Bt) do { __builtin_amdgcn_s_setprio(1); _Pragma("unroll") for (int m = 0; m < 4; ++m) _Pragma("unroll") for (int n = 0; n < 2; ++n) _Pragma("unroll") for (int k = 0; k < 2; ++k) \
        acc[ai][bj][m][n] = __builtin_amdgcn_mfma_f32_16x16x32_bf16(Bt[n][k], At[m][k], acc[ai][bj][m][n], 0, 0, 0); __builtin_amdgcn_s_setprio(0); } while (0)
#define G8_WAIT_V(n) asm volatile("s_waitcnt vmcnt(" #n ")" ::: "memory")
#define G8_WAIT_L(n) asm volatile("s_waitcnt lgkmcnt(" #n ")" ::: "memory")
#define G8_BAR __builtin_amdgcn_s_barrier()
#define G8_SCHED __builtin_amdgcn_sched_barrier(0)

template <class P>
__device__ __forceinline__ void gemm_phase(LAS unsigned char* lds, const P& pr) {
    typedef typename P::Unit Unit;
    constexpr int K = P::K, nt = K / BK;
    static_assert(K % 128 == 0 && nt >= 2, "K must be a multiple of 128");
    const int tid = tid_opaque(), wid = __builtin_amdgcn_readfirstlane(tid >> 6), lane = tid & 63, wr = wid >> 2, wc = wid & 3, fr = lane & 15, fq = lane >> 4;
    int Rr[2], Cc[2]; unsigned voffB[2];
#pragma unroll
    for (int i = 0; i < 2; ++i) { stage_rc(tid * 16 + i * 8192, Rr[i], Cc[i]); voffB[i] = (unsigned)(Rr[i] * K + Cc[i]) * 2u; }
    constexpr unsigned kstep = BK * 2;
    constexpr size_t hstepB = (size_t)HALF * K * 2;
    const unsigned ldsw = (unsigned)wid * 1024u;
    const int aoff = lds_byte(wr * 64 + fr, fq * 8), boff = lds_byte(wc * 32 + fr, fq * 8);
    Unit cur, nxt; int ui = 0;
    int pend = -1;
    if (!pr.next(0, cur)) return;
    f32x4 acc[2][2][4][2];
#pragma unroll
    for (int a = 0; a < 2; ++a)
#pragma unroll
        for (int b = 0; b < 2; ++b)
#pragma unroll
            for (int m = 0; m < 4; ++m)
#pragma unroll
                for (int n = 0; n < 2; ++n) acc[a][b][m][n] = (f32x4){0.f, 0.f, 0.f, 0.f};
    bf16x8 At[4][2], B0[2][2], B1[2][2];
    const char* Ab = pr.a_base();
    unsigned ca[2][2], na[2][2];
    pr.a_ready(cur);
    pr.a_offsets(cur, Rr, Cc, ca);
    const char* cB = pr.b_ptr(cur);
    G8_STAGE_B(G8_SB(0, 0), cB, 0); G8_STAGE_B(G8_SB(0, 1), cB + hstepB, 0); G8_STAGE_A(G8_SA(0, 0), ca[0][0], ca[0][1], 0); G8_STAGE_A(G8_SA(0, 1), ca[1][0], ca[1][1], 0);
    if (wr == 1) G8_BAR;
    G8_WAIT_V(2); G8_BAR;
    G8_STAGE_B(G8_SB(1, 0), cB, kstep); G8_STAGE_A(G8_SA(1, 0), ca[0][0], ca[0][1], kstep); G8_STAGE_B(G8_SB(1, 1), cB + hstepB, kstep);
    G8_WAIT_V(6); G8_BAR;
    for (;;) {
        const bool has_next = pr.next(ui + 1, nxt);
        const char* nB = cB;
#pragma unroll
        for (int h = 0; h < 2; ++h)
#pragma unroll
            for (int i = 0; i < 2; ++i) na[h][i] = ca[h][i];
        if (has_next) { pr.a_offsets(nxt, Rr, Cc, na); nB = pr.b_ptr(nxt); }
#pragma unroll 1
        for (int t = 0; t < nt; t += 2) {
            const bool last = (t == nt - 2);
            if (last && has_next) pr.a_ready(nxt);
            const unsigned k1 = (unsigned)(t + 1) * kstep, k2 = (unsigned)(t + 2) * kstep;
            unsigned a2[2][2];
#pragma unroll
            for (int h = 0; h < 2; ++h)
#pragma unroll
                for (int i = 0; i < 2; ++i) a2[h][i] = last ? na[h][i] : ca[h][i] + k2;
            const char* b2 = last ? nB : cB + k2;
            G8_LDB(B0, 0, 0); G8_LDB(B1, 0, 1); G8_SCHED; G8_LDA(At, 0, 0); G8_STAGE_A(G8_SA(1, 1), ca[1][0], ca[1][1], k1);
            G8_WAIT_V(8); G8_WAIT_L(0); G8_BAR; G8_MMA(0, 0, At, B0); G8_MMA(0, 1, At, B1); G8_BAR; G8_SCHED;
            G8_LDA(At, 0, 1); G8_STAGE_B(G8_SB(0, 0), b2, 0); G8_STAGE_B(G8_SB(0, 1), b2 + hstepB, 0); G8_STAGE_A(G8_SA(0, 0), a2[0][0], a2[0][1], 0);
            G8_WAIT_V(8); G8_WAIT_L(0); G8_BAR; G8_MMA(1, 0, At, B0); G8_MMA(1, 1, At, B1); G8_BAR; G8_SCHED;
            if (P::HAS_DONE && t == 0 && pend >= 0) { pr.done(pend); pend = -1; }
            G8_LDB(B0, 1, 0); G8_LDB(B1, 1, 1); G8_SCHED; G8_LDA(At, 1, 0); G8_STAGE_A(G8_SA(0, 1), a2[1][0], a2[1][1], 0);
            G8_WAIT_V(8); G8_WAIT_L(0); G8_BAR; G8_MMA(0, 0, At, B0); G8_MMA(0, 1, At, B1); G8_BAR; G8_SCHED;
            G8_LDA(At, 1, 1); G8_STAGE_B(G8_SB(1, 0), b2, kstep); G8_STAGE_B(G8_SB(1, 1), b2 + hstepB, kstep); G8_STAGE_A(G8_SA(1, 0), a2[0][0], a2[0][1], kstep);
            G8_WAIT_V(8); G8_WAIT_L(0); G8_BAR; G8_MMA(1, 0, At, B0); G8_MMA(1, 1, At, B1); G8_BAR; G8_SCHED;
        }
        if (wr == 0) G8_BAR;
        pr.epilogue(acc, cur, wr, wc, fr, fq);
        if (P::HAS_DONE) pend = pr.done_token(cur);
        if (!has_next) break;
#pragma unroll
        for (int a = 0; a < 2; ++a)
#pragma unroll
            for (int b = 0; b < 2; ++b)
#pragma unroll
                for (int m = 0; m < 4; ++m)
#pragma unroll
                    for (int n = 0; n < 2; ++n) acc[a][b][m][n] = (f32x4){0.f, 0.f, 0.f, 0.f};
        cur = nxt; cB = nB; ++ui;
#pragma unroll
        for (int h = 0; h < 2; ++h)
#pragma unroll
            for (int i = 0; i < 2; ++i) ca[h][i] = na[h][i];
        if (wr == 1) G8_BAR;
    }
    G8_WAIT_V(0);
    if (P::HAS_DONE && pend >= 0) pr.done(pend);
    G8_BAR;
}
}

struct Ws {
    unsigned* ctl; float* mod; float* lam; float* rope; float* ssq; float* sskv;
    bf16_t* XS; bf16_t* HB; bf16_t* PB; bf16_t* QM; bf16_t* KVM; bf16_t* WB;
    __device__ __host__ __forceinline__ explicit Ws(unsigned char* ws) {
        ctl = (unsigned*)(ws + WS_CTL); mod = (float*)(ws + WS_MOD); lam = mod + 2 * 17 * MODW; rope = (float*)(ws + WS_ROPE);
        ssq = (float*)(ws + WS_SSQ); sskv = ssq + (size_t)NTOK * 4;
        XS = (bf16_t*)(ws + WS_XS); HB = (bf16_t*)(ws + WS_HB); PB = (bf16_t*)(ws + WS_PB); QM = (bf16_t*)(ws + WS_QM); KVM = (bf16_t*)(ws + WS_KVM); WB = (bf16_t*)(ws + WS_WB);
    }
};

__device__ __forceinline__ int conv_drow(int ng, int mode) {
    if (mode == 1 || mode == 2) { const int a = ng & 127; return (ng & ~127) * 2 + 128 * ((a >> 2) & 1) + 32 * (a >> 5) + 16 * (mode - 1) + 4 * ((a >> 3) & 3) + (a & 3); }
    if (mode == 3) { const int c = ng & 63; return (ng & ~63) + 16 * ((c >> 2) & 3) + 4 * (c >> 4) + (c & 3); }
    if (mode == 4) { const int c = ng & 255, g = c >> 5; return (ng & ~255) + 128 * ((c >> 2) & 1) + 32 * (g >> 1) + 16 * ((c >> 4) & 1) + 4 * (2 * (g & 1) + ((c >> 3) & 1)) + (c & 3); }
    return ng;
}
struct ConvDesc { const float* W; const float* ks; bf16_t* Bt; int N, k0, n0, ldo, mode; };
__device__ __forceinline__ void conv_load(const ConvDesc& d, float (&v)[32], int lane) {
#pragma unroll
    for (int i = 0; i < 32; ++i) v[i] = d.W[(size_t)(d.k0 + 2 * i + (lane >> 5)) * d.N + d.n0 + (lane & 31)];
}
__device__ __forceinline__ void conv_store(const ConvDesc& d, float (&v)[32], LAS float* scr, int lane) {
    if (d.ks) {
#pragma unroll
        for (int i = 0; i < 32; ++i) v[i] *= d.ks[d.k0 + 2 * i + (lane >> 5)];
    }
#pragma unroll
    for (int i = 0; i < 32; ++i) scr[(2 * i + (lane >> 5)) * 33 + (lane & 31)] = v[i];
    asm volatile("s_waitcnt lgkmcnt(0)" ::: "memory");
    const int c = lane & 7;
#pragma unroll
    for (int j = 0; j < 4; ++j) {
        const int n = (lane >> 3) + 8 * j;
        const LAS float* sp = scr + (8 * c) * 33 + n;
        u32x4 o; o.x = pk_bf16(sp[0], sp[33]); o.y = pk_bf16(sp[66], sp[99]); o.z = pk_bf16(sp[132], sp[165]); o.w = pk_bf16(sp[198], sp[231]);
        *(u32x4*)(d.Bt + (size_t)conv_drow(d.n0 + n, d.mode) * d.ldo + d.k0 + 8 * c) = o;
    }
    asm volatile("s_waitcnt lgkmcnt(0)" ::: "memory");
}
constexpr int CV_E = 65 * 384, CV_IN = 16 * 61, CV_OUT = 512, CV_UQ = 96, CV_UKV = 64, CV_ITEMS = CV_E + CV_IN + CV_OUT + CV_UQ + CV_UKV;
__device__ __forceinline__ void conv_decode(const KP P, const Ws& W, int l, int it, ConvDesc& d) {
    int r = it; d.ks = nullptr;
    if (r < CV_E) {
        const int e = r / 384, w = (r % 384) >> 7, t = r & 127;
        if (w < 2) {
            d.W = e < 64 ? P->in[19 + w] + ((size_t)l * 64 + e) * 262144 : P->in[22 + w] + (size_t)l * 262144;
            d.N = 256; d.k0 = (t >> 3) * 64; d.n0 = (t & 7) * 32; d.Bt = W.WB + WB_WGU + (size_t)e * 524288; d.ldo = 1024; d.mode = 1 + w;
        } else {
            d.W = e < 64 ? P->in[21] + ((size_t)l * 64 + e) * 262144 : P->in[24] + (size_t)l * 262144;
            d.N = 1024; d.k0 = (t >> 5) * 64; d.n0 = (t & 31) * 32; d.Bt = W.WB + WB_WD + (size_t)e * 262144; d.ldo = 256; d.mode = 3;
        }
        return;
    }
    r -= CV_E;
    if (r < CV_IN) { d.W = P->in[8] + (size_t)l * 1024 * INC; d.N = INC; d.k0 = (r / 61) * 64; d.n0 = (r % 61) * 32; d.Bt = W.WB + WB_WIN; d.ldo = 1024; d.mode = 4; return; }
    r -= CV_IN;
    if (r < CV_OUT) { d.W = P->in[16] + (size_t)l * 1024 * 1024; d.N = 1024; d.k0 = (r >> 5) * 64; d.n0 = (r & 31) * 32; d.Bt = W.WB + WB_WOUT; d.ldo = 1024; d.mode = 0; return; }
    r -= CV_OUT;
    if (r < CV_UQ) { d.W = P->in[13] + (size_t)l * 256 * 768; d.N = 768; d.k0 = (r / 24) * 64; d.n0 = (r % 24) * 32; d.Bt = W.WB + WB_WUQ; d.ldo = 256; d.mode = 4; d.ks = P->in[12] + l * 256; return; }
    r -= CV_UQ;
    d.W = P->in[15] + (size_t)l * 128 * 1024; d.N = 1024; d.k0 = (r >> 5) * 64; d.n0 = (r & 31) * 32; d.Bt = W.WB + WB_WUKV; d.ldo = 256; d.mode = 4; d.ks = P->in[14] + l * 128;
}
__device__ __forceinline__ void conv_expert_items(const KP P, const Ws& W, int l, int k0, int gwave, int nwaves, LAS float* scr, int lane) {
    const int itA = gwave + k0 * nwaves, itB = itA + nwaves;
    if (itA >= CV_E) return;
    ConvDesc dA, dB; float vA[32], vB[32];
    conv_decode(P, W, l, itA, dA); conv_load(dA, vA, lane);
    const bool hB = itB < CV_E;
    if (hB) { conv_decode(P, W, l, itB, dB); conv_load(dB, vB, lane); }
    conv_store(dA, vA, scr, lane);
    if (hB) conv_store(dB, vB, scr, lane);
}
__device__ __forceinline__ void phase_convert(const int L_, const int CH_, LAS unsigned char* lds) {
    const KP P = kparams();
    const Ws W(P->ws);
    const int l = L_, tid = tid_opaque(), c = pblk<ID_CONV>(), G = pgrid<ID_CONV>();
    if (c < 0) return;
    const int wave = __builtin_amdgcn_readfirstlane(tid >> 6), lane = tid & 63;
    LAS float* scr = (LAS float*)(lds + wave * 8704);
    {
        const int stride = G * 8;
        int it = CV_E + c * 8 + wave;
        ConvDesc dA, dB; float vA[32], vB[32];
        bool hA = it < CV_ITEMS;
        if (hA) { conv_decode(P, W, l, it, dA); conv_load(dA, vA, lane); }
        while (hA) {
            const int itn = it + stride; const bool hB = itn < CV_ITEMS;
            if (hB) { conv_decode(P, W, l, itn, dB); conv_load(dB, vB, lane); }
            conv_store(dA, vA, scr, lane);
            if (!hB) break;
            it = itn + stride; hA = it < CV_ITEMS;
            if (hA) { conv_decode(P, W, l, it, dA); conv_load(dA, vA, lane); }
            conv_store(dB, vB, scr, lane);
        }
    }
    {
        const float* rw = P->in[17] + (size_t)l * DM * NEXP;
        for (int it = c * NTHREADS + tid; it < 8 * 8 * 2 * 64; it += G * NTHREADS) {
            const int ln = it & 63, n = (it >> 6) & 1, ks = (it >> 7) & 7, w = it >> 10;
            const float* p = rw + (size_t)(128 * w + 16 * ks + 8 * (ln >> 5)) * NEXP + 32 * n + (ln & 31);
            u32x4 h4, l4;
#pragma unroll
            for (int t = 0; t < 4; ++t) { const float w0 = p[(2 * t) * NEXP], w1 = p[(2 * t + 1) * NEXP]; const unsigned hi = pk_bf16(w0, w1); h4[t] = hi; l4[t] = pk_bf16(w0 - __uint_as_float(hi << 16), w1 - __uint_as_float(hi & 0xffff0000u)); }
            bf16_t* dst = W.WB + WB_RW + ((size_t)((w * 8 + ks) * 2 + n) * 2 * 64 + ln) * 8;
            *(u32x4*)dst = h4; *(u32x4*)(dst + 64 * 8) = l4;
        }
    }
    __syncthreads();
    {
        const int gid = c * NTHREADS + tid, gsz = G * NTHREADS;
        unsigned zz = 0u; asm volatile("" : "+v"(zz));
        const u32x4 z = {zz, zz, zz, zz};
        for (int i = gid; i < 96 * 128; i += gsz) *(u32x4*)(W.WB + WB_WIN + (size_t)conv_drow(1952 + (i >> 7), 4) * 1024 + (size_t)(i & 127) * 8) = z;
        for (int i = gid; i < 1024 * 16; i += gsz) *(u32x4*)(W.WB + WB_WUKV + (size_t)(i >> 4) * 256 + 128 + (i & 15) * 8) = z;
    }
    if (l == 0) {
        LAS float* st = (LAS float*)lds;
        LAS float* red = st + 17 * 1024;
        for (int u = c; u < 192; u += G) {
            const int l2 = u / 96, cg = u % 96;
            for (int i = tid; i < 17 * 1024; i += NTHREADS) { const int r = i >> 10, k = i & 1023; const float v = r < 16 ? P->in[1][r * 1024 + k] : P->in[3][k]; st[i] = v / (1.f + expf(-v)); }
            __syncthreads();
            const float* w = P->in[4] + (size_t)l2 * 1024 * MODW + cg * 64 + lane;
            float a[17];
#pragma unroll
            for (int r = 0; r < 17; ++r) a[r] = 0.f;
            for (int k = wave * 128; k < wave * 128 + 128; ++k) {
                const float wv = w[(size_t)k * MODW];
#pragma unroll
                for (int r = 0; r < 17; ++r) a[r] += st[r * 1024 + k] * wv;
            }
#pragma unroll
            for (int r = 0; r < 17; ++r) red[(wave * 17 + r) * 64 + lane] = a[r];
            __syncthreads();
            for (int i = tid; i < 17 * 64; i += NTHREADS) {
                const int r = i >> 6, col = i & 63; float s = 0.f;
#pragma unroll
                for (int w8 = 0; w8 < 8; ++w8) s += red[(w8 * 17 + r) * 64 + col];
                W.mod[((size_t)l2 * 17 + r) * MODW + cg * 64 + col] = s + P->in[5][l2 * MODW + cg * 64 + col];
            }
            __syncthreads();
        }
        for (int i = c * NTHREADS + tid; i < 2048 * 16; i += G * NTHREADS) { float cs, sn; rope_cs(i >> 4, i & 15, cs, sn); W.rope[2 * i] = cs; W.rope[2 * i + 1] = sn; }
        if (c == G - 1 && wave == 0) {
            for (int l2 = 0; l2 < 2; ++l2) {
                const float* lv = P->in[10] + l2 * 128;
                float a = lane < 32 ? lv[lane] * lv[32 + lane] : 0.f, b = lane < 32 ? lv[64 + lane] * lv[96 + lane] : 0.f;
                a = wave_sum(a); b = wave_sum(b);
                const float li = 0.8f - 0.6f * expf(-0.3f * (float)l2);
                if (lane == 0) W.lam[l2] = expf(a) - expf(b) + li;
            }
        }
    }
}

struct ProbInProj {
    typedef g8::Unit2 Unit; static constexpr int K = 1024;
    __device__ __forceinline__ void a_ready(const Unit&) const {}
    static constexpr bool HAS_DONE = false;
    __device__ __forceinline__ void done(int) const {}
    __device__ __forceinline__ int done_token(const Unit&) const { return -1; }
    g8::DenseOrder ord; const bf16_t* A; const bf16_t* Bt; bf16_t* PB; const float* rope; float* ssq; float* sskv;
    __device__ __forceinline__ bool next(int i, Unit& u) const { return ord.next(i, u); }
    __device__ __forceinline__ const char* a_base() const { return (const char*)A; }
    __device__ __forceinline__ void a_offsets(const Unit& u, const int (&R)[2], const int (&C)[2], unsigned (&o)[2][2]) const {
#pragma unroll
        for (int h = 0; h < 2; ++h)
#pragma unroll
            for (int i = 0; i < 2; ++i) o[h][i] = (unsigned)((u.pm * 256 + h * 128 + R[i]) * K + C[i]) * 2u;
    }
    __device__ __forceinline__ const char* b_ptr(const Unit& u) const { return (const char*)(Bt + (size_t)u.pn * 256 * K); }
    __device__ __forceinline__ void epilogue(const f32x4 (&acc)[2][2][4][2], const Unit& u, int wr, int wc, int fr, int fq) const {
        const int pn = u.pn; const bool lat = u.pm < NLAT / 256;
        const int g = 2 * wc + (fq >> 1);
        const int rowb = u.pm * 256 + wr * 64 + fr, colb = pn * 256 + 32 * g + 8 * (fq & 1);
        const bool want_ss = pn >= 6;
        const bool rp = lat && (pn == 3 || pn == 4 || (pn == 7 && g == 4));
        const bool ss_on = pn == 6 || (pn == 7 && g < 4);
#pragma unroll
        for (int ai = 0; ai < 2; ++ai)
#pragma unroll
            for (int m = 0; m < 4; ++m) {
                const int row = rowb + ai * 128 + m * 16;
                f32x4 x1[2] = {acc[ai][0][m][0], acc[ai][1][m][0]}, x2[2] = {acc[ai][0][m][1], acc[ai][1][m][1]};
                if (rp) {
                    const f32x4* tb = (const f32x4*)(rope + ((size_t)(row & 2047) * 16 + 8 * (fq & 1)) * 2);
#pragma unroll
                    for (int bj = 0; bj < 2; ++bj) {
                        const f32x4 t0 = tb[2 * bj], t1 = tb[2 * bj + 1];
                        const f32x4 cs = {t0[0], t0[2], t1[0], t1[2]}, sn = {t0[1], t0[3], t1[1], t1[3]};
                        const f32x4 o1 = x1[bj] * cs - x2[bj] * sn, o2 = x1[bj] * sn + x2[bj] * cs;
                        x1[bj] = o1; x2[bj] = o2;
                    }
                }
                u32x4 w1, w2;
                w1.x = pk_bf16(x1[0][0], x1[0][1]); w1.y = pk_bf16(x1[0][2], x1[0][3]); w1.z = pk_bf16(x1[1][0], x1[1][1]); w1.w = pk_bf16(x1[1][2], x1[1][3]);
                w2.x = pk_bf16(x2[0][0], x2[0][1]); w2.y = pk_bf16(x2[0][2], x2[0][3]); w2.z = pk_bf16(x2[1][0], x2[1][1]); w2.w = pk_bf16(x2[1][2], x2[1][3]);
                bf16_t* prow = PB + (size_t)row * PBS + colb;
                *(u32x4*)prow = w1; *(u32x4*)(prow + 16) = w2;
                if (want_ss) {
                    float ss = 0.f;
                    if (ss_on) {
#pragma unroll
                        for (int q = 0; q < 4; ++q) {
                            const float a0 = __uint_as_float(w1[q] << 16), a1 = __uint_as_float(w1[q] & 0xffff0000u), b0 = __uint_as_float(w2[q] << 16), b1 = __uint_as_float(w2[q] & 0xffff0000u);
                            ss += a0 * a0 + a1 * a1 + b0 * b0 + b1 * b1;
                        }
                    }
                    ss += __shfl_xor(ss, 16); ss += __shfl_xor(ss, 32);
                    if (fq == 0) (pn == 6 ? ssq : sskv)[(size_t)row * 4 + wc] = ss;
                }
            }
    }
};
__device__ __forceinline__ void phase_inproj(const int L_, const int CH_, LAS unsigned char* lds) {
    const KP P = kparams();
    const Ws W(P->ws);
    if (pblk<ID_INPROJ>() < 0) return;
    ProbInProj pr; pr.ord.init(NTOK / 256, 8, pgrid<ID_INPROJ>(), pblk<ID_INPROJ>());
    pr.A = W.HB; pr.Bt = W.WB + WB_WIN; pr.PB = W.PB; pr.rope = W.rope; pr.ssq = W.ssq; pr.sskv = W.sskv;
    g8::gemm_phase(lds, pr);
}

struct UnitM { int pm, pn, kv; };
struct ProbMla {
    typedef UnitM Unit; static constexpr int K = 256;
    __device__ __forceinline__ void a_ready(const Unit&) const {}
    static constexpr bool HAS_DONE = false;
    __device__ __forceinline__ void done(int) const {}
    __device__ __forceinline__ int done_token(const Unit&) const { return -1; }
    int nq_units, n_units, G, c;
    const bf16_t* PBp; const bf16_t* Wuq; const bf16_t* Wukv; bf16_t* QM; bf16_t* KVM; const float* rope; const float* ssq; const float* sskv;
    __device__ __forceinline__ bool next(int i, Unit& u) const {
        const int L = i * G + c; if (L >= n_units) return false;
        if (L < nq_units) { u.kv = 0; u.pm = L / 3; u.pn = L % 3; } else { const int r = L - nq_units; u.kv = 1; u.pm = r >> 2; u.pn = r & 3; }
        return true;
    }
    __device__ __forceinline__ const char* a_base() const { return (const char*)PBp; }
    __device__ __forceinline__ void a_offsets(const Unit& u, const int (&R)[2], const int (&C)[2], unsigned (&o)[2][2]) const {
        const int cb = u.kv ? O_CKV : O_CQ;
#pragma unroll
        for (int h = 0; h < 2; ++h)
#pragma unroll
            for (int i = 0; i < 2; ++i) o[h][i] = (unsigned)((u.pm * 256 + h * 128 + R[i]) * PBS + cb + C[i]) * 2u;
    }
    __device__ __forceinline__ const char* b_ptr(const Unit& u) const { return (const char*)((u.kv ? Wukv : Wuq) + (size_t)u.pn * 256 * K); }
    __device__ __forceinline__ void epilogue(const f32x4 (&acc)[2][2][4][2], const Unit& u, int wr, int wc, int fr, int fq) const {
        const bool lat = u.pm < NLAT / 256;
        const int g = 2 * wc + (fq >> 1);
        const int rowb = u.pm * 256 + wr * 64 + fr, colb = u.pn * 256 + 32 * g + 8 * (fq & 1);
        const float* ssp = u.kv ? sskv : ssq; const float inv = u.kv ? (1.f / 128.f) : (1.f / 256.f);
        bf16_t* O = u.kv ? KVM : QM; const int ldo = u.kv ? 1024 : 768;
        const bool rp = !u.kv && lat && ((u.pn * 8 + g) % 3) == 2;
        float rs[2][4];
#pragma unroll
        for (int ai = 0; ai < 2; ++ai)
#pragma unroll
            for (int m = 0; m < 4; ++m) { const f32x4 s4 = *(const f32x4*)(ssp + (size_t)(rowb + ai * 128 + m * 16) * 4); rs[ai][m] = rsqrtf((s4[0] + s4[1] + s4[2] + s4[3]) * inv + 1e-6f); }
#pragma unroll
        for (int ai = 0; ai < 2; ++ai)
#pragma unroll
            for (int m = 0; m < 4; ++m) {
                const int row = rowb + ai * 128 + m * 16;
                const float rstd = rs[ai][m];
                f32x4 x1[2] = {acc[ai][0][m][0] * rstd, acc[ai][1][m][0] * rstd}, x2[2] = {acc[ai][0][m][1] * rstd, acc[ai][1][m][1] * rstd};
                if (rp) {
                    const f32x4* tb = (const f32x4*)(rope + ((size_t)(row & 2047) * 16 + 8 * (fq & 1)) * 2);
#pragma unroll
                    for (int bj = 0; bj < 2; ++bj) {
                        const f32x4 t0 = tb[2 * bj], t1 = tb[2 * bj + 1];
                        const f32x4 cs = {t0[0], t0[2], t1[0], t1[2]}, sn = {t0[1], t0[3], t1[1], t1[3]};
                        const f32x4 o1 = x1[bj] * cs - x2[bj] * sn, o2 = x1[bj] * sn + x2[bj] * cs;
                        x1[bj] = o1; x2[bj] = o2;
                    }
                }
                u32x4 w1, w2;
                w1.x = pk_bf16(x1[0][0], x1[0][1]); w1.y = pk_bf16(x1[0][2], x1[0][3]); w1.z = pk_bf16(x1[1][0], x1[1][1]); w1.w = pk_bf16(x1[1][2], x1[1][3]);
                w2.x = pk_bf16(x2[0][0], x2[0][1]); w2.y = pk_bf16(x2[0][2], x2[0][3]); w2.z = pk_bf16(x2[1][0], x2[1][1]); w2.w = pk_bf16(x2[1][2], x2[1][3]);
                bf16_t* prow = O + (size_t)row * ldo + colb;
                *(u32x4*)prow = w1; *(u32x4*)(prow + 16) = w2;
            }
    }
};
__device__ __forceinline__ void phase_mla(const int L_, const int CH_, LAS unsigned char* lds) {
    const KP P = kparams();
    const Ws W(P->ws);
    const int nq = L_ == 0 ? NTOK : NLAT;
    ProbMla pr; pr.nq_units = (nq / 256) * 3; pr.n_units = pr.nq_units + (NTOK / 256) * 4; pr.G = pgrid<ID_MLA>(); pr.c = pblk<ID_MLA>();
    if (pr.c < 0) return;
    pr.PBp = W.PB; pr.Wuq = W.WB + WB_WUQ; pr.Wukv = W.WB + WB_WUKV; pr.QM = W.QM; pr.KVM = W.KVM; pr.rope = W.rope; pr.ssq = W.ssq; pr.sskv = W.sskv;
    g8::gemm_phase(lds, pr);
}

struct ProbOut {
    typedef g8::Unit2 Unit; static constexpr int K = 1024;
    __device__ __forceinline__ void a_ready(const Unit&) const {}
    static constexpr bool HAS_DONE = false;
    __device__ __forceinline__ void done(int) const {}
    __device__ __forceinline__ int done_token(const Unit&) const { return -1; }
    g8::DenseOrder ord; const bf16_t* A; const bf16_t* Bt; bf16_t* XS; const float* x_in; const float* ctx_in; const float* mod_l; int layer;
    __device__ __forceinline__ bool next(int i, Unit& u) const { return ord.next(i, u); }
    __device__ __forceinline__ const char* a_base() const { return (const char*)A; }
    __device__ __forceinline__ void a_offsets(const Unit& u, const int (&R)[2], const int (&C)[2], unsigned (&o)[2][2]) const {
#pragma unroll
        for (int h = 0; h < 2; ++h)
#pragma unroll
            for (int i = 0; i < 2; ++i) o[h][i] = (unsigned)((u.pm * 256 + h * 128 + R[i]) * K + C[i]) * 2u;
    }
    __device__ __forceinline__ const char* b_ptr(const Unit& u) const { return (const char*)(Bt + (size_t)u.pn * 256 * K); }
    template <int LAYER> __device__ __forceinline__ void res_load(f32x4 (&b)[2][2], int row, int colb) const {
        if (LAYER == 0) {
            const float* xi = (row < NLAT ? x_in + (size_t)row * DM : ctx_in + (size_t)(row - NLAT) * DM) + colb;
#pragma unroll
            for (int bj = 0; bj < 2; ++bj)
#pragma unroll
                for (int n = 0; n < 2; ++n) b[bj][n] = *(const f32x4*)(xi + bj * 128 + n * 16);
        } else {
            const bf16_t* xo = XS + (size_t)row * DM + colb;
#pragma unroll
            for (int bj = 0; bj < 2; ++bj)
#pragma unroll
                for (int n = 0; n < 2; ++n) { const u32x2 w = *(const u32x2*)(xo + bj * 128 + n * 16); b[bj][n] = (f32x4){__uint_as_float(w.x << 16), __uint_as_float(w.x & 0xffff0000u), __uint_as_float(w.y << 16), __uint_as_float(w.y & 0xffff0000u)}; }
        }
    }
    template <int LAYER> __device__ __forceinline__ void epi(const f32x4 (&acc)[2][2][4][2], const Unit& u, int wr, int wc, int fr, int fq) const {
        const int r = u.pm < NLAT / 256 ? (u.pm >> 3) : 16;
        const int rowb = u.pm * 256 + wr * 64 + fr, colb = u.pn * 256 + wc * 32 + 4 * fq;
        const float* gate = mod_l + r * MODW + 2 * DM + colb;
        f32x4 gv[2][2];
#pragma unroll
        for (int bj = 0; bj < 2; ++bj)
#pragma unroll
            for (int n = 0; n < 2; ++n) gv[bj][n] = *(const f32x4*)(gate + bj * 128 + n * 16);
        if (LAYER == 1) {
#pragma unroll
            for (int ai = 0; ai < 2; ++ai) {
                u32x2 raw[4][2][2];
#pragma unroll
                for (int m = 0; m < 4; ++m)
#pragma unroll
                    for (int bj = 0; bj < 2; ++bj)
#pragma unroll
                        for (int n = 0; n < 2; ++n) raw[m][bj][n] = *(const u32x2*)(XS + (size_t)(rowb + ai * 128 + m * 16) * DM + colb + bj * 128 + n * 16);
                __builtin_amdgcn_sched_barrier(0);
#pragma unroll
                for (int m = 0; m < 4; ++m) {
                    bf16_t* xo = XS + (size_t)(rowb + ai * 128 + m * 16) * DM + colb;
#pragma unroll
                    for (int bj = 0; bj < 2; ++bj)
#pragma unroll
                        for (int n = 0; n < 2; ++n) {
                            const u32x2 w = raw[m][bj][n];
                            const f32x4 b = {__uint_as_float(w.x << 16), __uint_as_float(w.x & 0xffff0000u), __uint_as_float(w.y << 16), __uint_as_float(w.y & 0xffff0000u)};
                            const f32x4 o = b + gv[bj][n] * acc[ai][bj][m][n];
                            u32x2 ow; ow.x = pk_bf16(o[0], o[1]); ow.y = pk_bf16(o[2], o[3]);
                            *(u32x2*)(xo + bj * 128 + n * 16) = ow;
                        }
                }
                __builtin_amdgcn_sched_barrier(0);
            }
            return;
        }
        f32x4 bc[2][2], bn[2][2];
        res_load<LAYER>(bc, rowb, colb);
#pragma unroll
        for (int g = 0; g < 8; ++g) {
            const int ai = g >> 2, m = g & 3;
            const int row = rowb + ai * 128 + m * 16;
            if (g + 1 < 8) res_load<LAYER>(bn, rowb + ((g + 1) >> 2) * 128 + ((g + 1) & 3) * 16, colb);
            bf16_t* xo = XS + (size_t)row * DM + colb;
#pragma unroll
            for (int bj = 0; bj < 2; ++bj)
#pragma unroll
                for (int n = 0; n < 2; ++n) {
                    const f32x4 o = bc[bj][n] + gv[bj][n] * acc[ai][bj][m][n];
                    u32x2 ow; ow.x = pk_bf16(o[0], o[1]); ow.y = pk_bf16(o[2], o[3]);
                    *(u32x2*)(xo + bj * 128 + n * 16) = ow;
                }
#pragma unroll
            for (int bj = 0; bj < 2; ++bj)
#pragma unroll
                for (int n = 0; n < 2; ++n) bc[bj][n] = bn[bj][n];
        }
    }
    __device__ __forceinline__ void epilogue(const f32x4 (&acc)[2][2][4][2], const Unit& u, int wr, int wc, int fr, int fq) const {
        if (layer == 0) epi<0>(acc, u, wr, wc, fr, fq); else epi<1>(acc, u, wr, wc, fr, fq);
    }
};
__device__ __forceinline__ void phase_outproj(const int L_, const int CH_, LAS unsigned char* lds) {
    const KP P = kparams();
    const Ws W(P->ws);
    const int nq = L_ == 0 ? NTOK : NLAT;
    if (pblk<ID_OUTPROJ>() < 0) return;
    ProbOut pr; pr.ord.init(nq / 256, 4, pgrid<ID_OUTPROJ>(), pblk<ID_OUTPROJ>());
    pr.A = W.HB; pr.Bt = W.WB + WB_WOUT; pr.XS = W.XS; pr.x_in = P->in[0]; pr.ctx_in = P->in[2]; pr.mod_l = W.mod + (size_t)L_ * 17 * MODW; pr.layer = L_;
    g8::gemm_phase(lds, pr);
}

constexpr int NCHUNK = 2;
constexpr int CAPC = NTOK / NCHUNK;
constexpr size_t WS_LIST2 = WS_PB;
constexpr size_t WS_ACT = WS_PB + 18 * MiB;
constexpr size_t WS_Y = WS_PB + 108 * MiB;
constexpr size_t ACT_BYTES = 90 * MiB;
static_assert(WS_Y + (size_t)CAPC * 9 * 1024 <= WS_WB && (size_t)(CAPC * 9 + 65 * 255 + 256) * 512 <= ACT_BYTES, "MoE overlay fits");
constexpr int CW_CNT = 8192, CNT_STRIDE = 64;
constexpr int CW_RT = 32768;
constexpr size_t CTL_ZERO_BYTES = (size_t)(CW_RT + 2 * NCHUNK * 1024 * 16) * 4;
constexpr float Y_SCALE = 8.f;
constexpr int LDS_TAB = 131072;

typedef float f32x16 __attribute__((ext_vector_type(16)));
template <int CTRL> __device__ __forceinline__ float dppf(float v) { return __int_as_float(__builtin_amdgcn_update_dpp(0, __float_as_int(v), CTRL, 0xf, 0xf, true)); }
template <int CTRL> __device__ __forceinline__ int dppi(int v) { return __builtin_amdgcn_update_dpp(0, v, CTRL, 0xf, 0xf, true); }
__device__ __forceinline__ float gmax8f(float x) { x = fmaxf(x, dppf<0xB1>(x)); x = fmaxf(x, dppf<0x4E>(x)); return fmaxf(x, dppf<0x141>(x)); }
__device__ __forceinline__ int gmin8i(int x) { x = min(x, dppi<0xB1>(x)); x = min(x, dppi<0x4E>(x)); return min(x, dppi<0x141>(x)); }
__device__ __forceinline__ unsigned wmaxu(unsigned x) {
    x = max(x, (unsigned)dppi<0xB1>((int)x)); x = max(x, (unsigned)dppi<0x4E>((int)x)); x = max(x, (unsigned)dppi<0x141>((int)x)); x = max(x, (unsigned)dppi<0x140>((int)x));
    const unsigned a = (unsigned)__builtin_amdgcn_readlane((int)x, 0), b = (unsigned)__builtin_amdgcn_readlane((int)x, 16), c = (unsigned)__builtin_amdgcn_readlane((int)x, 32), d = (unsigned)__builtin_amdgcn_readlane((int)x, 48);
    return max(max(a, b), max(c, d));
}
__device__ __forceinline__ float wsumf(float x) {
    x += dppf<0xB1>(x); x += dppf<0x4E>(x); x += dppf<0x141>(x); x += dppf<0x140>(x);
    const float a = __int_as_float(__builtin_amdgcn_readlane(__float_as_int(x), 0)), b = __int_as_float(__builtin_amdgcn_readlane(__float_as_int(x), 16));
    const float c = __int_as_float(__builtin_amdgcn_readlane(__float_as_int(x), 32)), d = __int_as_float(__builtin_amdgcn_readlane(__float_as_int(x), 48));
    return (a + b) + (c + d);
}
#define N2_BAR() do { asm volatile("s_waitcnt lgkmcnt(0)" ::: "memory"); __builtin_amdgcn_s_barrier(); asm volatile("" ::: "memory"); } while (0)
__device__ __forceinline__ void phase_norm2(const int L_, const int CH_, LAS unsigned char* lds) {
    const KP P = kparams();
    const Ws W(P->ws);
    const int l = L_, tid = tid_opaque(), wave = __builtin_amdgcn_readfirstlane(tid >> 6), lane = tid & 63, G = pgrid<ID_NORM2>(), c = pblk<ID_NORM2>();
    if (c < 0) return;
    const int nq = l == 0 ? NTOK : NLAT, csz = nq / NCHUNK, nunits = nq / 32;
    const float* mod_l = W.mod + (size_t)l * 17 * MODW;
    const float* gn = P->in[7] + l * DM;
    const float* rw = P->in[17] + (size_t)l * DM * NEXP;
    const float* rb = P->in[18] + l * NEXP;
    int* cnt = (int*)(W.ctl + CW_CNT) + L_ * NCHUNK * 64 * CNT_STRIDE;
    uint2* list = (uint2*)(P->ws + WS_LIST2);
    constexpr int ASB = 1032;
    LAS unsigned char* Ah = lds;
    LAS unsigned char* Al = lds + 32 * ASB * 2;
    LAS float* At = (LAS float*)lds;
    constexpr int NRES = 6;
    const bf16_t* rwf = W.WB + WB_RW + ((size_t)wave * 8 * 2 * 2 * 64 + lane) * 8;
    u32x4 Bh[NRES][2], Bl[NRES][2];
#pragma unroll
    for (int ks = 0; ks < NRES; ++ks)
#pragma unroll
        for (int n = 0; n < 2; ++n) { Bh[ks][n] = *(const u32x4*)(rwf + ((ks * 2 + n) * 2) * 512); if (ks + n > 0 && !(ks == 1 && n == 1)) Bl[ks][n] = *(const u32x4*)(rwf + ((ks * 2 + n) * 2 + 1) * 512); }
    LAS unsigned char* bx = lds + 2 * 32 * ASB * 2 + wave * 2048 + lane * 16;
    static_assert(2 * 32 * ASB * 2 + 8 * 2048 <= LDS_BYTES - 64, "parked fragments fit below the barrier words");
    *(LAS u32x4*)bx = *(const u32x4*)(rwf + 512); *(LAS u32x4*)(bx + 1024) = *(const u32x4*)(rwf + ((1 * 2 + 1) * 2 + 1) * 512);
    const float rbe = rb[lane];
    u32x2 nx[4][4];
    int u = c;
    if (u < nunits) {
#pragma unroll
        for (int j = 0; j < 4; ++j)
#pragma unroll
            for (int q = 0; q < 4; ++q) nx[j][q] = *(const u32x2*)(W.XS + (size_t)(u * 32 + wave * 4 + j) * DM + 256 * q + lane * 4);
    }
    for (; u < nunits; u += G) {
        const int t0 = u * 32, r = mod_row(t0);
        {
            const float* sh = mod_l + r * MODW + 3 * DM; const float* sc = mod_l + r * MODW + 4 * DM;
            float rstd[4];
#pragma unroll
            for (int j = 0; j < 4; ++j) {
                float ss = 0.f;
#pragma unroll
                for (int q = 0; q < 4; ++q) { const u32x2 w = nx[j][q];
                    const float a0 = __uint_as_float(w.x << 16), a1 = __uint_as_float(w.x & 0xffff0000u), a2 = __uint_as_float(w.y << 16), a3 = __uint_as_float(w.y & 0xffff0000u); ss += a0 * a0 + a1 * a1 + a2 * a2 + a3 * a3; }
                rstd[j] = rsqrtf(wsumf(ss) * (1.f / DM) + 1e-6f);
            }
#pragma unroll
            for (int q = 0; q < 4; ++q) {
                const int col = 256 * q + lane * 4;
                __builtin_amdgcn_sched_barrier(0);
                const f32x4 ga = *(const f32x4*)(gn + col) * (*(const f32x4*)(sc + col) + 1.f), hb = *(const f32x4*)(sh + col);
#pragma unroll
                for (int j = 0; j < 4; ++j) {
                    const int tl = wave * 4 + j, t = t0 + tl;
                    const u32x2 w = nx[j][q];
                    const f32x4 v = {__uint_as_float(w.x << 16), __uint_as_float(w.x & 0xffff0000u), __uint_as_float(w.y << 16), __uint_as_float(w.y & 0xffff0000u)};
                    const f32x4 o = v * rstd[j] * ga + hb;
                    u32x2 ow; ow.x = pk_bf16(o[0], o[1]); ow.y = pk_bf16(o[2], o[3]);
                    *(u32x2*)(W.HB + (size_t)t * DM + col) = ow;
                    u32x2 lw; lw.x = pk_bf16(o[0] - __uint_as_float(ow.x << 16), o[1] - __uint_as_float(ow.x & 0xffff0000u)); lw.y = pk_bf16(o[2] - __uint_as_float(ow.y << 16), o[3] - __uint_as_float(ow.y & 0xffff0000u));
                    *(LAS u32x2*)(Ah + (tl * ASB + col) * 2) = ow;
                    *(LAS u32x2*)(Al + (tl * ASB + col) * 2) = lw;
                }
            }
        }
        if (u + G < nunits) {
#pragma unroll
            for (int j = 0; j < 4; ++j)
#pragma unroll
                for (int q = 0; q < 4; ++q) nx[j][q] = *(const u32x2*)(W.XS + (size_t)((u + G) * 32 + wave * 4 + j) * DM + 256 * q + lane * 4);
        }
        u32x4 Bsh[8 - NRES][2], Bsl[8 - NRES][2];
        {
            const bf16_t* rws = rwf; asm volatile("" : "+v"(rws));
#pragma unroll
            for (int ks = NRES; ks < 8; ++ks)
#pragma unroll
                for (int n = 0; n < 2; ++n) { Bsh[ks - NRES][n] = *(const u32x4*)(rws + ((ks * 2 + n) * 2) * 512); Bsl[ks - NRES][n] = *(const u32x4*)(rws + ((ks * 2 + n) * 2 + 1) * 512); }
        }
        N2_BAR();
        f32x16 acc0, acc1;
#pragma unroll
        for (int i = 0; i < 16; ++i) { acc0[i] = 0.f; acc1[i] = 0.f; }
        const unsigned aoff = (unsigned)(((lane & 31) * ASB + 128 * wave + 8 * (lane >> 5)) * 2);
#pragma unroll
        for (int ks = 0; ks < 8; ++ks) {
            const bf16x8 arh = *(const LAS bf16x8*)(Ah + aoff + 32 * ks), arl = *(const LAS bf16x8*)(Al + aoff + 32 * ks);
#pragma unroll
            for (int n = 0; n < 2; ++n) {
                const bf16x8 bh = __builtin_bit_cast(bf16x8, ks < NRES ? Bh[ks < NRES ? ks : 0][n] : Bsh[ks < NRES ? 0 : ks - NRES][n]);
                const bf16x8 bl = (ks == 0 && n == 0) ? *(const LAS bf16x8*)bx : ((ks == 1 && n == 1) ? *(const LAS bf16x8*)(bx + 1024) : __builtin_bit_cast(bf16x8, ks < NRES ? Bl[ks < NRES ? ks : 0][n] : Bsl[ks < NRES ? 0 : ks - NRES][n]));
                f32x16& acc = n == 0 ? acc0 : acc1;
                acc = __builtin_amdgcn_mfma_f32_32x32x16_bf16(arh, bh, acc, 0, 0, 0);
                acc = __builtin_amdgcn_mfma_f32_32x32x16_bf16(arl, bh, acc, 0, 0, 0);
                acc = __builtin_amdgcn_mfma_f32_32x32x16_bf16(arh, bl, acc, 0, 0, 0);
            }
            __builtin_amdgcn_sched_barrier(0);
        }
        N2_BAR();
        LAS float* part = At;
#pragma unroll
        for (int i = 0; i < 16; ++i) {
            const int tok = (i & 3) + 8 * (i >> 2) + 4 * (lane >> 5);
            part[(wave * 32 + tok) * 64 + (lane & 31)] = acc0[i];
            part[(wave * 32 + tok) * 64 + 32 + (lane & 31)] = acc1[i];
        }
        N2_BAR();
        int slot_[4]; float w_[4]; int rk_[4];
#pragma unroll
        for (int j = 0; j < 4; ++j) {
            const int tl = wave * 4 + j, t = t0 + tl, e = lane;
            float lg = 0.f;
#pragma unroll
            for (int w8 = 0; w8 < 8; ++w8) lg += part[(w8 * 32 + tl) * 64 + e];
            const float sc = __builtin_amdgcn_rcpf(1.f + __expf(-lg));
            const float sel = sc + rbe;
            const float m1 = gmax8f(sel);
            const int cand = gmin8i((sel == m1) ? (e & 7) : 8);
            const float m2 = gmax8f(((e & 7) == cand) ? -INFINITY : sel);
            const float grp = m1 + m2;
            const int g = e >> 3;
            int grank = 0;
#pragma unroll
            for (int gg = 0; gg < 8; ++gg) { const float og = __int_as_float(__builtin_amdgcn_readlane(__float_as_int(grp), gg * 8)); grank += (og > grp || (og == grp && gg < g)) ? 1 : 0; }
            const bool gsel = grank < 4;
            const unsigned sb = __float_as_uint(sel);
            unsigned key = gsel ? (sb ^ ((sb >> 31) ? 0xffffffffu : 0x80000000u)) : 0u;
            int rk = 8;
#pragma unroll
            for (int k = 0; k < 8; ++k) {
                const unsigned M = wmaxu(key);
                const unsigned long long bal = __ballot(key == M);
                const int idx = __builtin_ctzll(bal);
                if (e == idx) { rk = k; key = 0u; }
            }
            const bool chosen = rk < 8;
            const float wsum = wsumf(chosen ? sc : 0.f);
            w_[j] = sc / wsum * 2.5f; rk_[j] = rk; slot_[j] = 0;
            if (chosen) slot_[j] = atomicAdd(&cnt[((t / csz) * 64 + e) * CNT_STRIDE], 1);
        }
#pragma unroll
        for (int j = 0; j < 4; ++j) {
            const int t = t0 + wave * 4 + j;
            if (rk_[j] < 8) list[((size_t)(t / csz) * 64 + lane) * CAPC + slot_[j]] = make_uint2((unsigned)(t * 8 + rk_[j]), __float_as_uint(w_[j]));
        }
        N2_BAR();
    }
}
#undef N2_BAR

struct UnitG { int e, t, pn, cnt, pb; };
struct MoeTab {
    const LAS int* cnts; const LAS int* pre;
    const LAS int* xpre; int ntiles, xl, x, nb, j, nseg, st0, xtiles;
    __device__ __forceinline__ void locate(int rtl, int& e, int& t) const {
        int sg = 0; while (xpre[sg + 1] <= rtl) ++sg;
        t = rtl - xpre[sg];
        if (sg < nseg - 1) e = x + xl * sg; else { e = 64; t += st0; }
    }
};
__device__ __forceinline__ MoeTab moe_table(const KP P, const int L_, LAS unsigned char* lds, int ch, int csz) {
    const Ws W(P->ws);
    LAS int* cnts = (LAS int*)(lds + LDS_TAB); LAS int* pre = cnts + 80; LAS int* xpre = pre + 80;
    const int tid = tid_opaque();
    const int G = pgrid<ID_MOE>(), c = pblk<ID_MOE>();
    MoeTab T; T.cnts = cnts; T.pre = pre; T.xpre = xpre;
    if ((G & 7) == 0) { T.xl = 8; T.x = c & 7; T.nb = G >> 3; T.j = c >> 3; } else { T.xl = 1; T.x = 0; T.nb = G; T.j = c; }
    T.nseg = 64 / T.xl + 1;
    if (tid < 64) cnts[tid] = (int)__hip_atomic_load(W.ctl + CW_CNT + ((L_ * NCHUNK + ch) * 64 + tid) * CNT_STRIDE, __ATOMIC_RELAXED, __HIP_MEMORY_SCOPE_AGENT);
    if (tid == 64) cnts[64] = csz;
    __syncthreads();
    const int stiles = (csz + 255) >> 8, sper = (stiles + T.xl - 1) / T.xl;
    T.st0 = T.x * sper;
    if (tid == 0) {
        int s = 0; for (int e = 0; e < 65; ++e) { pre[e] = s; s += (cnts[e] + 255) >> 8; } pre[65] = s;
        int q = 0;
        for (int sg = 0; sg < T.nseg - 1; ++sg) { xpre[sg] = q; q += (cnts[T.x + T.xl * sg] + 255) >> 8; }
        xpre[T.nseg - 1] = q; { int n = stiles - T.st0; n = n < 0 ? 0 : (n > sper ? sper : n); q += n; }
        xpre[T.nseg] = q;
    }
    __syncthreads();
    T.ntiles = pre[65]; T.xtiles = xpre[T.nseg];
    return T;
}
struct ProbMoe1 {
    typedef UnitG Unit; static constexpr int K = 1024;
    int G, c, chunk_base; MoeTab T;
    const uint2* list; const bf16_t* HB; const bf16_t* Wgu; __amdgpu_buffer_rsrc_t act_rs; unsigned* rtcnt;
    __device__ __forceinline__ bool next(int i, Unit& u) const {
        const int L = i * T.nb + T.j; if (L >= 2 * T.xtiles) return false;
        u.pn = L & 1;
        int e, t; T.locate(L >> 1, e, t);
        e = __builtin_amdgcn_readfirstlane(e); t = __builtin_amdgcn_readfirstlane(t);
        u.e = e; u.t = t; u.cnt = __builtin_amdgcn_readfirstlane(T.cnts[e]); u.pb = __builtin_amdgcn_readfirstlane((T.pre[e] + t) * 256); return true;
    }
    __device__ __forceinline__ void a_ready(const Unit&) const {}
    static constexpr bool HAS_DONE = true;
    __device__ __forceinline__ int done_token(const Unit& u) const { return __builtin_amdgcn_readfirstlane(u.pb >> 8); }
    __device__ __forceinline__ void done(int rt) const {
        if ((threadIdx.x & 63) == 0) (void)__hip_atomic_fetch_add(rtcnt + 16 * rt, 1u, __ATOMIC_RELAXED, __HIP_MEMORY_SCOPE_AGENT);
    }
    __device__ __forceinline__ const char* a_base() const { return (const char*)HB; }
    __device__ __forceinline__ void a_offsets(const Unit& u, const int (&R)[2], const int (&C)[2], unsigned (&o)[2][2]) const {
#pragma unroll
        for (int h = 0; h < 2; ++h)
#pragma unroll
            for (int i = 0; i < 2; ++i) {
                const int slot = u.t * 256 + h * 128 + R[i]; int tok = 0;
                if (slot < u.cnt) tok = u.e < 64 ? (int)(list[(size_t)u.e * CAPC + slot].x >> 3) : chunk_base + slot;
                o[h][i] = (unsigned)tok * 2048u + (unsigned)C[i] * 2u;
            }
    }
    __device__ __forceinline__ const char* b_ptr(const Unit& u) const { return (const char*)(Wgu + (size_t)u.e * 524288 + (size_t)u.pn * 256 * K); }
    __device__ __forceinline__ void epilogue(const f32x4 (&acc)[2][2][4][2], const Unit& u, int wr, int wc, int fr, int fq) const {
        float wv[2][4];
#pragma unroll
        for (int ai = 0; ai < 2; ++ai)
#pragma unroll
            for (int m = 0; m < 4; ++m) {
                const int slot = u.t * 256 + ai * 128 + wr * 64 + m * 16 + fr;
                wv[ai][m] = 0.f;
                if (slot < u.cnt) wv[ai][m] = u.e < 64 ? __uint_as_float(list[(size_t)u.e * CAPC + slot].y) : 1.f;
            }
#pragma unroll
        for (int ai = 0; ai < 2; ++ai)
#pragma unroll
            for (int m = 0; m < 4; ++m) {
                const int rl = ai * 128 + wr * 64 + m * 16 + fr;
                const float w = wv[ai][m];
                float a[8];
#pragma unroll
                for (int bj = 0; bj < 2; ++bj) {
                    const f32x4 g = acc[ai][bj][m][0], up = acc[ai][bj][m][1];
#pragma unroll
                    for (int j = 0; j < 4; ++j) a[4 * bj + j] = g[j] * __builtin_amdgcn_rcpf(1.f + __expf(-g[j])) * up[j] * w;
                }
                u32x4 o; o.x = pk_bf16(a[0], a[1]); o.y = pk_bf16(a[2], a[3]); o.z = pk_bf16(a[4], a[5]); o.w = pk_bf16(a[6], a[7]);
                __builtin_amdgcn_raw_buffer_store_b128(o, act_rs, (int)(((unsigned)(u.pb + rl) * 256u + 128u * u.pn + 32u * wc + 8u * fq) * 2u), 0, 16);
            }
    }
};
struct MoeDown {
    int G, c, chunk_base, shift; MoeTab T;
    const uint2* list; const bf16_t* act; const bf16_t* Wd; unsigned char* ws; unsigned junk; unsigned* rtcnt; unsigned* tmo;
};
__device__ __forceinline__ void moe_down_phase(LAS unsigned char* lds, const MoeDown& D) {
    const int tid = tid_opaque(), wave = __builtin_amdgcn_readfirstlane(tid >> 6), lane = tid & 63, fr = lane & 15, fq = lane >> 4;
    const int jblk = (D.T.j - D.shift + D.T.nb) % D.T.nb;
    unsigned goff[4];
#pragma unroll
    for (int i = 0; i < 4; ++i) { const int row = 2 * (4 * wave + i) + (lane >> 5), p = lane & 31; goff[i] = (unsigned)(row * 256 + ((p ^ (row & 15)) * 8)) * 2u; }
    const unsigned ldsw = (unsigned)wave * 4096u;
    for (int rtl = jblk; rtl < D.T.xtiles; rtl += D.T.nb) {
        int e, t_in; D.T.locate(rtl, e, t_in);
        e = __builtin_amdgcn_readfirstlane(e); t_in = __builtin_amdgcn_readfirstlane(t_in);
        const int rt = __builtin_amdgcn_readfirstlane(D.T.pre[e] + t_in), cnt = __builtin_amdgcn_readfirstlane(D.T.cnts[e]), pb = rt * 256;
        if (tid < 64) {
            unsigned* w = D.rtcnt + 16 * rt; unsigned sp = 0u;
            while ((unsigned)__builtin_amdgcn_readfirstlane(__hip_atomic_load(w, __ATOMIC_RELAXED, __HIP_MEMORY_SCOPE_AGENT)) < 16u) {
                __builtin_amdgcn_s_sleep(2);
                if ((++sp & 255u) == 0u) { if (__hip_atomic_load(D.tmo, __ATOMIC_RELAXED, __HIP_MEMORY_SCOPE_AGENT)) break; if (sp > (1u << 20)) { atomicAdd(D.tmo, 1u); break; } }
            }
            __builtin_amdgcn_fence(__ATOMIC_ACQUIRE, "agent");
            asm volatile("s_waitcnt vmcnt(0)" ::: "memory");
        }
        __syncthreads();
        bf16x8 af[2][8];
#pragma unroll
        for (int m = 0; m < 2; ++m)
#pragma unroll
            for (int ks = 0; ks < 8; ++ks) af[m][ks] = *(const bf16x8*)(D.act + (size_t)(pb + 32 * wave + 16 * m + fr) * 256 + 32 * ks + 8 * fq);
        unsigned yo[2];
#pragma unroll
        for (int m = 0; m < 2; ++m) {
            const int slot = t_in * 256 + 32 * wave + 16 * m + fr;
            yo[m] = D.junk;
            if (slot < cnt) {
                if (e < 64) { const unsigned x = D.list[(size_t)e * CAPC + slot].x; yo[m] = (unsigned)WS_Y + (unsigned)(((int)(x >> 3) - D.chunk_base) * 9 + (int)(x & 7u)) * 1024u; }
                else yo[m] = (unsigned)WS_Y + (unsigned)(slot * 9 + 8) * 1024u;
            }
        }
        const char* wb = (const char*)(D.Wd + (size_t)e * 262144);
#define MD_ISSUE(ch) do { _Pragma("unroll") for (int i = 0; i < 4; ++i) \
        __builtin_amdgcn_global_load_lds((const unsigned*)(wb + (size_t)(ch) * 32768 + goff[i]), (LAS unsigned*)(lds + ((ch) & 3) * 32768 + ldsw + i * 1024), 16, 0, 0); } while (0)
        MD_ISSUE(0); MD_ISSUE(1); MD_ISSUE(2);
#pragma unroll 1
        for (int ch = 0; ch < 16; ++ch) {
            if (ch >= 3 && ch < 14) asm volatile("s_waitcnt vmcnt(14)" ::: "memory");
            else if (ch < 3) asm volatile("s_waitcnt vmcnt(8)" ::: "memory");
            else asm volatile("s_waitcnt vmcnt(6)" ::: "memory");
            __builtin_amdgcn_s_barrier();
            asm volatile("" ::: "memory");
            if (ch + 3 < 16) MD_ISSUE(ch + 3);
            f32x4 acc[2][4];
#pragma unroll
            for (int m = 0; m < 2; ++m)
#pragma unroll
                for (int n = 0; n < 4; ++n) acc[m][n] = (f32x4){0.f, 0.f, 0.f, 0.f};
            const LAS unsigned char* bb = lds + (ch & 3) * 32768 + fr * 512;
            bf16x8 bq[3][4];
#pragma unroll
            for (int n = 0; n < 4; ++n) { bq[0][n] = *(const LAS bf16x8*)(bb + n * 8192 + ((fq ^ fr) * 16)); bq[1][n] = *(const LAS bf16x8*)(bb + n * 8192 + (((4 + fq) ^ fr) * 16)); }
#pragma unroll
            for (int ks = 0; ks < 8; ++ks) {
                __builtin_amdgcn_s_waitcnt(0xC07F);
                if (ks + 2 < 8) {
#pragma unroll
                    for (int n = 0; n < 4; ++n) bq[(ks + 2) % 3][n] = *(const LAS bf16x8*)(bb + n * 8192 + (((4 * (ks + 2) + fq) ^ fr) * 16));
                }
                __builtin_amdgcn_sched_barrier(0);
#pragma unroll
                for (int n = 0; n < 4; ++n) {
                    acc[0][n] = __builtin_amdgcn_mfma_f32_16x16x32_bf16(bq[ks % 3][n], af[0][ks], acc[0][n], 0, 0, 0);
                    acc[1][n] = __builtin_amdgcn_mfma_f32_16x16x32_bf16(bq[ks % 3][n], af[1][ks], acc[1][n], 0, 0, 0);
                }
                __builtin_amdgcn_sched_barrier(0);
            }
            asm volatile("s_waitcnt lgkmcnt(0)" ::: "memory");
#pragma unroll
            for (int m = 0; m < 2; ++m) {
                {
                    u32x4 o; int w;
#pragma unroll
                    for (int n = 0; n < 4; ++n) {
                        f32x4 v = acc[m][n] * Y_SCALE;
#pragma unroll
                        for (int q = 0; q < 4; ++q) v[q] = __builtin_amdgcn_fmed3f(v[q], -440.f, 440.f);
                        w = __builtin_amdgcn_cvt_pk_fp8_f32(v[0], v[1], 0, false); w = __builtin_amdgcn_cvt_pk_fp8_f32(v[2], v[3], w, true); o[n] = (unsigned)w;
                    }
                    *(u32x4*)(D.ws + yo[m] + 64 * ch + 16 * fq) = o;
                }
            }
        }
        asm volatile("s_waitcnt vmcnt(0)" ::: "memory");
        __syncthreads();
#undef MD_ISSUE
    }
}
__device__ __forceinline__ void phase_moe(const int L_, const int CH_, LAS unsigned char* lds) {
    const KP P = kparams();
    const Ws W(P->ws);
    const int nq = L_ == 0 ? NTOK : NLAT, csz = nq / NCHUNK, ch = CH_;
    unsigned* rtcnt = W.ctl + CW_RT + (size_t)(L_ * NCHUNK + ch) * 1024 * 16;
    if (pblk<ID_MOE>() < 0) return;
    const MoeTab T = moe_table(P, L_, lds, ch, csz);
    {
        ProbMoe1 pr; pr.G = pgrid<ID_MOE>(); pr.c = pblk<ID_MOE>(); pr.chunk_base = ch * csz; pr.T = T;
        pr.list = (const uint2*)(P->ws + WS_LIST2) + (size_t)ch * 64 * CAPC; pr.HB = W.HB; pr.Wgu = W.WB + WB_WGU;
        pr.act_rs = __builtin_amdgcn_make_buffer_rsrc((void*)(P->ws + WS_ACT), 0, (int)ACT_BYTES, 0x00020000); pr.rtcnt = rtcnt;
        g8::gemm_phase(lds, pr);
    }
    {
        MoeDown D; D.G = pgrid<ID_MOE>(); D.c = pblk<ID_MOE>(); D.chunk_base = ch * csz; D.shift = (2 * T.xtiles) % T.nb; D.T = T;
        D.list = (const uint2*)(P->ws + WS_LIST2) + (size_t)ch * 64 * CAPC; D.act = (const bf16_t*)(P->ws + WS_ACT); D.Wd = W.WB + WB_WD;
        D.ws = P->ws; D.junk = (unsigned)WS_JUNK + (unsigned)pblk<ID_MOE>() * 1024u; D.rtcnt = rtcnt; D.tmo = W.ctl + 128;
        moe_down_phase(lds, D);
    }
}
__device__ __forceinline__ void phase_comb(const int L_, const int CH_, LAS unsigned char* lds) {
    const KP P = kparams();
    const Ws W(P->ws);
    const int nq = L_ == 0 ? NTOK : NLAT, csz = nq / NCHUNK, ch = CH_, base = ch * csz;
    const int tid = tid_opaque(), wave = tid >> 6, lane = tid & 63;
    const float* mod_l = W.mod + (size_t)L_ * 17 * MODW;
    const float* mod_n = W.mod + (size_t)17 * MODW;
    const float* gn1 = P->in[6] + DM;
    const float* fg = P->in[25];
    const unsigned char* Y = (const unsigned char*)(P->ws + WS_Y);
    const int col = lane * 16;
    if (pblk<ID_COMB>() < 0) return;
    for (int tl = pblk<ID_COMB>() * 8 + wave; tl < csz; tl += pgrid<ID_COMB>() * 8) {
        const int t = base + tl, r = mod_row(t);
        const float* g2 = mod_l + r * MODW + 5 * DM + col;
        bf16_t* xr = W.XS + (size_t)t * DM + col;
        float s[16];
#pragma unroll
        for (int i = 0; i < 16; ++i) s[i] = 0.f;
#pragma unroll
        for (int k = 0; k < 9; ++k) {
            const u32x4 v = *(const u32x4*)(Y + ((size_t)tl * 9 + k) * 1024 + col);
            const unsigned wv[4] = {v.x, v.y, v.z, v.w};
#pragma unroll
            for (int q = 0; q < 4; ++q) {
                const f32x2 lo = __builtin_amdgcn_cvt_pk_f32_fp8((int)wv[q], false), hi = __builtin_amdgcn_cvt_pk_f32_fp8((int)wv[q], true);
                s[4 * q] += lo[0]; s[4 * q + 1] += lo[1]; s[4 * q + 2] += hi[0]; s[4 * q + 3] += hi[1];
            }
        }
        f32x4 xn[4]; float ss = 0.f;
        const u32x4 xw0 = *(const u32x4*)xr, xw1 = *(const u32x4*)(xr + 8);
        const unsigned xw[8] = {xw0.x, xw0.y, xw0.z, xw0.w, xw1.x, xw1.y, xw1.z, xw1.w};
        u32x4 xo[2];
#pragma unroll
        for (int q = 0; q < 4; ++q) {
            const f32x4 x = {__uint_as_float(xw[2 * q] << 16), __uint_as_float(xw[2 * q] & 0xffff0000u), __uint_as_float(xw[2 * q + 1] << 16), __uint_as_float(xw[2 * q + 1] & 0xffff0000u)};
            const f32x4 g = *(const f32x4*)(g2 + 4 * q);
            const f32x4 sv = {s[4 * q], s[4 * q + 1], s[4 * q + 2], s[4 * q + 3]};
            xn[q] = x + g * sv * (1.f / Y_SCALE);
            ss += xn[q][0] * xn[q][0] + xn[q][1] * xn[q][1] + xn[q][2] * xn[q][2] + xn[q][3] * xn[q][3];
            xo[q >> 1][2 * (q & 1)] = pk_bf16(xn[q][0], xn[q][1]); xo[q >> 1][2 * (q & 1) + 1] = pk_bf16(xn[q][2], xn[q][3]);
        }
        if (L_ == 0) { *(u32x4*)xr = xo[0]; *(u32x4*)(xr + 8) = xo[1]; }
        ss = wave_sum(ss);
        const float rstd = rsqrtf(ss * (1.f / DM) + 1e-6f);
        if (L_ == 0) {
            const float* sh = mod_n + r * MODW + col; const float* sc = mod_n + r * MODW + DM + col;
            u32x4 o[2];
#pragma unroll
            for (int q = 0; q < 4; ++q) {
                const f32x4 g4 = *(const f32x4*)(gn1 + col + 4 * q), s4 = *(const f32x4*)(sc + 4 * q), h4 = *(const f32x4*)(sh + 4 * q);
                const f32x4 ov = xn[q] * rstd * g4 * (s4 + 1.f) + h4;
                o[q >> 1][2 * (q & 1)] = pk_bf16(ov[0], ov[1]); o[q >> 1][2 * (q & 1) + 1] = pk_bf16(ov[2], ov[3]);
            }
            *(u32x4*)(W.HB + (size_t)t * DM + col) = o[0]; *(u32x4*)(W.HB + (size_t)t * DM + col + 8) = o[1];
        } else {
#pragma unroll
            for (int q = 0; q < 4; ++q) {
                const f32x4 g4 = *(const f32x4*)(fg + col + 4 * q);
                *(f32x4*)(P->out + (size_t)t * DM + col + 4 * q) = xn[q] * rstd * g4;
            }
        }
    }
}

__device__ __forceinline__ void phase_norm1(const int L_, const int CH_, LAS unsigned char* lds) {
    const KP P = kparams();
    const Ws W(P->ws);
    const int l = L_, tid = tid_opaque(), wave = tid >> 6, lane = tid & 63;
    const float* mod_l = W.mod + (size_t)l * 17 * MODW;
    const float* gn = P->in[6] + l * DM;
    if (pblk<ID_NORM1>() < 0) return;
    for (int t = pblk<ID_NORM1>() * 8 + wave; t < NTOK; t += pgrid<ID_NORM1>() * 8) {
        const int r = mod_row(t);
        const float* xr = t < NLAT ? P->in[0] + (size_t)t * DM : P->in[2] + (size_t)(t - NLAT) * DM;
        const float* sh = mod_l + r * MODW; const float* sc = mod_l + r * MODW + DM;
        f32x4 v[4]; float ss = 0.f;
#pragma unroll
        for (int q = 0; q < 4; ++q) { v[q] = *(const f32x4*)(xr + 256 * q + lane * 4); ss += v[q][0] * v[q][0] + v[q][1] * v[q][1] + v[q][2] * v[q][2] + v[q][3] * v[q][3]; }
        ss = wave_sum(ss);
        const float rstd = rsqrtf(ss * (1.f / DM) + 1e-6f);
#pragma unroll
        for (int q = 0; q < 4; ++q) {
            const int col = 256 * q + lane * 4;
            const f32x4 g4 = *(const f32x4*)(gn + col), s4 = *(const f32x4*)(sc + col), h4 = *(const f32x4*)(sh + col);
            const f32x4 o = v[q] * rstd * g4 * (s4 + 1.f) + h4;
            u32x2 w; w.x = pk_bf16(o[0], o[1]); w.y = pk_bf16(o[2], o[3]);
            *(u32x2*)(W.HB + (size_t)t * DM + col) = w;
        }
    }
}

typedef short v4i16_t __attribute__((ext_vector_type(4)));
__device__ __forceinline__ bf16x8 pack8(float a0, float a1, float a2, float a3, float a4, float a5, float a6, float a7) {
    u32x4 w; w.x = pk_bf16(a0, a1); w.y = pk_bf16(a2, a3); w.z = pk_bf16(a4, a5); w.w = pk_bf16(a6, a7); return __builtin_bit_cast(bf16x8, w);
}
__device__ __forceinline__ float max3f_w(float a, float b, float c) { float r; asm volatile("s_nop 7\n\ts_nop 7\n\ts_nop 3\n\tv_max3_f32 %0, %1, %2, %3" : "=v"(r) : "v"(a), "v"(b), "v"(c)); return r; }
__device__ __forceinline__ float max3f(float a, float b, float c) { float r; asm volatile("v_max3_f32 %0, %1, %2, %3" : "=v"(r) : "v"(a), "v"(b), "v"(c)); return r; }
__device__ __forceinline__ float max32(const f32x16& a, const f32x16& b) {
    float m0 = max3f_w(a[0], a[1], a[2]);
    float m1 = max3f_w(b[0], b[1], b[2]);
    m0 = max3f(m0, a[3], a[4]); m1 = max3f(m1, b[3], b[4]); m0 = max3f(m0, a[5], a[6]); m1 = max3f(m1, b[5], b[6]);
    m0 = max3f(m0, a[7], a[8]); m1 = max3f(m1, b[7], b[8]); m0 = max3f(m0, a[9], a[10]); m1 = max3f(m1, b[9], b[10]);
    m0 = max3f(m0, a[11], a[12]); m1 = max3f(m1, b[11], b[12]); m0 = max3f(m0, a[13], a[14]); m1 = max3f(m1, b[13], b[14]);
    return max3f(m0, m1, fmaxf(a[15], b[15]));
}
__device__ __forceinline__ bf16x8 scale8(bf16x8 v, float c) {
    u32x4 w = __builtin_bit_cast(u32x4, v);
#pragma unroll
    for (int i = 0; i < 4; ++i) w[i] = pk_bf16(__uint_as_float(w[i] << 16) * c, __uint_as_float(w[i] & 0xffff0000u) * c);
    return __builtin_bit_cast(bf16x8, w);
}
constexpr int AT_KBUF = 64 * 208, AT_STAGE = AT_KBUF + 8192, AT_BT = 3 * AT_STAGE;
template <int MODE>
__device__ __forceinline__ void attn_unit(const KP P, const int L_, const Ws& W, LAS unsigned char* lds, const int b, const int h, const int qb, const bool ctxq) {
    constexpr int NST = MODE == 2 ? 6 : (MODE == 1 ? 2 : 4);
    constexpr int NMAP = MODE == 1 ? 2 : 1;
    constexpr int KSTR = MODE == 2 ? 208 : 144;
    constexpr float CS = MODE == 2 ? 0.14724444602590306f : (MODE == 1 ? 0.25503486164919736f : 0.18033688011112042f);
    constexpr float NEG = -1e30f;
    const int tid = tid_opaque(), wave = __builtin_amdgcn_readfirstlane(tid >> 6), lane = tid & 63, r32 = lane & 31, hh = lane >> 5;
    const int l = L_;
    const int t0 = ctxq ? NLAT + b * CTX : b * SEQ + qb * 256;
    const int tq = t0 + wave * 32 + r32;
    bf16x8 qf[NMAP][NST];
    {
        const bf16_t* src = MODE == 2 ? W.QM + (size_t)tq * 768 + h * 96 : W.PB + (size_t)tq * PBS + (MODE == 1 ? O_DQ : O_NAQ) + h * 64;
#pragma unroll
        for (int mp = 0; mp < NMAP; ++mp)
#pragma unroll
            for (int st = 0; st < NST; ++st) qf[mp][st] = scale8(*(const bf16x8*)(src + 32 * mp + 16 * st + 8 * hh), CS);
    }
    int ntiles = 36, nwin = 0, krs = 0;
    if (ctxq) ntiles = 4;
    else if (MODE == 0) { krs = min(max(4 * qb - 4, 0), 24); nwin = min(max(4 * qb - 1, 0), 24) + 8 - krs; ntiles = nwin + 4; }
    LAS float* btab = (LAS float*)(lds + AT_BT);
    if (MODE == 0 && !ctxq) { const float* rbp = P->in[9] + ((size_t)l * 4 + h) * 465; for (int i = tid; i < 465; i += NTHREADS) btab[i] = 1.4426950408889634f * rbp[i]; }
    const int kkey = tid >> 3, kch = tid & 7;
    const unsigned kw_off = (unsigned)(kkey * KSTR + kch * 16);
    const unsigned rw_off = (unsigned)((tid >> 2) * KSTR + 128 + (tid & 3) * 16);
    const unsigned vw_off = (unsigned)(AT_KBUF + ((kkey >> 2) * 2 + (kch >> 2)) * 256 + (kkey & 3) * 64 + (kch & 3) * 16);
    u32x4 kregA, vregA, rregA = {0u, 0u, 0u, 0u}, kregB, vregB, rregB = {0u, 0u, 0u, 0u};
#define AT_ROW0(i) (ctxq ? NLAT + b * CTX + 64 * (i) : (MODE == 0 ? ((i) < nwin ? b * SEQ + 64 * (krs + (i)) : NLAT + b * CTX + 64 * ((i) - nwin)) : ((i) < 32 ? b * SEQ + 64 * (i) : NLAT + b * CTX + 64 * ((i) - 32))))
#define AT_LOAD(i, X) do { const int row0_ = AT_ROW0(i); \
        if (MODE == 2) { const bf16_t* kp_ = W.KVM + (size_t)(row0_ + kkey) * 1024 + h * 128 + 8 * kch; kreg##X = *(const u32x4*)kp_; vreg##X = *(const u32x4*)(kp_ + 64); \
                         if (tid < 256) rreg##X = *(const u32x4*)(W.PB + (size_t)(row0_ + (tid >> 2)) * PBS + O_KR + 8 * (tid & 3)); } \
        else { const bf16_t* kp_ = W.PB + (size_t)(row0_ + kkey) * PBS + h * 64 + 8 * kch; kreg##X = *(const u32x4*)(kp_ + (MODE == 1 ? O_DK : O_NAK)); vreg##X = *(const u32x4*)(kp_ + (MODE == 1 ? O_DV : O_NAV)); } } while (0)
#define AT_WRITE(buf, X) do { LAS unsigned char* sb_ = lds + (buf) * AT_STAGE; *(LAS u32x4*)(sb_ + kw_off) = kreg##X; *(LAS u32x4*)(sb_ + vw_off) = vreg##X; \
        if (MODE == 2 && tid < 256) *(LAS u32x4*)(sb_ + rw_off) = rreg##X; } while (0)
    constexpr float THR = 8.f;
    f32x16 O[NMAP][2], NM[NMAP]; float lrun[NMAP]; int started = 0;
    float one_a = 1.f, one_b = 1.f; asm volatile("" : "+v"(one_a)); asm volatile("" : "+v"(one_b));
#pragma unroll
    for (int mp = 0; mp < NMAP; ++mp) { lrun[mp] = 0.f;
#pragma unroll
        for (int i = 0; i < 16; ++i) NM[mp][i] = 0.f;
#pragma unroll
        for (int d = 0; d < 2; ++d)
#pragma unroll
            for (int i = 0; i < 16; ++i) O[mp][d][i] = 0.f; }
    const unsigned kr_off = (unsigned)(r32 * KSTR + hh * 16);
    const unsigned vr_off = (unsigned)(AT_KBUF + hh * 512 + ((lane & 15) >> 2) * 64 + (((lane >> 4) & 1) * 16 + (lane & 3) * 4) * 2);
#define AT_BAR() do { asm volatile("s_waitcnt lgkmcnt(0)" ::: "memory"); __builtin_amdgcn_s_barrier(); asm volatile("" ::: "memory"); } while (0)
    constexpr bool DEEP = (MODE != 1);
#define AT_QK(mp, Sa, Sb, sbp) do { \
        if (MODE == 1) {     \
            bf16x8 kq_[NST][2]; \
            _Pragma("unroll") for (int st = 0; st < NST; ++st) { \
                kq_[st][0] = *(const LAS bf16x8*)((sbp) + kr_off + (4 * (mp) + 2 * st) * 16); \
                kq_[st][1] = *(const LAS bf16x8*)((sbp) + kr_off + 32 * KSTR + (4 * (mp) + 2 * st) * 16); } \
            _Pragma("unroll") for (int st = 0; st < NST; ++st) { \
                Sa = __builtin_amdgcn_mfma_f32_32x32x16_bf16(kq_[st][0], qf[mp][st], st == 0 ? NM[mp] : Sa, 0, 0, 0); \
                Sb = __builtin_amdgcn_mfma_f32_32x32x16_bf16(kq_[st][1], qf[mp][st], st == 0 ? NM[mp] : Sb, 0, 0, 0); } \
        } else \
        _Pragma("unroll") for (int st = 0; st < NST; ++st) { \
            const bf16x8 k0_ = *(const LAS bf16x8*)((sbp) + kr_off + ((MODE == 1 ? 4 * (mp) : 0) + 2 * st) * 16); \
            const bf16x8 k1_ = *(const LAS bf16x8*)((sbp) + kr_off + 32 * KSTR + ((MODE == 1 ? 4 * (mp) : 0) + 2 * st) * 16); \
            Sa = __builtin_amdgcn_mfma_f32_32x32x16_bf16(k0_, qf[mp][st], st == 0 ? NM[mp] : Sa, 0, 0, 0); \
            Sb = __builtin_amdgcn_mfma_f32_32x32x16_bf16(k1_, qf[mp][st], st == 0 ? NM[mp] : Sb, 0, 0, 0); \
            if (MODE == 2 && (st & 1)) __builtin_amdgcn_sched_barrier(0); } } while (0)
#define AT_SMPV(mp, Sa, Sb, Xa, Xb, sbp, wt, krv, rqv) do { \
          \
        v4i16_t vq_[MODE != 2 ? 8 : 1][2]; \
        if (MODE != 2) { _Pragma("unroll") for (int d = 0; d < 2; ++d) _Pragma("unroll") for (int s4 = 0; s4 < 4; ++s4) { \
            const LAS unsigned char* vp_ = (sbp) + vr_off + (8 * s4 + d) * 256; \
            vq_[MODE != 2 ? 4 * d + s4 : 0][0] = __builtin_amdgcn_ds_read_tr16_b64_v4i16((LAS v4i16_t*)vp_); \
            vq_[MODE != 2 ? 4 * d + s4 : 0][1] = __builtin_amdgcn_ds_read_tr16_b64_v4i16((LAS v4i16_t*)(vp_ + 1024)); } } \
        if (wt) { const int cq_ = 32 * (wave & 1) + r32, cs_ = min(max(cq_ - 8, 0), 48); const LAS float* bt_ = btab + ((krv) - (rqv) + 7) * 31 + 15 - cq_; \
            _Pragma("unroll") for (int q = 0; q < 16; ++q) { const int kc0_ = (q & 3) + 8 * (q >> 2) + 4 * hh, kc1_ = kc0_ + 32; \
                Sa[q] = ((unsigned)(kc0_ - cs_) < 16u) ? Sa[q] + bt_[kc0_] : NEG; Sb[q] = ((unsigned)(kc1_ - cs_) < 16u) ? Sb[q] + bt_[kc1_] : NEG; } } \
        float mx_ = max32(Sa, Sb); mx_ = fmaxf(mx_, __shfl_xor(mx_, 32)); \
        if (!started || __any(mx_ > THR)) { \
            const float d_ = started ? fmaxf(mx_, 0.f) : mx_, f_ = __builtin_amdgcn_exp2f(-d_); \
            lrun[mp] *= f_; \
            _Pragma("unroll") for (int d = 0; d < 2; ++d) _Pragma("unroll") for (int q = 0; q < 16; ++q) O[mp][d][q] *= f_; \
              \
            _Pragma("unroll") for (int q = 0; q < 16; ++q) { Sa[q] -= d_; Sb[q] -= d_; Xa[q] -= d_; Xb[q] -= d_; } \
            __builtin_amdgcn_sched_barrier(0); \
            asm volatile("s_nop 7\n\ts_nop 7" :: "v"(Xa[15]), "v"(Xb[15])); \
            __builtin_amdgcn_sched_barrier(0); \
            _Pragma("unroll") for (int q = 0; q < 16; ++q) NM[mp][q] -= d_; } \
          \
        float la_ = 0.f, lb_ = 0.f; \
        _Pragma("unroll") for (int q = 0; q < 16; ++q) { Sa[q] = __builtin_amdgcn_exp2f(Sa[q]); Sb[q] = __builtin_amdgcn_exp2f(Sb[q]); la_ = __builtin_fmaf(Sa[q], one_a, la_); lb_ = __builtin_fmaf(Sb[q], one_b, lb_); } \
        lrun[mp] += la_ + lb_; \
        bf16x8 pf_[4]; \
        pf_[0] = pack8(Sa[0], Sa[1], Sa[2], Sa[3], Sa[4], Sa[5], Sa[6], Sa[7]); pf_[1] = pack8(Sa[8], Sa[9], Sa[10], Sa[11], Sa[12], Sa[13], Sa[14], Sa[15]); \
        pf_[2] = pack8(Sb[0], Sb[1], Sb[2], Sb[3], Sb[4], Sb[5], Sb[6], Sb[7]); pf_[3] = pack8(Sb[8], Sb[9], Sb[10], Sb[11], Sb[12], Sb[13], Sb[14], Sb[15]); \
        _Pragma("unroll") for (int d = 0; d < 2; ++d) _Pragma("unroll") for (int s4 = 0; s4 < 4; ++s4) { \
            const LAS unsigned char* vp_ = (sbp) + vr_off + (8 * s4 + d) * 256; \
            const v4i16_t va_ = MODE != 2 ? vq_[MODE != 2 ? 4 * d + s4 : 0][0] : __builtin_amdgcn_ds_read_tr16_b64_v4i16((LAS v4i16_t*)vp_); \
            const v4i16_t vb_ = MODE != 2 ? vq_[MODE != 2 ? 4 * d + s4 : 0][1] : __builtin_amdgcn_ds_read_tr16_b64_v4i16((LAS v4i16_t*)(vp_ + 1024)); \
            bf16x8 vf_; vf_[0] = va_[0]; vf_[1] = va_[1]; vf_[2] = va_[2]; vf_[3] = va_[3]; vf_[4] = vb_[0]; vf_[5] = vb_[1]; vf_[6] = vb_[2]; vf_[7] = vb_[3]; \
            O[mp][d] = __builtin_amdgcn_mfma_f32_32x32x16_bf16(vf_, pf_[s4], O[mp][d], 0, 0, 0); \
            if (NMAP == 2 && (s4 & 1)) __builtin_amdgcn_sched_barrier(0); } } while (0)
#define AT_ACTIVE(i, wt, act, krv, rqv) const bool wt = (MODE == 0) && !ctxq && (i) < nwin; bool act = true; int krv = 0, rqv = 0; \
        if (wt) { krv = krs + (i); rqv = 4 * qb + (wave >> 1); const int rsq_ = min(max(rqv - 4, 0), 24); act = krv >= rsq_ && krv < rsq_ + 8; }
    if (DEEP) {
        f32x16 SA0, SA1, SB0, SB1;
        AT_LOAD(0, A); AT_WRITE(0, A);
        if (ntiles > 1) { AT_LOAD(1, B); AT_WRITE(1, B); }
        if (ntiles > 2) AT_LOAD(2, A);
        if (ntiles > 3) AT_LOAD(3, B);
        AT_BAR();
        { AT_ACTIVE(0, wt0, act0, kr0, rq0); if (act0) AT_QK(0, SA0, SA1, lds); (void)wt0; (void)kr0; (void)rq0; }
        int s0 = 0;
#pragma unroll 1
        for (int i0 = 0; i0 < ntiles; i0 += 2) {
            const int s1 = s0 == 2 ? 0 : s0 + 1, s2 = s1 == 2 ? 0 : s1 + 1;
            {
                const int i = i0;
                if (i + 2 < ntiles) AT_WRITE(s2, A);
                if (i + 4 < ntiles) AT_LOAD(i + 4, A);
                if (i + 1 < ntiles) { AT_ACTIVE(i + 1, wtn, actn, krn, rqn); if (actn) AT_QK(0, SB0, SB1, lds + s1 * AT_STAGE); (void)wtn; (void)krn; (void)rqn; }
                __builtin_amdgcn_sched_barrier(0);
                AT_ACTIVE(i, wt, act, kr, rq);
                if (act) { AT_SMPV(0, SA0, SA1, SB0, SB1, lds + s0 * AT_STAGE, wt, kr, rq); started = 1; }
                AT_BAR();
            }
            if (i0 + 1 < ntiles) {
                const int i = i0 + 1;
                if (i + 2 < ntiles) AT_WRITE(s0, B);
                if (i + 4 < ntiles) AT_LOAD(i + 4, B);
                if (i + 1 < ntiles) { AT_ACTIVE(i + 1, wtn, actn, krn, rqn); if (actn) AT_QK(0, SA0, SA1, lds + s2 * AT_STAGE); (void)wtn; (void)krn; (void)rqn; }
                __builtin_amdgcn_sched_barrier(0);
                AT_ACTIVE(i, wt, act, kr, rq);
                if (act) { AT_SMPV(0, SB0, SB1, SA0, SA1, lds + s1 * AT_STAGE, wt, kr, rq); started = 1; }
                AT_BAR();
            }
            s0 = s2;
        }
    } else {
        AT_LOAD(0, A); AT_WRITE(0, A); if (ntiles > 1) AT_LOAD(1, A);
        AT_BAR();
#pragma unroll 1
        for (int i = 0; i < ntiles; ++i) {
            if (i + 1 < ntiles) AT_WRITE((i + 1) & 1, A);
            if (i + 2 < ntiles) AT_LOAD(i + 2, A);
            const LAS unsigned char* sb = lds + (i & 1) * AT_STAGE;
#pragma unroll
            for (int mp = 0; mp < NMAP; ++mp) {
                f32x16 S0, S1, X0, X1;
#pragma unroll
                for (int q = 0; q < 16; ++q) { X0[q] = 0.f; X1[q] = 0.f; }
                AT_QK(mp, S0, S1, sb);
                AT_SMPV(mp, S0, S1, X0, X1, sb, false, 0, 0);
                if (NMAP == 2) __builtin_amdgcn_sched_barrier(0);
            }
            started = 1;
            AT_BAR();
        }
    }
#undef AT_QK
#undef AT_SMPV
#undef AT_ACTIVE
#undef AT_BAR
    float inv[NMAP];
#pragma unroll
    for (int mp = 0; mp < NMAP; ++mp) { const float lt = lrun[mp] + __shfl_xor(lrun[mp], 32); inv[mp] = 1.f / lt; }
    bf16_t* orow = W.HB + (size_t)tq * DM + (MODE == 0 ? 0 : (MODE == 1 ? 256 : 512)) + h * 64 + 4 * hh;
    if (MODE == 1) {
        const float lam = W.lam[l], li = 0.8f - 0.6f * expf(-0.3f * (float)l);
        const float* sg = P->in[11] + l * 64;
        const float c2 = lam * inv[1];
        float ss = 0.f;
#pragma unroll
        for (int d = 0; d < 2; ++d)
#pragma unroll
            for (int q = 0; q < 16; ++q) { const float o = O[0][d][q] * inv[0] - c2 * O[NMAP - 1][d][q]; O[0][d][q] = o; ss += o * o; }
        ss += __shfl_xor(ss, 32);
        const float rs = rsqrtf(ss * (1.f / 64.f) + 1e-6f) * (1.f - li);
#pragma unroll
        for (int d = 0; d < 2; ++d)
#pragma unroll
            for (int g4 = 0; g4 < 4; ++g4) {
                const int dv = 32 * d + 8 * g4 + 4 * hh;
                const f32x4 gg = *(const f32x4*)(sg + dv);
                u32x2 w; w.x = pk_bf16(O[0][d][4 * g4] * rs * gg[0], O[0][d][4 * g4 + 1] * rs * gg[1]); w.y = pk_bf16(O[0][d][4 * g4 + 2] * rs * gg[2], O[0][d][4 * g4 + 3] * rs * gg[3]);
                *(u32x2*)(orow + 32 * d + 8 * g4) = w;
            }
    } else {
#pragma unroll
        for (int d = 0; d < 2; ++d)
#pragma unroll
            for (int g4 = 0; g4 < 4; ++g4) {
                u32x2 w; w.x = pk_bf16(O[0][d][4 * g4] * inv[0], O[0][d][4 * g4 + 1] * inv[0]); w.y = pk_bf16(O[0][d][4 * g4 + 2] * inv[0], O[0][d][4 * g4 + 3] * inv[0]);
                *(u32x2*)(orow + 32 * d + 8 * g4) = w;
            }
    }
#undef AT_ROW0
#undef AT_LOAD
#undef AT_WRITE
}
__device__ __forceinline__ void phase_attn(const int L_, const int CH_, LAS unsigned char* lds) {
    const KP P = kparams();
    const Ws W(P->ws);
    const int G = pgrid<ID_ATTN>(), c = pblk<ID_ATTN>();
    if (c < 0) return;
    const int gwave = c * 8 + __builtin_amdgcn_readfirstlane(tid_opaque() >> 6), nwaves = G * 8;
    int ck = 0;
#define AT_CONV() do { const int tid0_ = tid_opaque(), cwave_ = __builtin_amdgcn_readfirstlane(tid0_ >> 6); \
        conv_expert_items(P, W, L_, ck, gwave, nwaves, (LAS float*)(lds + 73728 + cwave_ * 8704)  , tid0_ & 63); ck += 2; } while (0)
    for (int u = c; u < 1024; u += G) { const int x = u & 7, j = u >> 3, qb = j & 7, bh = (j >> 3) * 8 + x; attn_unit<2>(P, L_, W, lds, bh >> 3, bh & 7, qb, false); AT_CONV(); }
    for (int u = c; u < 512; u += G) { const int x = u & 7, j = u >> 3, qb = j & 7, bh = (j >> 3) * 8 + x; attn_unit<1>(P, L_, W, lds, bh >> 2, bh & 3, qb, false); AT_CONV(); }
    for (int u = c; u < 512; u += G) { const int x = u & 7, j = u >> 3, qb = j & 7, bh = (j >> 3) * 8 + x; attn_unit<0>(P, L_, W, lds, bh >> 2, bh & 3, qb, false); AT_CONV(); }
    if (L_ == 0) {
        for (int u = c; u < 256; u += G) {
            if (u < 128) attn_unit<2>(P, L_, W, lds, u >> 3, u & 7, 0, true);
            else if (u < 192) attn_unit<1>(P, L_, W, lds, (u - 128) >> 2, (u - 128) & 3, 0, true);
            else attn_unit<0>(P, L_, W, lds, (u - 192) >> 2, (u - 192) & 3, 0, true);
        }
    }
    while (gwave + ck * nwaves < CV_E) AT_CONV();
#undef AT_CONV
}

#define XB_TMO      128
#define XB_XCNT(j)  (256  + 64 * (j))
#define XB_XSUB(j)  (1280 + 64 * (j))
#define XB_XGEN(j)  (2304 + 64 * (j))
#define XB_TOP      3328
#define XB_TOPGEN   3392
#define XCD_BAR_WORDS 3456
#define XB_SPIN_CAP (1u << 18)

__device__ __forceinline__ unsigned xb_ld(unsigned* p)              { return __hip_atomic_load(p, __ATOMIC_RELAXED, __HIP_MEMORY_SCOPE_AGENT); }
__device__ __forceinline__ unsigned xb_add(unsigned* p, unsigned v) { return __hip_atomic_fetch_add(p, v, __ATOMIC_RELAXED, __HIP_MEMORY_SCOPE_AGENT); }
__device__ __forceinline__ unsigned xb_xcc_id() { return (unsigned)__builtin_amdgcn_s_getreg((3 << 11) | 20) & 0xFu; }
#define XB_SPIN(cond, bar) do { unsigned _sp = 0; while (cond) { __builtin_amdgcn_s_sleep(1); \
    if ((++_sp & 255u) == 0u) { if (xb_ld(&(bar)[XB_TMO])) break; if (_sp > XB_SPIN_CAP) { atomicAdd(&(bar)[XB_TMO], 1u); break; } } } } while (0)

struct XcdBarrier {
    unsigned* bar; unsigned x;
    volatile LAS unsigned* st;
};

__device__ __forceinline__ XcdBarrier xcd_barrier_post(unsigned* bar, volatile LAS unsigned* st) {
    XcdBarrier b; b.bar = bar; b.x = xb_xcc_id(); b.st = st;
    if (threadIdx.x == 0) (void)xb_add(&bar[XB_XCNT(b.x)], 1u);
    return b;
}
__device__ __forceinline__ void xcd_barrier_complete(unsigned* bar, unsigned x, unsigned& nloc, unsigned& nx) {
    const unsigned G = gridDim.x * gridDim.y * gridDim.z;
    unsigned sum, cnt, mine, sp = 0u;
    for (;;) {
        sum = 0u; cnt = 0u; mine = 0u;
#pragma unroll
        for (unsigned j = 0; j < 16; ++j) { const unsigned c = xb_ld(&bar[XB_XCNT(j)]); sum += c; cnt += (c > 0u) ? 1u : 0u; mine = (j == x) ? c : mine; }
        if (sum == G) break;
        __builtin_amdgcn_s_sleep(1);
        if ((++sp & 255u) == 0u) { if (xb_ld(&bar[XB_TMO])) break; if (sp > XB_SPIN_CAP) { atomicAdd(&bar[XB_TMO], 1u); break; } }
    }
    nloc = mine > 0u ? mine : 1u; nx = cnt > 0u ? cnt : 1u;
}

__device__ __forceinline__ void xcd_barrier(const XcdBarrier& b) {
    asm volatile("s_waitcnt vmcnt(0)" ::: "memory");
    __syncthreads();
    if (threadIdx.x == 0) {
        unsigned* bar = b.bar;
        __builtin_amdgcn_s_waitcnt(0);
        unsigned nloc = b.st[0], nx = b.st[1];
        if (nloc == 0u) { xcd_barrier_complete(bar, b.x, nloc, nx); b.st[0] = nloc; b.st[1] = nx; }
        const unsigned old = xb_add(&bar[XB_XSUB(b.x)], 1u);
        const unsigned gen = old / nloc;
        if (old + 1u == (gen + 1u) * nloc) {
            __builtin_amdgcn_fence(__ATOMIC_RELEASE, "agent");
            asm volatile("s_waitcnt vmcnt(0)" ::: "memory");
            const unsigned og = xb_add(&bar[XB_TOP], 1u);
            const unsigned tg = og / nx;
            if (og + 1u == (tg + 1u) * nx) xb_add(&bar[XB_TOPGEN], 1u);
            else XB_SPIN(xb_ld(&bar[XB_TOPGEN]) == tg, bar);
            __builtin_amdgcn_fence(__ATOMIC_ACQUIRE, "agent");
            xb_add(&bar[XB_XGEN(b.x)], 1u);
            asm volatile("s_waitcnt vmcnt(0)" ::: "memory");
        } else {
            XB_SPIN(xb_ld(&bar[XB_XGEN(b.x)]) == gen, bar);
            __builtin_amdgcn_fence(__ATOMIC_ACQUIRE, "agent");
            asm volatile("s_waitcnt vmcnt(0)" ::: "memory");
        }
    }
    __syncthreads();
}

constexpr int NSTEPS = 2 + 2 * (5 + 2 * NCHUNK);
constexpr int LDS_BARW = LDS_BYTES - 64;
__global__ void __launch_bounds__(NTHREADS, 2) k_fwd(Params P) {
    extern __shared__ __attribute__((aligned(16))) unsigned char dyn_lds[];
    LAS unsigned char* lds = (LAS unsigned char*)dyn_lds;
    volatile LAS unsigned* st = (volatile LAS unsigned*)(lds + LDS_BARW);
    if (threadIdx.x == 0) { st[0] = 0u; st[1] = 0u; st[2] = 0u; st[3] = 0u; }
    __syncthreads();
    const XcdBarrier bar = xcd_barrier_post((unsigned*)(P.ws + WS_CTL), st);
    const int lo = P.ph_lo, hi = P.ph_hi;
    int step = 0;
#ifndef REP_ATTN
#define REP_ATTN 1
#endif
#ifndef REP_MOE1
#define REP_MOE1 1
#endif
#ifndef REP_MOE2
#define REP_MOE2 1
#endif
#ifndef REP_INPROJ
#define REP_INPROJ 1
#endif
#ifndef REP_MLA
#define REP_MLA 1
#endif
#ifndef REP_CONV
#define REP_CONV 1
#endif
#define STEP(body) do { const int s_ = step++; if (s_ >= lo && s_ < hi) { body; if (s_ + 1 < hi && s_ + 1 < NSTEPS) xcd_barrier(bar); } } while (0)
    STEP(for (int rep = 0; rep < REP_CONV; ++rep) { if (rep) xcd_barrier(bar); phase_convert(0, 0, lds); });
    STEP(phase_norm1(0, 0, lds));
#pragma unroll 1
    for (int l = 0; l < 2; ++l) {
        STEP(for (int rep = 0; rep < REP_INPROJ; ++rep) { if (rep) xcd_barrier(bar); phase_inproj(l, 0, lds); });
        STEP(for (int rep = 0; rep < REP_MLA; ++rep) { if (rep) xcd_barrier(bar); phase_mla(l, 0, lds); });
        STEP(for (int rep = 0; rep < REP_ATTN; ++rep) { if (rep) xcd_barrier(bar); phase_attn(l, 0, lds); });
        STEP(phase_outproj(l, 0, lds));
        STEP(phase_norm2(l, 0, lds));
#pragma unroll 1
        for (int ch = 0; ch < NCHUNK; ++ch) {
            STEP(phase_moe(l, ch, lds));
            STEP(phase_comb(l, ch, lds); if (l == 0 && ch == NCHUNK - 1) phase_convert(1, 0, lds));
        }
    }
#undef STEP
}

#ifndef MK_N_LAUNCHES
#define MK_N_LAUNCHES 1
#endif
extern "C" void kernel_launch(void* const* d_in, const int* in_sizes, int n_in, void* d_out, int out_size, void* d_ws, size_t ws_size, hipStream_t stream) {
    static int grid = 0;
    if (grid == 0) {
        if (ws_size < WS_END || n_in != 26 || out_size != NLAT * DM) { fprintf(stderr, "kernel_launch: workspace %zu < %zu or n_in %d != 26 or out %d; nothing launched\n", ws_size, (size_t)WS_END, n_in, out_size); grid = -1; return; }
        int dev = 0, cus = 0, per_cu = 0;
        if (hipGetDevice(&dev) != hipSuccess || hipDeviceGetAttribute(&cus, hipDeviceAttributeMultiprocessorCount, dev) != hipSuccess || cus <= 0) { fprintf(stderr, "kernel_launch: device query failed\n"); grid = -1; return; }
        if (hipFuncSetAttribute((const void*)k_fwd, hipFuncAttributeMaxDynamicSharedMemorySize, LDS_BYTES) != hipSuccess) { fprintf(stderr, "kernel_launch: hipFuncSetAttribute failed\n"); grid = -1; return; }
        if (hipOccupancyMaxActiveBlocksPerMultiprocessor(&per_cu, (const void*)k_fwd, NTHREADS, LDS_BYTES) != hipSuccess || per_cu < 1) { fprintf(stderr, "kernel_launch: occupancy query says %d workgroups per CU\n", per_cu); grid = -1; (void)hipGetLastError(); return; }
        grid = cus;
    }
    if (grid < 0) return;
    Params P{};
    for (int i = 0; i < 26; ++i) P.in[i] = (const float*)d_in[i];
    P.out = (float*)d_out; P.ws = (unsigned char*)d_ws;
    (void)hipMemsetAsync((unsigned char*)d_ws + WS_CTL, 0, CTL_ZERO_BYTES, stream);
    if (MK_N_LAUNCHES == 1) {
        P.ph_lo = 0; P.ph_hi = NSTEPS;
        hipLaunchKernelGGL(k_fwd, dim3(grid), dim3(NTHREADS), LDS_BYTES, stream, P);
#ifdef PROBE_STEP
        (void)hipMemsetAsync((unsigned char*)d_ws + WS_CTL, 0, XCD_BAR_WORDS * 4, stream);
        if (!(PROBE_I2 & 1)) (void)hipMemsetAsync((unsigned char*)d_ws + WS_CTL + (size_t)CW_RT * 4 + (size_t)2 * 1024 * 16 * 4, 0, (size_t)2 * 1024 * 16 * 4, stream);
        P.ph_lo = PROBE_STEP; P.ph_hi = PROBE_STEP + 1; P.i2 = PROBE_I2;
        hipLaunchKernelGGL(k_fwd, dim3(grid), dim3(NTHREADS), LDS_BYTES, stream, P);
#endif
    } else {
        for (int s = 0; s < NSTEPS; ++s) { P.ph_lo = s; P.ph_hi = s + 1; hipLaunchKernelGGL(k_fwd, dim3(grid), dim3(NTHREADS), LDS_BYTES, stream, P); }
    }
}
```

```cpp
#include <hip/hip_runtime.h>
#include <cstdint>
#include <cstdio>
#include <cmath>

typedef unsigned short bf16_t;

constexpr int NB = 16, SEQ = 2048, DM = 1024, CTX = 256;
constexpr int NLAT = NB * SEQ, NCTX = NB * CTX, NTOK = NLAT + NCTX;
constexpr int INC = 1952;
constexpr int PBS = 2048;
constexpr int O_NAQ = 0, O_NAK = 256, O_NAV = 512, O_DQ = 768, O_DK = 1024, O_DV = 1280, O_CQ = 1536, O_CKV = 1792, O_KR = 1920;
constexpr int NEXP = 64, EFF = 256;
constexpr int LCAP = NTOK;
constexpr int MODW = 6 * DM;

constexpr size_t MiB = 1u << 20;
constexpr size_t WS_CTL = 0;
constexpr size_t WS_MOD = 1 * MiB;
constexpr size_t WS_ROPE = 2 * MiB;
constexpr size_t WS_SSQ = 3 * MiB;
constexpr size_t WS_JUNK = 6 * MiB;
constexpr size_t WS_XS = 8 * MiB;
constexpr size_t WS_HB = 152 * MiB;
constexpr size_t WS_PB = 224 * MiB;
constexpr size_t WS_QM = 368 * MiB;
constexpr size_t WS_KVM = 422 * MiB;
constexpr size_t WS_WB = 494 * MiB;
constexpr size_t WS_END = 600 * MiB;
constexpr size_t WS_LOG = WS_PB;
constexpr size_t WS_LIST = WS_PB + 16 * MiB;
constexpr size_t WB_WIN = 0;
constexpr size_t WB_WUQ = WB_WIN + (size_t)2048 * 1024;
constexpr size_t WB_WUKV = WB_WUQ + (size_t)768 * 256;
constexpr size_t WB_WOUT = WB_WUKV + (size_t)1024 * 256;
constexpr size_t WB_WGU = WB_WOUT + (size_t)1024 * 1024;
constexpr size_t WB_WD = WB_WGU + (size_t)65 * 512 * 1024;
constexpr size_t WB_END = WB_WD + (size_t)65 * 1024 * 256;
constexpr size_t WB_RW = WB_END;
static_assert(WS_WB + (WB_RW + (size_t)8 * 8 * 2 * 2 * 64 * 8) * 2 <= WS_END, "weights fit");

__device__ __forceinline__ float bf2f(bf16_t v) { return __uint_as_float(((unsigned)v) << 16); }
__device__ __forceinline__ bf16_t f2bf(float f) { unsigned u = __float_as_uint(f); u += 0x7fffu + ((u >> 16) & 1u); return (bf16_t)(u >> 16); }
__device__ __forceinline__ float wave_sum(float v) {
#pragma unroll
    for (int o = 32; o > 0; o >>= 1) v += __shfl_xor(v, o);
    return v;
}
__device__ __forceinline__ float wave_max(float v) {
#pragma unroll
    for (int o = 32; o > 0; o >>= 1) v = fmaxf(v, __shfl_xor(v, o));
    return v;
}
__device__ __forceinline__ int mod_row(int t) { return t < NLAT ? (t >> 11) : 16; }

__device__ __forceinline__ void rope_cs(int s, int j, float& cs, float& sn) {
    const int rowi = s >> 6, coli = s & 63;
    const float freq = powf(10000.f, -(float)(j & 7) / 8.f);
    const float ang = (float)(j < 8 ? rowi : coli) * freq;
    cs = cosf(ang); sn = sinf(ang);
}
#define LAS __attribute__((address_space(3)))
typedef short bf16x8 __attribute__((ext_vector_type(8)));
typedef float f32x4 __attribute__((ext_vector_type(4)));
typedef float f32x2 __attribute__((ext_vector_type(2)));
typedef unsigned u32x2 __attribute__((ext_vector_type(2)));
typedef unsigned u32x4 __attribute__((ext_vector_type(4)));
typedef __bf16 bf16x2_t __attribute__((ext_vector_type(2)));

struct Params { const float* in[26]; float* out; unsigned char* ws; int ph_lo, ph_hi, i2, i3; };
typedef const Params __attribute__((address_space(4)))* KP;
__device__ __forceinline__ KP kparams() { KP p = (KP)__builtin_amdgcn_kernarg_segment_ptr(); asm volatile("" : "+s"(p)); return p; }
#ifndef PROBE_HALF
#define PROBE_HALF -1
#endif
enum { ID_CONV = 0, ID_NORM1, ID_INPROJ, ID_MLA, ID_ATTN, ID_OUTPROJ, ID_NORM2, ID_MOE, ID_COMB };
template <int ID> __device__ __forceinline__ int pgrid() { int g = (int)gridDim.x; asm volatile("" : "+s"(g)); return ID == PROBE_HALF ? g / 2 : g; }
template <int ID> __device__ __forceinline__ int pblk() { int b = (int)blockIdx.x; asm volatile("" : "+s"(b)); return ID == PROBE_HALF ? ((b & 1) ? -1 : b >> 1) : b; }
__device__ __forceinline__ int tid_opaque() { int t = (int)threadIdx.x; asm volatile("" : "+v"(t)); return t; }

constexpr int NTHREADS = 512;
constexpr int LDS_BYTES = 150528;

__device__ __forceinline__ unsigned pk_bf16(float lo, float hi) { f32x2 v = {lo, hi}; bf16x2_t b = __builtin_convertvector(v, bf16x2_t); return __builtin_bit_cast(unsigned, b); }

namespace g8 {
constexpr int BM = 256, BK = 64, HALF = 128, HTB = HALF * BK * 2, STAGE_BYTES = 8 * HTB, NXCD = 8, WGM = 8;
__host__ __device__ __forceinline__ int lds_byte(int r, int c) { const int st = (r >> 4) * 2 + (c >> 5), rr = r & 15, cc = c & 31, ob = rr * 64 + cc * 2; return st * 1024 + (ob ^ (((ob >> 9) & 1) << 5)); }
__host__ __device__ __forceinline__ void stage_rc(int b, int& R, int& C) { const int st = b / 1024, sb = b % 1024, swz = sb ^ (((sb >> 9) & 1) << 5); R = (st >> 1) * 16 + swz / 64; C = (st & 1) * 32 + (swz % 64) / 2; }

struct Unit2 { int pm, pn; };
struct DenseOrder {
    int nM, nN, nwg, G, c;
    __device__ __forceinline__ void init(int nM_, int nN_, int G_, int c_) { nM = nM_; nN = nN_; nwg = nM * nN; G = G_; c = c_; }
    __device__ __forceinline__ bool next(int i, Unit2& u) const {
        const long L = (long)i * G + c; if (L >= nwg) return false;
        int wgid = (int)L; { const int q = nwg / NXCD, r = nwg % NXCD, xcd = wgid % NXCD, off = wgid / NXCD; wgid = (xcd < r ? xcd * (q + 1) : r * (q + 1) + (xcd - r) * q) + off; }
        const int nig = WGM * nN, gid = wgid / nig, fm = gid * WGM, gsz = (nM - fm) < WGM ? (nM - fm) : WGM;
        u.pm = fm + ((wgid % nig) % gsz); u.pn = (wgid % nig) / gsz; return true;
    }
};

#define G8_SA(b, h) (((b) * 2 + (h)) * g8::HTB)
#define G8_SB(b, h) ((4 + (b) * 2 + (h)) * g8::HTB)
#define G8_GLDS(gp, ldsoff) __builtin_amdgcn_global_load_lds((const unsigned*)(gp), (LAS unsigned*)(lds + (ldsoff)), 16, 0, 0)
#define G8_STAGE_A(bufoff, o0, o1, kb) do { G8_GLDS(Ab + (o0) + (kb), (bufoff) + ldsw); G8_GLDS(Ab + (o1) + (kb), (bufoff) + ldsw + 8192); } while (0)
#define G8_STAGE_B(bufoff, bp, kb) do { G8_GLDS((bp) + voffB[0] + (kb), (bufoff) + ldsw); G8_GLDS((bp) + voffB[1] + (kb), (bufoff) + ldsw + 8192); } while (0)
#define G8_LDA(dst, b, h) do { _Pragma("unroll") for (int m = 0; m < 4; ++m) _Pragma("unroll") for (int k = 0; k < 2; ++k) dst[m][k] = *(const LAS bf16x8*)(lds + G8_SA(b, h) + aoff + m * 2048 + k * 1024); } while (0)
#define G8_LDB(dst, b, h) do { _Pragma("unroll") for (int n = 0; n < 2; ++n) _Pragma("unroll") for (int k = 0; k < 2; ++k) dst[n][k] = *(const LAS bf16x8*)(lds + G8_SB(b, h) + boff + n * 2048 + k * 1024); } while (0)
#define G8_MMA(ai, bj, At, Bt) do { __builtin_amdgcn_s_setprio(1); _Pragma("unroll") for (int m = 0; m < 4; ++m) _Pragma("unroll") for (int n = 0; n < 2; ++n) _Pragma("unroll") for (int k = 0; k < 2; ++k) \
        acc[ai][bj][m][n] = __builtin_amdgcn_mfma_f32_16x16x32_bf16(Bt[n][k], At[m][k], acc[ai][bj][m][n], 0, 0, 0); __builtin_amdgcn_s_setprio(0); } while (0)
#define G8_WAIT_V(n) asm volatile("s_waitcnt vmcnt(" #n ")" ::: "memory")
#define G8_WAIT_L(n) asm volatile("s_waitcnt lgkmcnt(" #n ")" ::: "memory")
#define G8_BAR __builtin_amdgcn_s_barrier()
#define G8_SCHED __builtin_amdgcn_sched_barrier(0)

template <class P>
__device__ __forceinline__ void gemm_phase(LAS unsigned char* lds, const P& pr) {
    typedef typename P::Unit Unit;
    constexpr int K = P::K, nt = K / BK;
    static_assert(K % 128 == 0 && nt >= 2, "K must be a multiple of 128");
    const int tid = tid_opaque(), wid = __builtin_amdgcn_readfirstlane(tid >> 6), lane = tid & 63, wr = wid >> 2, wc = wid & 3, fr = lane & 15, fq = lane >> 4;
    int Rr[2], Cc[2]; unsigned voffB[2];
#pragma unroll
    for (int i = 0; i < 2; ++i) { stage_rc(tid * 16 + i * 8192, Rr[i], Cc[i]); voffB[i] = (unsigned)(Rr[i] * K + Cc[i]) * 2u; }
    constexpr unsigned kstep = BK * 2;
    constexpr size_t hstepB = (size_t)HALF * K * 2;
    const unsigned ldsw = (unsigned)wid * 1024u;
    const int aoff = lds_byte(wr * 64 + fr, fq * 8), boff = lds_byte(wc * 32 + fr, fq * 8);
    Unit cur, nxt; int ui = 0;
    int pend = -1;
    if (!pr.next(0, cur)) return;
    f32x4 acc[2][2][4][2];
#pragma unroll
    for (int a = 0; a < 2; ++a)
#pragma unroll
        for (int b = 0; b < 2; ++b)
#pragma unroll
            for (int m = 0; m < 4; ++m)
#pragma unroll
                for (int n = 0; n < 2; ++n) acc[a][b][m][n] = (f32x4){0.f, 0.f, 0.f, 0.f};
    bf16x8 At[4][2], B0[2][2], B1[2][2];
    const char* Ab = pr.a_base();
    unsigned ca[2][2], na[2][2];
    pr.a_ready(cur);
    pr.a_offsets(cur, Rr, Cc, ca);
    const char* cB = pr.b_ptr(cur);
    G8_STAGE_B(G8_SB(0, 0), cB, 0); G8_STAGE_B(G8_SB(0, 1), cB + hstepB, 0); G8_STAGE_A(G8_SA(0, 0), ca[0][0], ca[0][1], 0); G8_STAGE_A(G8_SA(0, 1), ca[1][0], ca[1][1], 0);
    if (wr == 1) G8_BAR;
    G8_WAIT_V(2); G8_BAR;
    G8_STAGE_B(G8_SB(1, 0), cB, kstep); G8_STAGE_A(G8_SA(1, 0), ca[0][0], ca[0][1], kstep); G8_STAGE_B(G8_SB(1, 1), cB + hstepB, kstep);
    G8_WAIT_V(6); G8_BAR;
    for (;;) {
        const bool has_next = pr.next(ui + 1, nxt);
        const char* nB = cB;
#pragma unroll
        for (int h = 0; h < 2; ++h)
#pragma unroll
            for (int i = 0; i < 2; ++i) na[h][i] = ca[h][i];
        if (has_next) { pr.a_offsets(nxt, Rr, Cc, na); nB = pr.b_ptr(nxt); }
#pragma unroll 1
        for (int t = 0; t < nt; t += 2) {
            const bool last = (t == nt - 2);
            if (last && has_next) pr.a_ready(nxt);
            const unsigned k1 = (unsigned)(t + 1) * kstep, k2 = (unsigned)(t + 2) * kstep;
            unsigned a2[2][2];
#pragma unroll
            for (int h = 0; h < 2; ++h)
#pragma unroll
                for (int i = 0; i < 2; ++i) a2[h][i] = last ? na[h][i] : ca[h][i] + k2;
            const char* b2 = last ? nB : cB + k2;
            G8_LDB(B0, 0, 0); G8_LDB(B1, 0, 1); G8_SCHED; G8_LDA(At, 0, 0); G8_STAGE_A(G8_SA(1, 1), ca[1][0], ca[1][1], k1);
            G8_WAIT_V(8); G8_WAIT_L(0); G8_BAR; G8_MMA(0, 0, At, B0); G8_MMA(0, 1, At, B1); G8_BAR; G8_SCHED;
            G8_LDA(At, 0, 1); G8_STAGE_B(G8_SB(0, 0), b2, 0); G8_STAGE_B(G8_SB(0, 1), b2 + hstepB, 0); G8_STAGE_A(G8_SA(0, 0), a2[0][0], a2[0][1], 0);
            G8_WAIT_V(8); G8_WAIT_L(0); G8_BAR; G8_MMA(1, 0, At, B0); G8_MMA(1, 1, At, B1); G8_BAR; G8_SCHED;
            if (P::HAS_DONE && t == 0 && pend >= 0) { pr.done(pend); pend = -1; }
            G8_LDB(B0, 1, 0); G8_LDB(B1, 1, 1); G8_SCHED; G8_LDA(At, 1, 0); G8_STAGE_A(G8_SA(0, 1), a2[1][0], a2[1][1], 0);
            G8_WAIT_V(8); G8_WAIT_L(0); G8_BAR; G8_MMA(0, 0, At, B0); G8_MMA(0, 1, At, B1); G8_BAR; G8_SCHED;
            G8_LDA(At, 1, 1); G8_STAGE_B(G8_SB(1, 0), b2, kstep); G8_STAGE_B(G8_SB(1, 1), b2 + hstepB, kstep); G8_STAGE_A(G8_SA(1, 0), a2[0][0], a2[0][1], kstep);
            G8_WAIT_V(8); G8_WAIT_L(0); G8_BAR; G8_MMA(1, 0, At, B0); G8_MMA(1, 1, At, B1); G8_BAR; G8_SCHED;
        }
        if (wr == 0) G8_BAR;
        pr.epilogue(acc, cur, wr, wc, fr, fq);
        if (P::HAS_DONE) pend = pr.done_token(cur);
        if (!has_next) break;
#pragma unroll
        for (int a = 0; a < 2; ++a)
#pragma unroll
            for (int b = 0; b < 2; ++b)
#pragma unroll
                for (int m = 0; m < 4; ++m)
#pragma unroll
                    for (int n = 0; n < 2; ++n) acc[a][b][m][n] = (f32x4){0.f, 0.f, 0.f, 0.f};
        cur = nxt; cB = nB; ++ui;
#pragma unroll
        for (int h = 0; h < 2; ++h)
#pragma unroll
            for (int i = 0; i < 2; ++i) ca[h][i] = na[h][i];
        if (wr == 1) G8_BAR;
    }
    G8_WAIT_V(0);
    if (P::HAS_DONE && pend >= 0) pr.done(pend);
    G8_BAR;
}
}

struct Ws {
    unsigned* ctl; float* mod; float* lam; float* rope; float* ssq; float* sskv;
    bf16_t* XS; bf16_t* HB; bf16_t* PB; bf16_t* QM; bf16_t* KVM; bf16_t* WB;
    __device__ __host__ __forceinline__ explicit Ws(unsigned char* ws) {
        ctl = (unsigned*)(ws + WS_CTL); mod = (float*)(ws + WS_MOD); lam = mod + 2 * 17 * MODW; rope = (float*)(ws + WS_ROPE);
        ssq = (float*)(ws + WS_SSQ); sskv = ssq + (size_t)NTOK * 4;
        XS = (bf16_t*)(ws + WS_XS); HB = (bf16_t*)(ws + WS_HB); PB = (bf16_t*)(ws + WS_PB); QM = (bf16_t*)(ws + WS_QM); KVM = (bf16_t*)(ws + WS_KVM); WB = (bf16_t*)(ws + WS_WB);
    }
};

__device__ __forceinline__ int conv_drow(int ng, int mode) {
    if (mode == 1 || mode == 2) { const int a = ng & 127; return (ng & ~127) * 2 + 128 * ((a >> 2) & 1) + 32 * (a >> 5) + 16 * (mode - 1) + 4 * ((a >> 3) & 3) + (a & 3); }
    if (mode == 3) { const int c = ng & 63; return (ng & ~63) + 16 * ((c >> 2) & 3) + 4 * (c >> 4) + (c & 3); }
    if (mode == 4) { const int c = ng & 255, g = c >> 5; return (ng & ~255) + 128 * ((c >> 2) & 1) + 32 * (g >> 1) + 16 * ((c >> 4) & 1) + 4 * (2 * (g & 1) + ((c >> 3) & 1)) + (c & 3); }
    return ng;
}
struct ConvDesc { const float* W; const float* ks; bf16_t* Bt; int N, k0, n0, ldo, mode; };
__device__ __forceinline__ void conv_load(const ConvDesc& d, float (&v)[32], int lane) {
#pragma unroll
    for (int i = 0; i < 32; ++i) v[i] = d.W[(size_t)(d.k0 + 2 * i + (lane >> 5)) * d.N + d.n0 + (lane & 31)];
}
__device__ __forceinline__ void conv_store(const ConvDesc& d, float (&v)[32], LAS float* scr, int lane) {
    if (d.ks) {
#pragma unroll
        for (int i = 0; i < 32; ++i) v[i] *= d.ks[d.k0 + 2 * i + (lane >> 5)];
    }
#pragma unroll
    for (int i = 0; i < 32; ++i) scr[(2 * i + (lane >> 5)) * 33 + (lane & 31)] = v[i];
    asm volatile("s_waitcnt lgkmcnt(0)" ::: "memory");
    const int c = lane & 7;
#pragma unroll
    for (int j = 0; j < 4; ++j) {
        const int n = (lane >> 3) + 8 * j;
        const LAS float* sp = scr + (8 * c) * 33 + n;
        u32x4 o; o.x = pk_bf16(sp[0], sp[33]); o.y = pk_bf16(sp[66], sp[99]); o.z = pk_bf16(sp[132], sp[165]); o.w = pk_bf16(sp[198], sp[231]);
        *(u32x4*)(d.Bt + (size_t)conv_drow(d.n0 + n, d.mode) * d.ldo + d.k0 + 8 * c) = o;
    }
    asm volatile("s_waitcnt lgkmcnt(0)" ::: "memory");
}
constexpr int CV_E = 65 * 384, CV_IN = 16 * 61, CV_OUT = 512, CV_UQ = 96, CV_UKV = 64, CV_ITEMS = CV_E + CV_IN + CV_OUT + CV_UQ + CV_UKV;
__device__ __forceinline__ void conv_decode(const KP P, const Ws& W, int l, int it, ConvDesc& d) {
    int r = it; d.ks = nullptr;
    if (r < CV_E) {
        const int e = r / 384, w = (r % 384) >> 7, t = r & 127;
        if (w < 2) {
            d.W = e < 64 ? P->in[19 + w] + ((size_t)l * 64 + e) * 262144 : P->in[22 + w] + (size_t)l * 262144;
            d.N = 256; d.k0 = (t >> 3) * 64; d.n0 = (t & 7) * 32; d.Bt = W.WB + WB_WGU + (size_t)e * 524288; d.ldo = 1024; d.mode = 1 + w;
        } else {
            d.W = e < 64 ? P->in[21] + ((size_t)l * 64 + e) * 262144 : P->in[24] + (size_t)l * 262144;
            d.N = 1024; d.k0 = (t >> 5) * 64; d.n0 = (t & 31) * 32; d.Bt = W.WB + WB_WD + (size_t)e * 262144; d.ldo = 256; d.mode = 3;
        }
        return;
    }
    r -= CV_E;
    if (r < CV_IN) { d.W = P->in[8] + (size_t)l * 1024 * INC; d.N = INC; d.k0 = (r / 61) * 64; d.n0 = (r % 61) * 32; d.Bt = W.WB + WB_WIN; d.ldo = 1024; d.mode = 4; return; }
    r -= CV_IN;
    if (r < CV_OUT) { d.W = P->in[16] + (size_t)l * 1024 * 1024; d.N = 1024; d.k0 = (r >> 5) * 64; d.n0 = (r & 31) * 32; d.Bt = W.WB + WB_WOUT; d.ldo = 1024; d.mode = 0; return; }
    r -= CV_OUT;
    if (r < CV_UQ) { d.W = P->in[13] + (size_t)l * 256 * 768; d.N = 768; d.k0 = (r / 24) * 64; d.n0 = (r % 24) * 32; d.Bt = W.WB + WB_WUQ; d.ldo = 256; d.mode = 4; d.ks = P->in[12] + l * 256; return; }
    r -= CV_UQ;
    d.W = P->in[15] + (size_t)l * 128 * 1024; d.N = 1024; d.k0 = (r >> 5) * 64; d.n0 = (r & 31) * 32; d.Bt = W.WB + WB_WUKV; d.ldo = 256; d.mode = 4; d.ks = P->in[14] + l * 128;
}
__device__ __forceinline__ void conv_expert_items(const KP P, const Ws& W, int l, int k0, int gwave, int nwaves, LAS float* scr, int lane) {
    const int itA = gwave + k0 * nwaves, itB = itA + nwaves;
    if (itA >= CV_E) return;
    ConvDesc dA, dB; float vA[32], vB[32];
    conv_decode(P, W, l, itA, dA); conv_load(dA, vA, lane);
    const bool hB = itB < CV_E;
    if (hB) { conv_decode(P, W, l, itB, dB); conv_load(dB, vB, lane); }
    conv_store(dA, vA, scr, lane);
    if (hB) conv_store(dB, vB, scr, lane);
}
__device__ __forceinline__ void phase_convert(const int L_, const int CH_, LAS unsigned char* lds) {
    const KP P = kparams();
    const Ws W(P->ws);
    const int l = L_, tid = tid_opaque(), c = pblk<ID_CONV>(), G = pgrid<ID_CONV>();
    if (c < 0) return;
    const int wave = __builtin_amdgcn_readfirstlane(tid >> 6), lane = tid & 63;
    LAS float* scr = (LAS float*)(lds + wave * 8704);
    {
        const int stride = G * 8;
        int it = CV_E + c * 8 + wave;
        ConvDesc dA, dB; float vA[32], vB[32];
        bool hA = it < CV_ITEMS;
        if (hA) { conv_decode(P, W, l, it, dA); conv_load(dA, vA, lane); }
        while (hA) {
            const int itn = it + stride; const bool hB = itn < CV_ITEMS;
            if (hB) { conv_decode(P, W, l, itn, dB); conv_load(dB, vB, lane); }
            conv_store(dA, vA, scr, lane);
            if (!hB) break;
            it = itn + stride; hA = it < CV_ITEMS;
            if (hA) { conv_decode(P, W, l, it, dA); conv_load(dA, vA, lane); }
            conv_store(dB, vB, scr, lane);
        }
    }
    {
        const float* rw = P->in[17] + (size_t)l * DM * NEXP;
        for (int it = c * NTHREADS + tid; it < 8 * 8 * 2 * 64; it += G * NTHREADS) {
            const int ln = it & 63, n = (it >> 6) & 1, ks = (it >> 7) & 7, w = it >> 10;
            const float* p = rw + (size_t)(128 * w + 16 * ks + 8 * (ln >> 5)) * NEXP + 32 * n + (ln & 31);
            u32x4 h4, l4;
#pragma unroll
            for (int t = 0; t < 4; ++t) { const float w0 = p[(2 * t) * NEXP], w1 = p[(2 * t + 1) * NEXP]; const unsigned hi = pk_bf16(w0, w1); h4[t] = hi; l4[t] = pk_bf16(w0 - __uint_as_float(hi << 16), w1 - __uint_as_float(hi & 0xffff0000u)); }
            bf16_t* dst = W.WB + WB_RW + ((size_t)((w * 8 + ks) * 2 + n) * 2 * 64 + ln) * 8;
            *(u32x4*)dst = h4; *(u32x4*)(dst + 64 * 8) = l4;
        }
    }
    __syncthreads();
    {
        const int gid = c * NTHREADS + tid, gsz = G * NTHREADS;
        unsigned zz = 0u; asm volatile("" : "+v"(zz));
        const u32x4 z = {zz, zz, zz, zz};
        for (int i = gid; i < 96 * 128; i += gsz) *(u32x4*)(W.WB + WB_WIN + (size_t)conv_drow(1952 + (i >> 7), 4) * 1024 + (size_t)(i & 127) * 8) = z;
        for (int i = gid; i < 1024 * 16; i += gsz) *(u32x4*)(W.WB + WB_WUKV + (size_t)(i >> 4) * 256 + 128 + (i & 15) * 8) = z;
    }
    if (l == 0) {
        LAS float* st = (LAS float*)lds;
        LAS float* red = st + 17 * 1024;
        for (int u = c; u < 192; u += G) {
            const int l2 = u / 96, cg = u % 96;
            for (int i = tid; i < 17 * 1024; i += NTHREADS) { const int r = i >> 10, k = i & 1023; const float v = r < 16 ? P->in[1][r * 1024 + k] : P->in[3][k]; st[i] = v / (1.f + expf(-v)); }
            __syncthreads();
            const float* w = P->in[4] + (size_t)l2 * 1024 * MODW + cg * 64 + lane;
            float a[17];
#pragma unroll
            for (int r = 0; r < 17; ++r) a[r] = 0.f;
            for (int k = wave * 128; k < wave * 128 + 128; ++k) {
                const float wv = w[(size_t)k * MODW];
#pragma unroll
                for (int r = 0; r < 17; ++r) a[r] += st[r * 1024 + k] * wv;
            }
#pragma unroll
            for (int r = 0; r < 17; ++r) red[(wave * 17 + r) * 64 + lane] = a[r];
            __syncthreads();
            for (int i = tid; i < 17 * 64; i += NTHREADS) {
                const int r = i >> 6, col = i & 63; float s = 0.f;
#pragma unroll
                for (int w8 = 0; w8 < 8; ++w8) s += red[(w8 * 17 + r) * 64 + col];
                W.mod[((size_t)l2 * 17 + r) * MODW + cg * 64 + col] = s + P->in[5][l2 * MODW + cg * 64 + col];
            }
            __syncthreads();
        }
        for (int i = c * NTHREADS + tid; i < 2048 * 16; i += G * NTHREADS) { float cs, sn; rope_cs(i >> 4, i & 15, cs, sn); W.rope[2 * i] = cs; W.rope[2 * i + 1] = sn; }
        if (c == G - 1 && wave == 0) {
            for (int l2 = 0; l2 < 2; ++l2) {
                const float* lv = P->in[10] + l2 * 128;
                float a = lane < 32 ? lv[lane] * lv[32 + lane] : 0.f, b = lane < 32 ? lv[64 + lane] * lv[96 + lane] : 0.f;
                a = wave_sum(a); b = wave_sum(b);
                const float li = 0.8f - 0.6f * expf(-0.3f * (float)l2);
                if (lane == 0) W.lam[l2] = expf(a) - expf(b) + li;
            }
        }
    }
}

struct ProbInProj {
    typedef g8::Unit2 Unit; static constexpr int K = 1024;
    __device__ __forceinline__ void a_ready(const Unit&) const {}
    static constexpr bool HAS_DONE = false;
    __device__ __forceinline__ void done(int) const {}
    __device__ __forceinline__ int done_token(const Unit&) const { return -1; }
    g8::DenseOrder ord; const bf16_t* A; const bf16_t* Bt; bf16_t* PB; const float* rope; float* ssq; float* sskv;
    __device__ __forceinline__ bool next(int i, Unit& u) const { return ord.next(i, u); }
    __device__ __forceinline__ const char* a_base() const { return (const char*)A; }
    __device__ __forceinline__ void a_offsets(const Unit& u, const int (&R)[2], const int (&C)[2], unsigned (&o)[2][2]) const {
#pragma unroll
        for (int h = 0; h < 2; ++h)
#pragma unroll
            for (int i = 0; i < 2; ++i) o[h][i] = (unsigned)((u.pm * 256 + h * 128 + R[i]) * K + C[i]) * 2u;
    }
    __device__ __forceinline__ const char* b_ptr(const Unit& u) const { return (const char*)(Bt + (size_t)u.pn * 256 * K); }
    __device__ __forceinline__ void epilogue(const f32x4 (&acc)[2][2][4][2], const Unit& u, int wr, int wc, int fr, int fq) const {
        const int pn = u.pn; const bool lat = u.pm < NLAT / 256;
        const int g = 2 * wc + (fq >> 1);
        const int rowb = u.pm * 256 + wr * 64 + fr, colb = pn * 256 + 32 * g + 8 * (fq & 1);
        const bool want_ss = pn >= 6;
        const bool rp = lat && (pn == 3 || pn == 4 || (pn == 7 && g == 4));
        const bool ss_on = pn == 6 || (pn == 7 && g < 4);
#pragma unroll
        for (int ai = 0; ai < 2; ++ai)
#pragma unroll
            for (int m = 0; m < 4; ++m) {
                const int row = rowb + ai * 128 + m * 16;
                f32x4 x1[2] = {acc[ai][0][m][0], acc[ai][1][m][0]}, x2[2] = {acc[ai][0][m][1], acc[ai][1][m][1]};
                if (rp) {
                    const f32x4* tb = (const f32x4*)(rope + ((size_t)(row & 2047) * 16 + 8 * (fq & 1)) * 2);
#pragma unroll
                    for (int bj = 0; bj < 2; ++bj) {
                        const f32x4 t0 = tb[2 * bj], t1 = tb[2 * bj + 1];
                        const f32x4 cs = {t0[0], t0[2], t1[0], t1[2]}, sn = {t0[1], t0[3], t1[1], t1[3]};
                        const f32x4 o1 = x1[bj] * cs - x2[bj] * sn, o2 = x1[bj] * sn + x2[bj] * cs;
                        x1[bj] = o1; x2[bj] = o2;
                    }
                }
                u32x4 w1, w2;
                w1.x = pk_bf16(x1[0][0], x1[0][1]); w1.y = pk_bf16(x1[0][2], x1[0][3]); w1.z = pk_bf16(x1[1][0], x1[1][1]); w1.w = pk_bf16(x1[1][2], x1[1][3]);
                w2.x = pk_bf16(x2[0][0], x2[0][1]); w2.y = pk_bf16(x2[0][2], x2[0][3]); w2.z = pk_bf16(x2[1][0], x2[1][1]); w2.w = pk_bf16(x2[1][2], x2[1][3]);
                bf16_t* prow = PB + (size_t)row * PBS + colb;
                *(u32x4*)prow = w1; *(u32x4*)(prow + 16) = w2;
                if (want_ss) {
                    float ss = 0.f;
                    if (ss_on) {
#pragma unroll
                        for (int q = 0; q < 4; ++q) {
                            const float a0 = __uint_as_float(w1[q] << 16), a1 = __uint_as_float(w1[q] & 0xffff0000u), b0 = __uint_as_float(w2[q] << 16), b1 = __uint_as_float(w2[q] & 0xffff0000u);
                            ss += a0 * a0 + a1 * a1 + b0 * b0 + b1 * b1;
                        }
                    }
                    ss += __shfl_xor(ss, 16); ss += __shfl_xor(ss, 32);
                    if (fq == 0) (pn == 6 ? ssq : sskv)[(size_t)row * 4 + wc] = ss;
                }
            }
    }
};
__device__ __forceinline__ void phase_inproj(const int L_, const int CH_, LAS unsigned char* lds) {
    const KP P = kparams();
    const Ws W(P->ws);
    if (pblk<ID_INPROJ>() < 0) return;
    ProbInProj pr; pr.ord.init(NTOK / 256, 8, pgrid<ID_INPROJ>(), pblk<ID_INPROJ>());
    pr.A = W.HB; pr.Bt = W.WB + WB_WIN; pr.PB = W.PB; pr.rope = W.rope; pr.ssq = W.ssq; pr.sskv = W.sskv;
    g8::gemm_phase(lds, pr);
}

struct UnitM { int pm, pn, kv; };
struct ProbMla {
    typedef UnitM Unit; static constexpr int K = 256;
    __device__ __forceinline__ void a_ready(const Unit&) const {}
    static constexpr bool HAS_DONE = false;
    __device__ __forceinline__ void done(int) const {}
    __device__ __forceinline__ int done_token(const Unit&) const { return -1; }
    int nq_units, n_units, G, c;
    const bf16_t* PBp; const bf16_t* Wuq; const bf16_t* Wukv; bf16_t* QM; bf16_t* KVM; const float* rope; const float* ssq; const float* sskv;
    __device__ __forceinline__ bool next(int i, Unit& u) const {
        const int L = i * G + c; if (L >= n_units) return false;
        if (L < nq_units) { u.kv = 0; u.pm = L / 3; u.pn = L % 3; } else { const int r = L - nq_units; u.kv = 1; u.pm = r >> 2; u.pn = r & 3; }
        return true;
    }
    __device__ __forceinline__ const char* a_base() const { return (const char*)PBp; }
    __device__ __forceinline__ void a_offsets(const Unit& u, const int (&R)[2], const int (&C)[2], unsigned (&o)[2][2]) const {
        const int cb = u.kv ? O_CKV : O_CQ;
#pragma unroll
        for (int h = 0; h < 2; ++h)
#pragma unroll
            for (int i = 0; i < 2; ++i) o[h][i] = (unsigned)((u.pm * 256 + h * 128 + R[i]) * PBS + cb + C[i]) * 2u;
    }
    __device__ __forceinline__ const char* b_ptr(const Unit& u) const { return (const char*)((u.kv ? Wukv : Wuq) + (size_t)u.pn * 256 * K); }
    __device__ __forceinline__ void epilogue(const f32x4 (&acc)[2][2][4][2], const Unit& u, int wr, int wc, int fr, int fq) const {
        const bool lat = u.pm < NLAT / 256;
        const int g = 2 * wc + (fq >> 1);
        const int rowb = u.pm * 256 + wr * 64 + fr, colb = u.pn * 256 + 32 * g + 8 * (fq & 1);
        const float* ssp = u.kv ? sskv : ssq; const float inv = u.kv ? (1.f / 128.f) : (1.f / 256.f);
        bf16_t* O = u.kv ? KVM : QM; const int ldo = u.kv ? 1024 : 768;
        const bool rp = !u.kv && lat && ((u.pn * 8 + g) % 3) == 2;
        float rs[2][4];
#pragma unroll
        for (int ai = 0; ai < 2; ++ai)
#pragma unroll
            for (int m = 0; m < 4; ++m) { const f32x4 s4 = *(const f32x4*)(ssp + (size_t)(rowb + ai * 128 + m * 16) * 4); rs[ai][m] = rsqrtf((s4[0] + s4[1] + s4[2] + s4[3]) * inv + 1e-6f); }
#pragma unroll
        for (int ai = 0; ai < 2; ++ai)
#pragma unroll
            for (int m = 0; m < 4; ++m) {
                const int row = rowb + ai * 128 + m * 16;
                const float rstd = rs[ai][m];
                f32x4 x1[2] = {acc[ai][0][m][0] * rstd, acc[ai][1][m][0] * rstd}, x2[2] = {acc[ai][0][m][1] * rstd, acc[ai][1][m][1] * rstd};
                if (rp) {
                    const f32x4* tb = (const f32x4*)(rope + ((size_t)(row & 2047) * 16 + 8 * (fq & 1)) * 2);
#pragma unroll
                    for (int bj = 0; bj < 2; ++bj) {
                        const f32x4 t0 = tb[2 * bj], t1 = tb[2 * bj + 1];
                        const f32x4 cs = {t0[0], t0[2], t1[0], t1[2]}, sn = {t0[1], t0[3], t1[1], t1[3]};
                        const f32x4 o1 = x1[bj] * cs - x2[bj] * sn, o2 = x1[bj] * sn + x2[bj] * cs;
                        x1[bj] = o1; x2[bj] = o2;
                    }
                }
                u32x4 w1, w2;
                w1.x = pk_bf16(x1[0][0], x1[0][1]); w1.y = pk_bf16(x1[0][2], x1[0][3]); w1.z = pk_bf16(x1[1][0], x1[1][1]); w1.w = pk_bf16(x1[1][2], x1[1][3]);
                w2.x = pk_bf16(x2[0][0], x2[0][1]); w2.y = pk_bf16(x2[0][2], x2[0][3]); w2.z = pk_bf16(x2[1][0], x2[1][1]); w2.w = pk_bf16(x2[1][2], x2[1][3]);
                bf16_t* prow = O + (size_t)row * ldo + colb;
                *(u32x4*)prow = w1; *(u32x4*)(prow + 16) = w2;
            }
    }
};
__device__ __forceinline__ void phase_mla(const int L_, const int CH_, LAS unsigned char* lds) {
    const KP P = kparams();
    const Ws W(P->ws);
    const int nq = L_ == 0 ? NTOK : NLAT;
    ProbMla pr; pr.nq_units = (nq / 256) * 3; pr.n_units = pr.nq_units + (NTOK / 256) * 4; pr.G = pgrid<ID_MLA>(); pr.c = pblk<ID_MLA>();
    if (pr.c < 0) return;
    pr.PBp = W.PB; pr.Wuq = W.WB + WB_WUQ; pr.Wukv = W.WB + WB_WUKV; pr.QM = W.QM; pr.KVM = W.KVM; pr.rope = W.rope; pr.ssq = W.ssq; pr.sskv = W.sskv;
    g8::gemm_phase(lds, pr);
}

struct ProbOut {
    typedef g8::Unit2 Unit; static constexpr int K = 1024;
    __device__ __forceinline__ void a_ready(const Unit&) const {}
    static constexpr bool HAS_DONE = false;
    __device__ __forceinline__ void done(int) const {}
    __device__ __forceinline__ int done_token(const Unit&) const { return -1; }
    g8::DenseOrder ord; const bf16_t* A; const bf16_t* Bt; bf16_t* XS; const float* x_in; const float* ctx_in; const float* mod_l; int layer;
    __device__ __forceinline__ bool next(int i, Unit& u) const { return ord.next(i, u); }
    __device__ __forceinline__ const char* a_base() const { return (const char*)A; }
    __device__ __forceinline__ void a_offsets(const Unit& u, const int (&R)[2], const int (&C)[2], unsigned (&o)[2][2]) const {
#pragma unroll
        for (int h = 0; h < 2; ++h)
#pragma unroll
            for (int i = 0; i < 2; ++i) o[h][i] = (unsigned)((u.pm * 256 + h * 128 + R[i]) * K + C[i]) * 2u;
    }
    __device__ __forceinline__ const char* b_ptr(const Unit& u) const { return (const char*)(Bt + (size_t)u.pn * 256 * K); }
    template <int LAYER> __device__ __forceinline__ void res_load(f32x4 (&b)[2][2], int row, int colb) const {
        if (LAYER == 0) {
            const float* xi = (row < NLAT ? x_in + (size_t)row * DM : ctx_in + (size_t)(row - NLAT) * DM) + colb;
#pragma unroll
            for (int bj = 0; bj < 2; ++bj)
#pragma unroll
                for (int n = 0; n < 2; ++n) b[bj][n] = *(const f32x4*)(xi + bj * 128 + n * 16);
        } else {
            const bf16_t* xo = XS + (size_t)row * DM + colb;
#pragma unroll
            for (int bj = 0; bj < 2; ++bj)
#pragma unroll
                for (int n = 0; n < 2; ++n) { const u32x2 w = *(const u32x2*)(xo + bj * 128 + n * 16); b[bj][n] = (f32x4){__uint_as_float(w.x << 16), __uint_as_float(w.x & 0xffff0000u), __uint_as_float(w.y << 16), __uint_as_float(w.y & 0xffff0000u)}; }
        }
    }
    template <int LAYER> __device__ __forceinline__ void epi(const f32x4 (&acc)[2][2][4][2], const Unit& u, int wr, int wc, int fr, int fq) const {
        const int r = u.pm < NLAT / 256 ? (u.pm >> 3) : 16;
        const int rowb = u.pm * 256 + wr * 64 + fr, colb = u.pn * 256 + wc * 32 + 4 * fq;
        const float* gate = mod_l + r * MODW + 2 * DM + colb;
        f32x4 gv[2][2];
#pragma unroll
        for (int bj = 0; bj < 2; ++bj)
#pragma unroll
            for (int n = 0; n < 2; ++n) gv[bj][n] = *(const f32x4*)(gate + bj * 128 + n * 16);
        if (LAYER == 1) {
#pragma unroll
            for (int ai = 0; ai < 2; ++ai) {
                u32x2 raw[4][2][2];
#pragma unroll
                for (int m = 0; m < 4; ++m)
#pragma unroll
                    for (int bj = 0; bj < 2; ++bj)
#pragma unroll
                        for (int n = 0; n < 2; ++n) raw[m][bj][n] = *(const u32x2*)(XS + (size_t)(rowb + ai * 128 + m * 16) * DM + colb + bj * 128 + n * 16);
                __builtin_amdgcn_sched_barrier(0);
#pragma unroll
                for (int m = 0; m < 4; ++m) {
                    bf16_t* xo = XS + (size_t)(rowb + ai * 128 + m * 16) * DM + colb;
#pragma unroll
                    for (int bj = 0; bj < 2; ++bj)
#pragma unroll
                        for (int n = 0; n < 2; ++n) {
                            const u32x2 w = raw[m][bj][n];
                            const f32x4 b = {__uint_as_float(w.x << 16), __uint_as_float(w.x & 0xffff0000u), __uint_as_float(w.y << 16), __uint_as_float(w.y & 0xffff0000u)};
                            const f32x4 o = b + gv[bj][n] * acc[ai][bj][m][n];
                            u32x2 ow; ow.x = pk_bf16(o[0], o[1]); ow.y = pk_bf16(o[2], o[3]);
                            *(u32x2*)(xo + bj * 128 + n * 16) = ow;
                        }
                }
                __builtin_amdgcn_sched_barrier(0);
            }
            return;
        }
        f32x4 bc[2][2], bn[2][2];
        res_load<LAYER>(bc, rowb, colb);
#pragma unroll
        for (int g = 0; g < 8; ++g) {
            const int ai = g >> 2, m = g & 3;
            const int row = rowb + ai * 128 + m * 16;
            if (g + 1 < 8) res_load<LAYER>(bn, rowb + ((g + 1) >> 2) * 128 + ((g + 1) & 3) * 16, colb);
            bf16_t* xo = XS + (size_t)row * DM + colb;
#pragma unroll
            for (int bj = 0; bj < 2; ++bj)
#pragma unroll
                for (int n = 0; n < 2; ++n) {
                    const f32x4 o = bc[bj][n] + gv[bj][n] * acc[ai][bj][m][n];
                    u32x2 ow; ow.x = pk_bf16(o[0], o[1]); ow.y = pk_bf16(o[2], o[3]);
                    *(u32x2*)(xo + bj * 128 + n * 16) = ow;
                }
#pragma unroll
            for (int bj = 0; bj < 2; ++bj)
#pragma unroll
                for (int n = 0; n < 2; ++n) bc[bj][n] = bn[bj][n];
        }
    }
    __device__ __forceinline__ void epilogue(const f32x4 (&acc)[2][2][4][2], const Unit& u, int wr, int wc, int fr, int fq) const {
        if (layer == 0) epi<0>(acc, u, wr, wc, fr, fq); else epi<1>(acc, u, wr, wc, fr, fq);
    }
};
__device__ __forceinline__ void phase_outproj(const int L_, const int CH_, LAS unsigned char* lds) {
    const KP P = kparams();
    const Ws W(P->ws);
    const int nq = L_ == 0 ? NTOK : NLAT;
    if (pblk<ID_OUTPROJ>() < 0) return;
    ProbOut pr; pr.ord.init(nq / 256, 4, pgrid<ID_OUTPROJ>(), pblk<ID_OUTPROJ>());
    pr.A = W.HB; pr.Bt = W.WB + WB_WOUT; pr.XS = W.XS; pr.x_in = P->in[0]; pr.ctx_in = P->in[2]; pr.mod_l = W.mod + (size_t)L_ * 17 * MODW; pr.layer = L_;
    g8::gemm_phase(lds, pr);
}

constexpr int NCHUNK = 2;
constexpr int CAPC = NTOK / NCHUNK;
constexpr size_t WS_LIST2 = WS_PB;
constexpr size_t WS_ACT = WS_PB + 18 * MiB;
constexpr size_t WS_Y = WS_PB + 108 * MiB;
constexpr size_t ACT_BYTES = 90 * MiB;
static_assert(WS_Y + (size_t)CAPC * 9 * 1024 <= WS_WB && (size_t)(CAPC * 9 + 65 * 255 + 256) * 512 <= ACT_BYTES, "MoE overlay fits");
constexpr int CW_CNT = 8192, CNT_STRIDE = 64;
constexpr int CW_RT = 32768;
constexpr size_t CTL_ZERO_BYTES = (size_t)(CW_RT + 2 * NCHUNK * 1024 * 16) * 4;
constexpr float Y_SCALE = 8.f;
constexpr int LDS_TAB = 131072;

typedef float f32x16 __attribute__((ext_vector_type(16)));
template <int CTRL> __device__ __forceinline__ float dppf(float v) { return __int_as_float(__builtin_amdgcn_update_dpp(0, __float_as_int(v), CTRL, 0xf, 0xf, true)); }
template <int CTRL> __device__ __forceinline__ int dppi(int v) { return __builtin_amdgcn_update_dpp(0, v, CTRL, 0xf, 0xf, true); }
__device__ __forceinline__ float gmax8f(float x) { x = fmaxf(x, dppf<0xB1>(x)); x = fmaxf(x, dppf<0x4E>(x)); return fmaxf(x, dppf<0x141>(x)); }
__device__ __forceinline__ int gmin8i(int x) { x = min(x, dppi<0xB1>(x)); x = min(x, dppi<0x4E>(x)); return min(x, dppi<0x141>(x)); }
__device__ __forceinline__ unsigned wmaxu(unsigned x) {
    x = max(x, (unsigned)dppi<0xB1>((int)x)); x = max(x, (unsigned)dppi<0x4E>((int)x)); x = max(x, (unsigned)dppi<0x141>((int)x)); x = max(x, (unsigned)dppi<0x140>((int)x));
    const unsigned a = (unsigned)__builtin_amdgcn_readlane((int)x, 0), b = (unsigned)__builtin_amdgcn_readlane((int)x, 16), c = (unsigned)__builtin_amdgcn_readlane((int)x, 32), d = (unsigned)__builtin_amdgcn_readlane((int)x, 48);
    return max(max(a, b), max(c, d));
}
__device__ __forceinline__ float wsumf(float x) {
    x += dppf<0xB1>(x); x += dppf<0x4E>(x); x += dppf<0x141>(x); x += dppf<0x140>(x);
    const float a = __int_as_float(__builtin_amdgcn_readlane(__float_as_int(x), 0)), b = __int_as_float(__builtin_amdgcn_readlane(__float_as_int(x), 16));
    const float c = __int_as_float(__builtin_amdgcn_readlane(__float_as_int(x), 32)), d = __int_as_float(__builtin_amdgcn_readlane(__float_as_int(x), 48));
    return (a + b) + (c + d);
}
#define N2_BAR() do { asm volatile("s_waitcnt lgkmcnt(0)" ::: "memory"); __builtin_amdgcn_s_barrier(); asm volatile("" ::: "memory"); } while (0)
__device__ __forceinline__ void phase_norm2(const int L_, const int CH_, LAS unsigned char* lds) {
    const KP P = kparams();
    const Ws W(P->ws);
    const int l = L_, tid = tid_opaque(), wave = __builtin_amdgcn_readfirstlane(tid >> 6), lane = tid & 63, G = pgrid<ID_NORM2>(), c = pblk<ID_NORM2>();
    if (c < 0) return;
    const int nq = l == 0 ? NTOK : NLAT, csz = nq / NCHUNK, nunits = nq / 32;
    const float* mod_l = W.mod + (size_t)l * 17 * MODW;
    const float* gn = P->in[7] + l * DM;
    const float* rw = P->in[17] + (size_t)l * DM * NEXP;
    const float* rb = P->in[18] + l * NEXP;
    int* cnt = (int*)(W.ctl + CW_CNT) + L_ * NCHUNK * 64 * CNT_STRIDE;
    uint2* list = (uint2*)(P->ws + WS_LIST2);
    constexpr int ASB = 1032;
    LAS unsigned char* Ah = lds;
    LAS unsigned char* Al = lds + 32 * ASB * 2;
    LAS float* At = (LAS float*)lds;
    constexpr int NRES = 6;
    const bf16_t* rwf = W.WB + WB_RW + ((size_t)wave * 8 * 2 * 2 * 64 + lane) * 8;
    u32x4 Bh[NRES][2], Bl[NRES][2];
#pragma unroll
    for (int ks = 0; ks < NRES; ++ks)
#pragma unroll
        for (int n = 0; n < 2; ++n) { Bh[ks][n] = *(const u32x4*)(rwf + ((ks * 2 + n) * 2) * 512); if (ks + n > 0 && !(ks == 1 && n == 1)) Bl[ks][n] = *(const u32x4*)(rwf + ((ks * 2 + n) * 2 + 1) * 512); }
    LAS unsigned char* bx = lds + 2 * 32 * ASB * 2 + wave * 2048 + lane * 16;
    static_assert(2 * 32 * ASB * 2 + 8 * 2048 <= LDS_BYTES - 64, "parked fragments fit below the barrier words");
    *(LAS u32x4*)bx = *(const u32x4*)(rwf + 512); *(LAS u32x4*)(bx + 1024) = *(const u32x4*)(rwf + ((1 * 2 + 1) * 2 + 1) * 512);
    const float rbe = rb[lane];
    u32x2 nx[4][4];
    int u = c;
    if (u < nunits) {
#pragma unroll
        for (int j = 0; j < 4; ++j)
#pragma unroll
            for (int q = 0; q < 4; ++q) nx[j][q] = *(const u32x2*)(W.XS + (size_t)(u * 32 + wave * 4 + j) * DM + 256 * q + lane * 4);
    }
    for (; u < nunits; u += G) {
        const int t0 = u * 32, r = mod_row(t0);
        {
            const float* sh = mod_l + r * MODW + 3 * DM; const float* sc = mod_l + r * MODW + 4 * DM;
            float rstd[4];
#pragma unroll
            for (int j = 0; j < 4; ++j) {
                float ss = 0.f;
#pragma unroll
                for (int q = 0; q < 4; ++q) { const u32x2 w = nx[j][q];
                    const float a0 = __uint_as_float(w.x << 16), a1 = __uint_as_float(w.x & 0xffff0000u), a2 = __uint_as_float(w.y << 16), a3 = __uint_as_float(w.y & 0xffff0000u); ss += a0 * a0 + a1 * a1 + a2 * a2 + a3 * a3; }
                rstd[j] = rsqrtf(wsumf(ss) * (1.f / DM) + 1e-6f);
            }
#pragma unroll
            for (int q = 0; q < 4; ++q) {
                const int col = 256 * q + lane * 4;
                __builtin_amdgcn_sched_barrier(0);
                const f32x4 ga = *(const f32x4*)(gn + col) * (*(const f32x4*)(sc + col) + 1.f), hb = *(const f32x4*)(sh + col);
#pragma unroll
                for (int j = 0; j < 4; ++j) {
                    const int tl = wave * 4 + j, t = t0 + tl;
                    const u32x2 w = nx[j][q];
                    const f32x4 v = {__uint_as_float(w.x << 16), __uint_as_float(w.x & 0xffff0000u), __uint_as_float(w.y << 16), __uint_as_float(w.y & 0xffff0000u)};
                    const f32x4 o = v * rstd[j] * ga + hb;
                    u32x2 ow; ow.x = pk_bf16(o[0], o[1]); ow.y = pk_bf16(o[2], o[3]);
                    *(u32x2*)(W.HB + (size_t)t * DM + col) = ow;
                    u32x2 lw; lw.x = pk_bf16(o[0] - __uint_as_float(ow.x << 16), o[1] - __uint_as_float(ow.x & 0xffff0000u)); lw.y = pk_bf16(o[2] - __uint_as_float(ow.y << 16), o[3] - __uint_as_float(ow.y & 0xffff0000u));
                    *(LAS u32x2*)(Ah + (tl * ASB + col) * 2) = ow;
                    *(LAS u32x2*)(Al + (tl * ASB + col) * 2) = lw;
                }
            }
        }
        if (u + G < nunits) {
#pragma unroll
            for (int j = 0; j < 4; ++j)
#pragma unroll
                for (int q = 0; q < 4; ++q) nx[j][q] = *(const u32x2*)(W.XS + (size_t)((u + G) * 32 + wave * 4 + j) * DM + 256 * q + lane * 4);
        }
        u32x4 Bsh[8 - NRES][2], Bsl[8 - NRES][2];
        {
            const bf16_t* rws = rwf; asm volatile("" : "+v"(rws));
#pragma unroll
            for (int ks = NRES; ks < 8; ++ks)
#pragma unroll
                for (int n = 0; n < 2; ++n) { Bsh[ks - NRES][n] = *(const u32x4*)(rws + ((ks * 2 + n) * 2) * 512); Bsl[ks - NRES][n] = *(const u32x4*)(rws + ((ks * 2 + n) * 2 + 1) * 512); }
        }
        N2_BAR();
        f32x16 acc0, acc1;
#pragma unroll
        for (int i = 0; i < 16; ++i) { acc0[i] = 0.f; acc1[i] = 0.f; }
        const unsigned aoff = (unsigned)(((lane & 31) * ASB + 128 * wave + 8 * (lane >> 5)) * 2);
#pragma unroll
        for (int ks = 0; ks < 8; ++ks) {
            const bf16x8 arh = *(const LAS bf16x8*)(Ah + aoff + 32 * ks), arl = *(const LAS bf16x8*)(Al + aoff + 32 * ks);
#pragma unroll
            for (int n = 0; n < 2; ++n) {
                const bf16x8 bh = __builtin_bit_cast(bf16x8, ks < NRES ? Bh[ks < NRES ? ks : 0][n] : Bsh[ks < NRES ? 0 : ks - NRES][n]);
                const bf16x8 bl = (ks == 0 && n == 0) ? *(const LAS bf16x8*)bx : ((ks == 1 && n == 1) ? *(const LAS bf16x8*)(bx + 1024) : __builtin_bit_cast(bf16x8, ks < NRES ? Bl[ks < NRES ? ks : 0][n] : Bsl[ks < NRES ? 0 : ks - NRES][n]));
                f32x16& acc = n == 0 ? acc0 : acc1;
                acc = __builtin_amdgcn_mfma_f32_32x32x16_bf16(arh, bh, acc, 0, 0, 0);
                acc = __builtin_amdgcn_mfma_f32_32x32x16_bf16(arl, bh, acc, 0, 0, 0);
                acc = __builtin_amdgcn_mfma_f32_32x32x16_bf16(arh, bl, acc, 0, 0, 0);
            }
            __builtin_amdgcn_sched_barrier(0);
        }
        N2_BAR();
        LAS float* part = At;
#pragma unroll
        for (int i = 0; i < 16; ++i) {
            const int tok = (i & 3) + 8 * (i >> 2) + 4 * (lane >> 5);
            part[(wave * 32 + tok) * 64 + (lane & 31)] = acc0[i];
            part[(wave * 32 + tok) * 64 + 32 + (lane & 31)] = acc1[i];
        }
        N2_BAR();
        int slot_[4]; float w_[4]; int rk_[4];
#pragma unroll
        for (int j = 0; j < 4; ++j) {
            const int tl = wave * 4 + j, t = t0 + tl, e = lane;
            float lg = 0.f;
#pragma unroll
            for (int w8 = 0; w8 < 8; ++w8) lg += part[(w8 * 32 + tl) * 64 + e];
            const float sc = __builtin_amdgcn_rcpf(1.f + __expf(-lg));
            const float sel = sc + rbe;
            const float m1 = gmax8f(sel);
            const int cand = gmin8i((sel == m1) ? (e & 7) : 8);
            const float m2 = gmax8f(((e & 7) == cand) ? -INFINITY : sel);
            const float grp = m1 + m2;
            const int g = e >> 3;
            int grank = 0;
#pragma unroll
            for (int gg = 0; gg < 8; ++gg) { const float og = __int_as_float(__builtin_amdgcn_readlane(__float_as_int(grp), gg * 8)); grank += (og > grp || (og == grp && gg < g)) ? 1 : 0; }
            const bool gsel = grank < 4;
            const unsigned sb = __float_as_uint(sel);
            unsigned key = gsel ? (sb ^ ((sb >> 31) ? 0xffffffffu : 0x80000000u)) : 0u;
            int rk = 8;
#pragma unroll
            for (int k = 0; k < 8; ++k) {
                const unsigned M = wmaxu(key);
                const unsigned long long bal = __ballot(key == M);
                const int idx = __builtin_ctzll(bal);
                if (e == idx) { rk = k; key = 0u; }
            }
            const bool chosen = rk < 8;
            const float wsum = wsumf(chosen ? sc : 0.f);
            w_[j] = sc / wsum * 2.5f; rk_[j] = rk; slot_[j] = 0;
            if (chosen) slot_[j] = atomicAdd(&cnt[((t / csz) * 64 + e) * CNT_STRIDE], 1);
        }
#pragma unroll
        for (int j = 0; j < 4; ++j) {
            const int t = t0 + wave * 4 + j;
            if (rk_[j] < 8) list[((size_t)(t / csz) * 64 + lane) * CAPC + slot_[j]] = make_uint2((unsigned)(t * 8 + rk_[j]), __float_as_uint(w_[j]));
        }
        N2_BAR();
    }
}
#undef N2_BAR

struct UnitG { int e, t, pn, cnt, pb; };
struct MoeTab {
    const LAS int* cnts; const LAS int* pre;
    const LAS int* xpre; int ntiles, xl, x, nb, j, nseg, st0, xtiles;
    __device__ __forceinline__ void locate(int rtl, int& e, int& t) const {
        int sg = 0; while (xpre[sg + 1] <= rtl) ++sg;
        t = rtl - xpre[sg];
        if (sg < nseg - 1) e = x + xl * sg; else { e = 64; t += st0; }
    }
};
__device__ __forceinline__ MoeTab moe_table(const KP P, const int L_, LAS unsigned char* lds, int ch, int csz) {
    const Ws W(P->ws);
    LAS int* cnts = (LAS int*)(lds + LDS_TAB); LAS int* pre = cnts + 80; LAS int* xpre = pre + 80;
    const int tid = tid_opaque();
    const int G = pgrid<ID_MOE>(), c = pblk<ID_MOE>();
    MoeTab T; T.cnts = cnts; T.pre = pre; T.xpre = xpre;
    if ((G & 7) == 0) { T.xl = 8; T.x = c & 7; T.nb = G >> 3; T.j = c >> 3; } else { T.xl = 1; T.x = 0; T.nb = G; T.j = c; }
    T.nseg = 64 / T.xl + 1;
    if (tid < 64) cnts[tid] = (int)__hip_atomic_load(W.ctl + CW_CNT + ((L_ * NCHUNK + ch) * 64 + tid) * CNT_STRIDE, __ATOMIC_RELAXED, __HIP_MEMORY_SCOPE_AGENT);
    if (tid == 64) cnts[64] = csz;
    __syncthreads();
    const int stiles = (csz + 255) >> 8, sper = (stiles + T.xl - 1) / T.xl;
    T.st0 = T.x * sper;
    if (tid == 0) {
        int s = 0; for (int e = 0; e < 65; ++e) { pre[e] = s; s += (cnts[e] + 255) >> 8; } pre[65] = s;
        int q = 0;
        for (int sg = 0; sg < T.nseg - 1; ++sg) { xpre[sg] = q; q += (cnts[T.x + T.xl * sg] + 255) >> 8; }
        xpre[T.nseg - 1] = q; { int n = stiles - T.st0; n = n < 0 ? 0 : (n > sper ? sper : n); q += n; }
        xpre[T.nseg] = q;
    }
    __syncthreads();
    T.ntiles = pre[65]; T.xtiles = xpre[T.nseg];
    return T;
}
struct ProbMoe1 {
    typedef UnitG Unit; static constexpr int K = 1024;
    int G, c, chunk_base; MoeTab T;
    const uint2* list; const bf16_t* HB; const bf16_t* Wgu; __amdgpu_buffer_rsrc_t act_rs; unsigned* rtcnt;
    __device__ __forceinline__ bool next(int i, Unit& u) const {
        const int L = i * T.nb + T.j; if (L >= 2 * T.xtiles) return false;
        u.pn = L & 1;
        int e, t; T.locate(L >> 1, e, t);
        e = __builtin_amdgcn_readfirstlane(e); t = __builtin_amdgcn_readfirstlane(t);
        u.e = e; u.t = t; u.cnt = __builtin_amdgcn_readfirstlane(T.cnts[e]); u.pb = __builtin_amdgcn_readfirstlane((T.pre[e] + t) * 256); return true;
    }
    __device__ __forceinline__ void a_ready(const Unit&) const {}
    static constexpr bool HAS_DONE = true;
    __device__ __forceinline__ int done_token(const Unit& u) const { return __builtin_amdgcn_readfirstlane(u.pb >> 8); }
    __device__ __forceinline__ void done(int rt) const {
        if ((threadIdx.x & 63) == 0) (void)__hip_atomic_fetch_add(rtcnt + 16 * rt, 1u, __ATOMIC_RELAXED, __HIP_MEMORY_SCOPE_AGENT);
    }
    __device__ __forceinline__ const char* a_base() const { return (const char*)HB; }
    __device__ __forceinline__ void a_offsets(const Unit& u, const int (&R)[2], const int (&C)[2], unsigned (&o)[2][2]) const {
#pragma unroll
        for (int h = 0; h < 2; ++h)
#pragma unroll
            for (int i = 0; i < 2; ++i) {
                const int slot = u.t * 256 + h * 128 + R[i]; int tok = 0;
                if (slot < u.cnt) tok = u.e < 64 ? (int)(list[(size_t)u.e * CAPC + slot].x >> 3) : chunk_base + slot;
                o[h][i] = (unsigned)tok * 2048u + (unsigned)C[i] * 2u;
            }
    }
    __device__ __forceinline__ const char* b_ptr(const Unit& u) const { return (const char*)(Wgu + (size_t)u.e * 524288 + (size_t)u.pn * 256 * K); }
    __device__ __forceinline__ void epilogue(const f32x4 (&acc)[2][2][4][2], const Unit& u, int wr, int wc, int fr, int fq) const {
        float wv[2][4];
#pragma unroll
        for (int ai = 0; ai < 2; ++ai)
#pragma unroll
            for (int m = 0; m < 4; ++m) {
                const int slot = u.t * 256 + ai * 128 + wr * 64 + m * 16 + fr;
                wv[ai][m] = 0.f;
                if (slot < u.cnt) wv[ai][m] = u.e < 64 ? __uint_as_float(list[(size_t)u.e * CAPC + slot].y) : 1.f;
            }
#pragma unroll
        for (int ai = 0; ai < 2; ++ai)
#pragma unroll
            for (int m = 0; m < 4; ++m) {
                const int rl = ai * 128 + wr * 64 + m * 16 + fr;
                const float w = wv[ai][m];
                float a[8];
#pragma unroll
                for (int bj = 0; bj < 2; ++bj) {
                    const f32x4 g = acc[ai][bj][m][0], up = acc[ai][bj][m][1];
#pragma unroll
                    for (int j = 0; j < 4; ++j) a[4 * bj + j] = g[j] * __builtin_amdgcn_rcpf(1.f + __expf(-g[j])) * up[j] * w;
                }
                u32x4 o; o.x = pk_bf16(a[0], a[1]); o.y = pk_bf16(a[2], a[3]); o.z = pk_bf16(a[4], a[5]); o.w = pk_bf16(a[6], a[7]);
                __builtin_amdgcn_raw_buffer_store_b128(o, act_rs, (int)(((unsigned)(u.pb + rl) * 256u + 128u * u.pn + 32u * wc + 8u * fq) * 2u), 0, 16);
            }
    }
};
struct MoeDown {
    int G, c, chunk_base, shift; MoeTab T;
    const uint2* list; const bf16_t* act; const bf16_t* Wd; unsigned char* ws; unsigned junk; unsigned* rtcnt; unsigned* tmo;
};
__device__ __forceinline__ void moe_down_phase(LAS unsigned char* lds, const MoeDown& D) {
    const int tid = tid_opaque(), wave = __builtin_amdgcn_readfirstlane(tid >> 6), lane = tid & 63, fr = lane & 15, fq = lane >> 4;
    const int jblk = (D.T.j - D.shift + D.T.nb) % D.T.nb;
    unsigned goff[4];
#pragma unroll
    for (int i = 0; i < 4; ++i) { const int row = 2 * (4 * wave + i) + (lane >> 5), p = lane & 31; goff[i] = (unsigned)(row * 256 + ((p ^ (row & 15)) * 8)) * 2u; }
    const unsigned ldsw = (unsigned)wave * 4096u;
    for (int rtl = jblk; rtl < D.T.xtiles; rtl += D.T.nb) {
        int e, t_in; D.T.locate(rtl, e, t_in);
        e = __builtin_amdgcn_readfirstlane(e); t_in = __builtin_amdgcn_readfirstlane(t_in);
        const int rt = __builtin_amdgcn_readfirstlane(D.T.pre[e] + t_in), cnt = __builtin_amdgcn_readfirstlane(D.T.cnts[e]), pb = rt * 256;
        if (tid < 64) {
            unsigned* w = D.rtcnt + 16 * rt; unsigned sp = 0u;
            while ((unsigned)__builtin_amdgcn_readfirstlane(__hip_atomic_load(w, __ATOMIC_RELAXED, __HIP_MEMORY_SCOPE_AGENT)) < 16u) {
                __builtin_amdgcn_s_sleep(2);
                if ((++sp & 255u) == 0u) { if (__hip_atomic_load(D.tmo, __ATOMIC_RELAXED, __HIP_MEMORY_SCOPE_AGENT)) break; if (sp > (1u << 20)) { atomicAdd(D.tmo, 1u); break; } }
            }
            __builtin_amdgcn_fence(__ATOMIC_ACQUIRE, "agent");
            asm volatile("s_waitcnt vmcnt(0)" ::: "memory");
        }
        __syncthreads();
        bf16x8 af[2][8];
#pragma unroll
        for (int m = 0; m < 2; ++m)
#pragma unroll
            for (int ks = 0; ks < 8; ++ks) af[m][ks] = *(const bf16x8*)(D.act + (size_t)(pb + 32 * wave + 16 * m + fr) * 256 + 32 * ks + 8 * fq);
        unsigned yo[2];
#pragma unroll
        for (int m = 0; m < 2; ++m) {
            const int slot = t_in * 256 + 32 * wave + 16 * m + fr;
            yo[m] = D.junk;
            if (slot < cnt) {
                if (e < 64) { const unsigned x = D.list[(size_t)e * CAPC + slot].x; yo[m] = (unsigned)WS_Y + (unsigned)(((int)(x >> 3) - D.chunk_base) * 9 + (int)(x & 7u)) * 1024u; }
                else yo[m] = (unsigned)WS_Y + (unsigned)(slot * 9 + 8) * 1024u;
            }
        }
        const char* wb = (const char*)(D.Wd + (size_t)e * 262144);
#define MD_ISSUE(ch) do { _Pragma("unroll") for (int i = 0; i < 4; ++i) \
        __builtin_amdgcn_global_load_lds((const unsigned*)(wb + (size_t)(ch) * 32768 + goff[i]), (LAS unsigned*)(lds + ((ch) & 3) * 32768 + ldsw + i * 1024), 16, 0, 0); } while (0)
        MD_ISSUE(0); MD_ISSUE(1); MD_ISSUE(2);
#pragma unroll 1
        for (int ch = 0; ch < 16; ++ch) {
            if (ch >= 3 && ch < 14) asm volatile("s_waitcnt vmcnt(14)" ::: "memory");
            else if (ch < 3) asm volatile("s_waitcnt vmcnt(8)" ::: "memory");
            else asm volatile("s_waitcnt vmcnt(6)" ::: "memory");
            __builtin_amdgcn_s_barrier();
            asm volatile("" ::: "memory");
            if (ch + 3 < 16) MD_ISSUE(ch + 3);
            f32x4 acc[2][4];
#pragma unroll
            for (int m = 0; m < 2; ++m)
#pragma unroll
                for (int n = 0; n < 4; ++n) acc[m][n] = (f32x4){0.f, 0.f, 0.f, 0.f};
            const LAS unsigned char* bb = lds + (ch & 3) * 32768 + fr * 512;
            bf16x8 bq[3][4];
#pragma unroll
            for (int n = 0; n < 4; ++n) { bq[0][n] = *(const LAS bf16x8*)(bb + n * 8192 + ((fq ^ fr) * 16)); bq[1][n] = *(const LAS bf16x8*)(bb + n * 8192 + (((4 + fq) ^ fr) * 16)); }
#pragma unroll
            for (int ks = 0; ks < 8; ++ks) {
                __builtin_amdgcn_s_waitcnt(0xC07F);
                if (ks + 2 < 8) {
#pragma unroll
                    for (int n = 0; n < 4; ++n) bq[(ks + 2) % 3][n] = *(const LAS bf16x8*)(bb + n * 8192 + (((4 * (ks + 2) + fq) ^ fr) * 16));
                }
                __builtin_amdgcn_sched_barrier(0);
#pragma unroll
                for (int n = 0; n < 4; ++n) {
                    acc[0][n] = __builtin_amdgcn_mfma_f32_16x16x32_bf16(bq[ks % 3][n], af[0][ks], acc[0][n], 0, 0, 0);
                    acc[1][n] = __builtin_amdgcn_mfma_f32_16x16x32_bf16(bq[ks % 3][n], af[1][ks], acc[1][n], 0, 0, 0);
                }
                __builtin_amdgcn_sched_barrier(0);
            }
            asm volatile("s_waitcnt lgkmcnt(0)" ::: "memory");
#pragma unroll
            for (int m = 0; m < 2; ++m) {
                {
                    u32x4 o; int w;
#pragma unroll
                    for (int n = 0; n < 4; ++n) {
                        f32x4 v = acc[m][n] * Y_SCALE;
#pragma unroll
                        for (int q = 0; q < 4; ++q) v[q] = __builtin_amdgcn_fmed3f(v[q], -440.f, 440.f);
                        w = __builtin_amdgcn_cvt_pk_fp8_f32(v[0], v[1], 0, false); w = __builtin_amdgcn_cvt_pk_fp8_f32(v[2], v[3], w, true); o[n] = (unsigned)w;
                    }
                    *(u32x4*)(D.ws + yo[m] + 64 * ch + 16 * fq) = o;
                }
            }
        }
        asm volatile("s_waitcnt vmcnt(0)" ::: "memory");
        __syncthreads();
#undef MD_ISSUE
    }
}
__device__ __forceinline__ void phase_moe(const int L_, const int CH_, LAS unsigned char* lds) {
    const KP P = kparams();
    const Ws W(P->ws);
    const int nq = L_ == 0 ? NTOK : NLAT, csz = nq / NCHUNK, ch = CH_;
    unsigned* rtcnt = W.ctl + CW_RT + (size_t)(L_ * NCHUNK + ch) * 1024 * 16;
    if (pblk<ID_MOE>() < 0) return;
    const MoeTab T = moe_table(P, L_, lds, ch, csz);
    {
        ProbMoe1 pr; pr.G = pgrid<ID_MOE>(); pr.c = pblk<ID_MOE>(); pr.chunk_base = ch * csz; pr.T = T;
        pr.list = (const uint2*)(P->ws + WS_LIST2) + (size_t)ch * 64 * CAPC; pr.HB = W.HB; pr.Wgu = W.WB + WB_WGU;
        pr.act_rs = __builtin_amdgcn_make_buffer_rsrc((void*)(P->ws + WS_ACT), 0, (int)ACT_BYTES, 0x00020000); pr.rtcnt = rtcnt;
        g8::gemm_phase(lds, pr);
    }
    {
        MoeDown D; D.G = pgrid<ID_MOE>(); D.c = pblk<ID_MOE>(); D.chunk_base = ch * csz; D.shift = (2 * T.xtiles) % T.nb; D.T = T;
        D.list = (const uint2*)(P->ws + WS_LIST2) + (size_t)ch * 64 * CAPC; D.act = (const bf16_t*)(P->ws + WS_ACT); D.Wd = W.WB + WB_WD;
        D.ws = P->ws; D.junk = (unsigned)WS_JUNK + (unsigned)pblk<ID_MOE>() * 1024u; D.rtcnt = rtcnt; D.tmo = W.ctl + 128;
        moe_down_phase(lds, D);
    }
}
__device__ __forceinline__ void phase_comb(const int L_, const int CH_, LAS unsigned char* lds) {
    const KP P = kparams();
    const Ws W(P->ws);
    const int nq = L_ == 0 ? NTOK : NLAT, csz = nq / NCHUNK, ch = CH_, base = ch * csz;
    const int tid = tid_opaque(), wave = tid >> 6, lane = tid & 63;
    const float* mod_l = W.mod + (size_t)L_ * 17 * MODW;
    const float* mod_n = W.mod + (size_t)17 * MODW;
    const float* gn1 = P->in[6] + DM;
    const float* fg = P->in[25];
    const unsigned char* Y = (const unsigned char*)(P->ws + WS_Y);
    const int col = lane * 16;
    if (pblk<ID_COMB>() < 0) return;
    for (int tl = pblk<ID_COMB>() * 8 + wave; tl < csz; tl += pgrid<ID_COMB>() * 8) {
        const int t = base + tl, r = mod_row(t);
        const float* g2 = mod_l + r * MODW + 5 * DM + col;
        bf16_t* xr = W.XS + (size_t)t * DM + col;
        float s[16];
#pragma unroll
        for (int i = 0; i < 16; ++i) s[i] = 0.f;
#pragma unroll
        for (int k = 0; k < 9; ++k) {
            const u32x4 v = *(const u32x4*)(Y + ((size_t)tl * 9 + k) * 1024 + col);
            const unsigned wv[4] = {v.x, v.y, v.z, v.w};
#pragma unroll
            for (int q = 0; q < 4; ++q) {
                const f32x2 lo = __builtin_amdgcn_cvt_pk_f32_fp8((int)wv[q], false), hi = __builtin_amdgcn_cvt_pk_f32_fp8((int)wv[q], true);
                s[4 * q] += lo[0]; s[4 * q + 1] += lo[1]; s[4 * q + 2] += hi[0]; s[4 * q + 3] += hi[1];
            }
        }
        f32x4 xn[4]; float ss = 0.f;
        const u32x4 xw0 = *(const u32x4*)xr, xw1 = *(const u32x4*)(xr + 8);
        const unsigned xw[8] = {xw0.x, xw0.y, xw0.z, xw0.w, xw1.x, xw1.y, xw1.z, xw1.w};
        u32x4 xo[2];
#pragma unroll
        for (int q = 0; q < 4; ++q) {
            const f32x4 x = {__uint_as_float(xw[2 * q] << 16), __uint_as_float(xw[2 * q] & 0xffff0000u), __uint_as_float(xw[2 * q + 1] << 16), __uint_as_float(xw[2 * q + 1] & 0xffff0000u)};
            const f32x4 g = *(const f32x4*)(g2 + 4 * q);
            const f32x4 sv = {s[4 * q], s[4 * q + 1], s[4 * q + 2], s[4 * q + 3]};
            xn[q] = x + g * sv * (1.f / Y_SCALE);
            ss += xn[q][0] * xn[q][0] + xn[q][1] * xn[q][1] + xn[q][2] * xn[q][2] + xn[q][3] * xn[q][3];
            xo[q >> 1][2 * (q & 1)] = pk_bf16(xn[q][0], xn[q][1]); xo[q >> 1][2 * (q & 1) + 1] = pk_bf16(xn[q][2], xn[q][3]);
        }
        if (L_ == 0) { *(u32x4*)xr = xo[0]; *(u32x4*)(xr + 8) = xo[1]; }
        ss = wave_sum(ss);
        const float rstd = rsqrtf(ss * (1.f / DM) + 1e-6f);
        if (L_ == 0) {
            const float* sh = mod_n + r * MODW + col; const float* sc = mod_n + r * MODW + DM + col;
            u32x4 o[2];
#pragma unroll
            for (int q = 0; q < 4; ++q) {
                const f32x4 g4 = *(const f32x4*)(gn1 + col + 4 * q), s4 = *(const f32x4*)(sc + 4 * q), h4 = *(const f32x4*)(sh + 4 * q);
                const f32x4 ov = xn[q] * rstd * g4 * (s4 + 1.f) + h4;
                o[q >> 1][2 * (q & 1)] = pk_bf16(ov[0], ov[1]); o[q >> 1][2 * (q & 1) + 1] = pk_bf16(ov[2], ov[3]);
            }
            *(u32x4*)(W.HB + (size_t)t * DM + col) = o[0]; *(u32x4*)(W.HB + (size_t)t * DM + col + 8) = o[1];
        } else {
#pragma unroll
            for (int q = 0; q < 4; ++q) {
                const f32x4 g4 = *(const f32x4*)(fg + col + 4 * q);
                *(f32x4*)(P->out + (size_t)t * DM + col + 4 * q) = xn[q] * rstd * g4;
            }
        }
    }
}

__device__ __forceinline__ void phase_norm1(const int L_, const int CH_, LAS unsigned char* lds) {
    const KP P = kparams();
    const Ws W(P->ws);
    const int l = L_, tid = tid_opaque(), wave = tid >> 6, lane = tid & 63;
    const float* mod_l = W.mod + (size_t)l * 17 * MODW;
    const float* gn = P->in[6] + l * DM;
    if (pblk<ID_NORM1>() < 0) return;
    for (int t = pblk<ID_NORM1>() * 8 + wave; t < NTOK; t += pgrid<ID_NORM1>() * 8) {
        const int r = mod_row(t);
        const float* xr = t < NLAT ? P->in[0] + (size_t)t * DM : P->in[2] + (size_t)(t - NLAT) * DM;
        const float* sh = mod_l + r * MODW; const float* sc = mod_l + r * MODW + DM;
        f32x4 v[4]; float ss = 0.f;
#pragma unroll
        for (int q = 0; q < 4; ++q) { v[q] = *(const f32x4*)(xr + 256 * q + lane * 4); ss += v[q][0] * v[q][0] + v[q][1] * v[q][1] + v[q][2] * v[q][2] + v[q][3] * v[q][3]; }
        ss = wave_sum(ss);
        const float rstd = rsqrtf(ss * (1.f / DM) + 1e-6f);
#pragma unroll
        for (int q = 0; q < 4; ++q) {
            const int col = 256 * q + lane * 4;
            const f32x4 g4 = *(const f32x4*)(gn + col), s4 = *(const f32x4*)(sc + col), h4 = *(const f32x4*)(sh + col);
            const f32x4 o = v[q] * rstd * g4 * (s4 + 1.f) + h4;
            u32x2 w; w.x = pk_bf16(o[0], o[1]); w.y = pk_bf16(o[2], o[3]);
            *(u32x2*)(W.HB + (size_t)t * DM + col) = w;
        }
    }
}

typedef short v4i16_t __attribute__((ext_vector_type(4)));
__device__ __forceinline__ bf16x8 pack8(float a0, float a1, float a2, float a3, float a4, float a5, float a6, float a7) {
    u32x4 w; w.x = pk_bf16(a0, a1); w.y = pk_bf16(a2, a3); w.z = pk_bf16(a4, a5); w.w = pk_bf16(a6, a7); return __builtin_bit_cast(bf16x8, w);
}
__device__ __forceinline__ float max3f_w(float a, float b, float c) { float r; asm volatile("s_nop 7\n\ts_nop 7\n\ts_nop 3\n\tv_max3_f32 %0, %1, %2, %3" : "=v"(r) : "v"(a), "v"(b), "v"(c)); return r; }
__device__ __forceinline__ float max3f(float a, float b, float c) { float r; asm volatile("v_max3_f32 %0, %1, %2, %3" : "=v"(r) : "v"(a), "v"(b), "v"(c)); return r; }
__device__ __forceinline__ float max32(const f32x16& a, const f32x16& b) {
    float m0 = max3f_w(a[0], a[1], a[2]);
    float m1 = max3f_w(b[0], b[1], b[2]);
    m0 = max3f(m0, a[3], a[4]); m1 = max3f(m1, b[3], b[4]); m0 = max3f(m0, a[5], a[6]); m1 = max3f(m1, b[5], b[6]);
    m0 = max3f(m0, a[7], a[8]); m1 = max3f(m1, b[7], b[8]); m0 = max3f(m0, a[9], a[10]); m1 = max3f(m1, b[9], b[10]);
    m0 = max3f(m0, a[11], a[12]); m1 = max3f(m1, b[11], b[12]); m0 = max3f(m0, a[13], a[14]); m1 = max3f(m1, b[13], b[14]);
    return max3f(m0, m1, fmaxf(a[15], b[15]));
}
typedef unsigned u32v2 __attribute__((ext_vector_type(2)));
__device__ __forceinline__ float xhalf_max(float v) {
    const u32v2 r = __builtin_amdgcn_permlane32_swap(__float_as_uint(v), __float_as_uint(v), false, false);
    return fmaxf(__uint_as_float(r[0]), __uint_as_float(r[1]));
}
__device__ __forceinline__ bf16x8 scale8(bf16x8 v, float c) {
    u32x4 w = __builtin_bit_cast(u32x4, v);
#pragma unroll
    for (int i = 0; i < 4; ++i) w[i] = pk_bf16(__uint_as_float(w[i] << 16) * c, __uint_as_float(w[i] & 0xffff0000u) * c);
    return __builtin_bit_cast(bf16x8, w);
}
constexpr int AT_KBUF = 64 * 208, AT_STAGE = AT_KBUF + 8192, AT_BT = 3 * AT_STAGE;
template <int MODE>
__device__ __forceinline__ void attn_unit(const KP P, const int L_, const Ws& W, LAS unsigned char* lds, const int b, const int h, const int qb, const bool ctxq) {
    constexpr int NST = MODE == 2 ? 6 : (MODE == 1 ? 2 : 4);
    constexpr int NMAP = MODE == 1 ? 2 : 1;
    constexpr int KSTR = MODE == 2 ? 208 : 144;
    constexpr float CS = MODE == 2 ? 0.14724444602590306f : (MODE == 1 ? 0.25503486164919736f : 0.18033688011112042f);
    constexpr float NEG = -1e30f;
    const int tid = tid_opaque(), wave = __builtin_amdgcn_readfirstlane(tid >> 6), lane = tid & 63, r32 = lane & 31, hh = lane >> 5;
    const int l = L_;
    const int t0 = ctxq ? NLAT + b * CTX : b * SEQ + qb * 256;
    const int tq = t0 + wave * 32 + r32;
    bf16x8 qf[NMAP][NST];
    {
        const bf16_t* src = MODE == 2 ? W.QM + (size_t)tq * 768 + h * 96 : W.PB + (size_t)tq * PBS + (MODE == 1 ? O_DQ : O_NAQ) + h * 64;
#pragma unroll
        for (int mp = 0; mp < NMAP; ++mp)
#pragma unroll
            for (int st = 0; st < NST; ++st) qf[mp][st] = scale8(*(const bf16x8*)(src + 32 * mp + 16 * st + 8 * hh), CS);
    }
    int ntiles = 36, nwin = 0, krs = 0;
    if (ctxq) ntiles = 4;
    else if (MODE == 0) { krs = min(max(4 * qb - 4, 0), 24); nwin = min(max(4 * qb - 1, 0), 24) + 8 - krs; ntiles = nwin + 4; }
    LAS float* btab = (LAS float*)(lds + AT_BT);
    if (MODE == 0 && !ctxq) { const float* rbp = P->in[9] + ((size_t)l * 4 + h) * 465; for (int i = tid; i < 465; i += NTHREADS) btab[i] = 1.4426950408889634f * rbp[i]; }
    const int kkey = tid >> 3, kch = tid & 7;
    const unsigned kw_off = (unsigned)(kkey * KSTR + kch * 16);
    const unsigned rw_off = (unsigned)((tid >> 2) * KSTR + 128 + (tid & 3) * 16);
    const unsigned vw_off = (unsigned)(AT_KBUF + ((kkey >> 2) * 2 + (kch >> 2)) * 256 + (kkey & 3) * 64 + (kch & 3) * 16);
    u32x4 kregA, vregA, rregA = {0u, 0u, 0u, 0u}, kregB, vregB, rregB = {0u, 0u, 0u, 0u};
#define AT_ROW0(i) (ctxq ? NLAT + b * CTX + 64 * (i) : (MODE == 0 ? ((i) < nwin ? b * SEQ + 64 * (krs + (i)) : NLAT + b * CTX + 64 * ((i) - nwin)) : ((i) < 32 ? b * SEQ + 64 * (i) : NLAT + b * CTX + 64 * ((i) - 32))))
#define AT_LOAD(i, X) do { const int row0_ = AT_ROW0(i); \
        if (MODE == 2) { const bf16_t* kp_ = W.KVM + (size_t)(row0_ + kkey) * 1024 + h * 128 + 8 * kch; kreg##X = *(const u32x4*)kp_; vreg##X = *(const u32x4*)(kp_ + 64); \
                         if (tid < 256) rreg##X = *(const u32x4*)(W.PB + (size_t)(row0_ + (tid >> 2)) * PBS + O_KR + 8 * (tid & 3)); } \
        else { const bf16_t* kp_ = W.PB + (size_t)(row0_ + kkey) * PBS + h * 64 + 8 * kch; kreg##X = *(const u32x4*)(kp_ + (MODE == 1 ? O_DK : O_NAK)); vreg##X = *(const u32x4*)(kp_ + (MODE == 1 ? O_DV : O_NAV)); } } while (0)
#define AT_WRITE(buf, X) do { LAS unsigned char* sb_ = lds + (buf) * AT_STAGE; *(LAS u32x4*)(sb_ + kw_off) = kreg##X; *(LAS u32x4*)(sb_ + vw_off) = vreg##X; \
        if (MODE == 2 && tid < 256) *(LAS u32x4*)(sb_ + rw_off) = rreg##X; } while (0)
    constexpr float THR = 8.f;
    f32x16 O[NMAP][2], NM[NMAP]; float lrun[NMAP]; int started = 0;
    float one_a = 1.f, one_b = 1.f; asm volatile("" : "+v"(one_a)); asm volatile("" : "+v"(one_b));
#pragma unroll
    for (int mp = 0; mp < NMAP; ++mp) { lrun[mp] = 0.f;
#pragma unroll
        for (int i = 0; i < 16; ++i) NM[mp][i] = 0.f;
#pragma unroll
        for (int d = 0; d < 2; ++d)
#pragma unroll
            for (int i = 0; i < 16; ++i) O[mp][d][i] = 0.f; }
    const unsigned kr_off = (unsigned)(r32 * KSTR + hh * 16);
    const unsigned vr_off = (unsigned)(AT_KBUF + hh * 512 + ((lane & 15) >> 2) * 64 + (((lane >> 4) & 1) * 16 + (lane & 3) * 4) * 2);
#define AT_BAR() do { asm volatile("s_waitcnt lgkmcnt(0)" ::: "memory"); __builtin_amdgcn_s_barrier(); asm volatile("" ::: "memory"); } while (0)
    constexpr bool DEEP = (MODE != 1);
#define AT_QK(mp, Sa, Sb, sbp) do { \
        if (MODE == 1) {     \
            bf16x8 kq_[NST][2]; \
            _Pragma("unroll") for (int st = 0; st < NST; ++st) { \
                kq_[st][0] = *(const LAS bf16x8*)((sbp) + kr_off + (4 * (mp) + 2 * st) * 16); \
                kq_[st][1] = *(const LAS bf16x8*)((sbp) + kr_off + 32 * KSTR + (4 * (mp) + 2 * st) * 16); } \
            _Pragma("unroll") for (int st = 0; st < NST; ++st) { \
                Sa = __builtin_amdgcn_mfma_f32_32x32x16_bf16(kq_[st][0], qf[mp][st], st == 0 ? NM[mp] : Sa, 0, 0, 0); \
                Sb = __builtin_amdgcn_mfma_f32_32x32x16_bf16(kq_[st][1], qf[mp][st], st == 0 ? NM[mp] : Sb, 0, 0, 0); } \
        } else \
        _Pragma("unroll") for (int st = 0; st < NST; ++st) { \
            const bf16x8 k0_ = *(const LAS bf16x8*)((sbp) + kr_off + ((MODE == 1 ? 4 * (mp) : 0) + 2 * st) * 16); \
            const bf16x8 k1_ = *(const LAS bf16x8*)((sbp) + kr_off + 32 * KSTR + ((MODE == 1 ? 4 * (mp) : 0) + 2 * st) * 16); \
            Sa = __builtin_amdgcn_mfma_f32_32x32x16_bf16(k0_, qf[mp][st], st == 0 ? NM[mp] : Sa, 0, 0, 0); \
            Sb = __builtin_amdgcn_mfma_f32_32x32x16_bf16(k1_, qf[mp][st], st == 0 ? NM[mp] : Sb, 0, 0, 0); \
            if (MODE == 2 && (st & 1)) __builtin_amdgcn_sched_barrier(0); } } while (0)
#define AT_SMPV(mp, Sa, Sb, Xa, Xb, sbp, wt, krv, rqv) do { \
          \
        v4i16_t vq_[MODE != 2 ? 8 : 1][2]; \
        if (MODE != 2) { _Pragma("unroll") for (int d = 0; d < 2; ++d) _Pragma("unroll") for (int s4 = 0; s4 < 4; ++s4) { \
            const LAS unsigned char* vp_ = (sbp) + vr_off + (8 * s4 + d) * 256; \
            vq_[MODE != 2 ? 4 * d + s4 : 0][0] = __builtin_amdgcn_ds_read_tr16_b64_v4i16((LAS v4i16_t*)vp_); \
            vq_[MODE != 2 ? 4 * d + s4 : 0][1] = __builtin_amdgcn_ds_read_tr16_b64_v4i16((LAS v4i16_t*)(vp_ + 1024)); } } \
        if (wt) { const int cq_ = 32 * (wave & 1) + r32, cs_ = min(max(cq_ - 8, 0), 48); const LAS float* bt_ = btab + ((krv) - (rqv) + 7) * 31 + 15 - cq_; \
            _Pragma("unroll") for (int q = 0; q < 16; ++q) { const int kc0_ = (q & 3) + 8 * (q >> 2) + 4 * hh, kc1_ = kc0_ + 32; \
                Sa[q] = ((unsigned)(kc0_ - cs_) < 16u) ? Sa[q] + bt_[kc0_] : NEG; Sb[q] = ((unsigned)(kc1_ - cs_) < 16u) ? Sb[q] + bt_[kc1_] : NEG; } } \
        float mx_ = max32(Sa, Sb); mx_ = xhalf_max(mx_); \
        if (!started || __any(mx_ > THR)) { \
            const float d_ = started ? fmaxf(mx_, 0.f) : mx_, f_ = __builtin_amdgcn_exp2f(-d_); \
            lrun[mp] *= f_; \
            _Pragma("unroll") for (int d = 0; d < 2; ++d) _Pragma("unroll") for (int q = 0; q < 16; ++q) O[mp][d][q] *= f_; \
              \
            _Pragma("unroll") for (int q = 0; q < 16; ++q) { Sa[q] -= d_; Sb[q] -= d_; Xa[q] -= d_; Xb[q] -= d_; } \
            __builtin_amdgcn_sched_barrier(0); \
            asm volatile("s_nop 7\n\ts_nop 7" :: "v"(Xa[15]), "v"(Xb[15])); \
            __builtin_amdgcn_sched_barrier(0); \
            _Pragma("unroll") for (int q = 0; q < 16; ++q) NM[mp][q] -= d_; } \
          \
        float la_ = 0.f, lb_ = 0.f; \
        _Pragma("unroll") for (int q = 0; q < 16; ++q) { Sa[q] = __builtin_amdgcn_exp2f(Sa[q]); Sb[q] = __builtin_amdgcn_exp2f(Sb[q]); la_ = __builtin_fmaf(Sa[q], one_a, la_); lb_ = __builtin_fmaf(Sb[q], one_b, lb_); } \
        lrun[mp] += la_ + lb_; \
        bf16x8 pf_[4]; \
        pf_[0] = pack8(Sa[0], Sa[1], Sa[2], Sa[3], Sa[4], Sa[5], Sa[6], Sa[7]); pf_[1] = pack8(Sa[8], Sa[9], Sa[10], Sa[11], Sa[12], Sa[13], Sa[14], Sa[15]); \
        pf_[2] = pack8(Sb[0], Sb[1], Sb[2], Sb[3], Sb[4], Sb[5], Sb[6], Sb[7]); pf_[3] = pack8(Sb[8], Sb[9], Sb[10], Sb[11], Sb[12], Sb[13], Sb[14], Sb[15]); \
        _Pragma("unroll") for (int d = 0; d < 2; ++d) _Pragma("unroll") for (int s4 = 0; s4 < 4; ++s4) { \
            const LAS unsigned char* vp_ = (sbp) + vr_off + (8 * s4 + d) * 256; \
            const v4i16_t va_ = MODE != 2 ? vq_[MODE != 2 ? 4 * d + s4 : 0][0] : __builtin_amdgcn_ds_read_tr16_b64_v4i16((LAS v4i16_t*)vp_); \
            const v4i16_t vb_ = MODE != 2 ? vq_[MODE != 2 ? 4 * d + s4 : 0][1] : __builtin_amdgcn_ds_read_tr16_b64_v4i16((LAS v4i16_t*)(vp_ + 1024)); \
            bf16x8 vf_; vf_[0] = va_[0]; vf_[1] = va_[1]; vf_[2] = va_[2]; vf_[3] = va_[3]; vf_[4] = vb_[0]; vf_[5] = vb_[1]; vf_[6] = vb_[2]; vf_[7] = vb_[3]; \
            O[mp][d] = __builtin_amdgcn_mfma_f32_32x32x16_bf16(vf_, pf_[s4], O[mp][d], 0, 0, 0); \
            if (NMAP == 2 && (s4 & 1)) __builtin_amdgcn_sched_barrier(0); } } while (0)
#define AT_ACTIVE(i, wt, act, krv, rqv) const bool wt = (MODE == 0) && !ctxq && (i) < nwin; bool act = true; int krv = 0, rqv = 0; \
        if (wt) { krv = krs + (i); rqv = 4 * qb + (wave >> 1); const int rsq_ = min(max(rqv - 4, 0), 24); act = krv >= rsq_ && krv < rsq_ + 8; }
    if (DEEP) {
        f32x16 SA0, SA1, SB0, SB1;
        AT_LOAD(0, A); AT_WRITE(0, A);
        if (ntiles > 1) { AT_LOAD(1, B); AT_WRITE(1, B); }
        if (ntiles > 2) AT_LOAD(2, A);
        if (ntiles > 3) AT_LOAD(3, B);
        AT_BAR();
        { AT_ACTIVE(0, wt0, act0, kr0, rq0); if (act0) AT_QK(0, SA0, SA1, lds); (void)wt0; (void)kr0; (void)rq0; }
        int s0 = 0;
#pragma unroll 1
        for (int i0 = 0; i0 < ntiles; i0 += 2) {
            const int s1 = s0 == 2 ? 0 : s0 + 1, s2 = s1 == 2 ? 0 : s1 + 1;
            {
                const int i = i0;
                if (i + 2 < ntiles) AT_WRITE(s2, A);
                if (i + 4 < ntiles) AT_LOAD(i + 4, A);
                if (i + 1 < ntiles) { AT_ACTIVE(i + 1, wtn, actn, krn, rqn); if (actn) AT_QK(0, SB0, SB1, lds + s1 * AT_STAGE); (void)wtn; (void)krn; (void)rqn; }
                __builtin_amdgcn_sched_barrier(0);
                AT_ACTIVE(i, wt, act, kr, rq);
                if (act) { AT_SMPV(0, SA0, SA1, SB0, SB1, lds + s0 * AT_STAGE, wt, kr, rq); started = 1; }
                AT_BAR();
            }
            if (i0 + 1 < ntiles) {
                const int i = i0 + 1;
                if (i + 2 < ntiles) AT_WRITE(s0, B);
                if (i + 4 < ntiles) AT_LOAD(i + 4, B);
                if (i + 1 < ntiles) { AT_ACTIVE(i + 1, wtn, actn, krn, rqn); if (actn) AT_QK(0, SA0, SA1, lds + s2 * AT_STAGE); (void)wtn; (void)krn; (void)rqn; }
                __builtin_amdgcn_sched_barrier(0);
                AT_ACTIVE(i, wt, act, kr, rq);
                if (act) { AT_SMPV(0, SB0, SB1, SA0, SA1, lds + s1 * AT_STAGE, wt, kr, rq); started = 1; }
                AT_BAR();
            }
            s0 = s2;
        }
    } else {
        AT_LOAD(0, A); AT_WRITE(0, A); if (ntiles > 1) AT_LOAD(1, A);
        AT_BAR();
#pragma unroll 1
        for (int i = 0; i < ntiles; ++i) {
            if (i + 1 < ntiles) AT_WRITE((i + 1) & 1, A);
            if (i + 2 < ntiles) AT_LOAD(i + 2, A);
            const LAS unsigned char* sb = lds + (i & 1) * AT_STAGE;
#pragma unroll
            for (int mp = 0; mp < NMAP; ++mp) {
                f32x16 S0, S1, X0, X1;
#pragma unroll
                for (int q = 0; q < 16; ++q) { X0[q] = 0.f; X1[q] = 0.f; }
                AT_QK(mp, S0, S1, sb);
                AT_SMPV(mp, S0, S1, X0, X1, sb, false, 0, 0);
                if (NMAP == 2) __builtin_amdgcn_sched_barrier(0);
            }
            started = 1;
            AT_BAR();
        }
    }
#undef AT_QK
#undef AT_SMPV
#undef AT_ACTIVE
#undef AT_BAR
    float inv[NMAP];
#pragma unroll
    for (int mp = 0; mp < NMAP; ++mp) { const float lt = lrun[mp] + __shfl_xor(lrun[mp], 32); inv[mp] = 1.f / lt; }
    bf16_t* orow = W.HB + (size_t)tq * DM + (MODE == 0 ? 0 : (MODE == 1 ? 256 : 512)) + h * 64 + 4 * hh;
    if (MODE == 1) {
        const float lam = W.lam[l], li = 0.8f - 0.6f * expf(-0.3f * (float)l);
        const float* sg = P->in[11] + l * 64;
        const float c2 = lam * inv[1];
        float ss = 0.f;
#pragma unroll
        for (int d = 0; d < 2; ++d)
#pragma unroll
            for (int q = 0; q < 16; ++q) { const float o = O[0][d][q] * inv[0] - c2 * O[NMAP - 1][d][q]; O[0][d][q] = o; ss += o * o; }
        ss += __shfl_xor(ss, 32);
        const float rs = rsqrtf(ss * (1.f / 64.f) + 1e-6f) * (1.f - li);
#pragma unroll
        for (int d = 0; d < 2; ++d)
#pragma unroll
            for (int g4 = 0; g4 < 4; ++g4) {
                const int dv = 32 * d + 8 * g4 + 4 * hh;
                const f32x4 gg = *(const f32x4*)(sg + dv);
                u32x2 w; w.x = pk_bf16(O[0][d][4 * g4] * rs * gg[0], O[0][d][4 * g4 + 1] * rs * gg[1]); w.y = pk_bf16(O[0][d][4 * g4 + 2] * rs * gg[2], O[0][d][4 * g4 + 3] * rs * gg[3]);
                *(u32x2*)(orow + 32 * d + 8 * g4) = w;
            }
    } else {
#pragma unroll
        for (int d = 0; d < 2; ++d)
#pragma unroll
            for (int g4 = 0; g4 < 4; ++g4) {
                u32x2 w; w.x = pk_bf16(O[0][d][4 * g4] * inv[0], O[0][d][4 * g4 + 1] * inv[0]); w.y = pk_bf16(O[0][d][4 * g4 + 2] * inv[0], O[0][d][4 * g4 + 3] * inv[0]);
                *(u32x2*)(orow + 32 * d + 8 * g4) = w;
            }
    }
#undef AT_ROW0
#undef AT_LOAD
#undef AT_WRITE
}
__device__ __forceinline__ void phase_attn(const int L_, const int CH_, LAS unsigned char* lds) {
    const KP P = kparams();
    const Ws W(P->ws);
    const int G = pgrid<ID_ATTN>(), c = pblk<ID_ATTN>();
    if (c < 0) return;
    const int gwave = c * 8 + __builtin_amdgcn_readfirstlane(tid_opaque() >> 6), nwaves = G * 8;
    int ck = 0;
#define AT_CONV() do { const int tid0_ = tid_opaque(), cwave_ = __builtin_amdgcn_readfirstlane(tid0_ >> 6); \
        conv_expert_items(P, W, L_, ck, gwave, nwaves, (LAS float*)(lds + 73728 + cwave_ * 8704)  , tid0_ & 63); ck += 2; } while (0)
    for (int u = c; u < 1024; u += G) { const int x = u & 7, j = u >> 3, qb = j & 7, bh = (j >> 3) * 8 + x; attn_unit<2>(P, L_, W, lds, bh >> 3, bh & 7, qb, false); AT_CONV(); }
    for (int u = c; u < 512; u += G) { const int x = u & 7, j = u >> 3, qb = j & 7, bh = (j >> 3) * 8 + x; attn_unit<1>(P, L_, W, lds, bh >> 2, bh & 3, qb, false); AT_CONV(); }
    for (int u = c; u < 512; u += G) { const int x = u & 7, j = u >> 3, qb = j & 7, bh = (j >> 3) * 8 + x; attn_unit<0>(P, L_, W, lds, bh >> 2, bh & 3, qb, false); AT_CONV(); }
    if (L_ == 0) {
        for (int u = c; u < 256; u += G) {
            if (u < 128) attn_unit<2>(P, L_, W, lds, u >> 3, u & 7, 0, true);
            else if (u < 192) attn_unit<1>(P, L_, W, lds, (u - 128) >> 2, (u - 128) & 3, 0, true);
            else attn_unit<0>(P, L_, W, lds, (u - 192) >> 2, (u - 192) & 3, 0, true);
        }
    }
    while (gwave + ck * nwaves < CV_E) AT_CONV();
#undef AT_CONV
}

#define XB_TMO      128
#define XB_XCNT(j)  (256  + 64 * (j))
#define XB_XSUB(j)  (1280 + 64 * (j))
#define XB_XGEN(j)  (2304 + 64 * (j))
#define XB_TOP      3328
#define XB_TOPGEN   3392
#define XCD_BAR_WORDS 3456
#define XB_SPIN_CAP (1u << 18)

__device__ __forceinline__ unsigned xb_ld(unsigned* p)              { return __hip_atomic_load(p, __ATOMIC_RELAXED, __HIP_MEMORY_SCOPE_AGENT); }
__device__ __forceinline__ unsigned xb_add(unsigned* p, unsigned v) { return __hip_atomic_fetch_add(p, v, __ATOMIC_RELAXED, __HIP_MEMORY_SCOPE_AGENT); }
__device__ __forceinline__ unsigned xb_xcc_id() { return (unsigned)__builtin_amdgcn_s_getreg((3 << 11) | 20) & 0xFu; }
#define XB_SPIN(cond, bar) do { unsigned _sp = 0; while (cond) { __builtin_amdgcn_s_sleep(1); \
    if ((++_sp & 255u) == 0u) { if (xb_ld(&(bar)[XB_TMO])) break; if (_sp > XB_SPIN_CAP) { atomicAdd(&(bar)[XB_TMO], 1u); break; } } } } while (0)

struct XcdBarrier {
    unsigned* bar; unsigned x;
    volatile LAS unsigned* st;
};

__device__ __forceinline__ XcdBarrier xcd_barrier_post(unsigned* bar, volatile LAS unsigned* st) {
    XcdBarrier b; b.bar = bar; b.x = xb_xcc_id(); b.st = st;
    if (threadIdx.x == 0) (void)xb_add(&bar[XB_XCNT(b.x)], 1u);
    return b;
}
__device__ __forceinline__ void xcd_barrier_complete(unsigned* bar, unsigned x, unsigned& nloc, unsigned& nx) {
    const unsigned G = gridDim.x * gridDim.y * gridDim.z;
    unsigned sum, cnt, mine, sp = 0u;
    for (;;) {
        sum = 0u; cnt = 0u; mine = 0u;
#pragma unroll
        for (unsigned j = 0; j < 16; ++j) { const unsigned c = xb_ld(&bar[XB_XCNT(j)]); sum += c; cnt += (c > 0u) ? 1u : 0u; mine = (j == x) ? c : mine; }
        if (sum == G) break;
        __builtin_amdgcn_s_sleep(1);
        if ((++sp & 255u) == 0u) { if (xb_ld(&bar[XB_TMO])) break; if (sp > XB_SPIN_CAP) { atomicAdd(&bar[XB_TMO], 1u); break; } }
    }
    nloc = mine > 0u ? mine : 1u; nx = cnt > 0u ? cnt : 1u;
}

__device__ __forceinline__ void xcd_barrier(const XcdBarrier& b) {
    asm volatile("s_waitcnt vmcnt(0)" ::: "memory");
    __syncthreads();
    if (threadIdx.x == 0) {
        unsigned* bar = b.bar;
        __builtin_amdgcn_s_waitcnt(0);
        unsigned nloc = b.st[0], nx = b.st[1];
        if (nloc == 0u) { xcd_barrier_complete(bar, b.x, nloc, nx); b.st[0] = nloc; b.st[1] = nx; }
        const unsigned old = xb_add(&bar[XB_XSUB(b.x)], 1u);
        const unsigned gen = old / nloc;
        if (old + 1u == (gen + 1u) * nloc) {
            __builtin_amdgcn_fence(__ATOMIC_RELEASE, "agent");
            asm volatile("s_waitcnt vmcnt(0)" ::: "memory");
            const unsigned og = xb_add(&bar[XB_TOP], 1u);
            const unsigned tg = og / nx;
            if (og + 1u == (tg + 1u) * nx) xb_add(&bar[XB_TOPGEN], 1u);
            else XB_SPIN(xb_ld(&bar[XB_TOPGEN]) == tg, bar);
            __builtin_amdgcn_fence(__ATOMIC_ACQUIRE, "agent");
            xb_add(&bar[XB_XGEN(b.x)], 1u);
            asm volatile("s_waitcnt vmcnt(0)" ::: "memory");
        } else {
            XB_SPIN(xb_ld(&bar[XB_XGEN(b.x)]) == gen, bar);
            __builtin_amdgcn_fence(__ATOMIC_ACQUIRE, "agent");
            asm volatile("s_waitcnt vmcnt(0)" ::: "memory");
        }
    }
    __syncthreads();
}

constexpr int NSTEPS = 2 + 2 * (5 + 2 * NCHUNK);
constexpr int LDS_BARW = LDS_BYTES - 64;
__global__ void __launch_bounds__(NTHREADS, 2) k_fwd(Params P) {
    extern __shared__ __attribute__((aligned(16))) unsigned char dyn_lds[];
    LAS unsigned char* lds = (LAS unsigned char*)dyn_lds;
    volatile LAS unsigned* st = (volatile LAS unsigned*)(lds + LDS_BARW);
    if (threadIdx.x == 0) { st[0] = 0u; st[1] = 0u; st[2] = 0u; st[3] = 0u; }
    __syncthreads();
    const XcdBarrier bar = xcd_barrier_post((unsigned*)(P.ws + WS_CTL), st);
    const int lo = P.ph_lo, hi = P.ph_hi;
    int step = 0;
#ifndef REP_ATTN
#define REP_ATTN 1
#endif
#ifndef REP_MOE1
#define REP_MOE1 1
#endif
#ifndef REP_MOE2
#define REP_MOE2 1
#endif
#ifndef REP_INPROJ
#define REP_INPROJ 1
#endif
#ifndef REP_MLA
#define REP_MLA 1
#endif
#ifndef REP_CONV
#define REP_CONV 1
#endif
#define STEP(body) do { const int s_ = step++; if (s_ >= lo && s_ < hi) { body; if (s_ + 1 < hi && s_ + 1 < NSTEPS) xcd_barrier(bar); } } while (0)
    STEP(for (int rep = 0; rep < REP_CONV; ++rep) { if (rep) xcd_barrier(bar); phase_convert(0, 0, lds); });
    STEP(phase_norm1(0, 0, lds));
#pragma unroll 1
    for (int l = 0; l < 2; ++l) {
        STEP(for (int rep = 0; rep < REP_INPROJ; ++rep) { if (rep) xcd_barrier(bar); phase_inproj(l, 0, lds); });
        STEP(for (int rep = 0; rep < REP_MLA; ++rep) { if (rep) xcd_barrier(bar); phase_mla(l, 0, lds); });
        STEP(for (int rep = 0; rep < REP_ATTN; ++rep) { if (rep) xcd_barrier(bar); phase_attn(l, 0, lds); });
        STEP(phase_outproj(l, 0, lds));
        STEP(phase_norm2(l, 0, lds));
#pragma unroll 1
        for (int ch = 0; ch < NCHUNK; ++ch) {
            STEP(phase_moe(l, ch, lds));
            STEP(phase_comb(l, ch, lds); if (l == 0 && ch == NCHUNK - 1) phase_convert(1, 0, lds));
        }
    }
#undef STEP
}

#ifndef MK_N_LAUNCHES
#define MK_N_LAUNCHES 1
#endif
extern "C" void kernel_launch(void* const* d_in, const int* in_sizes, int n_in, void* d_out, int out_size, void* d_ws, size_t ws_size, hipStream_t stream) {
    static int grid = 0;
    if (grid == 0) {
        if (ws_size < WS_END || n_in != 26 || out_size != NLAT * DM) { fprintf(stderr, "kernel_launch: workspace %zu < %zu or n_in %d != 26 or out %d; nothing launched\n", ws_size, (size_t)WS_END, n_in, out_size); grid = -1; return; }
        int dev = 0, cus = 0, per_cu = 0;
        if (hipGetDevice(&dev) != hipSuccess || hipDeviceGetAttribute(&cus, hipDeviceAttributeMultiprocessorCount, dev) != hipSuccess || cus <= 0) { fprintf(stderr, "kernel_launch: device query failed\n"); grid = -1; return; }
        if (hipFuncSetAttribute((const void*)k_fwd, hipFuncAttributeMaxDynamicSharedMemorySize, LDS_BYTES) != hipSuccess) { fprintf(stderr, "kernel_launch: hipFuncSetAttribute failed\n"); grid = -1; return; }
        if (hipOccupancyMaxActiveBlocksPerMultiprocessor(&per_cu, (const void*)k_fwd, NTHREADS, LDS_BYTES) != hipSuccess || per_cu < 1) { fprintf(stderr, "kernel_launch: occupancy query says %d workgroups per CU\n", per_cu); grid = -1; (void)hipGetLastError(); return; }
        grid = cus;
    }
    if (grid < 0) return;
    Params P{};
    for (int i = 0; i < 26; ++i) P.in[i] = (const float*)d_in[i];
    P.out = (float*)d_out; P.ws = (unsigned char*)d_ws;
    (void)hipMemsetAsync((unsigned char*)d_ws + WS_CTL, 0, CTL_ZERO_BYTES, stream);
    if (MK_N_LAUNCHES == 1) {
        P.ph_lo = 0; P.ph_hi = NSTEPS;
        hipLaunchKernelGGL(k_fwd, dim3(grid), dim3(NTHREADS), LDS_BYTES, stream, P);
#ifdef PROBE_STEP
        (void)hipMemsetAsync((unsigned char*)d_ws + WS_CTL, 0, XCD_BAR_WORDS * 4, stream);
        if (!(PROBE_I2 & 1)) (void)hipMemsetAsync((unsigned char*)d_ws + WS_CTL + (size_t)CW_RT * 4 + (size_t)2 * 1024 * 16 * 4, 0, (size_t)2 * 1024 * 16 * 4, stream);
        P.ph_lo = PROBE_STEP; P.ph_hi = PROBE_STEP + 1; P.i2 = PROBE_I2;
        hipLaunchKernelGGL(k_fwd, dim3(grid), dim3(NTHREADS), LDS_BYTES, stream, P);
#endif
    } else {
        for (int s = 0; s < NSTEPS; ++s) { P.ph_lo = s; P.ph_hi = s + 1; hipLaunchKernelGGL(k_fwd, dim3(grid), dim3(NTHREADS), LDS_BYTES, stream, P); }
    }
}
```
